# Optimizing an MI355X kernel written in HIP

```python
import math
import jax, jax.numpy as jnp
from jax import lax
import numpy as np

D_MODEL = 1024
BATCH = 2
SEQ = 8192
DEPTH = 1

DA_QK_DIM = 64
DA_V_DIM = 2 * DA_QK_DIM
DA_WIDTH = D_MODEL // 2
DA_HEADS = DA_WIDTH // DA_V_DIM
DA_QK_COLS = 2 * DA_HEADS * DA_QK_DIM
ROPE_DIM = DA_QK_DIM // 4
ROPE_THETA = 500000.0
Q_BLOCK = 128
ML_WIDTH = D_MODEL // 2
ML_HEADS = 4
ML_HEAD_DIM = ML_WIDTH // ML_HEADS
ML_CONV = 5
ML_CHUNK = 64
STAB_INIT = -1e30
N_BRANCH = 2
IN_SPLIT_SIZES = (DA_QK_COLS, DA_QK_COLS, DA_WIDTH,
                  ML_WIDTH, ML_WIDTH, ML_WIDTH, ML_WIDTH, 4 * ML_HEADS,
                  N_BRANCH * D_MODEL)
IN_COLS = sum(IN_SPLIT_SIZES)
N_KEYS = 128
N_EXPERTS = N_KEYS * N_KEYS
PEER_HEADS = 8
PEER_QDIM = 256
PEER_TOPK = 16
PEER_TOK_BLOCK = 128
DN_ALPHA = (2 * DEPTH) ** 0.25
DN_BETA = (8 * DEPTH) ** -0.25
LN_EPS = 1e-5

kernel_name = "hybrid_diffattn_mlstm_peer_encoder"


def layer_norm(x, g, b):
    xf = x.astype(jnp.float32)
    mu = xf.mean(-1, keepdims=True)
    var = jnp.square(xf - mu).mean(-1, keepdims=True)
    return ((xf - mu) * lax.rsqrt(var + LN_EPS) * g.astype(jnp.float32)
            + b.astype(jnp.float32)).astype(x.dtype)


def rms_norm(x, g):
    xf = x.astype(jnp.float32)
    y = xf * lax.rsqrt(jnp.mean(xf * xf, -1, keepdims=True) + LN_EPS)
    return (y * g.astype(jnp.float32)).astype(x.dtype)


def head_layer_norm(x, g):
    xf = x.astype(jnp.float32)
    mu = xf.mean(-1, keepdims=True)
    var = jnp.square(xf - mu).mean(-1, keepdims=True)
    y = (xf - mu) * lax.rsqrt(var + LN_EPS)
    return y.reshape(x.shape[:-2] + (-1,)) * g.astype(jnp.float32)


def partial_rope(t, cos, sin):
    half = ROPE_DIM // 2
    c = cos[None, :, None, None, :]
    s = sin[None, :, None, None, :]
    t1 = t[..., :half].astype(jnp.float32)
    t2 = t[..., half:ROPE_DIM].astype(jnp.float32)
    rot = jnp.concatenate([t1 * c - t2 * s, t2 * c + t1 * s], -1).astype(t.dtype)
    return jnp.concatenate([rot, t[..., ROPE_DIM:]], -1)


def diff_attention(q, k, v, lam_params, subln_g, lambda_init):
    B, S, H, _, Dq = q.shape
    lp = lam_params.astype(jnp.float32)
    lam = jnp.exp(jnp.sum(lp[0] * lp[1])) - jnp.exp(jnp.sum(lp[2] * lp[3])) + lambda_init
    nb = S // Q_BLOCK
    qb = (q * (Dq ** -0.5)).reshape(B, nb, Q_BLOCK, H, 2, Dq).transpose(1, 0, 3, 4, 2, 5)
    kh = k.transpose(0, 2, 3, 1, 4)
    vh = v.transpose(0, 2, 1, 3)

    def block(qblk):
        s = jnp.einsum('bhmqd,bhmkd->bhmqk', qblk, kh,
                       preferred_element_type=jnp.float32)
        p = jax.nn.softmax(s, axis=-1)
        a = p[:, :, 0] - lam * p[:, :, 1]
        return jnp.einsum('bhqk,bhkd->bhqd', a.astype(vh.dtype), vh)

    o = lax.map(block, qb)
    o = o.transpose(1, 0, 3, 2, 4).reshape(B, S, H, -1)
    o = rms_norm(o, subln_g) * (1.0 - lambda_init)
    return o.reshape(B, S, -1)


def mlstm_chunkwise(q, k, v, i_pre, log_f):
    B, H, S, D = q.shape
    nc = S // ML_CHUNK
    to_chunks = lambda t: jnp.moveaxis(t.reshape(B, H, nc, ML_CHUNK, *t.shape[3:]), 2, 0)
    qc, kc, vc = to_chunks(q), to_chunks(k), to_chunks(v)
    ic = to_chunks(i_pre)
    bc = jnp.cumsum(to_chunks(log_f), axis=-1)
    causal_in_chunk = jnp.tril(jnp.ones((ML_CHUNK, ML_CHUNK), bool))

    def step(carry, inp):
        C, n, m = carry
        qj, kj, vj, ij, bj = inp
        bL = bj[..., -1]
        dmat = jnp.where(causal_in_chunk, bj[..., :, None] - bj[..., None, :] + ij[..., None, :], -jnp.inf)
        inter = bj + m[..., None]
        m_row = jnp.maximum(inter, dmat.max(-1))
        w_inter = jnp.exp(inter - m_row)
        s = jnp.einsum('bhjd,bhld->bhjl', qj, kj) * jnp.exp(dmat - m_row[..., None])
        num = w_inter[..., None] * jnp.einsum('bhjd,bhde->bhje', qj, C) + jnp.einsum('bhjl,bhle->bhje', s, vj)
        den = w_inter * jnp.einsum('bhjd,bhd->bhj', qj, n) + s.sum(-1)
        h = num / jnp.maximum(jnp.abs(den), jnp.exp(-m_row))[..., None]
        g = bL[..., None] - bj + ij
        m_new = jnp.maximum(bL + m, g.max(-1))
        a = jnp.exp(bL + m - m_new)
        wk = jnp.exp(g - m_new[..., None])
        C = a[..., None, None] * C + jnp.einsum('bhl,bhld,bhle->bhde', wk, kj, vj)
        n = a[..., None] * n + jnp.einsum('bhl,bhld->bhd', wk, kj)
        return (C, n, m_new), h

    init = (jnp.zeros((B, H, D, D), jnp.float32), jnp.zeros((B, H, D), jnp.float32),
            jnp.full((B, H), STAB_INIT, jnp.float32))
    _, hs = lax.scan(step, init, (qc, kc, vc, ic, bc))
    return jnp.moveaxis(hs, 0, 2).reshape(B, H, S, D)


def depthwise_conv_centred(x, w, b):
    pad = (w.shape[0] - 1) // 2
    y = lax.conv_general_dilated(x, w[:, None, :].astype(x.dtype), window_strides=(1,),
                                 padding=[(pad, pad)], dimension_numbers=('NWC', 'WIO', 'NWC'),
                                 feature_group_count=x.shape[-1])
    return y + b


def mlstm_branch(ml_q, ml_k, ml_v, ml_o, ml_g, conv_w, conv_b, gate_b, norm_g):
    B, S, _ = ml_q.shape
    qk = jax.nn.silu(depthwise_conv_centred(jnp.concatenate([ml_q, ml_k], -1), conv_w, conv_b))
    q, k = jnp.split(qk.astype(jnp.float32), 2, axis=-1)
    heads = lambda t: t.reshape(B, S, ML_HEADS, ML_HEAD_DIM).transpose(0, 2, 1, 3)
    q, k, v = heads(q), heads(k) * (ML_HEAD_DIM ** -0.5), heads(ml_v.astype(jnp.float32))
    gates = (ml_g.astype(jnp.float32).reshape(B, S, 4, ML_HEADS)
             + gate_b.astype(jnp.float32)).transpose(2, 0, 3, 1)
    i_fw, f_fw, i_bw, f_bw = gates[0], gates[1], gates[2], gates[3]
    h_fw = mlstm_chunkwise(q, k, v, i_fw, jax.nn.log_sigmoid(f_fw))
    flip = lambda t: jnp.flip(t, axis=2)
    h_bw = flip(mlstm_chunkwise(flip(q), flip(k), flip(v), flip(i_bw), flip(jax.nn.log_sigmoid(f_bw))))
    h = (h_fw + h_bw).transpose(0, 2, 1, 3)
    h = head_layer_norm(h, norm_g) * jax.nn.sigmoid(ml_o.astype(jnp.float32))
    return h.astype(ml_q.dtype)


def peer(x, w_q, sub_keys, u_tab, v_tab):
    B, S, D = x.shape
    T = B * S
    xt = x.reshape(T, D)
    q = (xt @ w_q).reshape(T, PEER_HEADS, 2, PEER_QDIM // 2)
    s = jnp.einsum('thpd,pnd->thpn', q, sub_keys, preferred_element_type=jnp.float32)
    sc, idx = lax.top_k(s, PEER_TOPK)
    cand = (sc[:, :, 0, :, None] + sc[:, :, 1, None, :]).reshape(T, PEER_HEADS, -1)
    cand_idx = (idx[:, :, 0, :, None] * N_KEYS + idx[:, :, 1, None, :]).reshape(T, PEER_HEADS, -1)
    top_sc, top_pos = lax.top_k(cand, PEER_TOPK)
    experts = jnp.take_along_axis(cand_idx, top_pos, axis=-1)
    gates = jax.nn.softmax(top_sc, axis=-1)
    nb = T // PEER_TOK_BLOCK

    def block(args):
        xb, eb, gb = args
        act = jax.nn.gelu(jnp.einsum('ted,td->te', u_tab[eb], xb), approximate=False)
        return jnp.einsum('te,ted->td', gb * act, v_tab[eb])

    y = lax.map(block, (xt.reshape(nb, PEER_TOK_BLOCK, D),
                        experts.reshape(nb, PEER_TOK_BLOCK, -1),
                        gates.reshape(nb, PEER_TOK_BLOCK, -1).astype(x.dtype)))
    return y.reshape(B, S, D)


def setup_inputs(seed: int = 0) -> dict:
    key = jax.random.key(seed)
    ks = jax.random.split(key, 20)
    L, D = DEPTH, D_MODEL
    nrm = lambda k, shape, scale: jax.random.normal(k, shape, jnp.float32) * scale
    fbias = jnp.linspace(3.0, 6.0, ML_HEADS, dtype=jnp.float32)
    zb = jnp.zeros((ML_HEADS,), jnp.float32)
    gate_base = jnp.stack([zb, fbias, zb, fbias])[None]
    return {
        "x": nrm(ks[0], (BATCH, SEQ, D), 1.0),
        "w_in": nrm(ks[1], (L, D, IN_COLS), D ** -0.5),
        "da_lambda": nrm(ks[2], (L, 4, DA_QK_DIM), 0.1),
        "da_subln_g": 1.0 + nrm(ks[3], (L, DA_V_DIM), 0.02),
        "ml_conv_w": nrm(ks[4], (L, ML_CONV, 2 * ML_WIDTH), ML_CONV ** -0.5),
        "ml_conv_b": nrm(ks[5], (L, 2 * ML_WIDTH), 0.02),
        "ml_gate_b": gate_base + nrm(ks[6], (L, 4, ML_HEADS), 0.1),
        "ml_norm_g": 1.0 + nrm(ks[7], (L, ML_WIDTH), 0.02),
        "w_branch_attn": nrm(ks[8], (L, DA_WIDTH, D), DA_WIDTH ** -0.5),
        "w_branch_mlstm": nrm(ks[9], (L, ML_WIDTH, D), ML_WIDTH ** -0.5),
        "w_out": nrm(ks[10], (L, D, D), DN_BETA * D ** -0.5),
        "ln1_g": 1.0 + nrm(ks[11], (L, D), 0.02),
        "ln1_b": nrm(ks[12], (L, D), 0.02),
        "peer_w_q": nrm(ks[13], (L, D, PEER_HEADS * PEER_QDIM), D ** -0.5),
        "peer_sub_keys": nrm(ks[14], (L, 2, N_KEYS, PEER_QDIM // 2), (PEER_QDIM // 2) ** -0.5),
        "peer_u": nrm(ks[15], (L, N_EXPERTS, D), D ** -0.5),
        "peer_v": nrm(ks[16], (L, N_EXPERTS, D), DN_BETA),
        "ln2_g": 1.0 + nrm(ks[17], (L, D), 0.02),
        "ln2_b": nrm(ks[18], (L, D), 0.02),
    }


def reference(x, w_in, da_lambda, da_subln_g, ml_conv_w, ml_conv_b, ml_gate_b, ml_norm_g,
              w_branch_attn, w_branch_mlstm, w_out, ln1_g, ln1_b,
              peer_w_q, peer_sub_keys, peer_u, peer_v, ln2_g, ln2_b):
    B, S, D = x.shape
    split_at = [int(c) for c in np.cumsum(IN_SPLIT_SIZES)[:-1]]
    pos = jnp.arange(S, dtype=jnp.float32)
    inv_freq = ROPE_THETA ** (-jnp.arange(0, ROPE_DIM, 2, dtype=jnp.float32) / ROPE_DIM)
    ang = pos[:, None] * inv_freq[None, :]
    cos, sin = jnp.cos(ang), jnp.sin(ang)
    for l in range(DEPTH):
        lambda_init = 0.8 - 0.6 * math.exp(-0.3 * l)
        proj = x @ w_in[l]
        da_q, da_k, da_v, ml_q, ml_k, ml_v, ml_o, ml_g, br_g = jnp.split(proj, split_at, axis=-1)
        qa = partial_rope(da_q.reshape(B, S, DA_HEADS, 2, DA_QK_DIM), cos, sin)
        ka = partial_rope(da_k.reshape(B, S, DA_HEADS, 2, DA_QK_DIM), cos, sin)
        va = da_v.reshape(B, S, DA_HEADS, DA_V_DIM)
        y_attn = diff_attention(qa, ka, va, da_lambda[l], da_subln_g[l], lambda_init)
        y_mlstm = mlstm_branch(ml_q, ml_k, ml_v, ml_o, ml_g, ml_conv_w[l], ml_conv_b[l],
                               ml_gate_b[l], ml_norm_g[l])
        gates = jax.nn.sigmoid(br_g.reshape(B, S, N_BRANCH, D))
        merged = gates[:, :, 0] * (y_attn @ w_branch_attn[l]) + gates[:, :, 1] * (y_mlstm @ w_branch_mlstm[l])
        x = layer_norm(DN_ALPHA * x + (merged @ w_out[l]).astype(x.dtype), ln1_g[l], ln1_b[l])
        y_peer = peer(x, peer_w_q[l], peer_sub_keys[l], peer_u[l], peer_v[l])
        x = layer_norm(DN_ALPHA * x + y_peer.astype(x.dtype), ln2_g[l], ln2_b[l])
    return x
```

```cpp
#include <hip/hip_runtime.h>
#include <hip/hip_cooperative_groups.h>
#include <cstdio>
#include <stdint.h>
#include <math.h>

namespace cg = cooperative_groups;
typedef unsigned short bf16_t;
typedef short bf16x8 __attribute__((ext_vector_type(8)));
typedef float f32x4 __attribute__((ext_vector_type(4)));
typedef unsigned u32x2 __attribute__((ext_vector_type(2)));
typedef unsigned u32x4 __attribute__((ext_vector_type(4)));

constexpr int T = 16384, SEQ = 8192, DM = 1024;
constexpr float ALPHA = 1.189207115002721f;
constexpr float LN_EPS = 1e-5f;
constexpr float LAMBDA_INIT = 0.2f;
constexpr float QSCALE = 0.125f * 1.4426950408889634f;

constexpr size_t MB = 1u << 20;
constexpr size_t WS_GPRE = 1 * MB;
constexpr size_t WS_CS = 2 * MB;
constexpr size_t WS_WA = 8 * MB;
constexpr size_t WS_WM = 9 * MB;
constexpr size_t WS_WOUT = 10 * MB;
constexpr size_t WS_WQ = 12 * MB;
constexpr size_t WS_G1 = 16 * MB;
constexpr size_t WS_Q = 16 * MB, WS_K = 32 * MB, WS_V = 48 * MB, WS_MQ = 64 * MB, WS_MK = 80 * MB, WS_MV = 96 * MB, WS_MO = 112 * MB;
constexpr size_t WS_BG = 128 * MB;
constexpr size_t WS_QC = 192 * MB, WS_KC = 208 * MB;
constexpr size_t WS_O0 = 224 * MB;
constexpr size_t WS_YA = WS_MQ, WS_YM = WS_MK;
constexpr size_t WS_MG = WS_Q;
constexpr size_t WS_X1B = WS_QC;
constexpr size_t WS_TU = 128 * MB, WS_TV = 160 * MB;
constexpr size_t WS_QP = 16 * MB;
constexpr size_t WS_EXP = 96 * MB, WS_GATE = 104 * MB;
constexpr size_t DO_XB = 0, DO_WINT = 32 * MB;

__device__ __forceinline__ float bf2f(bf16_t v) { return __uint_as_float(((unsigned)v) << 16); }
__device__ __forceinline__ bf16_t f2bf(float f) { unsigned u = __float_as_uint(f); u += 0x7fffu + ((u >> 16) & 1u); return (bf16_t)(u >> 16); }
__device__ __forceinline__ unsigned pk2(float lo, float hi) { return (unsigned)f2bf(lo) | ((unsigned)f2bf(hi) << 16); }
__device__ __forceinline__ float sigmoidf_(float x) { return 1.f / (1.f + __expf(-x)); }
__device__ __forceinline__ float wave_sum(float v) {
#pragma unroll
  for (int o = 1; o < 64; o <<= 1) v += __shfl_xor(v, o);
  return v;
}
__device__ __forceinline__ float wave_max(float v) {
#pragma unroll
  for (int o = 1; o < 64; o <<= 1) v = fmaxf(v, __shfl_xor(v, o));
  return v;
}
__device__ __forceinline__ unsigned wave_maxu(unsigned v) {
#pragma unroll
  for (int o = 1; o < 64; o <<= 1) { unsigned w = (unsigned)__shfl_xor((int)v, o); v = v > w ? v : w; }
  return v;
}

__device__ __forceinline__ void ph_prep_x(int bid, int nb, unsigned char* lds, const float* __restrict__ x, const float* __restrict__ w_in, const float* __restrict__ gate_b,
                                          bf16_t* __restrict__ xb, float* __restrict__ gpre) {
  const int lane = threadIdx.x & 63, wave = __builtin_amdgcn_readfirstlane(threadIdx.x >> 6), fr = lane & 15, fq = lane >> 4;
  bf16_t* WGb = (bf16_t*)lds;
  for (int i = threadIdx.x; i < 16 * 1024; i += 512) { const int k = i >> 4, g = i & 15; WGb[g * 1032 + k] = f2bf(w_in[(size_t)k * 5648 + 3584 + g]); }
  const int rpb = ((T / 16 + nb - 1) / nb) * 16, row0 = bid * rpb, nrow = row0 < T ? (T - row0 < rpb ? T - row0 : rpb) : 0;
  { const float4* xs = (const float4*)(x + (size_t)row0 * DM); u32x2* xd = (u32x2*)(xb + (size_t)row0 * DM);
    for (int i = threadIdx.x; i < nrow * 256; i += 512) { const float4 v = xs[i]; u32x2 w; w.x = pk2(v.x, v.y); w.y = pk2(v.z, v.w); xd[i] = w; } }
  asm volatile("s_waitcnt vmcnt(0)" ::: "memory");
  __syncthreads();
  for (int rt = wave; rt * 16 < nrow; rt += 8) {
    const bf16_t* xr = xb + (size_t)(row0 + rt * 16 + fr) * DM + 8 * fq; const bf16_t* wr = WGb + fr * 1032 + 8 * fq;
    f32x4 acc = {0.f, 0.f, 0.f, 0.f};
#pragma unroll 8
    for (int ks = 0; ks < 32; ++ks) { const bf16x8 a = *(const bf16x8*)(xr + 32 * ks), bv = *(const bf16x8*)(wr + 32 * ks);
      acc = __builtin_amdgcn_mfma_f32_16x16x32_bf16(a, bv, acc, 0, 0, 0); }
    const float gb = gate_b[fr];
#pragma unroll
    for (int r = 0; r < 4; ++r) gpre[(size_t)(row0 + rt * 16 + 4 * fq + r) * 16 + fr] = acc[r] + gb;
  }
  __syncthreads();
}
__device__ __forceinline__ int src_col(int n, int mode) {
  if (mode == 1) { if (n < 1024) { const int j = n & 63; const int pj = j < 16 ? ((j & 1) ? (j >> 1) + 8 : (j >> 1)) : j; return (n & ~63) + pj; } else if (n >= 3584) return n + 16; }
  return n;
}
__device__ __forceinline__ void transpose_item(const float* __restrict__ W, int ldw, int K, int nblk, bf16_t* __restrict__ WT, float* scr, int item, int lane, int mode, int ldo = 0) {
  if (ldo == 0) ldo = K;
  const int kb = item / nblk, nbk = item % nblk, k0 = 64 * kb, n0 = 32 * nbk;
  const int sc = src_col(n0 + (lane & 31), mode);
#pragma unroll 8
  for (int i = 0; i < 32; ++i) { const int kk = 2 * i + (lane >> 5); scr[kk * 33 + (lane & 31)] = W[(size_t)(k0 + kk) * ldw + sc]; }
  asm volatile("s_waitcnt lgkmcnt(0)" ::: "memory");
  const int c = lane & 7;
#pragma unroll
  for (int j = 0; j < 4; ++j) { const int n = (lane >> 3) + 8 * j; const float* s = scr + (8 * c) * 33 + n;
    u32x4 o; o.x = pk2(s[0 * 33], s[1 * 33]); o.y = pk2(s[2 * 33], s[3 * 33]); o.z = pk2(s[4 * 33], s[5 * 33]); o.w = pk2(s[6 * 33], s[7 * 33]);
    *(u32x4*)(WT + (size_t)(n0 + n) * ldo + k0 + 8 * c) = o; }
  asm volatile("s_waitcnt lgkmcnt(0)" ::: "memory");
}
__device__ __forceinline__ void ph_prep_weights(int bid, int nb, unsigned char* lds, const float* w_in, const float* w_ba, const float* w_bm, const float* w_out, const float* w_q,
                                                bf16_t* WinT, unsigned char* ws) {
  const int lane = threadIdx.x & 63, wave = threadIdx.x >> 6;
  float* scr = (float*)(lds + 65536 + wave * 8448);
  constexpr int I_IN = 16 * 176, I_BA = 8 * 32, I_OUT = 16 * 32, I_Q = 16 * 64, NIT = I_IN + 2 * I_BA + I_OUT + I_Q;
  for (int it = bid * 8 + wave; it < NIT; it += nb * 8) {
    int r = it;
    if (r < I_IN) { transpose_item(w_in, 5648, 1024, 176, WinT, scr, r, lane, 1); continue; } r -= I_IN;
    if (r < I_BA) { transpose_item(w_ba, 1024, 512, 32, (bf16_t*)(ws + WS_WA), scr, r, lane, 0, 1024); continue; } r -= I_BA;
    if (r < I_BA) { transpose_item(w_bm, 1024, 512, 32, (bf16_t*)(ws + WS_WA) + 512, scr, r, lane, 0, 1024); continue; } r -= I_BA;
    if (r < I_OUT) { transpose_item(w_out, 1024, 1024, 32, (bf16_t*)(ws + WS_WOUT), scr, r, lane, 0); continue; } r -= I_OUT;
    transpose_item(w_q, 2048, 1024, 64, (bf16_t*)(ws + WS_WQ), scr, r, lane, 0);
  }
}
__device__ __forceinline__ void ph_cvt(int bid, int nb, const float* __restrict__ in, bf16_t* __restrict__ out, size_t n4) {
  for (size_t i = (size_t)bid * 512 + threadIdx.x; i < n4; i += (size_t)nb * 512) {
    const float4 v = ((const float4*)in)[i]; u32x2 w; w.x = pk2(v.x, v.y); w.y = pk2(v.z, v.w); ((u32x2*)out)[i] = w; }
}
__device__ __forceinline__ void ph_rope_tab(int bid, int nb, float2* __restrict__ cs) {
  for (int idx = bid * 512 + threadIdx.x; idx < 8192 * 8; idx += nb * 512) {
    const int s = idx >> 3, i = idx & 7;
    const double inv = pow(500000.0, -(double)i / 8.0); const double ang = (double)s * inv;
    cs[idx] = make_float2((float)cos(ang), (float)sin(ang));
  }
}

struct EP { const float* x; unsigned char* ws; float* dout; const float2* cs; };
enum { EPI_G1 = 0, EPI_M1 = 1, EPI_M2 = 2, EPI_OUT = 3, EPI_QP = 4 };
template <int EPI> __device__ __forceinline__ void epi4(const EP& e, int row, int col, f32x4 v) {
  if (EPI == EPI_G1) {
    if (col < 1024) {
      if ((col & 63) < 16) { const int s = row & (SEQ - 1), i0 = (col & 15) >> 1; const float2 c0 = e.cs[s * 8 + i0], c1 = e.cs[s * 8 + i0 + 1];
        const float a0 = v[0] * c0.x - v[1] * c0.y, b0 = v[1] * c0.x + v[0] * c0.y, a1 = v[2] * c1.x - v[3] * c1.y, b1 = v[3] * c1.x + v[2] * c1.y;
        v[0] = a0; v[1] = b0; v[2] = a1; v[3] = b1; }
      if (col < 512) v = v * QSCALE;
    } else if (col >= 3072) { v[0] = sigmoidf_(v[0]); v[1] = sigmoidf_(v[1]); v[2] = sigmoidf_(v[2]); v[3] = sigmoidf_(v[3]); }
    bf16_t* dst = col < 3584 ? (bf16_t*)(e.ws + WS_G1) + (size_t)(col >> 9) * ((size_t)T * 512) + (size_t)row * 512 + (col & 511)
                             : (bf16_t*)(e.ws + WS_BG) + (size_t)row * 2048 + (col - 3584);
    u32x2 w; w.x = pk2(v[0], v[1]); w.y = pk2(v[2], v[3]); *(u32x2*)dst = w;
  } else if (EPI == EPI_M1 || EPI == EPI_M2) {
    const bf16_t* g = (const bf16_t*)(e.ws + WS_BG) + (size_t)row * 2048 + (EPI == EPI_M2 ? 1024 : 0) + col;
    const u32x2 gw = *(const u32x2*)g;
    bf16_t* dst = (bf16_t*)(e.ws + WS_MG) + (size_t)row * 1024 + col;
    float r0 = v[0] * __uint_as_float(gw.x << 16), r1 = v[1] * __uint_as_float(gw.x & 0xffff0000u), r2 = v[2] * __uint_as_float(gw.y << 16), r3 = v[3] * __uint_as_float(gw.y & 0xffff0000u);
    if (EPI == EPI_M2) { const u32x2 pw = *(const u32x2*)dst; r0 += __uint_as_float(pw.x << 16); r1 += __uint_as_float(pw.x & 0xffff0000u); r2 += __uint_as_float(pw.y << 16); r3 += __uint_as_float(pw.y & 0xffff0000u); }
    u32x2 w; w.x = pk2(r0, r1); w.y = pk2(r2, r3); *(u32x2*)dst = w;
  } else if (EPI == EPI_OUT) {
    const f32x4 xv = *(const f32x4*)(e.x + (size_t)row * DM + col);
    *(f32x4*)(e.dout + (size_t)row * DM + col) = xv * ALPHA + v;
  } else if (EPI == EPI_QP) {
    u32x2 w; w.x = pk2(v[0], v[1]); w.y = pk2(v[2], v[3]); *(u32x2*)((bf16_t*)(e.ws + WS_QP) + (size_t)row * 2048 + col) = w;
  }
}
__device__ __forceinline__ float fsig(float x) { return __builtin_amdgcn_rcpf(1.f + __builtin_amdgcn_exp2f(-1.4426950408889634f * x)); }
__device__ __forceinline__ void rope4(const float2* __restrict__ cs, int s, int i0, f32x4& v) {
  const float2 c0 = cs[s * 8 + i0], c1 = cs[s * 8 + i0 + 1];
  const float a0 = v[0] * c0.x - v[1] * c0.y, b0 = v[1] * c0.x + v[0] * c0.y, a1 = v[2] * c1.x - v[3] * c1.y, b1 = v[3] * c1.x + v[2] * c1.y;
  v[0] = a0; v[1] = b0; v[2] = a1; v[3] = b1;
}
__device__ __forceinline__ void unpk8(const u32x4 w, float* f) {
#pragma unroll
  for (int i = 0; i < 4; ++i) { f[2 * i] = __uint_as_float(w[i] << 16); f[2 * i + 1] = __uint_as_float(w[i] & 0xffff0000u); }
}
template <int EPI> __device__ __forceinline__ void epi8(const EP& e, int row, int col, f32x4 v0, f32x4 v1) {
  if (EPI == EPI_G1) {
    if (col < 1024) {
      if ((col & 63) < 16) { const int s = row & (SEQ - 1), i0 = (col & 15) >> 1; rope4(e.cs, s, i0, v0); rope4(e.cs, s, i0 + 2, v1); }
      if (col < 512) { v0 = v0 * QSCALE; v1 = v1 * QSCALE; }
    } else if (col >= 3072) {
#pragma unroll
      for (int i = 0; i < 4; ++i) { v0[i] = fsig(v0[i]); v1[i] = fsig(v1[i]); }
    }
    bf16_t* dst = col < 3584 ? (bf16_t*)(e.ws + WS_G1) + (size_t)(col >> 9) * ((size_t)T * 512) + (size_t)row * 512 + (col & 511)
                             : (bf16_t*)(e.ws + WS_BG) + (size_t)row * 2048 + (col - 3584);
    u32x4 w; w.x = pk2(v0[0], v0[1]); w.y = pk2(v0[2], v0[3]); w.z = pk2(v1[0], v1[1]); w.w = pk2(v1[2], v1[3]); *(u32x4*)dst = w;
  } else if (EPI == EPI_M1 || EPI == EPI_M2) {
    float g[8]; unpk8(*(const u32x4*)((const bf16_t*)(e.ws + WS_BG) + (size_t)row * 2048 + (EPI == EPI_M2 ? 1024 : 0) + col), g);
    bf16_t* dst = (bf16_t*)(e.ws + WS_MG) + (size_t)row * 1024 + col;
    float r[8];
#pragma unroll
    for (int i = 0; i < 4; ++i) { r[i] = v0[i] * g[i]; r[4 + i] = v1[i] * g[4 + i]; }
    if (EPI == EPI_M2) { float pv[8]; unpk8(*(const u32x4*)dst, pv);
#pragma unroll
      for (int i = 0; i < 8; ++i) r[i] += pv[i]; }
    u32x4 w; w.x = pk2(r[0], r[1]); w.y = pk2(r[2], r[3]); w.z = pk2(r[4], r[5]); w.w = pk2(r[6], r[7]); *(u32x4*)dst = w;
  } else if (EPI == EPI_OUT) {
    const f32x4 x0 = *(const f32x4*)(e.x + (size_t)row * DM + col), x1 = *(const f32x4*)(e.x + (size_t)row * DM + col + 4);
    const f32x4 r0 = x0 * ALPHA + v0, r1 = x1 * ALPHA + v1;
    u32x4 w; w.x = pk2(r0[0], r0[1]); w.y = pk2(r0[2], r0[3]); w.z = pk2(r1[0], r1[1]); w.w = pk2(r1[2], r1[3]); *(u32x4*)((bf16_t*)e.dout + (size_t)row * DM + col) = w;
  } else if (EPI == EPI_QP) {
    u32x4 w; w.x = pk2(v0[0], v0[1]); w.y = pk2(v0[2], v0[3]); w.z = pk2(v1[0], v1[1]); w.w = pk2(v1[2], v1[3]);
    *(u32x4*)((bf16_t*)(e.ws + WS_QP) + (size_t)row * 2048 + col) = w;
  }
}
template <int EPI> __device__ __forceinline__ void ph_gemm(int bid, int nb, const bf16_t* __restrict__ A, const bf16_t* __restrict__ Bt, int N, int K, const EP& e) {
  const int tid = threadIdx.x & 255, half = threadIdx.x >> 8, wave = tid >> 6, lane = tid & 63, fr = lane & 15, fq = lane >> 4;
  const int ntn = N / 64, ntiles = ntn * (T / 64);
  for (int tile = bid * 2 + half; tile < ntiles; tile += nb * 2) {
    const int m0 = (tile / ntn) * 64 + (wave & 1) * 32, n0 = (tile % ntn) * 64 + (wave >> 1) * 32;
    f32x4 acc[2][2];
#pragma unroll
    for (int i = 0; i < 2; ++i)
#pragma unroll
      for (int j = 0; j < 2; ++j) acc[i][j] = (f32x4){0.f, 0.f, 0.f, 0.f};
    const bf16_t* ap = A + (size_t)(m0 + fr) * K + fq * 8; const bf16_t* bp = Bt + (size_t)(n0 + fr) * K + fq * 8;
    for (int k0 = 0; k0 < K; k0 += 32) {
      bf16x8 a[2], b[2];
#pragma unroll
      for (int i = 0; i < 2; ++i) { a[i] = *(const bf16x8*)(ap + (size_t)i * 16 * K + k0); b[i] = *(const bf16x8*)(bp + (size_t)i * 16 * K + k0); }
#pragma unroll
      for (int i = 0; i < 2; ++i)
#pragma unroll
        for (int j = 0; j < 2; ++j) acc[i][j] = __builtin_amdgcn_mfma_f32_16x16x32_bf16(b[j], a[i], acc[i][j], 0, 0, 0);
    }
#pragma unroll
    for (int i = 0; i < 2; ++i)
#pragma unroll
      for (int j = 0; j < 2; ++j) epi4<EPI>(e, m0 + 16 * i + fr, n0 + 16 * j + 4 * fq, acc[i][j]);
  }
}

namespace pg8 {
#define PG8_LAS __attribute__((address_space(3)))
typedef unsigned short bf16_t;
typedef short bf16x8 __attribute__((ext_vector_type(8)));
typedef float f32x4 __attribute__((ext_vector_type(4)));
typedef unsigned u32x4 __attribute__((ext_vector_type(4)));
constexpr int BM = 256, BK = 64, HALF = 128, HTB = HALF * BK * 2  , STAGE_BYTES = 8 * HTB, NXCD = 8, WGM = 8;

__host__ __device__ __forceinline__ int lds_byte(int r, int c) { const int st = (r >> 4) * 2 + (c >> 5), rr = r & 15, cc = c & 31, ob = rr * 64 + cc * 2; return st * 1024 + (ob ^ (((ob >> 9) & 1) << 5)); }
__host__ __device__ __forceinline__ void stage_rc(int b, int& R, int& C) { const int st = b / 1024, sb = b % 1024, swz = sb ^ (((sb >> 9) & 1) << 5); R = (st >> 1) * 16 + swz / 64; C = (st & 1) * 32 + (swz % 64) / 2; }
__host__ __device__ __forceinline__ int perm32(int rho) { const int n = rho >> 4, i = rho & 15; return 8 * (i >> 2) + 4 * n + (i & 3); }

struct Unit { int pm, pn; };
struct Gemm { const bf16_t* A; const bf16_t* Bt; int M, N, K; };

struct StaticOrder {
    int nM, nN, nwg, G, c;
    __host__ __device__ void init(int M, int N, int G_, int c_) { nM = M / BM; nN = N / BM; nwg = nM * nN; G = G_; c = c_; }
    __host__ __device__ bool next(int i, Unit& u) const {
        const long L = (long)i * G + c; if (L >= nwg) return false;
        int wgid = (int)L; { const int q = nwg / NXCD, r = nwg % NXCD, xcd = wgid % NXCD, off = wgid / NXCD; wgid = (xcd < r ? xcd * (q + 1) : r * (q + 1) + (xcd - r) * q) + off; }
        const int nig = WGM * nN, gid = wgid / nig, fm = gid * WGM, gsz = (nM - fm) < WGM ? (nM - fm) : WGM;
        u.pm = fm + ((wgid % nig) % gsz); u.pn = (wgid % nig) / gsz; return true;
    }
    __device__ __forceinline__ void a_ready(const Unit&) const {}
    __device__ __forceinline__ void done(const Unit&) const {}
};

template <class Epi, class Sched, bool ALIGN_EPI = false, bool SP2 = false>
__device__ __forceinline__ void gemm_phase(PG8_LAS unsigned char* lds, const Gemm g, const Sched& S, const Epi& E) {
    const int tid = threadIdx.x, wid = __builtin_amdgcn_readfirstlane(tid >> 6), lane = tid & 63, wr = wid >> 2, wc = wid & 3, fr = lane & 15, fq = lane >> 4;
    const int K = g.K, nt = K / BK;
    unsigned voffA[2], voffB[2];
#pragma unroll
    for (int i = 0; i < 2; ++i) { int R, C; stage_rc(tid * 16 + i * 8192, R, C); const int Rb = Epi::PERM ? ((R & ~31) + perm32(R & 31)) : R;
        voffA[i] = (unsigned)(R * K + C) * 2u; voffB[i] = (unsigned)(Rb * K + C) * 2u; }
    const size_t kstep = (size_t)(BK * 2);
    const size_t hstep = (size_t)HALF * K * 2;
    const size_t tstep = 2 * hstep;
    const unsigned ldsw = (unsigned)wid * 1024u;
    const int aoff = lds_byte(wr * 64 + fr, fq * 8), boff = lds_byte(wc * 32 + fr, fq * 8);
#define PG8_SA(b, h) (((b) * 2 + (h)) * HTB)
#define PG8_SB(b, h) ((4 + (b) * 2 + (h)) * HTB)
#define PG8_STAGE(bufoff, gbase, voff) do { _Pragma("unroll") for (int _i = 0; _i < 2; ++_i) \
        __builtin_amdgcn_global_load_lds((const unsigned*)((const char*)(gbase) + (voff)[_i]), (PG8_LAS unsigned*)(lds + (bufoff) + ldsw + _i * 8192), 16, 0, 0); } while (0)
#define PG8_LDA(dst, b, h) do { _Pragma("unroll") for (int m = 0; m < 4; ++m) _Pragma("unroll") for (int k = 0; k < 2; ++k) dst[m][k] = *(const PG8_LAS bf16x8*)(lds + PG8_SA(b, h) + aoff + m * 2048 + k * 1024); } while (0)
#define PG8_LDB(dst, b, h) do { _Pragma("unroll") for (int n = 0; n < 2; ++n) _Pragma("unroll") for (int k = 0; k < 2; ++k) dst[n][k] = *(const PG8_LAS bf16x8*)(lds + PG8_SB(b, h) + boff + n * 2048 + k * 1024); } while (0)
#define PG8_MMA(ai, bj, At, Bt) do { __builtin_amdgcn_s_setprio(1); _Pragma("unroll") for (int m = 0; m < 4; ++m) _Pragma("unroll") for (int n = 0; n < 2; ++n) _Pragma("unroll") for (int k = 0; k < 2; ++k) \
        acc[ai][bj][m][n] = __builtin_amdgcn_mfma_f32_16x16x32_bf16(Bt[n][k], At[m][k], acc[ai][bj][m][n], 0, 0, 0); __builtin_amdgcn_s_setprio(0); } while (0)
#define PG8_WAIT_V(n) asm volatile("s_waitcnt vmcnt(" #n ")" ::: "memory")
#define PG8_WAIT_L(n) asm volatile("s_waitcnt lgkmcnt(" #n ")" ::: "memory")
#define PG8_BAR __builtin_amdgcn_s_barrier()
#define PG8_SCHED __builtin_amdgcn_sched_barrier(0)
    Unit cur, nxt; int ui = 0;
    if (!S.next(0, cur)) return;
    f32x4 acc[2][2][4][2];
#pragma unroll
    for (int a = 0; a < 2; ++a)
#pragma unroll
        for (int b = 0; b < 2; ++b)
#pragma unroll
            for (int m = 0; m < 4; ++m)
#pragma unroll
                for (int n = 0; n < 2; ++n) acc[a][b][m][n] = (f32x4){0.f, 0.f, 0.f, 0.f};
    bf16x8 At[4][2], B0[2][2], B1[2][2];
    const char* cA = (const char*)g.A + (size_t)cur.pm * tstep; const char* cB = (const char*)g.Bt + (size_t)cur.pn * tstep;
    S.a_ready(cur);
    if constexpr (SP2) {
        PG8_STAGE(PG8_SB(0, 0), cB, voffB); PG8_STAGE(PG8_SB(0, 1), cB + hstep, voffB); PG8_STAGE(PG8_SA(0, 0), cA, voffA); PG8_STAGE(PG8_SA(0, 1), cA + hstep, voffA);
        if (wr == 1) PG8_BAR;
        PG8_WAIT_V(2); PG8_BAR;
        PG8_STAGE(PG8_SB(1, 0), cB + kstep, voffB); PG8_STAGE(PG8_SA(1, 0), cA + kstep, voffA); PG8_STAGE(PG8_SB(1, 1), cB + hstep + kstep, voffB);
        PG8_WAIT_V(6); PG8_BAR;
    } else {
        PG8_STAGE(PG8_SB(0, 0), cB, voffB); PG8_STAGE(PG8_SA(0, 0), cA, voffA); PG8_STAGE(PG8_SB(0, 1), cB + hstep, voffB); PG8_STAGE(PG8_SA(0, 1), cA + hstep, voffA);
        if (wr == 1) PG8_BAR;
        PG8_WAIT_V(4); PG8_BAR;
        PG8_STAGE(PG8_SB(1, 0), cB + kstep, voffB); PG8_STAGE(PG8_SA(1, 0), cA + kstep, voffA); PG8_STAGE(PG8_SB(1, 1), cB + hstep + kstep, voffB);
        PG8_WAIT_V(6); PG8_BAR;
    }
    for (;;) {
        const bool has_next = S.next(ui + 1, nxt);
        const char* nA = has_next ? (const char*)g.A + (size_t)nxt.pm * tstep : cA; const char* nB = has_next ? (const char*)g.Bt + (size_t)nxt.pn * tstep : cB;
        for (int t = 0; t < nt; t += 2) {
            const bool last = (t == nt - 2);
            if constexpr (Epi::HAS_MID) { if (t == (nt >> 1)) E.mid(acc, cur, wr, wc, fr, fq); }
            const char* a1 = cA + (size_t)(t + 1) * kstep;
            const char* a2 = last ? nA : cA + (size_t)(t + 2) * kstep; const char* b2 = last ? nB : cB + (size_t)(t + 2) * kstep;
            const char* a3 = a2 + kstep; const char* b3 = b2 + kstep;
            if (last && has_next) S.a_ready(nxt);
            if constexpr (SP2) {
            PG8_LDB(B0, 0, 0); PG8_LDB(B1, 0, 1); PG8_SCHED; PG8_LDA(At, 0, 0); PG8_STAGE(PG8_SA(1, 1), a1 + hstep, voffA);
            PG8_WAIT_V(8); PG8_WAIT_L(0); PG8_BAR; PG8_MMA(0, 0, At, B0); PG8_MMA(0, 1, At, B1); PG8_BAR; PG8_SCHED;
            PG8_LDA(At, 0, 1); PG8_STAGE(PG8_SB(0, 0), b2, voffB); PG8_STAGE(PG8_SB(0, 1), b2 + hstep, voffB); PG8_STAGE(PG8_SA(0, 0), a2, voffA);
            PG8_WAIT_V(8); PG8_WAIT_L(0); PG8_BAR; PG8_MMA(1, 0, At, B0); PG8_MMA(1, 1, At, B1); PG8_BAR; PG8_SCHED;
            PG8_LDB(B0, 1, 0); PG8_LDB(B1, 1, 1); PG8_SCHED; PG8_LDA(At, 1, 0); PG8_STAGE(PG8_SA(0, 1), a2 + hstep, voffA);
            PG8_WAIT_V(8); PG8_WAIT_L(0); PG8_BAR; PG8_MMA(0, 0, At, B0); PG8_MMA(0, 1, At, B1); PG8_BAR; PG8_SCHED;
            PG8_LDA(At, 1, 1); PG8_STAGE(PG8_SB(1, 0), b3, voffB); PG8_STAGE(PG8_SB(1, 1), b3 + hstep, voffB); PG8_STAGE(PG8_SA(1, 0), a3, voffA);
            PG8_WAIT_V(8); PG8_WAIT_L(0); PG8_BAR; PG8_MMA(1, 0, At, B0); PG8_MMA(1, 1, At, B1); PG8_BAR; PG8_SCHED;
            } else {
            PG8_LDB(B0, 0, 0); PG8_SCHED; PG8_LDA(At, 0, 0); PG8_STAGE(PG8_SA(1, 1), a1 + hstep, voffA);
            PG8_WAIT_L(8); PG8_BAR; PG8_WAIT_L(0); PG8_MMA(0, 0, At, B0); PG8_BAR; PG8_SCHED;
            PG8_LDB(B1, 0, 1); PG8_STAGE(PG8_SB(0, 0), b2, voffB);
            PG8_BAR; PG8_WAIT_L(0); PG8_MMA(0, 1, At, B1); PG8_BAR;
            PG8_LDA(At, 0, 1); PG8_STAGE(PG8_SA(0, 0), a2, voffA);
            PG8_BAR; PG8_WAIT_L(0); PG8_MMA(1, 0, At, B0); PG8_BAR; PG8_SCHED;
            PG8_STAGE(PG8_SB(0, 1), b2 + hstep, voffB);
            PG8_WAIT_V(6); PG8_BAR; PG8_MMA(1, 1, At, B1); PG8_BAR;
            PG8_LDB(B0, 1, 0); PG8_SCHED; PG8_LDA(At, 1, 0); PG8_STAGE(PG8_SA(0, 1), a2 + hstep, voffA);
            PG8_WAIT_L(8); PG8_BAR; PG8_WAIT_L(0); PG8_MMA(0, 0, At, B0); PG8_BAR; PG8_SCHED;
            PG8_LDB(B1, 1, 1); PG8_STAGE(PG8_SB(1, 0), b3, voffB);
            PG8_BAR; PG8_WAIT_L(0); PG8_MMA(0, 1, At, B1); PG8_BAR;
            PG8_LDA(At, 1, 1); PG8_STAGE(PG8_SA(1, 0), a3, voffA);
            PG8_BAR; PG8_WAIT_L(0); PG8_MMA(1, 0, At, B0); PG8_BAR; PG8_SCHED;
            PG8_STAGE(PG8_SB(1, 1), b3 + hstep, voffB);
            PG8_WAIT_V(6); PG8_BAR; PG8_MMA(1, 1, At, B1); PG8_BAR;
            }
        }
        if constexpr (ALIGN_EPI) { if (wr == 0) PG8_BAR; }
        if constexpr (!Epi::AFTER_DRAIN) { E(acc, cur, wr, wc, fr, fq); S.done(cur); }
        if (!has_next) break;
#pragma unroll
        for (int a = 0; a < 2; ++a)
#pragma unroll
            for (int b = 0; b < 2; ++b)
#pragma unroll
                for (int m = 0; m < 4; ++m)
#pragma unroll
                    for (int n = 0; n < 2; ++n) acc[a][b][m][n] = (f32x4){0.f, 0.f, 0.f, 0.f};
        cur = nxt; cA = nA; cB = nB; ++ui;
        if constexpr (ALIGN_EPI) { if (wr == 1) PG8_BAR; }
    }
    PG8_WAIT_V(0);
    if constexpr (!ALIGN_EPI) { if (wr == 0) PG8_BAR; }
    PG8_BAR;
    if constexpr (Epi::AFTER_DRAIN) { E.fused(acc, cur, wr, wc, fr, fq, lds, wid, lane); S.done(cur); }
#undef PG8_SA
#undef PG8_SB
#undef PG8_STAGE
#undef PG8_LDA
#undef PG8_LDB
#undef PG8_MMA
#undef PG8_WAIT_V
#undef PG8_WAIT_L
#undef PG8_BAR
#undef PG8_SCHED
}
}

template <int EPI> struct EpiAd {
  static constexpr bool PERM = true, AFTER_DRAIN = false, HAS_MID = false;
  EP e;
  __device__ __forceinline__ void operator()(const pg8::f32x4 (&acc)[2][2][4][2], const pg8::Unit& u, int wr, int wc, int fr, int fq) const {
#pragma unroll
    for (int ai = 0; ai < 2; ++ai)
#pragma unroll
      for (int m = 0; m < 4; ++m)
#pragma unroll
        for (int bj = 0; bj < 2; ++bj)
          epi8<EPI>(e, u.pm * 256 + ai * 128 + wr * 64 + m * 16 + fr, u.pn * 256 + bj * 128 + wc * 32 + 8 * fq, acc[ai][bj][m][0], acc[ai][bj][m][1]);
  }
};
struct EpiMergeK {
  static constexpr bool PERM = true, AFTER_DRAIN = false, HAS_MID = true;
  unsigned char* ws;
  __device__ __forceinline__ void mid(pg8::f32x4 (&acc)[2][2][4][2], const pg8::Unit& u, int wr, int wc, int fr, int fq) const {
    const bf16_t* bg = (const bf16_t*)(ws + WS_BG);
#pragma unroll
    for (int ai = 0; ai < 2; ++ai)
#pragma unroll
      for (int m = 0; m < 4; ++m)
#pragma unroll
        for (int bj = 0; bj < 2; ++bj) {
          const int row = u.pm * 256 + ai * 128 + wr * 64 + m * 16 + fr, col = u.pn * 256 + bj * 128 + wc * 32 + 8 * fq;
          float g0[8], g1[8]; unpk8(*(const u32x4*)(bg + (size_t)row * 2048 + col), g0); unpk8(*(const u32x4*)(bg + (size_t)row * 2048 + 1024 + col), g1);
#pragma unroll
          for (int i = 0; i < 4; ++i) { acc[ai][bj][m][0][i] *= g0[i] * __builtin_amdgcn_rcpf(fmaxf(g1[i], 8.673617379884035e-19f));
                                        acc[ai][bj][m][1][i] *= g0[4 + i] * __builtin_amdgcn_rcpf(fmaxf(g1[4 + i], 8.673617379884035e-19f)); }
        }
  }
  __device__ __forceinline__ void operator()(const pg8::f32x4 (&acc)[2][2][4][2], const pg8::Unit& u, int wr, int wc, int fr, int fq) const {
    const bf16_t* bg = (const bf16_t*)(ws + WS_BG); bf16_t* mg = (bf16_t*)(ws + WS_MG);
#pragma unroll
    for (int ai = 0; ai < 2; ++ai)
#pragma unroll
      for (int m = 0; m < 4; ++m)
#pragma unroll
        for (int bj = 0; bj < 2; ++bj) {
          const int row = u.pm * 256 + ai * 128 + wr * 64 + m * 16 + fr, col = u.pn * 256 + bj * 128 + wc * 32 + 8 * fq;
          float g1[8], r[8]; unpk8(*(const u32x4*)(bg + (size_t)row * 2048 + 1024 + col), g1);
#pragma unroll
          for (int i = 0; i < 4; ++i) { r[i] = acc[ai][bj][m][0][i] * fmaxf(g1[i], 8.673617379884035e-19f); r[4 + i] = acc[ai][bj][m][1][i] * fmaxf(g1[4 + i], 8.673617379884035e-19f); }
          u32x4 w; w.x = pk2(r[0], r[1]); w.y = pk2(r[2], r[3]); w.z = pk2(r[4], r[5]); w.w = pk2(r[6], r[7]); *(u32x4*)(mg + (size_t)row * 1024 + col) = w;
        }
  }
};
__device__ __forceinline__ void ph_gemm_merge(unsigned char* lds, unsigned char* ws) {
  pg8::Gemm g{(const bf16_t*)(ws + WS_YA), (const bf16_t*)(ws + WS_WA), T, 1024, 1024}; pg8::StaticOrder S; S.init(T, 1024, (int)gridDim.x, (int)blockIdx.x);
  EpiMergeK E{ws};
  pg8::gemm_phase<EpiMergeK, pg8::StaticOrder, true, true>((PG8_LAS unsigned char*)lds, g, S, E);
}
template <int EPI> __device__ __forceinline__ void ph_gemm8(unsigned char* lds, const bf16_t* A, const bf16_t* Bt, int N, int K, const EP& e) {
  pg8::Gemm g{A, Bt, T, N, K}; pg8::StaticOrder S; S.init(T, N, (int)gridDim.x, (int)blockIdx.x);
  EpiAd<EPI> E{e};
  pg8::gemm_phase<EpiAd<EPI>, pg8::StaticOrder, true, true>((PG8_LAS unsigned char*)lds, g, S, E);
}

__device__ __forceinline__ float log_sigmoid(float f) { return fminf(f, 0.f) - log1pf(expf(-fabsf(f))); }
constexpr size_t WS_GP_P = 3 * MB, WS_GP_M = 3 * MB + 512 * 1024, WS_GP_B = 4 * MB, WS_GP_MC = 4 * MB + 512 * 1024, WS_GP_AC = 4 * MB + 520 * 1024;
constexpr size_t WS_NU = 5 * MB;
constexpr int RS = 136, TS = 72;
__device__ __forceinline__ void gp_scan(int scan, const float* __restrict__ gpre, unsigned char* ws, unsigned char* lds) {
  const int lane = threadIdx.x & 63, wave = threadIdx.x >> 6, dir = scan >> 3, b = (scan >> 2) & 1, h = scan & 3;
  float* P = (float*)(ws + WS_GP_P) + (size_t)scan * SEQ; float* Rp = (float*)(ws + WS_GP_M) + (size_t)scan * SEQ; float* BBp = (float*)(ws + WS_GP_B) + (size_t)scan * SEQ;
  float* mC = (float*)(ws + WS_GP_MC) + scan * 128; float* aC = (float*)(ws + WS_GP_AC) + scan * 128;
  float* LBL = (float*)lds; float* LR = LBL + 128;
  const int gi = (dir ? 8 : 0) + h, gf = (dir ? 12 : 4) + h;
  float ig[16], fg[16];
#pragma unroll
  for (int i = 0; i < 16; ++i) { const int c = wave * 16 + i, j = dir ? 127 - c : c, s = 64 * j + (dir ? 63 - lane : lane); const size_t t = (size_t)b * SEQ + s;
    ig[i] = gpre[t * 16 + gi]; fg[i] = gpre[t * 16 + gf]; }
#pragma unroll
  for (int i = 0; i < 16; ++i) { const int c = wave * 16 + i, j = dir ? 127 - c : c, s = 64 * j + (dir ? 63 - lane : lane);
    float bsum = log_sigmoid(fg[i]);
#pragma unroll
    for (int o = 1; o < 64; o <<= 1) { const float v = __shfl_up(bsum, o); if (lane >= o) bsum += v; }
    const float p = ig[i] - bsum; float r = p;
#pragma unroll
    for (int o = 1; o < 64; o <<= 1) { const float v = __shfl_up(r, o); if (lane >= o) r = fmaxf(r, v); }
    P[s] = p; Rp[s] = r; BBp[s] = bsum;
    if (lane == 63) { LBL[c] = bsum; LR[c] = r; } }
  __syncthreads();
  if (wave == 0) { float m = -1e30f;
    for (int c = 0; c < 128; ++c) { const int j = dir ? 127 - c : c; const float Ml = fmaxf(m, LR[c]);
      if (lane == 0) { mC[j] = m; aC[j] = expf(m - Ml); }
      m = LBL[c] + Ml; } }
  __syncthreads();
}
struct M1Pre { u32x4 raw[5]; u32x4 v[2]; float cwl[3]; float pv, rv, mc; };
__device__ __forceinline__ void m1_prefetch(int u, M1Pre& pr, const unsigned char* ws, const float* __restrict__ cw, const float* __restrict__ cb) {
  const int tid = threadIdx.x, lane = tid & 63, wave = __builtin_amdgcn_readfirstlane(tid >> 6);
  const int bh = u >> 7, j = u & 127, b = bh >> 2, h = bh & 3;
  const bf16_t* mq = (const bf16_t*)(ws + WS_MQ); const bf16_t* mk = (const bf16_t*)(ws + WS_MK); const bf16_t* mv = (const bf16_t*)(ws + WS_MV);
#pragma unroll
  for (int i = 0; i < 5; ++i) { const int it = tid + 512 * i; const int which = it >= 68 * 16, r = (it - which * 68 * 16) >> 4, ch = it & 15; const int s = 64 * j - 2 + r;
    pr.raw[i] = (u32x4){0u, 0u, 0u, 0u};
    if (it < 2 * 68 * 16 && s >= 0 && s < SEQ) pr.raw[i] = *(const u32x4*)((which ? mk : mq) + ((size_t)b * SEQ + s) * 512 + h * 128 + ch * 8); }
#pragma unroll
  for (int k2 = 0; k2 < 2; ++k2) pr.v[k2] = *(const u32x4*)(mv + ((size_t)b * SEQ + 64 * j + lane) * 512 + h * 128 + (wave + 8 * k2) * 8);
#pragma unroll
  for (int i3 = 0; i3 < 3; ++i3) { const int i = tid + 512 * i3; const int w = i >> 8, c = i & 255, ch = (c >> 7) * 512 + h * 128 + (c & 127); pr.cwl[i3] = w < 5 ? cw[w * 1024 + ch] : cb[ch]; }
  pr.pv = 0.f; pr.rv = 0.f; pr.mc = 0.f;
  if (tid < 128) { const int dir = tid >> 6, l = tid & 63; const int scan = dir * 8 + bh;
    pr.pv = ((const float*)(ws + WS_GP_P))[(size_t)scan * SEQ + 64 * j + l]; pr.rv = ((const float*)(ws + WS_GP_M))[(size_t)scan * SEQ + 64 * j + (dir ? 0 : 63)];
    pr.mc = ((const float*)(ws + WS_GP_MC))[scan * 128 + j]; }
}
template <bool HAS_NEXT> __device__ __forceinline__ void m1_unit(int u, int un, M1Pre& pr, unsigned char* lds, unsigned char* ws, bf16_t* UT, const float* __restrict__ cw, const float* __restrict__ cb) {
  const int tid = threadIdx.x, lane = tid & 63, wave = __builtin_amdgcn_readfirstlane(tid >> 6), fr = lane & 15, fq = lane >> 4;
  const int bh = u >> 7, j = u & 127, b = bh >> 2, h = bh & 3;
  bf16_t* RAWQ = (bf16_t*)lds; bf16_t* RAWK = RAWQ + 68 * RS; bf16_t* KWT0 = RAWK + 68 * RS; bf16_t* KWT1 = KWT0 + 128 * TS; bf16_t* VT = KWT1 + 128 * TS;
  float* WK = (float*)(VT + 144 * TS);
  float* CWL = WK + 128;
  bf16_t* qc = (bf16_t*)(ws + WS_QC); bf16_t* kc = (bf16_t*)(ws + WS_KC);
  const size_t trow0 = (size_t)b * SEQ + 64 * j;
#pragma unroll
  for (int i = 0; i < 5; ++i) { const int it = tid + 512 * i; const int which = it >= 68 * 16, r = (it - which * 68 * 16) >> 4, ch = it & 15;
    if (it < 2 * 68 * 16) *(u32x4*)((which ? RAWK : RAWQ) + r * RS + ch * 8) = pr.raw[i]; }
#pragma unroll
  for (int i3 = 0; i3 < 3; ++i3) CWL[tid + 512 * i3] = pr.cwl[i3];
  if (tid < 128) WK[tid] = expf(pr.pv - fmaxf(pr.mc, pr.rv));
#pragma unroll
  for (int k2 = 0; k2 < 2; ++k2) { const int ch = wave + 8 * k2; const u32x4 v = pr.v[k2];
#pragma unroll
    for (int i = 0; i < 4; ++i) { VT[(ch * 8 + 2 * i) * TS + lane] = (bf16_t)(v[i] & 0xffffu); VT[(ch * 8 + 2 * i + 1) * TS + lane] = (bf16_t)(v[i] >> 16); } }
  if (tid < 64) VT[128 * TS + tid] = 0x3f80;
  __syncthreads();
  if (HAS_NEXT) m1_prefetch(un, pr, ws, cw, cb);
  const float wkf = WK[lane], wkb = WK[64 + lane];
#pragma unroll
  for (int which = 0; which < 2; ++which)
#pragma unroll
    for (int k2 = 0; k2 < 2; ++k2) {
      const int ch = wave + 8 * k2; const float* cwl = CWL + which * 128 + ch * 8;
      float y[8];
      { const float4 ba = *(const float4*)(cwl + 5 * 256), bb = *(const float4*)(cwl + 5 * 256 + 4); y[0] = ba.x; y[1] = ba.y; y[2] = ba.z; y[3] = ba.w; y[4] = bb.x; y[5] = bb.y; y[6] = bb.z; y[7] = bb.w; }
#pragma unroll
      for (int w = 0; w < 5; ++w) {
        const u32x4 v = *(const u32x4*)((which ? RAWK : RAWQ) + (lane + w) * RS + ch * 8);
        const float4 wa = *(const float4*)(cwl + w * 256), wb = *(const float4*)(cwl + w * 256 + 4);
        y[0] += __uint_as_float(v[0] << 16) * wa.x; y[1] += __uint_as_float(v[0] & 0xffff0000u) * wa.y; y[2] += __uint_as_float(v[1] << 16) * wa.z; y[3] += __uint_as_float(v[1] & 0xffff0000u) * wa.w;
        y[4] += __uint_as_float(v[2] << 16) * wb.x; y[5] += __uint_as_float(v[2] & 0xffff0000u) * wb.y; y[6] += __uint_as_float(v[3] << 16) * wb.z; y[7] += __uint_as_float(v[3] & 0xffff0000u) * wb.w;
      }
#pragma unroll
      for (int i = 0; i < 8; ++i) { y[i] = y[i] * fsig(y[i]); if (which) y[i] *= 0.08838834764831845f; }
      u32x4 o; o.x = pk2(y[0], y[1]); o.y = pk2(y[2], y[3]); o.z = pk2(y[4], y[5]); o.w = pk2(y[6], y[7]);
      *(u32x4*)((which ? kc : qc) + (trow0 + lane) * 512 + h * 128 + ch * 8) = o;
      if (which) {
#pragma unroll
        for (int i = 0; i < 8; ++i) { const float kv = bf2f(f2bf(y[i])); KWT0[(ch * 8 + i) * TS + lane] = f2bf(kv * wkf); KWT1[(ch * 8 + i) * TS + lane] = f2bf(kv * wkb); }
      }
    }
  __syncthreads();
  bf16x8 xf[2][2];
#pragma unroll
  for (int dir = 0; dir < 2; ++dir)
#pragma unroll
    for (int ks = 0; ks < 2; ++ks) xf[dir][ks] = *(const bf16x8*)((dir ? KWT1 : KWT0) + (16 * wave + fr) * TS + ks * 32 + fq * 8);
#pragma unroll
  for (int et = 0; et < 9; ++et) {
    const bf16x8 y0 = *(const bf16x8*)(VT + (16 * et + fr) * TS + fq * 8), y1 = *(const bf16x8*)(VT + (16 * et + fr) * TS + 32 + fq * 8);
#pragma unroll
    for (int dir = 0; dir < 2; ++dir) {
      f32x4 acc = {0.f, 0.f, 0.f, 0.f};
      acc = __builtin_amdgcn_mfma_f32_16x16x32_bf16(xf[dir][0], y0, acc, 0, 0, 0);
      acc = __builtin_amdgcn_mfma_f32_16x16x32_bf16(xf[dir][1], y1, acc, 0, 0, 0);
      const int scan = dir * 8 + bh;
      if (et < 8) { u32x2 w; w.x = pk2(acc[0], acc[1]); w.y = pk2(acc[2], acc[3]);
        *(u32x2*)(UT + (((size_t)scan * 128 + j) * 128 + 16 * et + fr) * 128 + 16 * wave + 4 * fq) = w; }
      else if (fr == 0) *(f32x4*)((float*)(ws + WS_NU) + ((size_t)scan * 128 + j) * 128 + 16 * wave + 4 * fq) = acc;
    }
  }
  __syncthreads();
}
__device__ __forceinline__ void m2_scan(int bid, int nb, unsigned char* ws, bf16_t* UT) {
  for (int slab = bid; slab < 16 * 16; slab += nb) {
    const int scan = slab >> 4, dir = scan >> 3, el = ((slab & 15) * 512 + threadIdx.x) * 2;
    const float* aC = (const float*)(ws + WS_GP_AC) + scan * 128;
    bf16_t* base = UT + (size_t)scan * 128 * 16384 + el;
    float c0 = 0.f, c1 = 0.f;
    for (int c16 = 0; c16 < 128; c16 += 16) {
      unsigned uv[16];
#pragma unroll
      for (int i = 0; i < 16; ++i) { const int j = dir ? 127 - (c16 + i) : c16 + i; uv[i] = *(const unsigned*)(base + (size_t)j * 16384); }
#pragma unroll
      for (int i = 0; i < 16; ++i) { const int j = dir ? 127 - (c16 + i) : c16 + i; const float a = aC[j]; *(unsigned*)(base + (size_t)j * 16384) = pk2(c0, c1);
        c0 = a * c0 + __uint_as_float(uv[i] << 16); c1 = a * c1 + __uint_as_float(uv[i] & 0xffff0000u); }
    }
  }
  const int gt = bid * 512 + threadIdx.x, nthreads = nb * 512;
  for (int item = gt; item < 16 * 128; item += nthreads) {
    const int scan = item >> 7, d = item & 127, dir = scan >> 3;
    const float* aC = (const float*)(ws + WS_GP_AC) + scan * 128; float* base = (float*)(ws + WS_NU) + (size_t)scan * 128 * 128 + d;
    float n = 0.f;
    for (int c16 = 0; c16 < 128; c16 += 16) { float uv[16], av[16];
#pragma unroll
      for (int i = 0; i < 16; ++i) { const int j = dir ? 127 - (c16 + i) : c16 + i; uv[i] = base[j * 128]; av[i] = aC[j]; }
#pragma unroll
      for (int i = 0; i < 16; ++i) { const int j = dir ? 127 - (c16 + i) : c16 + i; base[j * 128] = n; n = av[i] * n + uv[i]; } }
  }
}
__device__ __forceinline__ void m3_unit(int u, unsigned char* lds, unsigned char* ws, const bf16_t* UT, const float* __restrict__ ng) {
  const int tid = threadIdx.x, lane = tid & 63, wave = __builtin_amdgcn_readfirstlane(tid >> 6), fr = lane & 15, fq = lane >> 4;
  const int bh = u >> 7, j = u & 127, b = bh >> 2, h = bh & 3, tt = wave & 3, eh = wave >> 2;
  bf16_t* QCS = (bf16_t*)lds; bf16_t* KCS = QCS + 64 * RS; bf16_t* VT = KCS + 64 * RS; bf16_t* CT0 = VT + 144 * TS; bf16_t* CT1 = CT0 + 144 * RS;
  float* GA = (float*)(CT1 + 144 * RS);
  float* ST = GA + 384;
  const bf16_t* qc = (const bf16_t*)(ws + WS_QC); const bf16_t* kc = (const bf16_t*)(ws + WS_KC); const bf16_t* mv = (const bf16_t*)(ws + WS_MV); const bf16_t* mo = (const bf16_t*)(ws + WS_MO);
  bf16_t* ym = (bf16_t*)(ws + WS_YA);
  const size_t trow0 = (size_t)b * SEQ + 64 * j;
  for (int it = tid; it < 2 * 64 * 16; it += 512) { const int which = it >> 10, r = (it >> 4) & 63, ch = it & 15;
    *(u32x4*)((which ? KCS : QCS) + r * RS + ch * 8) = *(const u32x4*)((which ? kc : qc) + (trow0 + r) * 512 + h * 128 + ch * 8); }
  for (int it = tid; it < 2 * 128 * 16; it += 512) { const int dir = it >> 11, e = (it >> 4) & 127, ch = it & 15; const int scan = dir * 8 + bh;
    *(u32x4*)((dir ? CT1 : CT0) + e * RS + ch * 8) = *(const u32x4*)(UT + (((size_t)scan * 128 + j) * 128 + e) * 128 + ch * 8); }
  if (tid < 256) { const int dir = tid >> 7, d = tid & 127; const int scan = dir * 8 + bh;
    (dir ? CT1 : CT0)[128 * RS + d] = f2bf(((const float*)(ws + WS_NU))[((size_t)scan * 128 + j) * 128 + d]); }
  if (tid < 384) { const int dir = tid / 192, k3 = (tid % 192) >> 6, l = tid & 63; const int scan = dir * 8 + bh;
    const float* src = (const float*)(ws + (k3 == 0 ? WS_GP_P : k3 == 1 ? WS_GP_M : WS_GP_B)) + (size_t)scan * SEQ;
    GA[(dir * 3 + k3) * 64 + l] = src[64 * j + l]; }
#pragma unroll
  for (int k2 = 0; k2 < 2; ++k2) { const int ch = wave + 8 * k2;
    const u32x4 v = *(const u32x4*)(mv + (trow0 + lane) * 512 + h * 128 + ch * 8);
#pragma unroll
    for (int i = 0; i < 4; ++i) { VT[(ch * 8 + 2 * i) * TS + lane] = (bf16_t)(v[i] & 0xffffu); VT[(ch * 8 + 2 * i + 1) * TS + lane] = (bf16_t)(v[i] >> 16); } }
  if (tid < 64) VT[128 * TS + tid] = 0x3f80;
  __syncthreads();
  f32x4 g[4];
  {
    bf16x8 qf[4];
#pragma unroll
    for (int ks = 0; ks < 4; ++ks) qf[ks] = *(const bf16x8*)(QCS + (16 * tt + fr) * RS + ks * 32 + fq * 8);
#pragma unroll
    for (int lt = 0; lt < 4; ++lt) { g[lt] = (f32x4){0.f, 0.f, 0.f, 0.f};
#pragma unroll
      for (int ks = 0; ks < 4; ++ks) { const bf16x8 kf = *(const bf16x8*)(KCS + (16 * lt + fr) * RS + ks * 32 + fq * 8);
        g[lt] = __builtin_amdgcn_mfma_f32_16x16x32_bf16(kf, qf[ks], g[lt], 0, 0, 0); } }
  }
  const int etl[5] = {4 * eh, 4 * eh + 1, 4 * eh + 2, 4 * eh + 3, 8};
  float hsum[4][4];
#pragma unroll
  for (int i = 0; i < 4; ++i)
#pragma unroll
    for (int r = 0; r < 4; ++r) hsum[i][r] = 0.f;
#pragma unroll
  for (int dir = 0; dir < 2; ++dir) {
    const float* Pd = GA + (dir * 3 + 0) * 64; const float* Md = GA + (dir * 3 + 1) * 64; const float* Bd = GA + (dir * 3 + 2) * 64;
    const int scan = dir * 8 + bh; const float mc = ((const float*)(ws + WS_GP_MC))[scan * 128 + j];
    const bf16_t* CT = dir ? CT1 : CT0;
    f32x4 acc[5];
#pragma unroll
    for (int i = 0; i < 5; ++i) acc[i] = (f32x4){0.f, 0.f, 0.f, 0.f};
#pragma unroll
    for (int ks = 0; ks < 4; ++ks) { const bf16x8 qf = *(const bf16x8*)(QCS + (16 * tt + fr) * RS + ks * 32 + fq * 8);
#pragma unroll
      for (int i = 0; i < 5; ++i) { const bf16x8 cf = *(const bf16x8*)(CT + (16 * etl[i] + fr) * RS + ks * 32 + fq * 8);
        acc[i] = __builtin_amdgcn_mfma_f32_16x16x32_bf16(qf, cf, acc[i], 0, 0, 0); } }
    float Mt[4], wi[4], emr[4];
#pragma unroll
    for (int r = 0; r < 4; ++r) { const int t = 16 * tt + 4 * fq + r; Mt[r] = fmaxf(mc, Md[t]); wi[r] = __expf(mc - Mt[r]); emr[r] = __expf(-(Bd[t] + Mt[r])); }
#pragma unroll
    for (int i = 0; i < 5; ++i)
#pragma unroll
      for (int r = 0; r < 4; ++r) acc[i][r] *= wi[r];
    const float Mrow = fmaxf(mc, Md[16 * tt + fr]); const int trow = 16 * tt + fr;
    bf16x8 sf[2];
#pragma unroll
    for (int ks = 0; ks < 2; ++ks) { unsigned pw[4];
#pragma unroll
      for (int hh = 0; hh < 2; ++hh) { const int lt = 2 * ks + hh; float sv[4];
#pragma unroll
        for (int r = 0; r < 4; ++r) { const int l = 16 * lt + 4 * fq + r; const bool ok = dir ? (l >= trow) : (l <= trow);
          sv[r] = ok ? g[lt][r] * __expf(Pd[l] - Mrow) : 0.f; }
        pw[2 * hh] = pk2(sv[0], sv[1]); pw[2 * hh + 1] = pk2(sv[2], sv[3]); }
      u32x4 w4 = {pw[0], pw[1], pw[2], pw[3]}; sf[ks] = *(bf16x8*)&w4; }
#pragma unroll
    for (int ks = 0; ks < 2; ++ks)
#pragma unroll
      for (int i = 0; i < 5; ++i) { const bf16_t* vr = VT + (16 * etl[i] + fr) * TS + 32 * ks + 4 * fq;
        const u32x2 lo = *(const u32x2*)vr, hi = *(const u32x2*)(vr + 16); u32x4 w4 = {lo.x, lo.y, hi.x, hi.y};
        acc[i] = __builtin_amdgcn_mfma_f32_16x16x32_bf16(sf[ks], *(bf16x8*)&w4, acc[i], 0, 0, 0); }
#pragma unroll
    for (int r = 0; r < 4; ++r) { const float den = __shfl(acc[4][r], lane & 48); const float inv = __builtin_amdgcn_rcpf(fmaxf(fabsf(den), emr[r]));
#pragma unroll
      for (int i = 0; i < 4; ++i) hsum[i][r] += acc[i][r] * inv; }
  }
#pragma unroll
  for (int r = 0; r < 4; ++r) { float s1 = 0.f, s2 = 0.f;
#pragma unroll
    for (int i = 0; i < 4; ++i) { s1 += hsum[i][r]; s2 += hsum[i][r] * hsum[i][r]; }
#pragma unroll
    for (int o = 1; o < 16; o <<= 1) { s1 += __shfl_xor(s1, o); s2 += __shfl_xor(s2, o); }
    if (fr == 0) { ST[(eh * 64 + 16 * tt + 4 * fq + r) * 2] = s1; ST[(eh * 64 + 16 * tt + 4 * fq + r) * 2 + 1] = s2; } }
  __syncthreads();
  bf16_t* YT = QCS;
#pragma unroll
  for (int r = 0; r < 4; ++r) { const int t = 16 * tt + 4 * fq + r;
    const float s1 = ST[t * 2] + ST[(64 + t) * 2], s2 = ST[t * 2 + 1] + ST[(64 + t) * 2 + 1];
    const float mu = s1 * (1.f / 128.f), var = fmaxf(s2 * (1.f / 128.f) - mu * mu, 0.f), rs = rsqrtf(var + LN_EPS);
#pragma unroll
    for (int i = 0; i < 4; ++i) { const int e = 16 * (4 * eh + i) + fr; YT[t * RS + e] = f2bf((hsum[i][r] - mu) * rs * ng[h * 128 + e]); } }
  __syncthreads();
  for (int it = tid; it < 64 * 16; it += 512) { const int r = it >> 4, ch = it & 15;
    const u32x4 yv = *(const u32x4*)(YT + r * RS + ch * 8); const u32x4 ov = *(const u32x4*)(mo + (trow0 + r) * 512 + h * 128 + ch * 8); u32x4 o;
#pragma unroll
    for (int i = 0; i < 4; ++i) o[i] = pk2(__uint_as_float(yv[i] << 16) * __uint_as_float(ov[i] << 16), __uint_as_float(yv[i] & 0xffff0000u) * __uint_as_float(ov[i] & 0xffff0000u));
    *(u32x4*)(ym + (trow0 + r) * 1024 + 512 + h * 128 + ch * 8) = o; }
  __syncthreads();
}
constexpr int LDS_BYTES = 147456;
__device__ __forceinline__ float compute_lambda(const float* __restrict__ lp, int lane) {
  const float s1 = wave_sum(lp[lane] * lp[64 + lane]), s2 = wave_sum(lp[128 + lane] * lp[192 + lane]);
  return expf(s1) - expf(s2) + LAMBDA_INIT;
}
namespace att {
using f32x16 = __attribute__((ext_vector_type(16))) float;
using s16x4 = __attribute__((ext_vector_type(4))) short;
constexpr int NW = 8, QBLK = 32, KVBLK = 64, LD = 512;
constexpr int SHM_V = KVBLK * 128 * 2, SHM_K = KVBLK * 64 * 2;
constexpr int NSL = 4;
constexpr int SHM_ATTN = NSL * SHM_V + NSL * SHM_K + NW * 64 * 4;
constexpr int ATT_QF = SHM_ATTN;
constexpr int ATT_STG = 0;
constexpr float THR = 8.f;
#define KSWZ64(row, colB) ((row) * 128 + ((colB) ^ ((((row) >> 1) & 7) << 4)))
#define SBAR() __builtin_amdgcn_sched_barrier(0)
__device__ __forceinline__ int crow(int r, int hi) { return (r & 3) + 8 * (r >> 2) + 4 * hi; }
__device__ __forceinline__ unsigned cvtpk(float lo, float hi) { unsigned r; asm volatile("v_cvt_pk_bf16_f32 %0, %1, %2" : "=v"(r) : "v"(lo), "v"(hi)); return r; }
template <bool FIRST> __device__ __forceinline__ void partialSM(f32x16& p0, f32x16& p1, float& m_reg, float& alpha) {
  constexpr float THR2 = THR * 1.4426950408889634f;
  float pmax = p0[0];
#pragma unroll
  for (int r = 1; r < 16; ++r) pmax = fmaxf(pmax, p0[r]);
#pragma unroll
  for (int r = 0; r < 16; ++r) pmax = fmaxf(pmax, p1[r]);
  { auto rr = __builtin_amdgcn_permlane32_swap(__float_as_uint(pmax), __float_as_uint(pmax), false, false);
    pmax = fmaxf(__uint_as_float(rr[0]), __uint_as_float(rr[1])); }
  if (!FIRST && __builtin_expect(__all(pmax <= THR2), 1)) { alpha = 1.f; }
  else { const float dl = FIRST ? pmax : fmaxf(pmax, 0.f); m_reg += dl; alpha = FIRST ? 1.f : __builtin_amdgcn_exp2f(-dl);
#pragma unroll
    for (int r = 0; r < 16; ++r) { p0[r] -= dl; p1[r] -= dl; } }
#pragma unroll
  for (int r = 0; r < 16; ++r) p0[r] = __builtin_amdgcn_exp2f(p0[r]);
}
__device__ __forceinline__ void finishSM(f32x16& p0, f32x16& p1, float alpha, float& l_reg, bf16x8& pa0, bf16x8& pa1, bf16x8& pa2, bf16x8& pa3) {
#pragma unroll
  for (int r = 0; r < 16; ++r) p1[r] = __builtin_amdgcn_exp2f(p1[r]);
  float ps = 0;
#pragma unroll
  for (int r = 0; r < 16; ++r) ps += p0[r];
#pragma unroll
  for (int r = 0; r < 16; ++r) ps += p1[r];
  { auto rr = __builtin_amdgcn_permlane32_swap(__float_as_uint(ps), __float_as_uint(ps), false, false);
    ps = __uint_as_float(rr[0]) + __uint_as_float(rr[1]); }
  l_reg = l_reg * alpha + ps;
#define PK4(P, BASE, OUT) do { unsigned a0 = cvtpk(P[BASE + 0], P[BASE + 1]), a1 = cvtpk(P[BASE + 2], P[BASE + 3]);   \
    unsigned b0 = cvtpk(P[BASE + 4], P[BASE + 5]), b1 = cvtpk(P[BASE + 6], P[BASE + 7]);                              \
    auto r0 = __builtin_amdgcn_permlane32_swap(a0, b0, false, false); auto r1 = __builtin_amdgcn_permlane32_swap(a1, b1, false, false); \
    u32x4 w = {r0[0], r1[0], r0[1], r1[1]}; OUT = *reinterpret_cast<bf16x8*>(&w); } while (0)
  PK4(p0, 0, pa0); PK4(p0, 8, pa1); PK4(p1, 0, pa2); PK4(p1, 8, pa3);
#undef PK4
}
__device__ __forceinline__ void qkt(f32x16& p0, f32x16& p1, const char* Ks, const char* ql, float negm, int r32, int hi) {
#pragma unroll
  for (int r = 0; r < 16; ++r) { p0[r] = negm; p1[r] = negm; }
#pragma unroll
  for (int d0 = 0; d0 < 4; ++d0) { const int cb = (d0 * 16 + hi * 8) * 2;
    const bf16x8 qf = *reinterpret_cast<const bf16x8*>(ql + d0 * 1024);
    const bf16x8 b0 = *reinterpret_cast<const bf16x8*>(Ks + KSWZ64(r32, cb));
    const bf16x8 b1 = *reinterpret_cast<const bf16x8*>(Ks + KSWZ64(32 + r32, cb));
    p0 = __builtin_amdgcn_mfma_f32_32x32x16_bf16(b0, qf, p0, 0, 0, 0);
    p1 = __builtin_amdgcn_mfma_f32_32x32x16_bf16(b1, qf, p1, 0, 0, 0); }
}
__device__ __forceinline__ int v_st(int k, int c) { const int kk = (k & ~0xC) | ((k & 4) << 1) | ((k & 8) >> 1); return ((kk >> 3) * 4 + (c >> 5)) * 512 + ((kk & 7) * 32 + (c & 31)) * 2; }
__device__ __forceinline__ int v_rd_base(int lane) { return ((lane & 3) << 3) | (((lane >> 2) & 3) << 6) | (((lane >> 4) & 1) << 5) | (((lane >> 5) & 1) << 8); }
constexpr int v_rd_off(int d0, int ks, int half) { return d0 * 512 + ks * 4096 + half * 2048; }
template <int OFF> __device__ __forceinline__ s16x4 tr_read(int vb) {
  s16x4 r; asm volatile("ds_read_b64_tr_b16 %0, %1 offset:%2" : "=&v"(r) : "v"(vb), "i"(OFF) : "memory"); return r;
}
#define PKV(L, H) (bf16x8){L[0], L[1], L[2], L[3], H[0], H[1], H[2], H[3]}
#define PV_R(X0, X1, X2, X3, D0, HF) do { X0 = tr_read<v_rd_off(D0, 2 * (HF), 0)>(vb); X1 = tr_read<v_rd_off(D0, 2 * (HF), 1)>(vb); \
    X2 = tr_read<v_rd_off(D0, 2 * (HF) + 1, 0)>(vb); X3 = tr_read<v_rd_off(D0, 2 * (HF) + 1, 1)>(vb); } while (0)
#define PV_M(X0, X1, X2, X3, D0, PA, PB) do { o[D0] = __builtin_amdgcn_mfma_f32_32x32x16_bf16(PA, PKV(X0, X1), o[D0], 0, 0, 0); \
    o[D0] = __builtin_amdgcn_mfma_f32_32x32x16_bf16(PB, PKV(X2, X3), o[D0], 0, 0, 0); } while (0)
#define PV_W(N) do { asm volatile("s_waitcnt lgkmcnt(" #N ")" ::: "memory"); SBAR(); } while (0)
__device__ __forceinline__ void pv_d0(f32x16* o, int vb, bf16x8 pa0, bf16x8 pa1, bf16x8 pa2, bf16x8 pa3) {
  s16x4 a0, a1, a2, a3, b0, b1, b2, b3;
  PV_R(a0, a1, a2, a3, 0, 0); PV_R(b0, b1, b2, b3, 0, 1);
  PV_W(4); PV_M(a0, a1, a2, a3, 0, pa0, pa1); SBAR(); PV_R(a0, a1, a2, a3, 1, 0);
  PV_W(4); PV_M(b0, b1, b2, b3, 0, pa2, pa3); SBAR(); PV_R(b0, b1, b2, b3, 1, 1);
  PV_W(4); PV_M(a0, a1, a2, a3, 1, pa0, pa1); SBAR(); PV_R(a0, a1, a2, a3, 2, 0);
  PV_W(4); PV_M(b0, b1, b2, b3, 1, pa2, pa3); SBAR(); PV_R(b0, b1, b2, b3, 2, 1);
  PV_W(4); PV_M(a0, a1, a2, a3, 2, pa0, pa1); SBAR(); PV_R(a0, a1, a2, a3, 3, 0);
  PV_W(4); PV_M(b0, b1, b2, b3, 2, pa2, pa3); SBAR(); PV_R(b0, b1, b2, b3, 3, 1);
  PV_W(4); PV_M(a0, a1, a2, a3, 3, pa0, pa1); SBAR();
  PV_W(0); PV_M(b0, b1, b2, b3, 3, pa2, pa3);
}
#undef PKV
__device__ __forceinline__ void attn_unit(int bh, int qb, const unsigned char* __restrict__ ws, int unit,
                                          float lam, const float* __restrict__ sg, char* lds) {
  const int tid = threadIdx.x, lane = tid & 63, r32 = lane & 31, hi = lane >> 5;
  const int wid = __builtin_amdgcn_readfirstlane(tid >> 6);
  const int b = bh >> 2, h = bh & 3;
  char* V_lds = lds; char* K_lds = lds + NSL * SHM_V;
  float* wsf = (float*)(lds + NSL * SHM_V + NSL * SHM_K) + wid * 64; float* li_l = wsf; float* al_l = wsf + 32;
  const unsigned row0 = (unsigned)b * SEQ; const int q0 = qb * 256;
  const unsigned char* Vh = ws + WS_V + ((size_t)row0 * LD + h * 128) * 2;
  const int sr = tid >> 4, sc = (tid & 15) * 8, vst0 = v_st(sr, sc);
  constexpr int vst1d = 8192;
  const unsigned voffV = (unsigned)(sr * LD + sc) * 2u, voffK = (unsigned)((tid >> 3) * LD + (tid & 7) * 8) * 2u;
  const int kst = KSWZ64(tid >> 3, (tid & 7) * 16);
  const int vb0 = (int)(uintptr_t)V_lds + v_rd_base(lane);
  constexpr int NT = SEQ / KVBLK;
  constexpr unsigned TILEB = KVBLK * LD * 2;
  for (int mp = 0; mp < 2; ++mp) {
    const unsigned char* Kh = ws + WS_K + ((size_t)row0 * LD + h * 128 + mp * 64) * 2;
    const __amdgpu_buffer_rsrc_t rsK = __builtin_amdgcn_make_buffer_rsrc((void*)Kh, (short)0, SEQ * LD * 2, 0x00020000);
    const __amdgpu_buffer_rsrc_t rsV = __builtin_amdgcn_make_buffer_rsrc((void*)Vh, (short)0, SEQ * LD * 2, 0x00020000);
    float m_reg = 0.f, l_reg = 0; f32x16 o[4] = {};
    char* ql = lds + ATT_QF + wid * 4096 + lane * 16;
    { const unsigned char* Qb = ws + WS_Q + ((size_t)(row0 + q0 + wid * QBLK) * LD + h * 128 + mp * 64) * 2;
      int tq = lane; asm volatile("" : "+v"(tq));
      const unsigned qoff = (unsigned)((tq & 31) * LD + (tq >> 5) * 8) * 2u;
#pragma unroll
      for (int d0 = 0; d0 < 4; ++d0) *reinterpret_cast<bf16x8*>(ql + d0 * 1024) = *reinterpret_cast<const bf16x8*>(Qb + qoff + d0 * 32); }
    struct { bf16x8 vs0, vs1, ks0; } sr_[2];
#define SLOAD(i, t) do { const unsigned so_ = (unsigned)(t) * TILEB; \
    sr_[i].vs0 = __builtin_bit_cast(bf16x8, __builtin_amdgcn_raw_buffer_load_b128(rsV, voffV, so_, 0)); \
    sr_[i].vs1 = __builtin_bit_cast(bf16x8, __builtin_amdgcn_raw_buffer_load_b128(rsV, voffV + 32 * LD * 2, so_, 0)); \
    sr_[i].ks0 = __builtin_bit_cast(bf16x8, __builtin_amdgcn_raw_buffer_load_b128(rsK, voffK, so_, 0)); } while (0)
#define SWRITE(bb, i) do { *(bf16x8*)(V_lds + (bb) * SHM_V + vst0) = sr_[i].vs0; *(bf16x8*)(V_lds + (bb) * SHM_V + vst0 + vst1d) = sr_[i].vs1; \
    *(bf16x8*)(K_lds + (bb) * SHM_K + kst) = sr_[i].ks0; } while (0)
#define SWAIT() asm volatile("s_waitcnt vmcnt(3)" ::: "memory")
#define RESC(a) do { if (__any((a) < 1.f)) { if (hi == 0) al_l[r32] = (a); asm volatile("s_waitcnt lgkmcnt(0)" ::: "memory"); \
    _Pragma("unroll") for (int d = 0; d < 4; ++d) _Pragma("unroll") for (int r = 0; r < 16; ++r) o[d][r] *= al_l[crow(r, hi)]; } } while (0)
    f32x16 pA0, pA1, pB0, pB1; float alA, alB; bf16x8 pa0, pa1, pa2, pa3;
    int s_pp = 0, s_prev = 0, s_cur = 1, s_next = 2;
#define ROT() do { s_pp = s_prev; s_prev = s_cur; s_cur = s_next; s_next = (s_next + 1) & (NSL - 1); } while (0)
    SLOAD(0, 0); asm volatile("s_waitcnt vmcnt(0)" ::: "memory"); SWRITE(0, 0); __syncthreads();
    if (wid < 4) {
      qkt(pA0, pA1, K_lds, ql, -m_reg, r32, hi); partialSM<true>(pA0, pA1, m_reg, alA);
      SLOAD(1, 1); SLOAD(0, 2);
      SWAIT(); SWRITE(1, 1); __syncthreads();
      for (int j = 1; j + 1 < NT; j += 2) {
        SBAR(); qkt(pB0, pB1, K_lds + s_cur * SHM_K, ql, -m_reg, r32, hi);
        finishSM(pA0, pA1, alA, l_reg, pa0, pa1, pa2, pa3); SBAR();
        SLOAD(1, j + 2); SBAR();
        pv_d0(o, vb0 + s_prev * SHM_V, pa0, pa1, pa2, pa3); partialSM<false>(pB0, pB1, m_reg, alB);
        SWAIT(); SWRITE(s_next, 0);
        RESC(alB); __syncthreads(); ROT();
        SBAR(); qkt(pA0, pA1, K_lds + s_cur * SHM_K, ql, -m_reg, r32, hi);
        finishSM(pB0, pB1, alB, l_reg, pa0, pa1, pa2, pa3); SBAR();
        if (j + 3 < NT) SLOAD(0, j + 3); SBAR();
        pv_d0(o, vb0 + s_prev * SHM_V, pa0, pa1, pa2, pa3); partialSM<false>(pA0, pA1, m_reg, alA);
        SWAIT(); SWRITE(s_next, 1);
        RESC(alA); __syncthreads(); ROT();
      }
      SBAR(); qkt(pB0, pB1, K_lds + s_cur * SHM_K, ql, -m_reg, r32, hi);
      finishSM(pA0, pA1, alA, l_reg, pa0, pa1, pa2, pa3); SBAR();
      pv_d0(o, vb0 + s_prev * SHM_V, pa0, pa1, pa2, pa3); partialSM<false>(pB0, pB1, m_reg, alB);
      RESC(alB);
      finishSM(pB0, pB1, alB, l_reg, pa0, pa1, pa2, pa3); SBAR();
      pv_d0(o, vb0 + s_cur * SHM_V, pa0, pa1, pa2, pa3);
    } else {
      qkt(pA0, pA1, K_lds, ql, -m_reg, r32, hi);
      SLOAD(1, 1); SLOAD(0, 2);
      SWAIT(); SWRITE(1, 1); __syncthreads();
      SBAR(); partialSM<true>(pA0, pA1, m_reg, alA);
      SBAR(); SLOAD(1, 3); SBAR();
      qkt(pB0, pB1, K_lds + s_cur * SHM_K, ql, -m_reg, r32, hi);
      finishSM(pA0, pA1, alA, l_reg, pa0, pa1, pa2, pa3); SBAR();
      SWAIT(); SWRITE(s_next, 0);
      __syncthreads(); ROT();
      for (int j = 2; j + 2 < NT; j += 2) {
        SBAR(); pv_d0(o, vb0 + s_pp * SHM_V, pa0, pa1, pa2, pa3); partialSM<false>(pB0, pB1, m_reg, alB); RESC(alB);
        SBAR(); SLOAD(0, j + 2); SBAR();
        qkt(pA0, pA1, K_lds + s_cur * SHM_K, ql, -m_reg, r32, hi);
        finishSM(pB0, pB1, alB, l_reg, pa0, pa1, pa2, pa3); SBAR();
        SWAIT(); SWRITE(s_next, 1);
        __syncthreads(); ROT();
        SBAR(); pv_d0(o, vb0 + s_pp * SHM_V, pa0, pa1, pa2, pa3); partialSM<false>(pA0, pA1, m_reg, alA); RESC(alA);
        SBAR(); SLOAD(1, j + 3); SBAR();
        qkt(pB0, pB1, K_lds + s_cur * SHM_K, ql, -m_reg, r32, hi);
        finishSM(pA0, pA1, alA, l_reg, pa0, pa1, pa2, pa3); SBAR();
        SWAIT(); SWRITE(s_next, 0);
        __syncthreads(); ROT();
      }
      SBAR(); pv_d0(o, vb0 + s_pp * SHM_V, pa0, pa1, pa2, pa3); partialSM<false>(pB0, pB1, m_reg, alB); RESC(alB);
      SBAR(); qkt(pA0, pA1, K_lds + s_cur * SHM_K, ql, -m_reg, r32, hi);
      finishSM(pB0, pB1, alB, l_reg, pa0, pa1, pa2, pa3); SBAR();
      SWAIT(); SWRITE(s_next, 1);
      __syncthreads(); ROT();
      SBAR(); pv_d0(o, vb0 + s_pp * SHM_V, pa0, pa1, pa2, pa3); partialSM<false>(pA0, pA1, m_reg, alA); RESC(alA);
      SBAR(); qkt(pB0, pB1, K_lds + s_cur * SHM_K, ql, -m_reg, r32, hi);
      finishSM(pA0, pA1, alA, l_reg, pa0, pa1, pa2, pa3); SBAR();
      pv_d0(o, vb0 + s_prev * SHM_V, pa0, pa1, pa2, pa3); partialSM<false>(pB0, pB1, m_reg, alB); RESC(alB);
      finishSM(pB0, pB1, alB, l_reg, pa0, pa1, pa2, pa3); SBAR();
      pv_d0(o, vb0 + s_cur * SHM_V, pa0, pa1, pa2, pa3);
    }
#undef ROT
    __syncthreads();
    if (hi == 0) li_l[r32] = l_reg; asm volatile("s_waitcnt lgkmcnt(0)" ::: "memory");
    float rli[16];
#pragma unroll
    for (int r = 0; r < 16; ++r) rli[r] = __builtin_amdgcn_rcpf(li_l[crow(r, hi)]);
    int t2 = tid; asm volatile("" : "+v"(t2));
    const int lane2 = t2 & 63, wid2 = __builtin_amdgcn_readfirstlane(t2 >> 6);
    f32x4* st = (f32x4*)((unsigned char*)ws + WS_O0) + ((size_t)unit * 512 + t2) * 16;
    if (mp == 0) {
#pragma unroll
      for (int d0 = 0; d0 < 4; ++d0)
#pragma unroll
        for (int r4 = 0; r4 < 4; ++r4) st[d0 * 4 + r4] = (f32x4){o[d0][4 * r4] * rli[4 * r4], o[d0][4 * r4 + 1] * rli[4 * r4 + 1], o[d0][4 * r4 + 2] * rli[4 * r4 + 2], o[d0][4 * r4 + 3] * rli[4 * r4 + 3]};
    } else {
      float ss[16];
#pragma unroll
      for (int r = 0; r < 16; ++r) ss[r] = 0.f;
#pragma unroll
      for (int d0 = 0; d0 < 4; ++d0)
#pragma unroll
        for (int r4 = 0; r4 < 4; ++r4) { const f32x4 o0 = st[d0 * 4 + r4];
#pragma unroll
          for (int i = 0; i < 4; ++i) { const int r = 4 * r4 + i; const float v = o0[i] - lam * (o[d0][r] * rli[r]); o[d0][r] = v; ss[r] += v * v; } }
#pragma unroll
      for (int r = 0; r < 16; ++r) {
#pragma unroll
        for (int of = 1; of < 32; of <<= 1) ss[r] += __shfl_xor(ss[r], of);
        ss[r] = rsqrtf(ss[r] * (1.f / 128.f) + LN_EPS) * (1.f - LAMBDA_INIT); }
      bf16_t* stg = (bf16_t*)(lds + ATT_STG + wid2 * 8704);
      const int r32b = lane2 & 31, hib = lane2 >> 5;
#pragma unroll
      for (int d0 = 0; d0 < 4; ++d0) { const float g = sg[d0 * 32 + r32b];
#pragma unroll
        for (int r = 0; r < 16; ++r) stg[crow(r, hib) * 136 + d0 * 32 + r32b] = f2bf(o[d0][r] * ss[r] * g); }
      asm volatile("s_waitcnt lgkmcnt(0)" ::: "memory");
      const int orow = lane2 >> 1, oh = lane2 & 1;
      bf16_t* yw = (bf16_t*)((unsigned char*)ws + WS_YA) + ((size_t)(row0 + q0 + wid2 * QBLK + orow) * 1024 + h * 128 + oh * 64);
#pragma unroll
      for (int i = 0; i < 8; ++i) *(u32x4*)(yw + i * 8) = *(const u32x4*)(stg + orow * 136 + oh * 64 + i * 8);
    }
    __syncthreads();
#undef SLOAD
#undef SWRITE
#undef SWAIT
#undef RESC
  }
}
#undef SBAR
}
__device__ __forceinline__ void ph_ln1(int bid, int nb, float* __restrict__ x1, const float* __restrict__ g, const float* __restrict__ bb, bf16_t* __restrict__ x1b) {
  const int lane = threadIdx.x & 63;
  for (int t0 = (bid * 8 + (threadIdx.x >> 6)) * 2; t0 < T; t0 += nb * 16) {
    float4 v[2][4]; float s[2] = {0.f, 0.f};
#pragma unroll
    for (int r = 0; r < 2; ++r) { const float4* xr = (const float4*)(x1 + (size_t)(t0 + r) * DM);
#pragma unroll
      for (int j = 0; j < 4; ++j) { v[r][j] = xr[lane + 64 * j]; s[r] += (v[r][j].x + v[r][j].y) + (v[r][j].z + v[r][j].w); } }
#pragma unroll
    for (int r = 0; r < 2; ++r) {
      const float mu = wave_sum(s[r]) * (1.f / DM); float q = 0.f;
#pragma unroll
      for (int j = 0; j < 4; ++j) { v[r][j].x -= mu; v[r][j].y -= mu; v[r][j].z -= mu; v[r][j].w -= mu; q += (v[r][j].x * v[r][j].x + v[r][j].y * v[r][j].y) + (v[r][j].z * v[r][j].z + v[r][j].w * v[r][j].w); }
      const float rs = rsqrtf(wave_sum(q) * (1.f / DM) + LN_EPS);
      float4* xo = (float4*)(x1 + (size_t)(t0 + r) * DM);
#pragma unroll
      for (int j = 0; j < 4; ++j) { const float4 gg = ((const float4*)g)[lane + 64 * j], b4 = ((const float4*)bb)[lane + 64 * j];
        float4 o; o.x = v[r][j].x * rs * gg.x + b4.x; o.y = v[r][j].y * rs * gg.y + b4.y; o.z = v[r][j].z * rs * gg.z + b4.z; o.w = v[r][j].w * rs * gg.w + b4.w;
        xo[lane + 64 * j] = o; u32x2 w; w.x = pk2(o.x, o.y); w.y = pk2(o.z, o.w); *(u32x2*)(x1b + (size_t)(t0 + r) * DM + 4 * (lane + 64 * j)) = w; }
    }
  }
}

constexpr size_t WS_TU8 = 128 * MB, WS_SU = 160 * MB, WS_SV = 160 * MB + 65536;
constexpr int REC6 = 1536;
typedef float f32x2v __attribute__((ext_vector_type(2)));
__device__ __forceinline__ unsigned f2ord(float f) { const unsigned u = __float_as_uint(f); return (u & 0x80000000u) ? ~u : (u | 0x80000000u); }
__device__ __forceinline__ float ord2f(unsigned o) { const unsigned u = (o & 0x80000000u) ? (o & 0x7fffffffu) : ~o; return __uint_as_float(u); }
template <int CTRL, int RM> __device__ __forceinline__ float dppf(float s) { return __uint_as_float(__builtin_amdgcn_update_dpp(0u, __float_as_uint(s), CTRL, RM, 0xf, true)); }
__device__ __forceinline__ float readlane_f(float v, int l) { return __uint_as_float((unsigned)__builtin_amdgcn_readlane((int)__float_as_uint(v), l)); }
__device__ __forceinline__ float wave_sum63(float v) {
  v += dppf<0xB1, 0xf>(v); v += dppf<0x4E, 0xf>(v); v += dppf<0x141, 0xf>(v); v += dppf<0x140, 0xf>(v);
  v += dppf<0x142, 0xA>(v); v += dppf<0x143, 0xC>(v);
  return v;
}
__device__ __forceinline__ float gelu_erf(float v) {
  const float t = __builtin_amdgcn_rcpf(fabsf(v) * 0.2316418882f + 1.0f);
  float q = t * 0.5307027145f + (-0.7265760135f); q = q * t + 0.7107068705f; q = q * t + (-0.142248368f); q = q * t + 0.127414796f; q = q * t;
  const float m = v * (q * __builtin_amdgcn_exp2f((v * v) * (-0.72134752044f)));
  return v < 0.f ? m : v - m;
}
__device__ __forceinline__ unsigned fp6_code(float a) {
  const float m = fabsf(a);
  const float c = m < 2.f ? __builtin_rintf(m * 8.f) : (m < 4.f ? __builtin_rintf(m * 4.f) + 8.f : __builtin_rintf(m * 2.f) + 16.f);
  const unsigned code = (unsigned)fminf(c, 31.f);
  return a < 0.f ? (code | 32u) : code;
}
struct U3 { unsigned x, y, z; };
__device__ __forceinline__ U3 fp6_pack16(const float4 (&v)[4], float inv) {
  unsigned f[16];
#pragma unroll
  for (int c = 0; c < 4; ++c) { f[4 * c] = fp6_code(v[c].x * inv); f[4 * c + 1] = fp6_code(v[c].y * inv); f[4 * c + 2] = fp6_code(v[c].z * inv); f[4 * c + 3] = fp6_code(v[c].w * inv); }
  U3 o;
  o.x = f[0] | (f[1] << 6) | (f[2] << 12) | (f[3] << 18) | (f[4] << 24) | (f[5] << 30);
  o.y = (f[5] >> 2) | (f[6] << 4) | (f[7] << 10) | (f[8] << 16) | (f[9] << 22) | (f[10] << 28);
  o.z = (f[10] >> 4) | (f[11] << 2) | (f[12] << 8) | (f[13] << 14) | (f[14] << 20) | (f[15] << 26);
  return o;
}
__device__ __forceinline__ void ph_ln1_tab8(int bid, int nb, float* __restrict__ x1, const float* __restrict__ g, const float* __restrict__ bb, bf16_t* __restrict__ x1b,
                                            const float* __restrict__ pu, const float* __restrict__ pv, unsigned char* ws) {
  const int lane = threadIdx.x & 63, gw = bid * 8 + (threadIdx.x >> 6), ngw = nb * 8;
  int t0 = gw * 2, r4 = gw * 4;
  for (; t0 < T || r4 < 32768; t0 += ngw * 2, r4 += ngw * 4) {
    const bool do_ln = t0 < T, do_tb = r4 < 32768;
    float4 v[2][4], va[4][4];
    if (do_ln) {
#pragma unroll
      for (int r = 0; r < 2; ++r) { const u32x2* xr = (const u32x2*)((const bf16_t*)x1 + (size_t)(t0 + r) * DM);
#pragma unroll
        for (int j = 0; j < 4; ++j) { const u32x2 a = xr[lane + 64 * j]; v[r][j] = make_float4(__uint_as_float(a.x << 16), __uint_as_float(a.x & 0xffff0000u), __uint_as_float(a.y << 16), __uint_as_float(a.y & 0xffff0000u)); } } }
    if (do_tb) {
#pragma unroll
      for (int i = 0; i < 4; ++i) { const int r = r4 + i, which = r >> 14, row = r & 16383; const float4* src = (const float4*)((which ? pv : pu) + (size_t)row * DM) + 128 * (lane & 1) + (lane >> 1);
#pragma unroll
        for (int c = 0; c < 4; ++c) va[i][c] = src[32 * c]; } }
    if (do_ln) {
#pragma unroll
      for (int r = 0; r < 2; ++r) { float sm = 0.f;
#pragma unroll
        for (int j = 0; j < 4; ++j) sm += (v[r][j].x + v[r][j].y) + (v[r][j].z + v[r][j].w);
        const float mu = wave_sum(sm) * (1.f / DM); float q = 0.f;
#pragma unroll
        for (int j = 0; j < 4; ++j) { v[r][j].x -= mu; v[r][j].y -= mu; v[r][j].z -= mu; v[r][j].w -= mu; q += (v[r][j].x * v[r][j].x + v[r][j].y * v[r][j].y) + (v[r][j].z * v[r][j].z + v[r][j].w * v[r][j].w); }
        const float rs = rsqrtf(wave_sum(q) * (1.f / DM) + LN_EPS);
#pragma unroll
        for (int j = 0; j < 4; ++j) { const float4 gg = ((const float4*)g)[lane + 64 * j], b4 = ((const float4*)bb)[lane + 64 * j];
          float4 o; o.x = v[r][j].x * rs * gg.x + b4.x; o.y = v[r][j].y * rs * gg.y + b4.y; o.z = v[r][j].z * rs * gg.z + b4.z; o.w = v[r][j].w * rs * gg.w + b4.w;
          u32x2 w; w.x = pk2(o.x, o.y); w.y = pk2(o.z, o.w); *(u32x2*)(x1b + (size_t)(t0 + r) * DM + 4 * (lane + 64 * j)) = w; } } }
    if (do_tb) {
#pragma unroll
      for (int i = 0; i < 4; ++i) { const int r = r4 + i, which = r >> 14, row = r & 16383;
        float mx = 0.f;
#pragma unroll
        for (int c = 0; c < 4; ++c) mx = fmaxf(mx, fmaxf(fmaxf(fabsf(va[i][c].x), fabsf(va[i][c].y)), fmaxf(fabsf(va[i][c].z), fabsf(va[i][c].w))));
        mx = wave_max(mx);
        const float scale = fmaxf(mx, 1e-30f) * (1.f / 7.5f), inv = 1.f / scale;
        { const U3 o = fp6_pack16(va[i], inv); unsigned char* rec = ws + WS_TU8 + (size_t)row * REC6 + which * 768;
          if ((lane & 1) == 0) *(U3*)(rec + 16 * (lane >> 1)) = o;
          else { *(unsigned*)(rec + 16 * (lane >> 1) + 12) = o.x; u32x2 q; q.x = o.y; q.y = o.z; *(u32x2*)(rec + 512 + 8 * (lane >> 1)) = q; } }
        if (lane == 0) ((float*)(ws + (which ? WS_SV : WS_SU)))[row] = scale; } }
  }
}
#define CE_D(a, b) do { const unsigned hi_ = (a) > (b) ? (a) : (b), lo_ = (a) > (b) ? (b) : (a); (a) = hi_; (b) = lo_; } while (0)
__device__ __forceinline__ void merge16_desc(unsigned* m) {
#pragma unroll
  for (int j = 8; j > 0; j >>= 1)
#pragma unroll
    for (int i = 0; i < 16; ++i) { const int l = i ^ j; if (l > i) CE_D(m[i], m[l]); }
}
__device__ __forceinline__ void sort16_desc(unsigned* k) {
#pragma unroll
  for (int kk = 2; kk <= 16; kk <<= 1)
#pragma unroll
    for (int j = kk >> 1; j > 0; j >>= 1)
#pragma unroll
      for (int i = 0; i < 16; ++i) { const int l = i ^ j; if (l > i) { if ((i & kk) == 0) CE_D(k[i], k[l]); else CE_D(k[l], k[i]); } }
}
__device__ __forceinline__ void top16_of_64(unsigned* k, unsigned* out) {
  sort16_desc(k); sort16_desc(k + 16); sort16_desc(k + 32); sort16_desc(k + 48);
  unsigned m1[16];
#pragma unroll
  for (int i = 0; i < 16; ++i) { out[i] = k[i] > k[31 - i] ? k[i] : k[31 - i]; m1[i] = k[32 + i] > k[63 - i] ? k[32 + i] : k[63 - i]; }
  merge16_desc(out); merge16_desc(m1);
#pragma unroll
  for (int i = 0; i < 16; ++i) out[i] = out[i] > m1[15 - i] ? out[i] : m1[15 - i];
  merge16_desc(out);
}
constexpr int pairs_before(int r, int c) { int n = 0; for (int rr = 0; rr < 16; ++rr) for (int cc = 0; cc < 16; ++cc) { if (rr == r && cc == c) return n; if ((rr + 1) * (cc + 1) <= 16) ++n; } return n; }
constexpr int PEER_TB = 32;
constexpr int PL_SK = 0, PL_LIST = 2 * 128 * 136 * 2, PL_LBUF = PEER_TB * 128 * 8, PL_IDX = PL_LIST + 2 * PL_LBUF;
__device__ __forceinline__ void peer_select_tile(int t0, int lb, unsigned char* lds, const bf16_t* __restrict__ qp) {
  using f32x16 = att::f32x16;
  int lane = threadIdx.x & 63; asm volatile("" : "+v"(lane));
  const int r32 = lane & 31, hi = lane >> 5, h = __builtin_amdgcn_readfirstlane(threadIdx.x >> 6);
  const bf16_t* SK = (const bf16_t*)(lds + PL_SK);
  unsigned top[2][16];
#pragma unroll
  for (int p = 0; p < 2; ++p) {
    f32x16 acc[4] = {};
    const bf16_t* qrow = qp + (size_t)(t0 + r32) * 2048 + h * 256 + p * 128 + hi * 8;
    bf16x8 qf[8];
#pragma unroll
    for (int ks = 0; ks < 8; ++ks) qf[ks] = *(const bf16x8*)(qrow + ks * 16);
#pragma unroll
    for (int ks = 0; ks < 8; ++ks) {
#pragma unroll
      for (int nt = 0; nt < 4; ++nt) { const bf16x8 kf = *(const bf16x8*)(SK + (p * 128 + nt * 32 + r32) * 136 + ks * 16 + hi * 8);
        acc[nt] = __builtin_amdgcn_mfma_f32_32x32x16_bf16(kf, qf[ks], acc[nt], 0, 0, 0); }
      __builtin_amdgcn_sched_barrier(0); }
    unsigned k[64];
#pragma unroll
    for (int nt = 0; nt < 4; ++nt)
#pragma unroll
      for (int r = 0; r < 16; ++r) k[nt * 16 + r] = (f2ord(acc[nt][r]) & 0xffffff80u) | (unsigned)(nt * 32 + (r & 3) + 8 * (r >> 2) + 4 * hi);
    unsigned own[16]; top16_of_64(k, own);
    unsigned X[16], Y[16];
#pragma unroll
    for (int i = 0; i < 16; ++i) { auto rr = __builtin_amdgcn_permlane32_swap(own[i], own[i], false, false); X[i] = rr[0]; Y[i] = rr[1]; }
#pragma unroll
    for (int i = 0; i < 16; ++i) top[p][i] = X[i] > Y[15 - i] ? X[i] : Y[15 - i];
    merge16_desc(top[p]);
  }
  float sa[16], sb[16];
#pragma unroll
  for (int i = 0; i < 16; ++i) { sa[i] = ord2f(top[0][i] & 0xffffff80u); sb[i] = ord2f(top[1][i] & 0xffffff80u); }
  unsigned ck[64];
#pragma unroll
  for (int i = 0; i < 64; ++i) ck[i] = 0u;
#pragma unroll
  for (int r = 0; r < 16; ++r)
#pragma unroll
    for (int c = 0; c < 16; ++c) if ((r + 1) * (c + 1) <= 16) ck[pairs_before(r, c)] = (f2ord(sa[r] + sb[c]) & 0xffffff00u) | (unsigned)(r * 16 + c);
  unsigned win[16]; top16_of_64(ck, win);
  unsigned char* slot = lds + PL_IDX + ((threadIdx.x >> 6) * 32 + r32) * 32;
  u32x4 ia, ib;
#pragma unroll
  for (int q4 = 0; q4 < 4; ++q4) { ia[q4] = (top[0][4 * q4] & 127u) | ((top[0][4 * q4 + 1] & 127u) << 8) | ((top[0][4 * q4 + 2] & 127u) << 16) | ((top[0][4 * q4 + 3] & 127u) << 24);
    ib[q4] = (top[1][4 * q4] & 127u) | ((top[1][4 * q4 + 1] & 127u) << 8) | ((top[1][4 * q4 + 2] & 127u) << 16) | ((top[1][4 * q4 + 3] & 127u) << 24); }
  *(u32x4*)slot = ia; *(u32x4*)(slot + 16) = ib;
  asm volatile("s_waitcnt lgkmcnt(0)" ::: "memory");
  const float s0 = ord2f(win[0] & 0xffffff00u);
  float ex[16], sum = 0.f; int ee[16];
#pragma unroll
  for (int j = 0; j < 16; ++j) { const unsigned pr = (win[j] >> 4) & 15u, pc = win[j] & 15u;
    ee[j] = (int)slot[pr] * 128 + (int)slot[16 + pc];
    ex[j] = __expf(ord2f(win[j] & 0xffffff00u) - s0); sum += ex[j]; }
  const float inv = 1.f / sum;
  if (hi == 0) { u32x2* L = (u32x2*)(lds + PL_LIST + lb * PL_LBUF) + r32 * 128 + h * 16;
#pragma unroll
    for (int j = 0; j < 16; ++j) L[j] = (u32x2){(unsigned)ee[j], __float_as_uint(ex[j] * inv)}; }
}
typedef unsigned u32x6 __attribute__((ext_vector_type(6)));
typedef float f32x32 __attribute__((ext_vector_type(32)));
typedef __bf16 bf16x32v __attribute__((ext_vector_type(32)));
typedef __bf16 bf16x2v __attribute__((ext_vector_type(2)));
__device__ __forceinline__ void peer_expert_tok(int t, int tl, int lb, unsigned char* lds, const unsigned char* __restrict__ ws, float* __restrict__ x1io, const float* __restrict__ g2, const float* __restrict__ b2) {
  int lane = threadIdx.x & 63; asm volatile("" : "+v"(lane));
  const int li = lane & 31; const bool hi = lane >= 32;
  unsigned xu[16]; float y[32];
  { const bf16_t* xbr = (const bf16_t*)(ws + WS_X1B) + (size_t)t * DM + li * 4;
#pragma unroll
    for (int c = 0; c < 8; ++c) { const u32x2 a = *(const u32x2*)(xbr + 128 * c); xu[2 * c] = a.x; xu[2 * c + 1] = a.y; } }
#pragma unroll
  for (int i = 0; i < 32; ++i) y[i] = 0.f;
  const __amdgpu_buffer_rsrc_t rsT = __builtin_amdgcn_make_buffer_rsrc((void*)(ws + WS_TU8), (short)0, 16384 * REC6, 0x00020000);
  const int voP0 = li * 16, voQ0 = 512 + li * 8;
  const float* SU = (const float*)(ws + WS_SU); const float* SV = (const float*)(ws + WS_SV);
  u32x2* SORT = (u32x2*)(lds + PL_IDX) + (threadIdx.x >> 6) * 128;
  { const u32x2* Lraw = (const u32x2*)(lds + PL_LIST + lb * PL_LBUF) + tl * 128;
    const u32x2 p0 = Lraw[2 * lane], p1 = Lraw[2 * lane + 1];
    const int b0 = (int)(p0.x >> 10), b1 = (int)(p1.x >> 10);
    int base = 0, pos0 = 0, pos1 = 0;
#pragma unroll
    for (int v = 0; v < 16; ++v) {
      const unsigned long long m0 = __ballot(b0 == v), m1 = __ballot(b1 == v);
      const int c0 = __builtin_popcountll(m0), c1 = __builtin_popcountll(m1);
      const int r0 = __builtin_amdgcn_mbcnt_hi((unsigned)(m0 >> 32), __builtin_amdgcn_mbcnt_lo((unsigned)m0, 0u));
      const int r1 = __builtin_amdgcn_mbcnt_hi((unsigned)(m1 >> 32), __builtin_amdgcn_mbcnt_lo((unsigned)m1, 0u));
      if (b0 == v) pos0 = base + r0;
      if (b1 == v) pos1 = base + c0 + r1;
      base += c0 + c1; }
    SORT[pos0] = p0; SORT[pos1] = p1;
    asm volatile("s_waitcnt lgkmcnt(0)" ::: "memory"); }
  const u32x2* L = SORT;
  constexpr int PGS = 4, NPR = PGS / 2;
#define PG_LOAD(UP, UQ, VP, VQ, EL, GL, SUv, SVv, hg) do { const u32x2 eg_ = L[(hg) * PGS + (lane & (PGS - 1))]; EL = (int)eg_.x; GL = __uint_as_float(eg_.y); SUv = SU[EL]; SVv = SV[EL]; \
    _Pragma("unroll") for (int pr = 0; pr < NPR; ++pr) { const int eb_ = (int)L[(hg) * PGS + 2 * pr + (hi ? 1 : 0)].x * REC6; \
      UP[pr] = __builtin_amdgcn_raw_buffer_load_b128(rsT, eb_ + voP0, 0, 0); UQ[pr] = __builtin_amdgcn_raw_buffer_load_b64(rsT, eb_ + voQ0, 0, 0); \
      VP[pr] = __builtin_amdgcn_raw_buffer_load_b128(rsT, eb_ + voP0 + 768, 0, 0); VQ[pr] = __builtin_amdgcn_raw_buffer_load_b64(rsT, eb_ + voQ0 + 768, 0, 0); } } while (0)
#define PG_COMP(UP, UQ, VP, VQ, GL, SUv, SVv) do { float dd_ = 0.f; \
    _Pragma("unroll") for (int pr = 0; pr < NPR; ++pr) { \
      const u32x6 uu_ = {UP[pr].x, UP[pr].y, UP[pr].z, UP[pr].w, UQ[pr].x, UQ[pr].y}; \
      const bf16x32v ub_ = __builtin_amdgcn_cvt_scalef32_pk32_bf16_fp6(uu_, 1.0f); \
      float d0_ = 0.f, d1_ = 0.f; \
      _Pragma("unroll") for (int i = 0; i < 16; i += 2) { \
        const bf16x2v ua_ = {ub_[2 * i], ub_[2 * i + 1]}, uc_ = {ub_[2 * i + 2], ub_[2 * i + 3]}; \
        d0_ = __builtin_amdgcn_fdot2_f32_bf16(ua_, __builtin_bit_cast(bf16x2v, xu[i]), d0_, false); d1_ = __builtin_amdgcn_fdot2_f32_bf16(uc_, __builtin_bit_cast(bf16x2v, xu[i + 1]), d1_, false); } \
      d0_ += d1_; d0_ += dppf<0xB1, 0xf>(d0_); d0_ += dppf<0x4E, 0xf>(d0_); d0_ += dppf<0x141, 0xf>(d0_); d0_ += dppf<0x140, 0xf>(d0_); d0_ += dppf<0x142, 0xA>(d0_);     \
      const float t0_ = readlane_f(d0_, 31), t1_ = readlane_f(d0_, 63); if (lane == 2 * pr) dd_ = t0_; if (lane == 2 * pr + 1) dd_ = t1_; } \
    const float av_ = dd_ * SUv; const float wl_ = GL * gelu_erf(av_) * SVv; \
    _Pragma("unroll") for (int pr = 0; pr < NPR; ++pr) { const float w0_ = readlane_f(wl_, 2 * pr), w1_ = readlane_f(wl_, 2 * pr + 1); const float w_ = hi ? w1_ : w0_; \
      const u32x6 vv_ = {VP[pr].x, VP[pr].y, VP[pr].z, VP[pr].w, VQ[pr].x, VQ[pr].y}; \
      const f32x32 vf_ = __builtin_amdgcn_cvt_scalef32_pk32_f32_fp6(vv_, 1.0f); \
      _Pragma("unroll") for (int i = 0; i < 32; ++i) y[i] = __builtin_fmaf(w_, vf_[i], y[i]); \
      __builtin_amdgcn_sched_barrier(0); } } while (0)
  {
    u32x4 upA[NPR], vpA[NPR], upB[NPR], vpB[NPR]; u32x2 uqA[NPR], vqA[NPR], uqB[NPR], vqB[NPR]; int elA, elB; float glA, glB, suA, suB, svA, svB;
    PG_LOAD(upA, uqA, vpA, vqA, elA, glA, suA, svA, 0);
    for (int hg = 0; hg < 128 / PGS - 2; hg += 2) {
      PG_LOAD(upB, uqB, vpB, vqB, elB, glB, suB, svB, hg + 1);
      PG_COMP(upA, uqA, vpA, vqA, glA, suA, svA);
      PG_LOAD(upA, uqA, vpA, vqA, elA, glA, suA, svA, hg + 2);
      PG_COMP(upB, uqB, vpB, vqB, glB, suB, svB);
    }
    PG_LOAD(upB, uqB, vpB, vqB, elB, glB, suB, svB, 128 / PGS - 1);
    PG_COMP(upA, uqA, vpA, vqA, glA, suA, svA);
    PG_COMP(upB, uqB, vpB, vqB, glB, suB, svB);
  }
#undef PG_LOAD
#undef PG_COMP
  float yt[16];
#pragma unroll
  for (int k = 0; k < 16; ++k) { auto rr = __builtin_amdgcn_permlane32_swap(__float_as_uint(y[k]), __float_as_uint(y[k + 16]), false, false); yt[k] = __uint_as_float(rr[0]) + __uint_as_float(rr[1]); }
  float s = 0.f;
#pragma unroll
  for (int i = 0; i < 8; ++i) { const unsigned xw = hi ? xu[8 + i] : xu[i];
    yt[2 * i] = ALPHA * __uint_as_float(xw << 16) + yt[2 * i]; yt[2 * i + 1] = ALPHA * __uint_as_float(xw & 0xffff0000u) + yt[2 * i + 1]; s += yt[2 * i] + yt[2 * i + 1]; }
  const float mu = wave_sum(s) * (1.f / DM); float q = 0.f;
#pragma unroll
  for (int i = 0; i < 16; ++i) { yt[i] -= mu; q += yt[i] * yt[i]; }
  const float rs = rsqrtf(wave_sum(q) * (1.f / DM) + LN_EPS);
  int ch0 = (hi ? 512 : 0) + li * 4; asm volatile("" : "+v"(ch0));
  float* xr = x1io + (size_t)t * DM + ch0;
#pragma unroll
  for (int c = 0; c < 4; ++c) { const float4 gg = *(const float4*)(g2 + ch0 + 128 * c), bb = *(const float4*)(b2 + ch0 + 128 * c);
    float4 o; o.x = yt[4 * c] * rs * gg.x + bb.x; o.y = yt[4 * c + 1] * rs * gg.y + bb.y; o.z = yt[4 * c + 2] * rs * gg.z + bb.z; o.w = yt[4 * c + 3] * rs * gg.w + bb.w;
    *(float4*)(xr + 128 * c) = o; }
}
__device__ __forceinline__ void ph_peer(int bid, int nb, unsigned char* lds, unsigned char* ws, const float* __restrict__ subk, float* __restrict__ dout, const float* __restrict__ g2, const float* __restrict__ b2) {
  bf16_t* SK = (bf16_t*)(lds + PL_SK);
  for (int i = threadIdx.x; i < 2 * 128 * 32; i += 512) { const int row = i >> 5, c4 = i & 31; const float4 v = ((const float4*)subk)[i];
    u32x2 w; w.x = pk2(v.x, v.y); w.y = pk2(v.z, v.w); *(u32x2*)(SK + row * 136 + c4 * 4) = w; }
  __syncthreads();
  const int wave = threadIdx.x >> 6;
  const bf16_t* qp = (const bf16_t*)(ws + WS_QP);
  const bool both_first = (bid & 1) != 0;
  for (int tile = bid; tile < T / PEER_TB; tile += 2 * nb) {
    const int ta = tile * PEER_TB, tb = (tile + nb) * PEER_TB; const bool has_b = tile + nb < T / PEER_TB;
    peer_select_tile(ta, 0, lds, qp);
    if (both_first && has_b) peer_select_tile(tb, 1, lds, qp);
    __syncthreads();
    for (int i = 0; i < PEER_TB / 8; ++i) { const int tl = wave * (PEER_TB / 8) + i; peer_expert_tok(ta + tl, tl, 0, lds, ws, dout, g2, b2); }
    if (has_b) {
      if (!both_first) { __syncthreads(); peer_select_tile(tb, 1, lds, qp); __syncthreads(); }
      for (int i = 0; i < PEER_TB / 8; ++i) { const int tl = wave * (PEER_TB / 8) + i; peer_expert_tok(tb + tl, tl, 1, lds, ws, dout, g2, b2); }
    }
    __syncthreads();
  }
}

#define LAS __attribute__((address_space(3)))
#define XB_TMO      128
#define XB_XCNT(j)  (256  + 64 * (j))
#define XB_XSUB(j)  (1280 + 64 * (j))
#define XB_XGEN(j)  (2304 + 64 * (j))
#define XB_TOP      3328
#define XB_TOPGEN   3392
#define XCD_BAR_WORDS 3456
#define XB_SPIN_CAP (1u << 18)

__device__ __forceinline__ unsigned xb_ld(unsigned* p)              { return __hip_atomic_load(p, __ATOMIC_RELAXED, __HIP_MEMORY_SCOPE_AGENT); }
__device__ __forceinline__ unsigned xb_add(unsigned* p, unsigned v) { return __hip_atomic_fetch_add(p, v, __ATOMIC_RELAXED, __HIP_MEMORY_SCOPE_AGENT); }
__device__ __forceinline__ unsigned xb_xcc_id() { return (unsigned)__builtin_amdgcn_s_getreg((3 << 11) | 20) & 0xFu; }
#define XB_SPIN(cond, bar) do { unsigned _sp = 0; while (cond) { __builtin_amdgcn_s_sleep(1); \
    if ((++_sp & 255u) == 0u) { if (xb_ld(&(bar)[XB_TMO])) break; if (_sp > XB_SPIN_CAP) { atomicAdd(&(bar)[XB_TMO], 1u); break; } } } } while (0)

struct XcdBarrier {
    unsigned* bar; unsigned x;
    volatile LAS unsigned* st;
};

__device__ __forceinline__ XcdBarrier xcd_barrier_post(unsigned* bar, volatile LAS unsigned* st) {
    XcdBarrier b; b.bar = bar; b.x = xb_xcc_id(); b.st = st;
    if (threadIdx.x == 0) (void)xb_add(&bar[XB_XCNT(b.x)], 1u);
    return b;
}
__device__ __forceinline__ void xcd_barrier_complete(unsigned* bar, unsigned x, unsigned& nloc, unsigned& nx) {
    const unsigned G = gridDim.x * gridDim.y * gridDim.z;
    unsigned sum, cnt, mine, sp = 0u;
    for (;;) {
        sum = 0u; cnt = 0u; mine = 0u;
#pragma unroll
        for (unsigned j = 0; j < 16; ++j) { const unsigned c = xb_ld(&bar[XB_XCNT(j)]); sum += c; cnt += (c > 0u) ? 1u : 0u; mine = (j == x) ? c : mine; }
        if (sum == G) break;
        __builtin_amdgcn_s_sleep(1);
        if ((++sp & 255u) == 0u) { if (xb_ld(&bar[XB_TMO])) break; if (sp > XB_SPIN_CAP) { atomicAdd(&bar[XB_TMO], 1u); break; } }
    }
    nloc = mine > 0u ? mine : 1u; nx = cnt > 0u ? cnt : 1u;
}

__device__ __forceinline__ void xcd_barrier(const XcdBarrier& b) {
    asm volatile("s_waitcnt vmcnt(0)" ::: "memory");
    __syncthreads();
    if (threadIdx.x == 0) {
        unsigned* bar = b.bar;
        __builtin_amdgcn_s_waitcnt(0);
        unsigned nloc = b.st[0], nx = b.st[1];
        if (nloc == 0u) { xcd_barrier_complete(bar, b.x, nloc, nx); b.st[0] = nloc; b.st[1] = nx; }
        const unsigned old = xb_add(&bar[XB_XSUB(b.x)], 1u);
        const unsigned gen = old / nloc;
        if (old + 1u == (gen + 1u) * nloc) {
            __builtin_amdgcn_fence(__ATOMIC_RELEASE, "agent");
            asm volatile("s_waitcnt vmcnt(0)" ::: "memory");
            const unsigned og = xb_add(&bar[XB_TOP], 1u);
            const unsigned tg = og / nx;
            if (og + 1u == (tg + 1u) * nx) xb_add(&bar[XB_TOPGEN], 1u);
            else XB_SPIN(xb_ld(&bar[XB_TOPGEN]) == tg, bar);
            __builtin_amdgcn_fence(__ATOMIC_ACQUIRE, "agent");
            xb_add(&bar[XB_XGEN(b.x)], 1u);
            asm volatile("s_waitcnt vmcnt(0)" ::: "memory");
        } else {
            XB_SPIN(xb_ld(&bar[XB_XGEN(b.x)]) == gen, bar);
            __builtin_amdgcn_fence(__ATOMIC_ACQUIRE, "agent");
            asm volatile("s_waitcnt vmcnt(0)" ::: "memory");
        }
    }
    __syncthreads();
}

struct KP { const float* in[19]; float* out; unsigned char* ws; int ph_lo, ph_hi; };
constexpr int NPHASE = 10;
#ifndef MK_LAUNCHES
#define MK_LAUNCHES 1
#endif
__global__ __launch_bounds__(512) void mega(KP p) {
  extern __shared__ __attribute__((aligned(16))) unsigned char lds[];
  cg::grid_group grid = cg::this_grid();
  const int bid = blockIdx.x, nb = gridDim.x, lane = threadIdx.x & 63;
  unsigned char* ws = p.ws; unsigned char* dob = (unsigned char*)p.out; float* dout = p.out;
  const float* x = p.in[0]; const float* w_in = p.in[1];
  bf16_t* xb = (bf16_t*)(dob + DO_XB); bf16_t* WinT = (bf16_t*)(dob + DO_WINT); bf16_t* UT = (bf16_t*)dob;
  float* gpre = (float*)(ws + WS_GPRE); float2* cs = (float2*)(ws + WS_CS);
  EP e; e.x = x; e.ws = ws; e.dout = dout; e.cs = cs;
#ifdef ONLY_PH
#define IN(k) ((k) == ONLY_PH && p.ph_lo <= (k) && (k) < p.ph_hi)
#else
#define IN(k) (p.ph_lo <= (k) && (k) < p.ph_hi)
#endif
  volatile LAS unsigned* bst = (volatile LAS unsigned*)((LAS unsigned char*)lds + (LDS_BYTES - 64));
  if (threadIdx.x < 2) bst[threadIdx.x] = 0u;
  __syncthreads();
  const XcdBarrier xbar = xcd_barrier_post((unsigned*)ws, bst);
#define SEAM(k) do { if (IN(k) && IN((k) + 1)) xcd_barrier(xbar); } while (0)
  if (IN(0)) {
    ph_prep_x(bid, nb, lds, x, w_in, p.in[6], xb, gpre);
    ph_prep_weights(bid, nb, lds, w_in, p.in[8], p.in[9], p.in[10], p.in[13], WinT, ws);
    ph_rope_tab(bid, nb, cs);
  }
  SEAM(0);
  if (IN(1)) {
    if (bid >= nb - 16) gp_scan(bid - (nb - 16), gpre, ws, lds);
    ph_gemm8<EPI_G1>(lds, xb, WinT, 5632, 1024, e);
  }
  SEAM(1);
  if (IN(2)) { M1Pre pr; if (bid < 1024) m1_prefetch(bid, pr, ws, p.in[4], p.in[5]);
    for (int u = bid; u < 1024; u += nb) { if (u + nb < 1024) m1_unit<true>(u, u + nb, pr, lds, ws, UT, p.in[4], p.in[5]); else m1_unit<false>(u, u, pr, lds, ws, UT, p.in[4], p.in[5]); } }
  SEAM(2);
  if (IN(3)) m2_scan(bid, nb, ws, UT);
  SEAM(3);
  if (IN(4)) {
    const float lam = compute_lambda(p.in[2], lane);
    for (int u = bid; u < 256; u += nb) att::attn_unit(u & 7, u >> 3, ws, u, lam, p.in[3], (char*)lds);
    for (int u = bid; u < 1024; u += nb) m3_unit(u, lds, ws, UT, p.in[7]);
  }
  SEAM(4);
  if (IN(5)) {
    ph_gemm_merge(lds, ws);
  }
  SEAM(5);
  if (IN(6)) ph_gemm8<EPI_OUT>(lds, (const bf16_t*)(ws + WS_MG), (const bf16_t*)(ws + WS_WOUT), 1024, 1024, e);
  SEAM(6);
  if (IN(7)) {
    ph_ln1_tab8(bid, nb, dout, p.in[11], p.in[12], (bf16_t*)(ws + WS_X1B), p.in[15], p.in[16], ws);
  }
  SEAM(7);
  if (IN(8)) ph_gemm8<EPI_QP>(lds, (const bf16_t*)(ws + WS_X1B), (const bf16_t*)(ws + WS_WQ), 2048, 1024, e);
  SEAM(8);
  if (IN(9)) ph_peer(bid, nb, lds, ws, p.in[14], dout, p.in[17], p.in[18]);
  if (p.ph_hi - p.ph_lo == NPHASE) grid.sync();
#undef IN
#undef SEAM
}

extern "C" void kernel_launch(void* const* d_in, const int* in_sizes, int n_in, void* d_out, int out_size, void* d_ws, size_t ws_size, hipStream_t stream) {
  static int grid = 0;
  if (grid == 0) {
    int dev = 0, cus = 0, per_cu = 0;
    hipGetDevice(&dev); hipDeviceGetAttribute(&cus, hipDeviceAttributeMultiprocessorCount, dev);
    hipFuncSetAttribute((const void*)mega, hipFuncAttributeMaxDynamicSharedMemorySize, LDS_BYTES);
    hipOccupancyMaxActiveBlocksPerMultiprocessor(&per_cu, (const void*)mega, 512, LDS_BYTES);
    if (per_cu < 1) { fprintf(stderr, "kernel_launch: occupancy query says %d blocks per CU\n", per_cu); per_cu = 1; }
    grid = cus * 1;
  }
  hipMemsetAsync(d_ws, 0, 16384, stream);
  KP p{};
  for (int i = 0; i < 19; ++i) p.in[i] = (const float*)d_in[i];
  p.out = (float*)d_out; p.ws = (unsigned char*)d_ws;
  if (MK_LAUNCHES == 1) {
    p.ph_lo = 0; p.ph_hi = NPHASE;
    void* args[] = {&p};
    hipError_t er = hipLaunchCooperativeKernel((void*)mega, dim3(grid), dim3(512), args, LDS_BYTES, stream);
    if (er != hipSuccess) fprintf(stderr, "cooperative launch failed: %s (grid %d)\n", hipGetErrorString(er), grid);
  } else {
    for (int k = 0; k < NPHASE; ++k) { p.ph_lo = k; p.ph_hi = k + 1; hipLaunchKernelGGL(mega, dim3(grid), dim3(512), LDS_BYTES, stream, p); }
  }
}
```

```cpp
#include <hip/hip_runtime.h>
#include <hip/hip_cooperative_groups.h>
#include <cstdio>
#include <stdint.h>
#include <math.h>

namespace cg = cooperative_groups;
typedef unsigned short bf16_t;
typedef short bf16x8 __attribute__((ext_vector_type(8)));
typedef float f32x4 __attribute__((ext_vector_type(4)));
typedef unsigned u32x2 __attribute__((ext_vector_type(2)));
typedef unsigned u32x4 __attribute__((ext_vector_type(4)));

constexpr int T = 16384, SEQ = 8192, DM = 1024;
constexpr float ALPHA = 1.189207115002721f;
constexpr float LN_EPS = 1e-5f;
constexpr float LAMBDA_INIT = 0.2f;
constexpr float QSCALE = 0.125f * 1.4426950408889634f;

constexpr size_t MB = 1u << 20;
constexpr size_t WS_GPRE = 1 * MB;
constexpr size_t WS_CS = 2 * MB;
constexpr size_t WS_WA = 8 * MB;
constexpr size_t WS_WM = 9 * MB;
constexpr size_t WS_WOUT = 10 * MB;
constexpr size_t WS_WQ = 12 * MB;
constexpr size_t WS_G1 = 16 * MB;
constexpr size_t WS_Q = 16 * MB, WS_K = 32 * MB, WS_V = 48 * MB, WS_MQ = 64 * MB, WS_MK = 80 * MB, WS_MV = 96 * MB, WS_MO = 112 * MB;
constexpr size_t WS_BG = 128 * MB;
constexpr size_t WS_QC = 192 * MB, WS_KC = 208 * MB;
constexpr size_t WS_O0 = 224 * MB;
constexpr size_t WS_YA = WS_MQ, WS_YM = WS_MK;
constexpr size_t WS_MG = WS_Q;
constexpr size_t WS_X1B = WS_QC;
constexpr size_t WS_TU = 128 * MB, WS_TV = 160 * MB;
constexpr size_t WS_QP = 16 * MB;
constexpr size_t WS_EXP = 96 * MB, WS_GATE = 104 * MB;
constexpr size_t DO_XB = 0, DO_WINT = 32 * MB;

__device__ __forceinline__ float bf2f(bf16_t v) { return __uint_as_float(((unsigned)v) << 16); }
__device__ __forceinline__ bf16_t f2bf(float f) { unsigned u = __float_as_uint(f); u += 0x7fffu + ((u >> 16) & 1u); return (bf16_t)(u >> 16); }
__device__ __forceinline__ unsigned pk2(float lo, float hi) { return (unsigned)f2bf(lo) | ((unsigned)f2bf(hi) << 16); }
__device__ __forceinline__ float sigmoidf_(float x) { return 1.f / (1.f + __expf(-x)); }
__device__ __forceinline__ float wave_sum(float v) {
#pragma unroll
  for (int o = 1; o < 64; o <<= 1) v += __shfl_xor(v, o);
  return v;
}
__device__ __forceinline__ float wave_max(float v) {
#pragma unroll
  for (int o = 1; o < 64; o <<= 1) v = fmaxf(v, __shfl_xor(v, o));
  return v;
}
__device__ __forceinline__ unsigned wave_maxu(unsigned v) {
#pragma unroll
  for (int o = 1; o < 64; o <<= 1) { unsigned w = (unsigned)__shfl_xor((int)v, o); v = v > w ? v : w; }
  return v;
}

__device__ __forceinline__ void ph_prep_x(int bid, int nb, unsigned char* lds, const float* __restrict__ x, const float* __restrict__ w_in, const float* __restrict__ gate_b,
                                          bf16_t* __restrict__ xb, float* __restrict__ gpre) {
  const int lane = threadIdx.x & 63, wave = __builtin_amdgcn_readfirstlane(threadIdx.x >> 6), fr = lane & 15, fq = lane >> 4;
  bf16_t* WGb = (bf16_t*)lds;
  for (int i = threadIdx.x; i < 16 * 1024; i += 512) { const int k = i >> 4, g = i & 15; WGb[g * 1032 + k] = f2bf(w_in[(size_t)k * 5648 + 3584 + g]); }
  const int rpb = ((T / 16 + nb - 1) / nb) * 16, row0 = bid * rpb, nrow = row0 < T ? (T - row0 < rpb ? T - row0 : rpb) : 0;
  { const float4* xs = (const float4*)(x + (size_t)row0 * DM); u32x2* xd = (u32x2*)(xb + (size_t)row0 * DM);
    for (int i = threadIdx.x; i < nrow * 256; i += 512) { const float4 v = xs[i]; u32x2 w; w.x = pk2(v.x, v.y); w.y = pk2(v.z, v.w); xd[i] = w; } }
  asm volatile("s_waitcnt vmcnt(0)" ::: "memory");
  __syncthreads();
  for (int rt = wave; rt * 16 < nrow; rt += 8) {
    const bf16_t* xr = xb + (size_t)(row0 + rt * 16 + fr) * DM + 8 * fq; const bf16_t* wr = WGb + fr * 1032 + 8 * fq;
    f32x4 acc = {0.f, 0.f, 0.f, 0.f};
#pragma unroll 8
    for (int ks = 0; ks < 32; ++ks) { const bf16x8 a = *(const bf16x8*)(xr + 32 * ks), bv = *(const bf16x8*)(wr + 32 * ks);
      acc = __builtin_amdgcn_mfma_f32_16x16x32_bf16(a, bv, acc, 0, 0, 0); }
    const float gb = gate_b[fr];
#pragma unroll
    for (int r = 0; r < 4; ++r) gpre[(size_t)(row0 + rt * 16 + 4 * fq + r) * 16 + fr] = acc[r] + gb;
  }
  __syncthreads();
}
__device__ __forceinline__ int src_col(int n, int mode) {
  if (mode == 1) { if (n < 1024) { const int j = n & 63; const int pj = j < 16 ? ((j & 1) ? (j >> 1) + 8 : (j >> 1)) : j; return (n & ~63) + pj; } else if (n >= 3584) return n + 16; }
  return n;
}
__device__ __forceinline__ void transpose_item(const float* __restrict__ W, int ldw, int K, int nblk, bf16_t* __restrict__ WT, float* scr, int item, int lane, int mode, int ldo = 0) {
  if (ldo == 0) ldo = K;
  const int kb = item / nblk, nbk = item % nblk, k0 = 64 * kb, n0 = 32 * nbk;
  const int sc = src_col(n0 + (lane & 31), mode);
#pragma unroll 8
  for (int i = 0; i < 32; ++i) { const int kk = 2 * i + (lane >> 5); scr[kk * 33 + (lane & 31)] = W[(size_t)(k0 + kk) * ldw + sc]; }
  asm volatile("s_waitcnt lgkmcnt(0)" ::: "memory");
  const int c = lane & 7;
#pragma unroll
  for (int j = 0; j < 4; ++j) { const int n = (lane >> 3) + 8 * j; const float* s = scr + (8 * c) * 33 + n;
    u32x4 o; o.x = pk2(s[0 * 33], s[1 * 33]); o.y = pk2(s[2 * 33], s[3 * 33]); o.z = pk2(s[4 * 33], s[5 * 33]); o.w = pk2(s[6 * 33], s[7 * 33]);
    *(u32x4*)(WT + (size_t)(n0 + n) * ldo + k0 + 8 * c) = o; }
  asm volatile("s_waitcnt lgkmcnt(0)" ::: "memory");
}
__device__ __forceinline__ void ph_prep_weights(int bid, int nb, unsigned char* lds, const float* w_in, const float* w_ba, const float* w_bm, const float* w_out, const float* w_q,
                                                bf16_t* WinT, unsigned char* ws) {
  const int lane = threadIdx.x & 63, wave = threadIdx.x >> 6;
  float* scr = (float*)(lds + 65536 + wave * 8448);
  constexpr int I_IN = 16 * 176, I_BA = 8 * 32, I_OUT = 16 * 32, I_Q = 16 * 64, NIT = I_IN + 2 * I_BA + I_OUT + I_Q;
  for (int it = bid * 8 + wave; it < NIT; it += nb * 8) {
    int r = it;
    if (r < I_IN) { transpose_item(w_in, 5648, 1024, 176, WinT, scr, r, lane, 1); continue; } r -= I_IN;
    if (r < I_BA) { transpose_item(w_ba, 1024, 512, 32, (bf16_t*)(ws + WS_WA), scr, r, lane, 0, 1024); continue; } r -= I_BA;
    if (r < I_BA) { transpose_item(w_bm, 1024, 512, 32, (bf16_t*)(ws + WS_WA) + 512, scr, r, lane, 0, 1024); continue; } r -= I_BA;
    if (r < I_OUT) { transpose_item(w_out, 1024, 1024, 32, (bf16_t*)(ws + WS_WOUT), scr, r, lane, 0); continue; } r -= I_OUT;
    transpose_item(w_q, 2048, 1024, 64, (bf16_t*)(ws + WS_WQ), scr, r, lane, 0);
  }
}
__device__ __forceinline__ void ph_cvt(int bid, int nb, const float* __restrict__ in, bf16_t* __restrict__ out, size_t n4) {
  for (size_t i = (size_t)bid * 512 + threadIdx.x; i < n4; i += (size_t)nb * 512) {
    const float4 v = ((const float4*)in)[i]; u32x2 w; w.x = pk2(v.x, v.y); w.y = pk2(v.z, v.w); ((u32x2*)out)[i] = w; }
}
__device__ __forceinline__ void ph_rope_tab(int bid, int nb, float2* __restrict__ cs) {
  for (int idx = bid * 512 + threadIdx.x; idx < 8192 * 8; idx += nb * 512) {
    const int s = idx >> 3, i = idx & 7;
    const double inv = pow(500000.0, -(double)i / 8.0); const double ang = (double)s * inv;
    cs[idx] = make_float2((float)cos(ang), (float)sin(ang));
  }
}

struct EP { const float* x; unsigned char* ws; float* dout; const float2* cs; };
enum { EPI_G1 = 0, EPI_M1 = 1, EPI_M2 = 2, EPI_OUT = 3, EPI_QP = 4 };
template <int EPI> __device__ __forceinline__ void epi4(const EP& e, int row, int col, f32x4 v) {
  if (EPI == EPI_G1) {
    if (col < 1024) {
      if ((col & 63) < 16) { const int s = row & (SEQ - 1), i0 = (col & 15) >> 1; const float2 c0 = e.cs[s * 8 + i0], c1 = e.cs[s * 8 + i0 + 1];
        const float a0 = v[0] * c0.x - v[1] * c0.y, b0 = v[1] * c0.x + v[0] * c0.y, a1 = v[2] * c1.x - v[3] * c1.y, b1 = v[3] * c1.x + v[2] * c1.y;
        v[0] = a0; v[1] = b0; v[2] = a1; v[3] = b1; }
      if (col < 512) v = v * QSCALE;
    } else if (col >= 3072) { v[0] = sigmoidf_(v[0]); v[1] = sigmoidf_(v[1]); v[2] = sigmoidf_(v[2]); v[3] = sigmoidf_(v[3]); }
    bf16_t* dst = col < 3584 ? (bf16_t*)(e.ws + WS_G1) + (size_t)(col >> 9) * ((size_t)T * 512) + (size_t)row * 512 + (col & 511)
                             : (bf16_t*)(e.ws + WS_BG) + (size_t)row * 2048 + (col - 3584);
    u32x2 w; w.x = pk2(v[0], v[1]); w.y = pk2(v[2], v[3]); *(u32x2*)dst = w;
  } else if (EPI == EPI_M1 || EPI == EPI_M2) {
    const bf16_t* g = (const bf16_t*)(e.ws + WS_BG) + (size_t)row * 2048 + (EPI == EPI_M2 ? 1024 : 0) + col;
    const u32x2 gw = *(const u32x2*)g;
    bf16_t* dst = (bf16_t*)(e.ws + WS_MG) + (size_t)row * 1024 + col;
    float r0 = v[0] * __uint_as_float(gw.x << 16), r1 = v[1] * __uint_as_float(gw.x & 0xffff0000u), r2 = v[2] * __uint_as_float(gw.y << 16), r3 = v[3] * __uint_as_float(gw.y & 0xffff0000u);
    if (EPI == EPI_M2) { const u32x2 pw = *(const u32x2*)dst; r0 += __uint_as_float(pw.x << 16); r1 += __uint_as_float(pw.x & 0xffff0000u); r2 += __uint_as_float(pw.y << 16); r3 += __uint_as_float(pw.y & 0xffff0000u); }
    u32x2 w; w.x = pk2(r0, r1); w.y = pk2(r2, r3); *(u32x2*)dst = w;
  } else if (EPI == EPI_OUT) {
    const f32x4 xv = *(const f32x4*)(e.x + (size_t)row * DM + col);
    *(f32x4*)(e.dout + (size_t)row * DM + col) = xv * ALPHA + v;
  } else if (EPI == EPI_QP) {
    u32x2 w; w.x = pk2(v[0], v[1]); w.y = pk2(v[2], v[3]); *(u32x2*)((bf16_t*)(e.ws + WS_QP) + (size_t)row * 2048 + col) = w;
  }
}
__device__ __forceinline__ float fsig(float x) { return __builtin_amdgcn_rcpf(1.f + __builtin_amdgcn_exp2f(-1.4426950408889634f * x)); }
__device__ __forceinline__ void rope4(const float2* __restrict__ cs, int s, int i0, f32x4& v) {
  const float2 c0 = cs[s * 8 + i0], c1 = cs[s * 8 + i0 + 1];
  const float a0 = v[0] * c0.x - v[1] * c0.y, b0 = v[1] * c0.x + v[0] * c0.y, a1 = v[2] * c1.x - v[3] * c1.y, b1 = v[3] * c1.x + v[2] * c1.y;
  v[0] = a0; v[1] = b0; v[2] = a1; v[3] = b1;
}
__device__ __forceinline__ void unpk8(const u32x4 w, float* f) {
#pragma unroll
  for (int i = 0; i < 4; ++i) { f[2 * i] = __uint_as_float(w[i] << 16); f[2 * i + 1] = __uint_as_float(w[i] & 0xffff0000u); }
}
template <int EPI> __device__ __forceinline__ void epi8(const EP& e, int row, int col, f32x4 v0, f32x4 v1) {
  if (EPI == EPI_G1) {
    if (col < 1024) {
      if ((col & 63) < 16) { const int s = row & (SEQ - 1), i0 = (col & 15) >> 1; rope4(e.cs, s, i0, v0); rope4(e.cs, s, i0 + 2, v1); }
      if (col < 512) { v0 = v0 * QSCALE; v1 = v1 * QSCALE; }
    } else if (col >= 3072) {
#pragma unroll
      for (int i = 0; i < 4; ++i) { v0[i] = fsig(v0[i]); v1[i] = fsig(v1[i]); }
    }
    bf16_t* dst = col < 3584 ? (bf16_t*)(e.ws + WS_G1) + (size_t)(col >> 9) * ((size_t)T * 512) + (size_t)row * 512 + (col & 511)
                             : (bf16_t*)(e.ws + WS_BG) + (size_t)row * 2048 + (col - 3584);
    u32x4 w; w.x = pk2(v0[0], v0[1]); w.y = pk2(v0[2], v0[3]); w.z = pk2(v1[0], v1[1]); w.w = pk2(v1[2], v1[3]); *(u32x4*)dst = w;
  } else if (EPI == EPI_M1 || EPI == EPI_M2) {
    float g[8]; unpk8(*(const u32x4*)((const bf16_t*)(e.ws + WS_BG) + (size_t)row * 2048 + (EPI == EPI_M2 ? 1024 : 0) + col), g);
    bf16_t* dst = (bf16_t*)(e.ws + WS_MG) + (size_t)row * 1024 + col;
    float r[8];
#pragma unroll
    for (int i = 0; i < 4; ++i) { r[i] = v0[i] * g[i]; r[4 + i] = v1[i] * g[4 + i]; }
    if (EPI == EPI_M2) { float pv[8]; unpk8(*(const u32x4*)dst, pv);
#pragma unroll
      for (int i = 0; i < 8; ++i) r[i] += pv[i]; }
    u32x4 w; w.x = pk2(r[0], r[1]); w.y = pk2(r[2], r[3]); w.z = pk2(r[4], r[5]); w.w = pk2(r[6], r[7]); *(u32x4*)dst = w;
  } else if (EPI == EPI_OUT) {
    const f32x4 x0 = *(const f32x4*)(e.x + (size_t)row * DM + col), x1 = *(const f32x4*)(e.x + (size_t)row * DM + col + 4);
    const f32x4 r0 = x0 * ALPHA + v0, r1 = x1 * ALPHA + v1;
    u32x4 w; w.x = pk2(r0[0], r0[1]); w.y = pk2(r0[2], r0[3]); w.z = pk2(r1[0], r1[1]); w.w = pk2(r1[2], r1[3]); *(u32x4*)((bf16_t*)e.dout + (size_t)row * DM + col) = w;
  } else if (EPI == EPI_QP) {
    u32x4 w; w.x = pk2(v0[0], v0[1]); w.y = pk2(v0[2], v0[3]); w.z = pk2(v1[0], v1[1]); w.w = pk2(v1[2], v1[3]);
    *(u32x4*)((bf16_t*)(e.ws + WS_QP) + (size_t)row * 2048 + col) = w;
  }
}
template <int EPI> __device__ __forceinline__ void ph_gemm(int bid, int nb, const bf16_t* __restrict__ A, const bf16_t* __restrict__ Bt, int N, int K, const EP& e) {
  const int tid = threadIdx.x & 255, half = threadIdx.x >> 8, wave = tid >> 6, lane = tid & 63, fr = lane & 15, fq = lane >> 4;
  const int ntn = N / 64, ntiles = ntn * (T / 64);
  for (int tile = bid * 2 + half; tile < ntiles; tile += nb * 2) {
    const int m0 = (tile / ntn) * 64 + (wave & 1) * 32, n0 = (tile % ntn) * 64 + (wave >> 1) * 32;
    f32x4 acc[2][2];
#pragma unroll
    for (int i = 0; i < 2; ++i)
#pragma unroll
      for (int j = 0; j < 2; ++j) acc[i][j] = (f32x4){0.f, 0.f, 0.f, 0.f};
    const bf16_t* ap = A + (size_t)(m0 + fr) * K + fq * 8; const bf16_t* bp = Bt + (size_t)(n0 + fr) * K + fq * 8;
    for (int k0 = 0; k0 < K; k0 += 32) {
      bf16x8 a[2], b[2];
#pragma unroll
      for (int i = 0; i < 2; ++i) { a[i] = *(const bf16x8*)(ap + (size_t)i * 16 * K + k0); b[i] = *(const bf16x8*)(bp + (size_t)i * 16 * K + k0); }
#pragma unroll
      for (int i = 0; i < 2; ++i)
#pragma unroll
        for (int j = 0; j < 2; ++j) acc[i][j] = __builtin_amdgcn_mfma_f32_16x16x32_bf16(b[j], a[i], acc[i][j], 0, 0, 0);
    }
#pragma unroll
    for (int i = 0; i < 2; ++i)
#pragma unroll
      for (int j = 0; j < 2; ++j) epi4<EPI>(e, m0 + 16 * i + fr, n0 + 16 * j + 4 * fq, acc[i][j]);
  }
}

namespace pg8 {
#define PG8_LAS __attribute__((address_space(3)))
typedef unsigned short bf16_t;
typedef short bf16x8 __attribute__((ext_vector_type(8)));
typedef float f32x4 __attribute__((ext_vector_type(4)));
typedef unsigned u32x4 __attribute__((ext_vector_type(4)));
constexpr int BM = 256, BK = 64, HALF = 128, HTB = HALF * BK * 2  , STAGE_BYTES = 8 * HTB, NXCD = 8, WGM = 8;

__host__ __device__ __forceinline__ int lds_byte(int r, int c) { const int st = (r >> 4) * 2 + (c >> 5), rr = r & 15, cc = c & 31, ob = rr * 64 + cc * 2; return st * 1024 + (ob ^ (((ob >> 9) & 1) << 5)); }
__host__ __device__ __forceinline__ void stage_rc(int b, int& R, int& C) { const int st = b / 1024, sb = b % 1024, swz = sb ^ (((sb >> 9) & 1) << 5); R = (st >> 1) * 16 + swz / 64; C = (st & 1) * 32 + (swz % 64) / 2; }
__host__ __device__ __forceinline__ int perm32(int rho) { const int n = rho >> 4, i = rho & 15; return 8 * (i >> 2) + 4 * n + (i & 3); }

struct Unit { int pm, pn; };
struct Gemm { const bf16_t* A; const bf16_t* Bt; int M, N, K; };

struct StaticOrder {
    int nM, nN, nwg, G, c;
    __host__ __device__ void init(int M, int N, int G_, int c_) { nM = M / BM; nN = N / BM; nwg = nM * nN; G = G_; c = c_; }
    __host__ __device__ bool next(int i, Unit& u) const {
        const long L = (long)i * G + c; if (L >= nwg) return false;
        int wgid = (int)L; { const int q = nwg / NXCD, r = nwg % NXCD, xcd = wgid % NXCD, off = wgid / NXCD; wgid = (xcd < r ? xcd * (q + 1) : r * (q + 1) + (xcd - r) * q) + off; }
        const int nig = WGM * nN, gid = wgid / nig, fm = gid * WGM, gsz = (nM - fm) < WGM ? (nM - fm) : WGM;
        u.pm = fm + ((wgid % nig) % gsz); u.pn = (wgid % nig) / gsz; return true;
    }
    __device__ __forceinline__ void a_ready(const Unit&) const {}
    __device__ __forceinline__ void done(const Unit&) const {}
};

template <class Epi, class Sched, bool ALIGN_EPI = false, bool SP2 = false>
__device__ __forceinline__ void gemm_phase(PG8_LAS unsigned char* lds, const Gemm g, const Sched& S, const Epi& E) {
    const int tid = threadIdx.x, wid = __builtin_amdgcn_readfirstlane(tid >> 6), lane = tid & 63, wr = wid >> 2, wc = wid & 3, fr = lane & 15, fq = lane >> 4;
    const int K = g.K, nt = K / BK;
    unsigned voffA[2], voffB[2];
#pragma unroll
    for (int i = 0; i < 2; ++i) { int R, C; stage_rc(tid * 16 + i * 8192, R, C); const int Rb = Epi::PERM ? ((R & ~31) + perm32(R & 31)) : R;
        voffA[i] = (unsigned)(R * K + C) * 2u; voffB[i] = (unsigned)(Rb * K + C) * 2u; }
    const size_t kstep = (size_t)(BK * 2);
    const size_t hstep = (size_t)HALF * K * 2;
    const size_t tstep = 2 * hstep;
    const unsigned ldsw = (unsigned)wid * 1024u;
    const int aoff = lds_byte(wr * 64 + fr, fq * 8), boff = lds_byte(wc * 32 + fr, fq * 8);
#define PG8_SA(b, h) (((b) * 2 + (h)) * HTB)
#define PG8_SB(b, h) ((4 + (b) * 2 + (h)) * HTB)
#define PG8_STAGE(bufoff, gbase, voff) do { _Pragma("unroll") for (int _i = 0; _i < 2; ++_i) \
        __builtin_amdgcn_global_load_lds((const unsigned*)((const char*)(gbase) + (voff)[_i]), (PG8_LAS unsigned*)(lds + (bufoff) + ldsw + _i * 8192), 16, 0, 0); } while (0)
#define PG8_LDA(dst, b, h) do { _Pragma("unroll") for (int m = 0; m < 4; ++m) _Pragma("unroll") for (int k = 0; k < 2; ++k) dst[m][k] = *(const PG8_LAS bf16x8*)(lds + PG8_SA(b, h) + aoff + m * 2048 + k * 1024); } while (0)
#define PG8_LDB(dst, b, h) do { _Pragma("unroll") for (int n = 0; n < 2; ++n) _Pragma("unroll") for (int k = 0; k < 2; ++k) dst[n][k] = *(const PG8_LAS bf16x8*)(lds + PG8_SB(b, h) + boff + n * 2048 + k * 1024); } while (0)
#define PG8_MMA(ai, bj, At, Bt) do { __builtin_amdgcn_s_setprio(1); _Pragma("unroll") for (int m = 0; m < 4; ++m) _Pragma("unroll") for (int n = 0; n < 2; ++n) _Pragma("unroll") for (int k = 0; k < 2; ++k) \
        acc[ai][bj][m][n] = __builtin_amdgcn_mfma_f32_16x16x32_bf16(Bt[n][k], At[m][k], acc[ai][bj][m][n], 0, 0, 0); __builtin_amdgcn_s_setprio(0); } while (0)
#define PG8_WAIT_V(n) asm volatile("s_waitcnt vmcnt(" #n ")" ::: "memory")
#define PG8_WAIT_L(n) asm volatile("s_waitcnt lgkmcnt(" #n ")" ::: "memory")
#define PG8_BAR __builtin_amdgcn_s_barrier()
#define PG8_SCHED __builtin_amdgcn_sched_barrier(0)
    Unit cur, nxt; int ui = 0;
    if (!S.next(0, cur)) return;
    f32x4 acc[2][2][4][2];
#pragma unroll
    for (int a = 0; a < 2; ++a)
#pragma unroll
        for (int b = 0; b < 2; ++b)
#pragma unroll
            for (int m = 0; m < 4; ++m)
#pragma unroll
                for (int n = 0; n < 2; ++n) acc[a][b][m][n] = (f32x4){0.f, 0.f, 0.f, 0.f};
    bf16x8 At[4][2], B0[2][2], B1[2][2];
    const char* cA = (const char*)g.A + (size_t)cur.pm * tstep; const char* cB = (const char*)g.Bt + (size_t)cur.pn * tstep;
    S.a_ready(cur);
    if constexpr (SP2) {
        PG8_STAGE(PG8_SB(0, 0), cB, voffB); PG8_STAGE(PG8_SB(0, 1), cB + hstep, voffB); PG8_STAGE(PG8_SA(0, 0), cA, voffA); PG8_STAGE(PG8_SA(0, 1), cA + hstep, voffA);
        if (wr == 1) PG8_BAR;
        PG8_WAIT_V(2); PG8_BAR;
        PG8_STAGE(PG8_SB(1, 0), cB + kstep, voffB); PG8_STAGE(PG8_SA(1, 0), cA + kstep, voffA); PG8_STAGE(PG8_SB(1, 1), cB + hstep + kstep, voffB);
        PG8_WAIT_V(6); PG8_BAR;
    } else {
        PG8_STAGE(PG8_SB(0, 0), cB, voffB); PG8_STAGE(PG8_SA(0, 0), cA, voffA); PG8_STAGE(PG8_SB(0, 1), cB + hstep, voffB); PG8_STAGE(PG8_SA(0, 1), cA + hstep, voffA);
        if (wr == 1) PG8_BAR;
        PG8_WAIT_V(4); PG8_BAR;
        PG8_STAGE(PG8_SB(1, 0), cB + kstep, voffB); PG8_STAGE(PG8_SA(1, 0), cA + kstep, voffA); PG8_STAGE(PG8_SB(1, 1), cB + hstep + kstep, voffB);
        PG8_WAIT_V(6); PG8_BAR;
    }
    for (;;) {
        const bool has_next = S.next(ui + 1, nxt);
        const char* nA = has_next ? (const char*)g.A + (size_t)nxt.pm * tstep : cA; const char* nB = has_next ? (const char*)g.Bt + (size_t)nxt.pn * tstep : cB;
        for (int t = 0; t < nt; t += 2) {
            const bool last = (t == nt - 2);
            if constexpr (Epi::HAS_MID) { if (t == (nt >> 1)) E.mid(acc, cur, wr, wc, fr, fq); }
            const char* a1 = cA + (size_t)(t + 1) * kstep;
            const char* a2 = last ? nA : cA + (size_t)(t + 2) * kstep; const char* b2 = last ? nB : cB + (size_t)(t + 2) * kstep;
            const char* a3 = a2 + kstep; const char* b3 = b2 + kstep;
            if (last && has_next) S.a_ready(nxt);
            if constexpr (SP2) {
            PG8_LDB(B0, 0, 0); PG8_LDB(B1, 0, 1); PG8_SCHED; PG8_LDA(At, 0, 0); PG8_STAGE(PG8_SA(1, 1), a1 + hstep, voffA);
            PG8_WAIT_V(8); PG8_WAIT_L(0); PG8_BAR; PG8_MMA(0, 0, At, B0); PG8_MMA(0, 1, At, B1); PG8_BAR; PG8_SCHED;
            PG8_LDA(At, 0, 1); PG8_STAGE(PG8_SB(0, 0), b2, voffB); PG8_STAGE(PG8_SB(0, 1), b2 + hstep, voffB); PG8_STAGE(PG8_SA(0, 0), a2, voffA);
            PG8_WAIT_V(8); PG8_WAIT_L(0); PG8_BAR; PG8_MMA(1, 0, At, B0); PG8_MMA(1, 1, At, B1); PG8_BAR; PG8_SCHED;
            PG8_LDB(B0, 1, 0); PG8_LDB(B1, 1, 1); PG8_SCHED; PG8_LDA(At, 1, 0); PG8_STAGE(PG8_SA(0, 1), a2 + hstep, voffA);
            PG8_WAIT_V(8); PG8_WAIT_L(0); PG8_BAR; PG8_MMA(0, 0, At, B0); PG8_MMA(0, 1, At, B1); PG8_BAR; PG8_SCHED;
            PG8_LDA(At, 1, 1); PG8_STAGE(PG8_SB(1, 0), b3, voffB); PG8_STAGE(PG8_SB(1, 1), b3 + hstep, voffB); PG8_STAGE(PG8_SA(1, 0), a3, voffA);
            PG8_WAIT_V(8); PG8_WAIT_L(0); PG8_BAR; PG8_MMA(1, 0, At, B0); PG8_MMA(1, 1, At, B1); PG8_BAR; PG8_SCHED;
            } else {
            PG8_LDB(B0, 0, 0); PG8_SCHED; PG8_LDA(At, 0, 0); PG8_STAGE(PG8_SA(1, 1), a1 + hstep, voffA);
            PG8_WAIT_L(8); PG8_BAR; PG8_WAIT_L(0); PG8_MMA(0, 0, At, B0); PG8_BAR; PG8_SCHED;
            PG8_LDB(B1, 0, 1); PG8_STAGE(PG8_SB(0, 0), b2, voffB);
            PG8_BAR; PG8_WAIT_L(0); PG8_MMA(0, 1, At, B1); PG8_BAR;
            PG8_LDA(At, 0, 1); PG8_STAGE(PG8_SA(0, 0), a2, voffA);
            PG8_BAR; PG8_WAIT_L(0); PG8_MMA(1, 0, At, B0); PG8_BAR; PG8_SCHED;
            PG8_STAGE(PG8_SB(0, 1), b2 + hstep, voffB);
            PG8_WAIT_V(6); PG8_BAR; PG8_MMA(1, 1, At, B1); PG8_BAR;
            PG8_LDB(B0, 1, 0); PG8_SCHED; PG8_LDA(At, 1, 0); PG8_STAGE(PG8_SA(0, 1), a2 + hstep, voffA);
            PG8_WAIT_L(8); PG8_BAR; PG8_WAIT_L(0); PG8_MMA(0, 0, At, B0); PG8_BAR; PG8_SCHED;
            PG8_LDB(B1, 1, 1); PG8_STAGE(PG8_SB(1, 0), b3, voffB);
            PG8_BAR; PG8_WAIT_L(0); PG8_MMA(0, 1, At, B1); PG8_BAR;
            PG8_LDA(At, 1, 1); PG8_STAGE(PG8_SA(1, 0), a3, voffA);
            PG8_BAR; PG8_WAIT_L(0); PG8_MMA(1, 0, At, B0); PG8_BAR; PG8_SCHED;
            PG8_STAGE(PG8_SB(1, 1), b3 + hstep, voffB);
            PG8_WAIT_V(6); PG8_BAR; PG8_MMA(1, 1, At, B1); PG8_BAR;
            }
        }
        if constexpr (ALIGN_EPI) { if (wr == 0) PG8_BAR; }
        if constexpr (!Epi::AFTER_DRAIN) { E(acc, cur, wr, wc, fr, fq); S.done(cur); }
        if (!has_next) break;
#pragma unroll
        for (int a = 0; a < 2; ++a)
#pragma unroll
            for (int b = 0; b < 2; ++b)
#pragma unroll
                for (int m = 0; m < 4; ++m)
#pragma unroll
                    for (int n = 0; n < 2; ++n) acc[a][b][m][n] = (f32x4){0.f, 0.f, 0.f, 0.f};
        cur = nxt; cA = nA; cB = nB; ++ui;
        if constexpr (ALIGN_EPI) { if (wr == 1) PG8_BAR; }
    }
    PG8_WAIT_V(0);
    if constexpr (!ALIGN_EPI) { if (wr == 0) PG8_BAR; }
    PG8_BAR;
    if constexpr (Epi::AFTER_DRAIN) { E.fused(acc, cur, wr, wc, fr, fq, lds, wid, lane); S.done(cur); }
#undef PG8_SA
#undef PG8_SB
#undef PG8_STAGE
#undef PG8_LDA
#undef PG8_LDB
#undef PG8_MMA
#undef PG8_WAIT_V
#undef PG8_WAIT_L
#undef PG8_BAR
#undef PG8_SCHED
}
}

template <int EPI> struct EpiAd {
  static constexpr bool PERM = true, AFTER_DRAIN = false, HAS_MID = false;
  EP e;
  __device__ __forceinline__ void operator()(const pg8::f32x4 (&acc)[2][2][4][2], const pg8::Unit& u, int wr, int wc, int fr, int fq) const {
#pragma unroll
    for (int ai = 0; ai < 2; ++ai)
#pragma unroll
      for (int m = 0; m < 4; ++m)
#pragma unroll
        for (int bj = 0; bj < 2; ++bj)
          epi8<EPI>(e, u.pm * 256 + ai * 128 + wr * 64 + m * 16 + fr, u.pn * 256 + bj * 128 + wc * 32 + 8 * fq, acc[ai][bj][m][0], acc[ai][bj][m][1]);
  }
};
struct EpiMergeK {
  static constexpr bool PERM = true, AFTER_DRAIN = false, HAS_MID = true;
  unsigned char* ws;
  __device__ __forceinline__ void mid(pg8::f32x4 (&acc)[2][2][4][2], const pg8::Unit& u, int wr, int wc, int fr, int fq) const {
    const bf16_t* bg = (const bf16_t*)(ws + WS_BG);
#pragma unroll
    for (int ai = 0; ai < 2; ++ai)
#pragma unroll
      for (int m = 0; m < 4; ++m)
#pragma unroll
        for (int bj = 0; bj < 2; ++bj) {
          const int row = u.pm * 256 + ai * 128 + wr * 64 + m * 16 + fr, col = u.pn * 256 + bj * 128 + wc * 32 + 8 * fq;
          float g0[8], g1[8]; unpk8(*(const u32x4*)(bg + (size_t)row * 2048 + col), g0); unpk8(*(const u32x4*)(bg + (size_t)row * 2048 + 1024 + col), g1);
#pragma unroll
          for (int i = 0; i < 4; ++i) { acc[ai][bj][m][0][i] *= g0[i] * __builtin_amdgcn_rcpf(fmaxf(g1[i], 8.673617379884035e-19f));
                                        acc[ai][bj][m][1][i] *= g0[4 + i] * __builtin_amdgcn_rcpf(fmaxf(g1[4 + i], 8.673617379884035e-19f)); }
        }
  }
  __device__ __forceinline__ void operator()(const pg8::f32x4 (&acc)[2][2][4][2], const pg8::Unit& u, int wr, int wc, int fr, int fq) const {
    const bf16_t* bg = (const bf16_t*)(ws + WS_BG); bf16_t* mg = (bf16_t*)(ws + WS_MG);
#pragma unroll
    for (int ai = 0; ai < 2; ++ai)
#pragma unroll
      for (int m = 0; m < 4; ++m)
#pragma unroll
        for (int bj = 0; bj < 2; ++bj) {
          const int row = u.pm * 256 + ai * 128 + wr * 64 + m * 16 + fr, col = u.pn * 256 + bj * 128 + wc * 32 + 8 * fq;
          float g1[8], r[8]; unpk8(*(const u32x4*)(bg + (size_t)row * 2048 + 1024 + col), g1);
#pragma unroll
          for (int i = 0; i < 4; ++i) { r[i] = acc[ai][bj][m][0][i] * fmaxf(g1[i], 8.673617379884035e-19f); r[4 + i] = acc[ai][bj][m][1][i] * fmaxf(g1[4 + i], 8.673617379884035e-19f); }
          u32x4 w; w.x = pk2(r[0], r[1]); w.y = pk2(r[2], r[3]); w.z = pk2(r[4], r[5]); w.w = pk2(r[6], r[7]); *(u32x4*)(mg + (size_t)row * 1024 + col) = w;
        }
  }
};
__device__ __forceinline__ void ph_gemm_merge(unsigned char* lds, unsigned char* ws) {
  pg8::Gemm g{(const bf16_t*)(ws + WS_YA), (const bf16_t*)(ws + WS_WA), T, 1024, 1024}; pg8::StaticOrder S; S.init(T, 1024, (int)gridDim.x, (int)blockIdx.x);
  EpiMergeK E{ws};
  pg8::gemm_phase<EpiMergeK, pg8::StaticOrder, true, true>((PG8_LAS unsigned char*)lds, g, S, E);
}
template <int EPI> __device__ __forceinline__ void ph_gemm8(unsigned char* lds, const bf16_t* A, const bf16_t* Bt, int N, int K, const EP& e) {
  pg8::Gemm g{A, Bt, T, N, K}; pg8::StaticOrder S; S.init(T, N, (int)gridDim.x, (int)blockIdx.x);
  EpiAd<EPI> E{e};
  pg8::gemm_phase<EpiAd<EPI>, pg8::StaticOrder, true, true>((PG8_LAS unsigned char*)lds, g, S, E);
}

__device__ __forceinline__ float log_sigmoid(float f) { return fminf(f, 0.f) - log1pf(expf(-fabsf(f))); }
constexpr size_t WS_GP_P = 3 * MB, WS_GP_M = 3 * MB + 512 * 1024, WS_GP_B = 4 * MB, WS_GP_MC = 4 * MB + 512 * 1024, WS_GP_AC = 4 * MB + 520 * 1024;
constexpr size_t WS_NU = 5 * MB;
constexpr int RS = 136, TS = 72;
__device__ __forceinline__ void gp_scan(int scan, const float* __restrict__ gpre, unsigned char* ws, unsigned char* lds) {
  const int lane = threadIdx.x & 63, wave = threadIdx.x >> 6, dir = scan >> 3, b = (scan >> 2) & 1, h = scan & 3;
  float* P = (float*)(ws + WS_GP_P) + (size_t)scan * SEQ; float* Rp = (float*)(ws + WS_GP_M) + (size_t)scan * SEQ; float* BBp = (float*)(ws + WS_GP_B) + (size_t)scan * SEQ;
  float* mC = (float*)(ws + WS_GP_MC) + scan * 128; float* aC = (float*)(ws + WS_GP_AC) + scan * 128;
  float* LBL = (float*)lds; float* LR = LBL + 128;
  const int gi = (dir ? 8 : 0) + h, gf = (dir ? 12 : 4) + h;
  float ig[16], fg[16];
#pragma unroll
  for (int i = 0; i < 16; ++i) { const int c = wave * 16 + i, j = dir ? 127 - c : c, s = 64 * j + (dir ? 63 - lane : lane); const size_t t = (size_t)b * SEQ + s;
    ig[i] = gpre[t * 16 + gi]; fg[i] = gpre[t * 16 + gf]; }
#pragma unroll
  for (int i = 0; i < 16; ++i) { const int c = wave * 16 + i, j = dir ? 127 - c : c, s = 64 * j + (dir ? 63 - lane : lane);
    float bsum = log_sigmoid(fg[i]);
#pragma unroll
    for (int o = 1; o < 64; o <<= 1) { const float v = __shfl_up(bsum, o); if (lane >= o) bsum += v; }
    const float p = ig[i] - bsum; float r = p;
#pragma unroll
    for (int o = 1; o < 64; o <<= 1) { const float v = __shfl_up(r, o); if (lane >= o) r = fmaxf(r, v); }
    P[s] = p; Rp[s] = r; BBp[s] = bsum;
    if (lane == 63) { LBL[c] = bsum; LR[c] = r; } }
  __syncthreads();
  if (wave == 0) { float m = -1e30f;
    for (int c = 0; c < 128; ++c) { const int j = dir ? 127 - c : c; const float Ml = fmaxf(m, LR[c]);
      if (lane == 0) { mC[j] = m; aC[j] = expf(m - Ml); }
      m = LBL[c] + Ml; } }
  __syncthreads();
}
struct M1Pre { u32x4 raw[5]; u32x4 v[2]; float cwl[3]; float pv, rv, mc; };
__device__ __forceinline__ void m1_prefetch(int u, M1Pre& pr, const unsigned char* ws, const float* __restrict__ cw, const float* __restrict__ cb) {
  const int tid = threadIdx.x, lane = tid & 63, wave = __builtin_amdgcn_readfirstlane(tid >> 6);
  const int bh = u >> 7, j = u & 127, b = bh >> 2, h = bh & 3;
  const bf16_t* mq = (const bf16_t*)(ws + WS_MQ); const bf16_t* mk = (const bf16_t*)(ws + WS_MK); const bf16_t* mv = (const bf16_t*)(ws + WS_MV);
#pragma unroll
  for (int i = 0; i < 5; ++i) { const int it = tid + 512 * i; const int which = it >= 68 * 16, r = (it - which * 68 * 16) >> 4, ch = it & 15; const int s = 64 * j - 2 + r;
    pr.raw[i] = (u32x4){0u, 0u, 0u, 0u};
    if (it < 2 * 68 * 16 && s >= 0 && s < SEQ) pr.raw[i] = *(const u32x4*)((which ? mk : mq) + ((size_t)b * SEQ + s) * 512 + h * 128 + ch * 8); }
#pragma unroll
  for (int k2 = 0; k2 < 2; ++k2) pr.v[k2] = *(const u32x4*)(mv + ((size_t)b * SEQ + 64 * j + lane) * 512 + h * 128 + (wave + 8 * k2) * 8);
#pragma unroll
  for (int i3 = 0; i3 < 3; ++i3) { const int i = tid + 512 * i3; const int w = i >> 8, c = i & 255, ch = (c >> 7) * 512 + h * 128 + (c & 127); pr.cwl[i3] = w < 5 ? cw[w * 1024 + ch] : cb[ch]; }
  pr.pv = 0.f; pr.rv = 0.f; pr.mc = 0.f;
  if (tid < 128) { const int dir = tid >> 6, l = tid & 63; const int scan = dir * 8 + bh;
    pr.pv = ((const float*)(ws + WS_GP_P))[(size_t)scan * SEQ + 64 * j + l]; pr.rv = ((const float*)(ws + WS_GP_M))[(size_t)scan * SEQ + 64 * j + (dir ? 0 : 63)];
    pr.mc = ((const float*)(ws + WS_GP_MC))[scan * 128 + j]; }
}
template <bool HAS_NEXT> __device__ __forceinline__ void m1_unit(int u, int un, M1Pre& pr, unsigned char* lds, unsigned char* ws, bf16_t* UT, const float* __restrict__ cw, const float* __restrict__ cb) {
  const int tid = threadIdx.x, lane = tid & 63, wave = __builtin_amdgcn_readfirstlane(tid >> 6), fr = lane & 15, fq = lane >> 4;
  const int bh = u >> 7, j = u & 127, b = bh >> 2, h = bh & 3;
  bf16_t* RAWQ = (bf16_t*)lds; bf16_t* RAWK = RAWQ + 68 * RS; bf16_t* KWT0 = RAWK + 68 * RS; bf16_t* KWT1 = KWT0 + 128 * TS; bf16_t* VT = KWT1 + 128 * TS;
  float* WK = (float*)(VT + 144 * TS);
  float* CWL = WK + 128;
  bf16_t* qc = (bf16_t*)(ws + WS_QC); bf16_t* kc = (bf16_t*)(ws + WS_KC);
  const size_t trow0 = (size_t)b * SEQ + 64 * j;
#pragma unroll
  for (int i = 0; i < 5; ++i) { const int it = tid + 512 * i; const int which = it >= 68 * 16, r = (it - which * 68 * 16) >> 4, ch = it & 15;
    if (it < 2 * 68 * 16) *(u32x4*)((which ? RAWK : RAWQ) + r * RS + ch * 8) = pr.raw[i]; }
#pragma unroll
  for (int i3 = 0; i3 < 3; ++i3) CWL[tid + 512 * i3] = pr.cwl[i3];
  if (tid < 128) WK[tid] = expf(pr.pv - fmaxf(pr.mc, pr.rv));
#pragma unroll
  for (int k2 = 0; k2 < 2; ++k2) { const int ch = wave + 8 * k2; const u32x4 v = pr.v[k2];
#pragma unroll
    for (int i = 0; i < 4; ++i) { VT[(ch * 8 + 2 * i) * TS + lane] = (bf16_t)(v[i] & 0xffffu); VT[(ch * 8 + 2 * i + 1) * TS + lane] = (bf16_t)(v[i] >> 16); } }
  if (tid < 64) VT[128 * TS + tid] = 0x3f80;
  __syncthreads();
  if (HAS_NEXT) m1_prefetch(un, pr, ws, cw, cb);
  const float wkf = WK[lane], wkb = WK[64 + lane];
#pragma unroll
  for (int which = 0; which < 2; ++which)
#pragma unroll
    for (int k2 = 0; k2 < 2; ++k2) {
      const int ch = wave + 8 * k2; const float* cwl = CWL + which * 128 + ch * 8;
      float y[8];
      { const float4 ba = *(const float4*)(cwl + 5 * 256), bb = *(const float4*)(cwl + 5 * 256 + 4); y[0] = ba.x; y[1] = ba.y; y[2] = ba.z; y[3] = ba.w; y[4] = bb.x; y[5] = bb.y; y[6] = bb.z; y[7] = bb.w; }
#pragma unroll
      for (int w = 0; w < 5; ++w) {
        const u32x4 v = *(const u32x4*)((which ? RAWK : RAWQ) + (lane + w) * RS + ch * 8);
        const float4 wa = *(const float4*)(cwl + w * 256), wb = *(const float4*)(cwl + w * 256 + 4);
        y[0] += __uint_as_float(v[0] << 16) * wa.x; y[1] += __uint_as_float(v[0] & 0xffff0000u) * wa.y; y[2] += __uint_as_float(v[1] << 16) * wa.z; y[3] += __uint_as_float(v[1] & 0xffff0000u) * wa.w;
        y[4] += __uint_as_float(v[2] << 16) * wb.x; y[5] += __uint_as_float(v[2] & 0xffff0000u) * wb.y; y[6] += __uint_as_float(v[3] << 16) * wb.z; y[7] += __uint_as_float(v[3] & 0xffff0000u) * wb.w;
      }
#pragma unroll
      for (int i = 0; i < 8; ++i) { y[i] = y[i] * fsig(y[i]); if (which) y[i] *= 0.08838834764831845f; }
      u32x4 o; o.x = pk2(y[0], y[1]); o.y = pk2(y[2], y[3]); o.z = pk2(y[4], y[5]); o.w = pk2(y[6], y[7]);
      *(u32x4*)((which ? kc : qc) + (trow0 + lane) * 512 + h * 128 + ch * 8) = o;
      if (which) {
#pragma unroll
        for (int i = 0; i < 8; ++i) { const float kv = bf2f(f2bf(y[i])); KWT0[(ch * 8 + i) * TS + lane] = f2bf(kv * wkf); KWT1[(ch * 8 + i) * TS + lane] = f2bf(kv * wkb); }
      }
    }
  __syncthreads();
  bf16x8 xf[2][2];
#pragma unroll
  for (int dir = 0; dir < 2; ++dir)
#pragma unroll
    for (int ks = 0; ks < 2; ++ks) xf[dir][ks] = *(const bf16x8*)((dir ? KWT1 : KWT0) + (16 * wave + fr) * TS + ks * 32 + fq * 8);
#pragma unroll
  for (int et = 0; et < 9; ++et) {
    const bf16x8 y0 = *(const bf16x8*)(VT + (16 * et + fr) * TS + fq * 8), y1 = *(const bf16x8*)(VT + (16 * et + fr) * TS + 32 + fq * 8);
#pragma unroll
    for (int dir = 0; dir < 2; ++dir) {
      f32x4 acc = {0.f, 0.f, 0.f, 0.f};
      acc = __builtin_amdgcn_mfma_f32_16x16x32_bf16(xf[dir][0], y0, acc, 0, 0, 0);
      acc = __builtin_amdgcn_mfma_f32_16x16x32_bf16(xf[dir][1], y1, acc, 0, 0, 0);
      const int scan = dir * 8 + bh;
      if (et < 8) { u32x2 w; w.x = pk2(acc[0], acc[1]); w.y = pk2(acc[2], acc[3]);
        *(u32x2*)(UT + (((size_t)scan * 128 + j) * 128 + 16 * et + fr) * 128 + 16 * wave + 4 * fq) = w; }
      else if (fr == 0) *(f32x4*)((float*)(ws + WS_NU) + ((size_t)scan * 128 + j) * 128 + 16 * wave + 4 * fq) = acc;
    }
  }
  __syncthreads();
}
__device__ __forceinline__ void m2_scan(int bid, int nb, unsigned char* ws, bf16_t* UT) {
  for (int slab = bid; slab < 16 * 16; slab += nb) {
    const int scan = slab >> 4, dir = scan >> 3, el = ((slab & 15) * 512 + threadIdx.x) * 2;
    const float* aC = (const float*)(ws + WS_GP_AC) + scan * 128;
    bf16_t* base = UT + (size_t)scan * 128 * 16384 + el;
    float c0 = 0.f, c1 = 0.f;
    for (int c16 = 0; c16 < 128; c16 += 16) {
      unsigned uv[16];
#pragma unroll
      for (int i = 0; i < 16; ++i) { const int j = dir ? 127 - (c16 + i) : c16 + i; uv[i] = *(const unsigned*)(base + (size_t)j * 16384); }
#pragma unroll
      for (int i = 0; i < 16; ++i) { const int j = dir ? 127 - (c16 + i) : c16 + i; const float a = aC[j]; *(unsigned*)(base + (size_t)j * 16384) = pk2(c0, c1);
        c0 = a * c0 + __uint_as_float(uv[i] << 16); c1 = a * c1 + __uint_as_float(uv[i] & 0xffff0000u); }
    }
  }
  const int gt = bid * 512 + threadIdx.x, nthreads = nb * 512;
  for (int item = gt; item < 16 * 128; item += nthreads) {
    const int scan = item >> 7, d = item & 127, dir = scan >> 3;
    const float* aC = (const float*)(ws + WS_GP_AC) + scan * 128; float* base = (float*)(ws + WS_NU) + (size_t)scan * 128 * 128 + d;
    float n = 0.f;
    for (int c16 = 0; c16 < 128; c16 += 16) { float uv[16], av[16];
#pragma unroll
      for (int i = 0; i < 16; ++i) { const int j = dir ? 127 - (c16 + i) : c16 + i; uv[i] = base[j * 128]; av[i] = aC[j]; }
#pragma unroll
      for (int i = 0; i < 16; ++i) { const int j = dir ? 127 - (c16 + i) : c16 + i; base[j * 128] = n; n = av[i] * n + uv[i]; } }
  }
}
__device__ __forceinline__ void m3_unit(int u, unsigned char* lds, unsigned char* ws, const bf16_t* UT, const float* __restrict__ ng) {
  const int tid = threadIdx.x, lane = tid & 63, wave = __builtin_amdgcn_readfirstlane(tid >> 6), fr = lane & 15, fq = lane >> 4;
  const int bh = u >> 7, j = u & 127, b = bh >> 2, h = bh & 3, tt = wave & 3, eh = wave >> 2;
  bf16_t* QCS = (bf16_t*)lds; bf16_t* KCS = QCS + 64 * RS; bf16_t* VT = KCS + 64 * RS; bf16_t* CT0 = VT + 144 * TS; bf16_t* CT1 = CT0 + 144 * RS;
  float* GA = (float*)(CT1 + 144 * RS);
  float* ST = GA + 384;
  const bf16_t* qc = (const bf16_t*)(ws + WS_QC); const bf16_t* kc = (const bf16_t*)(ws + WS_KC); const bf16_t* mv = (const bf16_t*)(ws + WS_MV); const bf16_t* mo = (const bf16_t*)(ws + WS_MO);
  bf16_t* ym = (bf16_t*)(ws + WS_YA);
  const size_t trow0 = (size_t)b * SEQ + 64 * j;
  for (int it = tid; it < 2 * 64 * 16; it += 512) { const int which = it >> 10, r = (it >> 4) & 63, ch = it & 15;
    *(u32x4*)((which ? KCS : QCS) + r * RS + ch * 8) = *(const u32x4*)((which ? kc : qc) + (trow0 + r) * 512 + h * 128 + ch * 8); }
  for (int it = tid; it < 2 * 128 * 16; it += 512) { const int dir = it >> 11, e = (it >> 4) & 127, ch = it & 15; const int scan = dir * 8 + bh;
    *(u32x4*)((dir ? CT1 : CT0) + e * RS + ch * 8) = *(const u32x4*)(UT + (((size_t)scan * 128 + j) * 128 + e) * 128 + ch * 8); }
  if (tid < 256) { const int dir = tid >> 7, d = tid & 127; const int scan = dir * 8 + bh;
    (dir ? CT1 : CT0)[128 * RS + d] = f2bf(((const float*)(ws + WS_NU))[((size_t)scan * 128 + j) * 128 + d]); }
  if (tid < 384) { const int dir = tid / 192, k3 = (tid % 192) >> 6, l = tid & 63; const int scan = dir * 8 + bh;
    const float* src = (const float*)(ws + (k3 == 0 ? WS_GP_P : k3 == 1 ? WS_GP_M : WS_GP_B)) + (size_t)scan * SEQ;
    GA[(dir * 3 + k3) * 64 + l] = src[64 * j + l]; }
#pragma unroll
  for (int k2 = 0; k2 < 2; ++k2) { const int ch = wave + 8 * k2;
    const u32x4 v = *(const u32x4*)(mv + (trow0 + lane) * 512 + h * 128 + ch * 8);
#pragma unroll
    for (int i = 0; i < 4; ++i) { VT[(ch * 8 + 2 * i) * TS + lane] = (bf16_t)(v[i] & 0xffffu); VT[(ch * 8 + 2 * i + 1) * TS + lane] = (bf16_t)(v[i] >> 16); } }
  if (tid < 64) VT[128 * TS + tid] = 0x3f80;
  __syncthreads();
  f32x4 g[4];
  {
    bf16x8 qf[4];
#pragma unroll
    for (int ks = 0; ks < 4; ++ks) qf[ks] = *(const bf16x8*)(QCS + (16 * tt + fr) * RS + ks * 32 + fq * 8);
#pragma unroll
    for (int lt = 0; lt < 4; ++lt) { g[lt] = (f32x4){0.f, 0.f, 0.f, 0.f};
#pragma unroll
      for (int ks = 0; ks < 4; ++ks) { const bf16x8 kf = *(const bf16x8*)(KCS + (16 * lt + fr) * RS + ks * 32 + fq * 8);
        g[lt] = __builtin_amdgcn_mfma_f32_16x16x32_bf16(kf, qf[ks], g[lt], 0, 0, 0); } }
  }
  const int etl[5] = {4 * eh, 4 * eh + 1, 4 * eh + 2, 4 * eh + 3, 8};
  float hsum[4][4];
#pragma unroll
  for (int i = 0; i < 4; ++i)
#pragma unroll
    for (int r = 0; r < 4; ++r) hsum[i][r] = 0.f;
#pragma unroll
  for (int dir = 0; dir < 2; ++dir) {
    const float* Pd = GA + (dir * 3 + 0) * 64; const float* Md = GA + (dir * 3 + 1) * 64; const float* Bd = GA + (dir * 3 + 2) * 64;
    const int scan = dir * 8 + bh; const float mc = ((const float*)(ws + WS_GP_MC))[scan * 128 + j];
    const bf16_t* CT = dir ? CT1 : CT0;
    f32x4 acc[5];
#pragma unroll
    for (int i = 0; i < 5; ++i) acc[i] = (f32x4){0.f, 0.f, 0.f, 0.f};
#pragma unroll
    for (int ks = 0; ks < 4; ++ks) { const bf16x8 qf = *(const bf16x8*)(QCS + (16 * tt + fr) * RS + ks * 32 + fq * 8);
#pragma unroll
      for (int i = 0; i < 5; ++i) { const bf16x8 cf = *(const bf16x8*)(CT + (16 * etl[i] + fr) * RS + ks * 32 + fq * 8);
        acc[i] = __builtin_amdgcn_mfma_f32_16x16x32_bf16(qf, cf, acc[i], 0, 0, 0); } }
    float Mt[4], wi[4], emr[4];
#pragma unroll
    for (int r = 0; r < 4; ++r) { const int t = 16 * tt + 4 * fq + r; Mt[r] = fmaxf(mc, Md[t]); wi[r] = __expf(mc - Mt[r]); emr[r] = __expf(-(Bd[t] + Mt[r])); }
#pragma unroll
    for (int i = 0; i < 5; ++i)
#pragma unroll
      for (int r = 0; r < 4; ++r) acc[i][r] *= wi[r];
    const float Mrow = fmaxf(mc, Md[16 * tt + fr]); const int trow = 16 * tt + fr;
    bf16x8 sf[2];
#pragma unroll
    for (int ks = 0; ks < 2; ++ks) { unsigned pw[4];
#pragma unroll
      for (int hh = 0; hh < 2; ++hh) { const int lt = 2 * ks + hh; float sv[4];
#pragma unroll
        for (int r = 0; r < 4; ++r) { const int l = 16 * lt + 4 * fq + r; const bool ok = dir ? (l >= trow) : (l <= trow);
          sv[r] = ok ? g[lt][r] * __expf(Pd[l] - Mrow) : 0.f; }
        pw[2 * hh] = pk2(sv[0], sv[1]); pw[2 * hh + 1] = pk2(sv[2], sv[3]); }
      u32x4 w4 = {pw[0], pw[1], pw[2], pw[3]}; sf[ks] = *(bf16x8*)&w4; }
#pragma unroll
    for (int ks = 0; ks < 2; ++ks)
#pragma unroll
      for (int i = 0; i < 5; ++i) { const bf16_t* vr = VT + (16 * etl[i] + fr) * TS + 32 * ks + 4 * fq;
        const u32x2 lo = *(const u32x2*)vr, hi = *(const u32x2*)(vr + 16); u32x4 w4 = {lo.x, lo.y, hi.x, hi.y};
        acc[i] = __builtin_amdgcn_mfma_f32_16x16x32_bf16(sf[ks], *(bf16x8*)&w4, acc[i], 0, 0, 0); }
#pragma unroll
    for (int r = 0; r < 4; ++r) { const float den = __shfl(acc[4][r], lane & 48); const float inv = __builtin_amdgcn_rcpf(fmaxf(fabsf(den), emr[r]));
#pragma unroll
      for (int i = 0; i < 4; ++i) hsum[i][r] += acc[i][r] * inv; }
  }
#pragma unroll
  for (int r = 0; r < 4; ++r) { float s1 = 0.f, s2 = 0.f;
#pragma unroll
    for (int i = 0; i < 4; ++i) { s1 += hsum[i][r]; s2 += hsum[i][r] * hsum[i][r]; }
#pragma unroll
    for (int o = 1; o < 16; o <<= 1) { s1 += __shfl_xor(s1, o); s2 += __shfl_xor(s2, o); }
    if (fr == 0) { ST[(eh * 64 + 16 * tt + 4 * fq + r) * 2] = s1; ST[(eh * 64 + 16 * tt + 4 * fq + r) * 2 + 1] = s2; } }
  __syncthreads();
  bf16_t* YT = QCS;
#pragma unroll
  for (int r = 0; r < 4; ++r) { const int t = 16 * tt + 4 * fq + r;
    const float s1 = ST[t * 2] + ST[(64 + t) * 2], s2 = ST[t * 2 + 1] + ST[(64 + t) * 2 + 1];
    const float mu = s1 * (1.f / 128.f), var = fmaxf(s2 * (1.f / 128.f) - mu * mu, 0.f), rs = rsqrtf(var + LN_EPS);
#pragma unroll
    for (int i = 0; i < 4; ++i) { const int e = 16 * (4 * eh + i) + fr; YT[t * RS + e] = f2bf((hsum[i][r] - mu) * rs * ng[h * 128 + e]); } }
  __syncthreads();
  for (int it = tid; it < 64 * 16; it += 512) { const int r = it >> 4, ch = it & 15;
    const u32x4 yv = *(const u32x4*)(YT + r * RS + ch * 8); const u32x4 ov = *(const u32x4*)(mo + (trow0 + r) * 512 + h * 128 + ch * 8); u32x4 o;
#pragma unroll
    for (int i = 0; i < 4; ++i) o[i] = pk2(__uint_as_float(yv[i] << 16) * __uint_as_float(ov[i] << 16), __uint_as_float(yv[i] & 0xffff0000u) * __uint_as_float(ov[i] & 0xffff0000u));
    *(u32x4*)(ym + (trow0 + r) * 1024 + 512 + h * 128 + ch * 8) = o; }
  __syncthreads();
}
constexpr int LDS_BYTES = 155648;
__device__ __forceinline__ float compute_lambda(const float* __restrict__ lp, int lane) {
  const float s1 = wave_sum(lp[lane] * lp[64 + lane]), s2 = wave_sum(lp[128 + lane] * lp[192 + lane]);
  return expf(s1) - expf(s2) + LAMBDA_INIT;
}
namespace att {
using f32x16 = __attribute__((ext_vector_type(16))) float;
using s16x4 = __attribute__((ext_vector_type(4))) short;
constexpr int NW = 8, QBLK = 32, KVBLK = 64, LD = 512;
constexpr int SHM_V = KVBLK * 128 * 2, SHM_K = KVBLK * 64 * 2;
constexpr int NSL = 4;
constexpr int SHM_ATTN = NSL * SHM_V + NSL * SHM_K + NW * 64 * 4;
constexpr int ATT_QF = SHM_ATTN;
constexpr int ATT_STG = 0;
constexpr float THR = 8.f;
#define KSWZ64(row, colB) ((row) * 128 + ((colB) ^ ((((row) >> 1) & 7) << 4)))
#define SBAR() __builtin_amdgcn_sched_barrier(0)
__device__ __forceinline__ int crow(int r, int hi) { return (r & 3) + 8 * (r >> 2) + 4 * hi; }
__device__ __forceinline__ unsigned cvtpk(float lo, float hi) { unsigned r; asm volatile("v_cvt_pk_bf16_f32 %0, %1, %2" : "=v"(r) : "v"(lo), "v"(hi)); return r; }
template <bool FIRST> __device__ __forceinline__ void partialSM(f32x16& p0, f32x16& p1, float& m_reg, float& alpha) {
  constexpr float THR2 = THR * 1.4426950408889634f;
  float pmax = p0[0];
#pragma unroll
  for (int r = 1; r < 16; ++r) pmax = fmaxf(pmax, p0[r]);
#pragma unroll
  for (int r = 0; r < 16; ++r) pmax = fmaxf(pmax, p1[r]);
  { auto rr = __builtin_amdgcn_permlane32_swap(__float_as_uint(pmax), __float_as_uint(pmax), false, false);
    pmax = fmaxf(__uint_as_float(rr[0]), __uint_as_float(rr[1])); }
  if (!FIRST && __builtin_expect(__all(pmax <= THR2), 1)) { alpha = 1.f; }
  else { const float dl = FIRST ? pmax : fmaxf(pmax, 0.f); m_reg += dl; alpha = FIRST ? 1.f : __builtin_amdgcn_exp2f(-dl);
#pragma unroll
    for (int r = 0; r < 16; ++r) { p0[r] -= dl; p1[r] -= dl; } }
#pragma unroll
  for (int r = 0; r < 16; ++r) p0[r] = __builtin_amdgcn_exp2f(p0[r]);
}
__device__ __forceinline__ void finishSM(f32x16& p0, f32x16& p1, float alpha, float& l_reg, bf16x8& pa0, bf16x8& pa1, bf16x8& pa2, bf16x8& pa3) {
#pragma unroll
  for (int r = 0; r < 16; ++r) p1[r] = __builtin_amdgcn_exp2f(p1[r]);
  float ps = 0;
#pragma unroll
  for (int r = 0; r < 16; ++r) ps += p0[r];
#pragma unroll
  for (int r = 0; r < 16; ++r) ps += p1[r];
  { auto rr = __builtin_amdgcn_permlane32_swap(__float_as_uint(ps), __float_as_uint(ps), false, false);
    ps = __uint_as_float(rr[0]) + __uint_as_float(rr[1]); }
  l_reg = l_reg * alpha + ps;
#define PK4(P, BASE, OUT) do { unsigned a0 = cvtpk(P[BASE + 0], P[BASE + 1]), a1 = cvtpk(P[BASE + 2], P[BASE + 3]);   \
    unsigned b0 = cvtpk(P[BASE + 4], P[BASE + 5]), b1 = cvtpk(P[BASE + 6], P[BASE + 7]);                              \
    auto r0 = __builtin_amdgcn_permlane32_swap(a0, b0, false, false); auto r1 = __builtin_amdgcn_permlane32_swap(a1, b1, false, false); \
    u32x4 w = {r0[0], r1[0], r0[1], r1[1]}; OUT = *reinterpret_cast<bf16x8*>(&w); } while (0)
  PK4(p0, 0, pa0); PK4(p0, 8, pa1); PK4(p1, 0, pa2); PK4(p1, 8, pa3);
#undef PK4
}
__device__ __forceinline__ void qkt(f32x16& p0, f32x16& p1, const char* Ks, const char* ql, float negm, int r32, int hi) {
#pragma unroll
  for (int r = 0; r < 16; ++r) { p0[r] = negm; p1[r] = negm; }
#pragma unroll
  for (int d0 = 0; d0 < 4; ++d0) { const int cb = (d0 * 16 + hi * 8) * 2;
    const bf16x8 qf = *reinterpret_cast<const bf16x8*>(ql + d0 * 1024);
    const bf16x8 b0 = *reinterpret_cast<const bf16x8*>(Ks + KSWZ64(r32, cb));
    const bf16x8 b1 = *reinterpret_cast<const bf16x8*>(Ks + KSWZ64(32 + r32, cb));
    p0 = __builtin_amdgcn_mfma_f32_32x32x16_bf16(b0, qf, p0, 0, 0, 0);
    p1 = __builtin_amdgcn_mfma_f32_32x32x16_bf16(b1, qf, p1, 0, 0, 0); }
}
__device__ __forceinline__ int v_st(int k, int c) { const int kk = (k & ~0xC) | ((k & 4) << 1) | ((k & 8) >> 1); return ((kk >> 3) * 4 + (c >> 5)) * 512 + ((kk & 7) * 32 + (c & 31)) * 2; }
__device__ __forceinline__ int v_rd_base(int lane) { return ((lane & 3) << 3) | (((lane >> 2) & 3) << 6) | (((lane >> 4) & 1) << 5) | (((lane >> 5) & 1) << 8); }
constexpr int v_rd_off(int d0, int ks, int half) { return d0 * 512 + ks * 4096 + half * 2048; }
template <int OFF> __device__ __forceinline__ s16x4 tr_read(int vb) {
  s16x4 r; asm volatile("ds_read_b64_tr_b16 %0, %1 offset:%2" : "=&v"(r) : "v"(vb), "i"(OFF) : "memory"); return r;
}
#define PKV(L, H) (bf16x8){L[0], L[1], L[2], L[3], H[0], H[1], H[2], H[3]}
#define PV_R(X0, X1, X2, X3, D0, HF) do { X0 = tr_read<v_rd_off(D0, 2 * (HF), 0)>(vb); X1 = tr_read<v_rd_off(D0, 2 * (HF), 1)>(vb); \
    X2 = tr_read<v_rd_off(D0, 2 * (HF) + 1, 0)>(vb); X3 = tr_read<v_rd_off(D0, 2 * (HF) + 1, 1)>(vb); } while (0)
#define PV_M(X0, X1, X2, X3, D0, PA, PB) do { o[D0] = __builtin_amdgcn_mfma_f32_32x32x16_bf16(PA, PKV(X0, X1), o[D0], 0, 0, 0); \
    o[D0] = __builtin_amdgcn_mfma_f32_32x32x16_bf16(PB, PKV(X2, X3), o[D0], 0, 0, 0); } while (0)
#define PV_W(N) do { asm volatile("s_waitcnt lgkmcnt(" #N ")" ::: "memory"); SBAR(); } while (0)
__device__ __forceinline__ void pv_d0(f32x16* o, int vb, bf16x8 pa0, bf16x8 pa1, bf16x8 pa2, bf16x8 pa3) {
  s16x4 a0, a1, a2, a3, b0, b1, b2, b3;
  PV_R(a0, a1, a2, a3, 0, 0); PV_R(b0, b1, b2, b3, 0, 1);
  PV_W(4); PV_M(a0, a1, a2, a3, 0, pa0, pa1); SBAR(); PV_R(a0, a1, a2, a3, 1, 0);
  PV_W(4); PV_M(b0, b1, b2, b3, 0, pa2, pa3); SBAR(); PV_R(b0, b1, b2, b3, 1, 1);
  PV_W(4); PV_M(a0, a1, a2, a3, 1, pa0, pa1); SBAR(); PV_R(a0, a1, a2, a3, 2, 0);
  PV_W(4); PV_M(b0, b1, b2, b3, 1, pa2, pa3); SBAR(); PV_R(b0, b1, b2, b3, 2, 1);
  PV_W(4); PV_M(a0, a1, a2, a3, 2, pa0, pa1); SBAR(); PV_R(a0, a1, a2, a3, 3, 0);
  PV_W(4); PV_M(b0, b1, b2, b3, 2, pa2, pa3); SBAR(); PV_R(b0, b1, b2, b3, 3, 1);
  PV_W(4); PV_M(a0, a1, a2, a3, 3, pa0, pa1); SBAR();
  PV_W(0); PV_M(b0, b1, b2, b3, 3, pa2, pa3);
}
#undef PKV
__device__ __forceinline__ void attn_unit(int bh, int qb, const unsigned char* __restrict__ ws, int unit,
                                          float lam, const float* __restrict__ sg, char* lds) {
  const int tid = threadIdx.x, lane = tid & 63, r32 = lane & 31, hi = lane >> 5;
  const int wid = __builtin_amdgcn_readfirstlane(tid >> 6);
  const int b = bh >> 2, h = bh & 3;
  char* V_lds = lds; char* K_lds = lds + NSL * SHM_V;
  float* wsf = (float*)(lds + NSL * SHM_V + NSL * SHM_K) + wid * 64; float* li_l = wsf; float* al_l = wsf + 32;
  const unsigned row0 = (unsigned)b * SEQ; const int q0 = qb * 256;
  const unsigned char* Vh = ws + WS_V + ((size_t)row0 * LD + h * 128) * 2;
  const int sr = tid >> 4, sc = (tid & 15) * 8, vst0 = v_st(sr, sc);
  constexpr int vst1d = 8192;
  const unsigned voffV = (unsigned)(sr * LD + sc) * 2u, voffK = (unsigned)((tid >> 3) * LD + (tid & 7) * 8) * 2u;
  const int kst = KSWZ64(tid >> 3, (tid & 7) * 16);
  const int vb0 = (int)(uintptr_t)V_lds + v_rd_base(lane);
  constexpr int NT = SEQ / KVBLK;
  constexpr unsigned TILEB = KVBLK * LD * 2;
  for (int mp = 0; mp < 2; ++mp) {
    const unsigned char* Kh = ws + WS_K + ((size_t)row0 * LD + h * 128 + mp * 64) * 2;
    const __amdgpu_buffer_rsrc_t rsK = __builtin_amdgcn_make_buffer_rsrc((void*)Kh, (short)0, SEQ * LD * 2, 0x00020000);
    const __amdgpu_buffer_rsrc_t rsV = __builtin_amdgcn_make_buffer_rsrc((void*)Vh, (short)0, SEQ * LD * 2, 0x00020000);
    float m_reg = 0.f, l_reg = 0; f32x16 o[4] = {};
    char* ql = lds + ATT_QF + wid * 4096 + lane * 16;
    { const unsigned char* Qb = ws + WS_Q + ((size_t)(row0 + q0 + wid * QBLK) * LD + h * 128 + mp * 64) * 2;
      int tq = lane; asm volatile("" : "+v"(tq));
      const unsigned qoff = (unsigned)((tq & 31) * LD + (tq >> 5) * 8) * 2u;
#pragma unroll
      for (int d0 = 0; d0 < 4; ++d0) *reinterpret_cast<bf16x8*>(ql + d0 * 1024) = *reinterpret_cast<const bf16x8*>(Qb + qoff + d0 * 32); }
    struct { bf16x8 vs0, vs1, ks0; } sr_[2];
#define SLOAD(i, t) do { const unsigned so_ = (unsigned)(t) * TILEB; \
    sr_[i].vs0 = __builtin_bit_cast(bf16x8, __builtin_amdgcn_raw_buffer_load_b128(rsV, voffV, so_, 0)); \
    sr_[i].vs1 = __builtin_bit_cast(bf16x8, __builtin_amdgcn_raw_buffer_load_b128(rsV, voffV + 32 * LD * 2, so_, 0)); \
    sr_[i].ks0 = __builtin_bit_cast(bf16x8, __builtin_amdgcn_raw_buffer_load_b128(rsK, voffK, so_, 0)); } while (0)
#define SWRITE(bb, i) do { *(bf16x8*)(V_lds + (bb) * SHM_V + vst0) = sr_[i].vs0; *(bf16x8*)(V_lds + (bb) * SHM_V + vst0 + vst1d) = sr_[i].vs1; \
    *(bf16x8*)(K_lds + (bb) * SHM_K + kst) = sr_[i].ks0; } while (0)
#define SWAIT() asm volatile("s_waitcnt vmcnt(3)" ::: "memory")
#define RESC(a) do { if (__any((a) < 1.f)) { if (hi == 0) al_l[r32] = (a); asm volatile("s_waitcnt lgkmcnt(0)" ::: "memory"); \
    _Pragma("unroll") for (int d = 0; d < 4; ++d) _Pragma("unroll") for (int r = 0; r < 16; ++r) o[d][r] *= al_l[crow(r, hi)]; } } while (0)
    f32x16 pA0, pA1, pB0, pB1; float alA, alB; bf16x8 pa0, pa1, pa2, pa3;
    int s_pp = 0, s_prev = 0, s_cur = 1, s_next = 2;
#define ROT() do { s_pp = s_prev; s_prev = s_cur; s_cur = s_next; s_next = (s_next + 1) & (NSL - 1); } while (0)
    SLOAD(0, 0); asm volatile("s_waitcnt vmcnt(0)" ::: "memory"); SWRITE(0, 0); __syncthreads();
    if (wid < 4) {
      qkt(pA0, pA1, K_lds, ql, -m_reg, r32, hi); partialSM<true>(pA0, pA1, m_reg, alA);
      SLOAD(1, 1); SLOAD(0, 2);
      SWAIT(); SWRITE(1, 1); __syncthreads();
      for (int j = 1; j + 1 < NT; j += 2) {
        SBAR(); qkt(pB0, pB1, K_lds + s_cur * SHM_K, ql, -m_reg, r32, hi);
        finishSM(pA0, pA1, alA, l_reg, pa0, pa1, pa2, pa3); SBAR();
        SLOAD(1, j + 2); SBAR();
        pv_d0(o, vb0 + s_prev * SHM_V, pa0, pa1, pa2, pa3); partialSM<false>(pB0, pB1, m_reg, alB);
        SWAIT(); SWRITE(s_next, 0);
        RESC(alB); __syncthreads(); ROT();
        SBAR(); qkt(pA0, pA1, K_lds + s_cur * SHM_K, ql, -m_reg, r32, hi);
        finishSM(pB0, pB1, alB, l_reg, pa0, pa1, pa2, pa3); SBAR();
        if (j + 3 < NT) SLOAD(0, j + 3); SBAR();
        pv_d0(o, vb0 + s_prev * SHM_V, pa0, pa1, pa2, pa3); partialSM<false>(pA0, pA1, m_reg, alA);
        SWAIT(); SWRITE(s_next, 1);
        RESC(alA); __syncthreads(); ROT();
      }
      SBAR(); qkt(pB0, pB1, K_lds + s_cur * SHM_K, ql, -m_reg, r32, hi);
      finishSM(pA0, pA1, alA, l_reg, pa0, pa1, pa2, pa3); SBAR();
      pv_d0(o, vb0 + s_prev * SHM_V, pa0, pa1, pa2, pa3); partialSM<false>(pB0, pB1, m_reg, alB);
      RESC(alB);
      finishSM(pB0, pB1, alB, l_reg, pa0, pa1, pa2, pa3); SBAR();
      pv_d0(o, vb0 + s_cur * SHM_V, pa0, pa1, pa2, pa3);
    } else {
      qkt(pA0, pA1, K_lds, ql, -m_reg, r32, hi);
      SLOAD(1, 1); SLOAD(0, 2);
      SWAIT(); SWRITE(1, 1); __syncthreads();
      SBAR(); partialSM<true>(pA0, pA1, m_reg, alA);
      SBAR(); SLOAD(1, 3); SBAR();
      qkt(pB0, pB1, K_lds + s_cur * SHM_K, ql, -m_reg, r32, hi);
      finishSM(pA0, pA1, alA, l_reg, pa0, pa1, pa2, pa3); SBAR();
      SWAIT(); SWRITE(s_next, 0);
      __syncthreads(); ROT();
      for (int j = 2; j + 2 < NT; j += 2) {
        SBAR(); pv_d0(o, vb0 + s_pp * SHM_V, pa0, pa1, pa2, pa3); partialSM<false>(pB0, pB1, m_reg, alB); RESC(alB);
        SBAR(); SLOAD(0, j + 2); SBAR();
        qkt(pA0, pA1, K_lds + s_cur * SHM_K, ql, -m_reg, r32, hi);
        finishSM(pB0, pB1, alB, l_reg, pa0, pa1, pa2, pa3); SBAR();
        SWAIT(); SWRITE(s_next, 1);
        __syncthreads(); ROT();
        SBAR(); pv_d0(o, vb0 + s_pp * SHM_V, pa0, pa1, pa2, pa3); partialSM<false>(pA0, pA1, m_reg, alA); RESC(alA);
        SBAR(); SLOAD(1, j + 3); SBAR();
        qkt(pB0, pB1, K_lds + s_cur * SHM_K, ql, -m_reg, r32, hi);
        finishSM(pA0, pA1, alA, l_reg, pa0, pa1, pa2, pa3); SBAR();
        SWAIT(); SWRITE(s_next, 0);
        __syncthreads(); ROT();
      }
      SBAR(); pv_d0(o, vb0 + s_pp * SHM_V, pa0, pa1, pa2, pa3); partialSM<false>(pB0, pB1, m_reg, alB); RESC(alB);
      SBAR(); qkt(pA0, pA1, K_lds + s_cur * SHM_K, ql, -m_reg, r32, hi);
      finishSM(pB0, pB1, alB, l_reg, pa0, pa1, pa2, pa3); SBAR();
      SWAIT(); SWRITE(s_next, 1);
      __syncthreads(); ROT();
      SBAR(); pv_d0(o, vb0 + s_pp * SHM_V, pa0, pa1, pa2, pa3); partialSM<false>(pA0, pA1, m_reg, alA); RESC(alA);
      SBAR(); qkt(pB0, pB1, K_lds + s_cur * SHM_K, ql, -m_reg, r32, hi);
      finishSM(pA0, pA1, alA, l_reg, pa0, pa1, pa2, pa3); SBAR();
      pv_d0(o, vb0 + s_prev * SHM_V, pa0, pa1, pa2, pa3); partialSM<false>(pB0, pB1, m_reg, alB); RESC(alB);
      finishSM(pB0, pB1, alB, l_reg, pa0, pa1, pa2, pa3); SBAR();
      pv_d0(o, vb0 + s_cur * SHM_V, pa0, pa1, pa2, pa3);
    }
#undef ROT
    __syncthreads();
    if (hi == 0) li_l[r32] = l_reg; asm volatile("s_waitcnt lgkmcnt(0)" ::: "memory");
    float rli[16];
#pragma unroll
    for (int r = 0; r < 16; ++r) rli[r] = __builtin_amdgcn_rcpf(li_l[crow(r, hi)]);
    int t2 = tid; asm volatile("" : "+v"(t2));
    const int lane2 = t2 & 63, wid2 = __builtin_amdgcn_readfirstlane(t2 >> 6);
    f32x4* st = (f32x4*)((unsigned char*)ws + WS_O0) + ((size_t)unit * 512 + t2) * 16;
    if (mp == 0) {
#pragma unroll
      for (int d0 = 0; d0 < 4; ++d0)
#pragma unroll
        for (int r4 = 0; r4 < 4; ++r4) st[d0 * 4 + r4] = (f32x4){o[d0][4 * r4] * rli[4 * r4], o[d0][4 * r4 + 1] * rli[4 * r4 + 1], o[d0][4 * r4 + 2] * rli[4 * r4 + 2], o[d0][4 * r4 + 3] * rli[4 * r4 + 3]};
    } else {
      float ss[16];
#pragma unroll
      for (int r = 0; r < 16; ++r) ss[r] = 0.f;
#pragma unroll
      for (int d0 = 0; d0 < 4; ++d0)
#pragma unroll
        for (int r4 = 0; r4 < 4; ++r4) { const f32x4 o0 = st[d0 * 4 + r4];
#pragma unroll
          for (int i = 0; i < 4; ++i) { const int r = 4 * r4 + i; const float v = o0[i] - lam * (o[d0][r] * rli[r]); o[d0][r] = v; ss[r] += v * v; } }
#pragma unroll
      for (int r = 0; r < 16; ++r) {
#pragma unroll
        for (int of = 1; of < 32; of <<= 1) ss[r] += __shfl_xor(ss[r], of);
        ss[r] = rsqrtf(ss[r] * (1.f / 128.f) + LN_EPS) * (1.f - LAMBDA_INIT); }
      bf16_t* stg = (bf16_t*)(lds + ATT_STG + wid2 * 8704);
      const int r32b = lane2 & 31, hib = lane2 >> 5;
#pragma unroll
      for (int d0 = 0; d0 < 4; ++d0) { const float g = sg[d0 * 32 + r32b];
#pragma unroll
        for (int r = 0; r < 16; ++r) stg[crow(r, hib) * 136 + d0 * 32 + r32b] = f2bf(o[d0][r] * ss[r] * g); }
      asm volatile("s_waitcnt lgkmcnt(0)" ::: "memory");
      const int orow = lane2 >> 1, oh = lane2 & 1;
      bf16_t* yw = (bf16_t*)((unsigned char*)ws + WS_YA) + ((size_t)(row0 + q0 + wid2 * QBLK + orow) * 1024 + h * 128 + oh * 64);
#pragma unroll
      for (int i = 0; i < 8; ++i) *(u32x4*)(yw + i * 8) = *(const u32x4*)(stg + orow * 136 + oh * 64 + i * 8);
    }
    __syncthreads();
#undef SLOAD
#undef SWRITE
#undef SWAIT
#undef RESC
  }
}
#undef SBAR
}
__device__ __forceinline__ void ph_ln1(int bid, int nb, float* __restrict__ x1, const float* __restrict__ g, const float* __restrict__ bb, bf16_t* __restrict__ x1b) {
  const int lane = threadIdx.x & 63;
  for (int t0 = (bid * 8 + (threadIdx.x >> 6)) * 2; t0 < T; t0 += nb * 16) {
    float4 v[2][4]; float s[2] = {0.f, 0.f};
#pragma unroll
    for (int r = 0; r < 2; ++r) { const float4* xr = (const float4*)(x1 + (size_t)(t0 + r) * DM);
#pragma unroll
      for (int j = 0; j < 4; ++j) { v[r][j] = xr[lane + 64 * j]; s[r] += (v[r][j].x + v[r][j].y) + (v[r][j].z + v[r][j].w); } }
#pragma unroll
    for (int r = 0; r < 2; ++r) {
      const float mu = wave_sum(s[r]) * (1.f / DM); float q = 0.f;
#pragma unroll
      for (int j = 0; j < 4; ++j) { v[r][j].x -= mu; v[r][j].y -= mu; v[r][j].z -= mu; v[r][j].w -= mu; q += (v[r][j].x * v[r][j].x + v[r][j].y * v[r][j].y) + (v[r][j].z * v[r][j].z + v[r][j].w * v[r][j].w); }
      const float rs = rsqrtf(wave_sum(q) * (1.f / DM) + LN_EPS);
      float4* xo = (float4*)(x1 + (size_t)(t0 + r) * DM);
#pragma unroll
      for (int j = 0; j < 4; ++j) { const float4 gg = ((const float4*)g)[lane + 64 * j], b4 = ((const float4*)bb)[lane + 64 * j];
        float4 o; o.x = v[r][j].x * rs * gg.x + b4.x; o.y = v[r][j].y * rs * gg.y + b4.y; o.z = v[r][j].z * rs * gg.z + b4.z; o.w = v[r][j].w * rs * gg.w + b4.w;
        xo[lane + 64 * j] = o; u32x2 w; w.x = pk2(o.x, o.y); w.y = pk2(o.z, o.w); *(u32x2*)(x1b + (size_t)(t0 + r) * DM + 4 * (lane + 64 * j)) = w; }
    }
  }
}

constexpr size_t WS_TU8 = 128 * MB, WS_SU = 160 * MB, WS_SV = 160 * MB + 65536;
constexpr int REC6 = 1536;
typedef float f32x2v __attribute__((ext_vector_type(2)));
__device__ __forceinline__ unsigned f2ord(float f) { const unsigned u = __float_as_uint(f); return (u & 0x80000000u) ? ~u : (u | 0x80000000u); }
__device__ __forceinline__ float ord2f(unsigned o) { const unsigned u = (o & 0x80000000u) ? (o & 0x7fffffffu) : ~o; return __uint_as_float(u); }
template <int CTRL, int RM> __device__ __forceinline__ float dppf(float s) { return __uint_as_float(__builtin_amdgcn_update_dpp(0u, __float_as_uint(s), CTRL, RM, 0xf, true)); }
__device__ __forceinline__ float readlane_f(float v, int l) { return __uint_as_float((unsigned)__builtin_amdgcn_readlane((int)__float_as_uint(v), l)); }
__device__ __forceinline__ float wave_sum63(float v) {
  v += dppf<0xB1, 0xf>(v); v += dppf<0x4E, 0xf>(v); v += dppf<0x141, 0xf>(v); v += dppf<0x140, 0xf>(v);
  v += dppf<0x142, 0xA>(v); v += dppf<0x143, 0xC>(v);
  return v;
}
__device__ __forceinline__ float gelu_erf(float v) {
  const float t = __builtin_amdgcn_rcpf(fabsf(v) * 0.2316418882f + 1.0f);
  float q = t * 0.5307027145f + (-0.7265760135f); q = q * t + 0.7107068705f; q = q * t + (-0.142248368f); q = q * t + 0.127414796f; q = q * t;
  const float m = v * (q * __builtin_amdgcn_exp2f((v * v) * (-0.72134752044f)));
  return v < 0.f ? m : v - m;
}
__device__ __forceinline__ unsigned fp6_code(float a) {
  const float m = fabsf(a);
  const float c = m < 2.f ? __builtin_rintf(m * 8.f) : (m < 4.f ? __builtin_rintf(m * 4.f) + 8.f : __builtin_rintf(m * 2.f) + 16.f);
  const unsigned code = (unsigned)fminf(c, 31.f);
  return a < 0.f ? (code | 32u) : code;
}
struct U3 { unsigned x, y, z; };
__device__ __forceinline__ U3 fp6_pack16(const float4 (&v)[4], float inv) {
  unsigned f[16];
#pragma unroll
  for (int c = 0; c < 4; ++c) { f[4 * c] = fp6_code(v[c].x * inv); f[4 * c + 1] = fp6_code(v[c].y * inv); f[4 * c + 2] = fp6_code(v[c].z * inv); f[4 * c + 3] = fp6_code(v[c].w * inv); }
  U3 o;
  o.x = f[0] | (f[1] << 6) | (f[2] << 12) | (f[3] << 18) | (f[4] << 24) | (f[5] << 30);
  o.y = (f[5] >> 2) | (f[6] << 4) | (f[7] << 10) | (f[8] << 16) | (f[9] << 22) | (f[10] << 28);
  o.z = (f[10] >> 4) | (f[11] << 2) | (f[12] << 8) | (f[13] << 14) | (f[14] << 20) | (f[15] << 26);
  return o;
}
__device__ __forceinline__ void ph_ln1_tab8(int bid, int nb, float* __restrict__ x1, const float* __restrict__ g, const float* __restrict__ bb, bf16_t* __restrict__ x1b,
                                            const float* __restrict__ pu, const float* __restrict__ pv, unsigned char* ws) {
  const int lane = threadIdx.x & 63, gw = bid * 8 + (threadIdx.x >> 6), ngw = nb * 8;
  int t0 = gw * 2, r4 = gw * 4;
  for (; t0 < T || r4 < 32768; t0 += ngw * 2, r4 += ngw * 4) {
    const bool do_ln = t0 < T, do_tb = r4 < 32768;
    float4 v[2][4], va[4][4];
    if (do_ln) {
#pragma unroll
      for (int r = 0; r < 2; ++r) { const u32x2* xr = (const u32x2*)((const bf16_t*)x1 + (size_t)(t0 + r) * DM);
#pragma unroll
        for (int j = 0; j < 4; ++j) { const u32x2 a = xr[lane + 64 * j]; v[r][j] = make_float4(__uint_as_float(a.x << 16), __uint_as_float(a.x & 0xffff0000u), __uint_as_float(a.y << 16), __uint_as_float(a.y & 0xffff0000u)); } } }
    if (do_tb) {
#pragma unroll
      for (int i = 0; i < 4; ++i) { const int r = r4 + i, which = r >> 14, row = r & 16383; const float4* src = (const float4*)((which ? pv : pu) + (size_t)row * DM) + 128 * (lane & 1) + (lane >> 1);
#pragma unroll
        for (int c = 0; c < 4; ++c) va[i][c] = src[32 * c]; } }
    if (do_ln) {
#pragma unroll
      for (int r = 0; r < 2; ++r) { float sm = 0.f;
#pragma unroll
        for (int j = 0; j < 4; ++j) sm += (v[r][j].x + v[r][j].y) + (v[r][j].z + v[r][j].w);
        const float mu = wave_sum(sm) * (1.f / DM); float q = 0.f;
#pragma unroll
        for (int j = 0; j < 4; ++j) { v[r][j].x -= mu; v[r][j].y -= mu; v[r][j].z -= mu; v[r][j].w -= mu; q += (v[r][j].x * v[r][j].x + v[r][j].y * v[r][j].y) + (v[r][j].z * v[r][j].z + v[r][j].w * v[r][j].w); }
        const float rs = rsqrtf(wave_sum(q) * (1.f / DM) + LN_EPS);
#pragma unroll
        for (int j = 0; j < 4; ++j) { const float4 gg = ((const float4*)g)[lane + 64 * j], b4 = ((const float4*)bb)[lane + 64 * j];
          float4 o; o.x = v[r][j].x * rs * gg.x + b4.x; o.y = v[r][j].y * rs * gg.y + b4.y; o.z = v[r][j].z * rs * gg.z + b4.z; o.w = v[r][j].w * rs * gg.w + b4.w;
          u32x2 w; w.x = pk2(o.x, o.y); w.y = pk2(o.z, o.w); *(u32x2*)(x1b + (size_t)(t0 + r) * DM + 4 * (lane + 64 * j)) = w; } } }
    if (do_tb) {
#pragma unroll
      for (int i = 0; i < 4; ++i) { const int r = r4 + i, which = r >> 14, row = r & 16383;
        float mx = 0.f;
#pragma unroll
        for (int c = 0; c < 4; ++c) mx = fmaxf(mx, fmaxf(fmaxf(fabsf(va[i][c].x), fabsf(va[i][c].y)), fmaxf(fabsf(va[i][c].z), fabsf(va[i][c].w))));
        mx = wave_max(mx);
        const float scale = fmaxf(mx, 1e-30f) * (1.f / 7.5f), inv = 1.f / scale;
        { const U3 o = fp6_pack16(va[i], inv); unsigned char* rec = ws + WS_TU8 + (size_t)row * REC6 + which * 768;
          if ((lane & 1) == 0) *(U3*)(rec + 16 * (lane >> 1)) = o;
          else { *(unsigned*)(rec + 16 * (lane >> 1) + 12) = o.x; u32x2 q; q.x = o.y; q.y = o.z; *(u32x2*)(rec + 512 + 8 * (lane >> 1)) = q; } }
        if (lane == 0) ((float*)(ws + (which ? WS_SV : WS_SU)))[row] = scale; } }
  }
}
#define CE_D(a, b) do { const unsigned hi_ = (a) > (b) ? (a) : (b), lo_ = (a) > (b) ? (b) : (a); (a) = hi_; (b) = lo_; } while (0)
__device__ __forceinline__ void merge16_desc(unsigned* m) {
#pragma unroll
  for (int j = 8; j > 0; j >>= 1)
#pragma unroll
    for (int i = 0; i < 16; ++i) { const int l = i ^ j; if (l > i) CE_D(m[i], m[l]); }
}
__device__ __forceinline__ void sort16_desc(unsigned* k) {
#pragma unroll
  for (int kk = 2; kk <= 16; kk <<= 1)
#pragma unroll
    for (int j = kk >> 1; j > 0; j >>= 1)
#pragma unroll
      for (int i = 0; i < 16; ++i) { const int l = i ^ j; if (l > i) { if ((i & kk) == 0) CE_D(k[i], k[l]); else CE_D(k[l], k[i]); } }
}
__device__ __forceinline__ void top16_of_64(unsigned* k, unsigned* out) {
  sort16_desc(k); sort16_desc(k + 16); sort16_desc(k + 32); sort16_desc(k + 48);
  unsigned m1[16];
#pragma unroll
  for (int i = 0; i < 16; ++i) { out[i] = k[i] > k[31 - i] ? k[i] : k[31 - i]; m1[i] = k[32 + i] > k[63 - i] ? k[32 + i] : k[63 - i]; }
  merge16_desc(out); merge16_desc(m1);
#pragma unroll
  for (int i = 0; i < 16; ++i) out[i] = out[i] > m1[15 - i] ? out[i] : m1[15 - i];
  merge16_desc(out);
}
constexpr int pairs_before(int r, int c) { int n = 0; for (int rr = 0; rr < 16; ++rr) for (int cc = 0; cc < 16; ++cc) { if (rr == r && cc == c) return n; if ((rr + 1) * (cc + 1) <= 16) ++n; } return n; }
constexpr int PEER_TB = 32;
constexpr int PL_SK = 0, PL_LIST = 2 * 128 * 136 * 2, PL_LBUF = PEER_TB * 128 * 8, PL_IDX = PL_LIST + 2 * PL_LBUF;
__device__ __forceinline__ void peer_select_tile(int t0, int lb, unsigned char* lds, const bf16_t* __restrict__ qp) {
  using f32x16 = att::f32x16;
  int lane = threadIdx.x & 63; asm volatile("" : "+v"(lane));
  const int r32 = lane & 31, hi = lane >> 5, h = __builtin_amdgcn_readfirstlane(threadIdx.x >> 6);
  const bf16_t* SK = (const bf16_t*)(lds + PL_SK);
  unsigned top[2][16];
#pragma unroll
  for (int p = 0; p < 2; ++p) {
    f32x16 acc[4] = {};
    const bf16_t* qrow = qp + (size_t)(t0 + r32) * 2048 + h * 256 + p * 128 + hi * 8;
    bf16x8 qf[8];
#pragma unroll
    for (int ks = 0; ks < 8; ++ks) qf[ks] = *(const bf16x8*)(qrow + ks * 16);
#pragma unroll
    for (int ks = 0; ks < 8; ++ks) {
#pragma unroll
      for (int nt = 0; nt < 4; ++nt) { const bf16x8 kf = *(const bf16x8*)(SK + (p * 128 + nt * 32 + r32) * 136 + ks * 16 + hi * 8);
        acc[nt] = __builtin_amdgcn_mfma_f32_32x32x16_bf16(kf, qf[ks], acc[nt], 0, 0, 0); }
      __builtin_amdgcn_sched_barrier(0); }
    unsigned k[64];
#pragma unroll
    for (int nt = 0; nt < 4; ++nt)
#pragma unroll
      for (int r = 0; r < 16; ++r) k[nt * 16 + r] = (f2ord(acc[nt][r]) & 0xffffff80u) | (unsigned)(nt * 32 + (r & 3) + 8 * (r >> 2) + 4 * hi);
    unsigned own[16]; top16_of_64(k, own);
    unsigned X[16], Y[16];
#pragma unroll
    for (int i = 0; i < 16; ++i) { auto rr = __builtin_amdgcn_permlane32_swap(own[i], own[i], false, false); X[i] = rr[0]; Y[i] = rr[1]; }
#pragma unroll
    for (int i = 0; i < 16; ++i) top[p][i] = X[i] > Y[15 - i] ? X[i] : Y[15 - i];
    merge16_desc(top[p]);
  }
  float sa[16], sb[16];
#pragma unroll
  for (int i = 0; i < 16; ++i) { sa[i] = ord2f(top[0][i] & 0xffffff80u); sb[i] = ord2f(top[1][i] & 0xffffff80u); }
  unsigned ck[64];
#pragma unroll
  for (int i = 0; i < 64; ++i) ck[i] = 0u;
#pragma unroll
  for (int r = 0; r < 16; ++r)
#pragma unroll
    for (int c = 0; c < 16; ++c) if ((r + 1) * (c + 1) <= 16) ck[pairs_before(r, c)] = (f2ord(sa[r] + sb[c]) & 0xffffff00u) | (unsigned)(r * 16 + c);
  unsigned win[16]; top16_of_64(ck, win);
  unsigned char* slot = lds + PL_IDX + ((threadIdx.x >> 6) * 32 + r32) * 32;
  u32x4 ia, ib;
#pragma unroll
  for (int q4 = 0; q4 < 4; ++q4) { ia[q4] = (top[0][4 * q4] & 127u) | ((top[0][4 * q4 + 1] & 127u) << 8) | ((top[0][4 * q4 + 2] & 127u) << 16) | ((top[0][4 * q4 + 3] & 127u) << 24);
    ib[q4] = (top[1][4 * q4] & 127u) | ((top[1][4 * q4 + 1] & 127u) << 8) | ((top[1][4 * q4 + 2] & 127u) << 16) | ((top[1][4 * q4 + 3] & 127u) << 24); }
  *(u32x4*)slot = ia; *(u32x4*)(slot + 16) = ib;
  asm volatile("s_waitcnt lgkmcnt(0)" ::: "memory");
  const float s0 = ord2f(win[0] & 0xffffff00u);
  float ex[16], sum = 0.f; int ee[16];
#pragma unroll
  for (int j = 0; j < 16; ++j) { const unsigned pr = (win[j] >> 4) & 15u, pc = win[j] & 15u;
    ee[j] = (int)slot[pr] * 128 + (int)slot[16 + pc];
    ex[j] = __expf(ord2f(win[j] & 0xffffff00u) - s0); sum += ex[j]; }
  const float inv = 1.f / sum;
  if (hi == 0) { u32x2* L = (u32x2*)(lds + PL_LIST + lb * PL_LBUF) + r32 * 128 + h * 16;
#pragma unroll
    for (int j = 0; j < 16; ++j) L[j] = (u32x2){(unsigned)ee[j], __float_as_uint(ex[j] * inv)}; }
}
typedef unsigned u32x6 __attribute__((ext_vector_type(6)));
typedef float f32x32 __attribute__((ext_vector_type(32)));
typedef __bf16 bf16x32v __attribute__((ext_vector_type(32)));
typedef __bf16 bf16x2v __attribute__((ext_vector_type(2)));
__device__ __forceinline__ float half_sum(float v, bool hi) {
  v += dppf<0xB1, 0xf>(v); v += dppf<0x4E, 0xf>(v); v += dppf<0x141, 0xf>(v); v += dppf<0x140, 0xf>(v); v += dppf<0x142, 0xA>(v);
  const float a = readlane_f(v, 31), b = readlane_f(v, 63); return hi ? b : a;
}
__device__ __forceinline__ void peer_expert_tok2(int t0, int tl, int lb, unsigned char* lds, const unsigned char* __restrict__ ws, float* __restrict__ x1io, const float* __restrict__ g2, const float* __restrict__ b2) {
  int lane = threadIdx.x & 63; asm volatile("" : "+v"(lane));
  const int li = lane & 31; const bool hi = lane >= 32;
  const int t = t0 + tl + (hi ? 1 : 0);
  unsigned xu[16]; float y[32];
  { const bf16_t* xbr = (const bf16_t*)(ws + WS_X1B) + (size_t)t * DM + li * 4;
#pragma unroll
    for (int c = 0; c < 8; ++c) { const u32x2 a = *(const u32x2*)(xbr + 128 * c); xu[2 * c] = a.x; xu[2 * c + 1] = a.y; } }
#pragma unroll
  for (int i = 0; i < 32; ++i) y[i] = 0.f;
  const __amdgpu_buffer_rsrc_t rsT = __builtin_amdgcn_make_buffer_rsrc((void*)(ws + WS_TU8), (short)0, 16384 * REC6, 0x00020000);
  const int voP0 = li * 16, voQ0 = 512 + li * 8;
  const float* SU = (const float*)(ws + WS_SU); const float* SV = (const float*)(ws + WS_SV);
  u32x2* SORT = (u32x2*)(lds + PL_IDX) + (threadIdx.x >> 6) * 256;
#pragma unroll
  for (int hh = 0; hh < 2; ++hh) { const u32x2* Lraw = (const u32x2*)(lds + PL_LIST + lb * PL_LBUF) + (tl + hh) * 128;
    const u32x2 p0 = Lraw[2 * lane], p1 = Lraw[2 * lane + 1];
    const int b0 = (int)(p0.x >> 10), b1 = (int)(p1.x >> 10);
    int base = 0, pos0 = 0, pos1 = 0;
#pragma unroll
    for (int v = 0; v < 16; ++v) {
      const unsigned long long m0 = __ballot(b0 == v), m1 = __ballot(b1 == v);
      const int c0 = __builtin_popcountll(m0), c1 = __builtin_popcountll(m1);
      const int r0 = __builtin_amdgcn_mbcnt_hi((unsigned)(m0 >> 32), __builtin_amdgcn_mbcnt_lo((unsigned)m0, 0u));
      const int r1 = __builtin_amdgcn_mbcnt_hi((unsigned)(m1 >> 32), __builtin_amdgcn_mbcnt_lo((unsigned)m1, 0u));
      if (b0 == v) pos0 = base + r0;
      if (b1 == v) pos1 = base + c0 + r1;
      base += c0 + c1; }
    SORT[2 * pos0 + hh] = p0; SORT[2 * pos1 + hh] = p1; }
  asm volatile("s_waitcnt lgkmcnt(0)" ::: "memory");
  const u32x2* L = SORT;
  constexpr int PGS = 4, NPR = PGS / 2, NG = 256 / PGS;
#define PG_LOAD(UP, UQ, VP, VQ, EL, GL, SUv, SVv, hg) do { const u32x2 eg_ = L[(hg) * PGS + (lane & (PGS - 1))]; EL = (int)eg_.x; GL = __uint_as_float(eg_.y); SUv = SU[EL]; SVv = SV[EL]; \
    _Pragma("unroll") for (int pr = 0; pr < NPR; ++pr) { const int eb_ = (int)L[(hg) * PGS + 2 * pr + (hi ? 1 : 0)].x * REC6; \
      UP[pr] = __builtin_amdgcn_raw_buffer_load_b128(rsT, eb_ + voP0, 0, 0); UQ[pr] = __builtin_amdgcn_raw_buffer_load_b64(rsT, eb_ + voQ0, 0, 0); \
      VP[pr] = __builtin_amdgcn_raw_buffer_load_b128(rsT, eb_ + voP0 + 768, 0, 0); VQ[pr] = __builtin_amdgcn_raw_buffer_load_b64(rsT, eb_ + voQ0 + 768, 0, 0); } } while (0)
#define PG_COMP(UP, UQ, VP, VQ, GL, SUv, SVv) do { float dd_ = 0.f; \
    _Pragma("unroll") for (int pr = 0; pr < NPR; ++pr) { \
      const u32x6 uu_ = {UP[pr].x, UP[pr].y, UP[pr].z, UP[pr].w, UQ[pr].x, UQ[pr].y}; \
      const bf16x32v ub_ = __builtin_amdgcn_cvt_scalef32_pk32_bf16_fp6(uu_, 1.0f); \
      float d0_ = 0.f, d1_ = 0.f; \
      _Pragma("unroll") for (int i = 0; i < 16; i += 2) { \
        const bf16x2v ua_ = {ub_[2 * i], ub_[2 * i + 1]}, uc_ = {ub_[2 * i + 2], ub_[2 * i + 3]}; \
        d0_ = __builtin_amdgcn_fdot2_f32_bf16(ua_, __builtin_bit_cast(bf16x2v, xu[i]), d0_, false); d1_ = __builtin_amdgcn_fdot2_f32_bf16(uc_, __builtin_bit_cast(bf16x2v, xu[i + 1]), d1_, false); } \
      d0_ += d1_; d0_ += dppf<0xB1, 0xf>(d0_); d0_ += dppf<0x4E, 0xf>(d0_); d0_ += dppf<0x141, 0xf>(d0_); d0_ += dppf<0x140, 0xf>(d0_); d0_ += dppf<0x142, 0xA>(d0_);     \
      const float t0_ = readlane_f(d0_, 31), t1_ = readlane_f(d0_, 63); if (lane == 2 * pr) dd_ = t0_; if (lane == 2 * pr + 1) dd_ = t1_; } \
    const float av_ = dd_ * SUv; const float wl_ = GL * gelu_erf(av_) * SVv; \
    _Pragma("unroll") for (int pr = 0; pr < NPR; ++pr) { const float w0_ = readlane_f(wl_, 2 * pr), w1_ = readlane_f(wl_, 2 * pr + 1); const float w_ = hi ? w1_ : w0_; \
      const u32x6 vv_ = {VP[pr].x, VP[pr].y, VP[pr].z, VP[pr].w, VQ[pr].x, VQ[pr].y}; \
      const f32x32 vf_ = __builtin_amdgcn_cvt_scalef32_pk32_f32_fp6(vv_, 1.0f); \
      _Pragma("unroll") for (int i = 0; i < 32; ++i) y[i] = __builtin_fmaf(w_, vf_[i], y[i]); \
      __builtin_amdgcn_sched_barrier(0); } } while (0)
  {
    u32x4 upA[NPR], vpA[NPR], upB[NPR], vpB[NPR]; u32x2 uqA[NPR], vqA[NPR], uqB[NPR], vqB[NPR]; int elA, elB; float glA, glB, suA, suB, svA, svB;
    PG_LOAD(upA, uqA, vpA, vqA, elA, glA, suA, svA, 0);
    for (int hg = 0; hg < NG - 2; hg += 2) {
      PG_LOAD(upB, uqB, vpB, vqB, elB, glB, suB, svB, hg + 1);
      PG_COMP(upA, uqA, vpA, vqA, glA, suA, svA);
      PG_LOAD(upA, uqA, vpA, vqA, elA, glA, suA, svA, hg + 2);
      PG_COMP(upB, uqB, vpB, vqB, glB, suB, svB);
    }
    PG_LOAD(upB, uqB, vpB, vqB, elB, glB, suB, svB, NG - 1);
    PG_COMP(upA, uqA, vpA, vqA, glA, suA, svA);
    PG_COMP(upB, uqB, vpB, vqB, glB, suB, svB);
  }
#undef PG_LOAD
#undef PG_COMP
  float s = 0.f;
#pragma unroll
  for (int i = 0; i < 16; ++i) { y[2 * i] = ALPHA * __uint_as_float(xu[i] << 16) + y[2 * i]; y[2 * i + 1] = ALPHA * __uint_as_float(xu[i] & 0xffff0000u) + y[2 * i + 1]; s += y[2 * i] + y[2 * i + 1]; }
  const float mu = half_sum(s, hi) * (1.f / DM); float q = 0.f;
#pragma unroll
  for (int i = 0; i < 32; ++i) { y[i] -= mu; q += y[i] * y[i]; }
  const float rs = rsqrtf(half_sum(q, hi) * (1.f / DM) + LN_EPS);
  int ch0 = li * 4; asm volatile("" : "+v"(ch0));
  float* xr = x1io + (size_t)t * DM + ch0;
#pragma unroll
  for (int c = 0; c < 8; ++c) { const float4 gg = *(const float4*)(g2 + ch0 + 128 * c), bb = *(const float4*)(b2 + ch0 + 128 * c);
    float4 o; o.x = y[4 * c] * rs * gg.x + bb.x; o.y = y[4 * c + 1] * rs * gg.y + bb.y; o.z = y[4 * c + 2] * rs * gg.z + bb.z; o.w = y[4 * c + 3] * rs * gg.w + bb.w;
    *(float4*)(xr + 128 * c) = o; }
}
__device__ __forceinline__ void ph_peer(int bid, int nb, unsigned char* lds, unsigned char* ws, const float* __restrict__ subk, float* __restrict__ dout, const float* __restrict__ g2, const float* __restrict__ b2) {
  bf16_t* SK = (bf16_t*)(lds + PL_SK);
  for (int i = threadIdx.x; i < 2 * 128 * 32; i += 512) { const int row = i >> 5, c4 = i & 31; const float4 v = ((const float4*)subk)[i];
    u32x2 w; w.x = pk2(v.x, v.y); w.y = pk2(v.z, v.w); *(u32x2*)(SK + row * 136 + c4 * 4) = w; }
  __syncthreads();
  const int wave = threadIdx.x >> 6;
  const bf16_t* qp = (const bf16_t*)(ws + WS_QP);
  const bool both_first = (bid & 1) != 0;
  for (int tile = bid; tile < T / PEER_TB; tile += 2 * nb) {
    const int ta = tile * PEER_TB, tb = (tile + nb) * PEER_TB; const bool has_b = tile + nb < T / PEER_TB;
    peer_select_tile(ta, 0, lds, qp);
    if (both_first && has_b) peer_select_tile(tb, 1, lds, qp);
    __syncthreads();
    for (int i = 0; i < PEER_TB / 8; i += 2) { const int tl = wave * (PEER_TB / 8) + i; peer_expert_tok2(ta, tl, 0, lds, ws, dout, g2, b2); }
    if (has_b) {
      if (!both_first) { __syncthreads(); peer_select_tile(tb, 1, lds, qp); __syncthreads(); }
      for (int i = 0; i < PEER_TB / 8; i += 2) { const int tl = wave * (PEER_TB / 8) + i; peer_expert_tok2(tb, tl, 1, lds, ws, dout, g2, b2); }
    }
    __syncthreads();
  }
}

#define LAS __attribute__((address_space(3)))
#define XB_TMO      128
#define XB_XCNT(j)  (256  + 64 * (j))
#define XB_XSUB(j)  (1280 + 64 * (j))
#define XB_XGEN(j)  (2304 + 64 * (j))
#define XB_TOP      3328
#define XB_TOPGEN   3392
#define XCD_BAR_WORDS 3456
#define XB_SPIN_CAP (1u << 18)

__device__ __forceinline__ unsigned xb_ld(unsigned* p)              { return __hip_atomic_load(p, __ATOMIC_RELAXED, __HIP_MEMORY_SCOPE_AGENT); }
__device__ __forceinline__ unsigned xb_add(unsigned* p, unsigned v) { return __hip_atomic_fetch_add(p, v, __ATOMIC_RELAXED, __HIP_MEMORY_SCOPE_AGENT); }
__device__ __forceinline__ unsigned xb_xcc_id() { return (unsigned)__builtin_amdgcn_s_getreg((3 << 11) | 20) & 0xFu; }
#define XB_SPIN(cond, bar) do { unsigned _sp = 0; while (cond) { __builtin_amdgcn_s_sleep(1); \
    if ((++_sp & 255u) == 0u) { if (xb_ld(&(bar)[XB_TMO])) break; if (_sp > XB_SPIN_CAP) { atomicAdd(&(bar)[XB_TMO], 1u); break; } } } } while (0)

struct XcdBarrier {
    unsigned* bar; unsigned x;
    volatile LAS unsigned* st;
};

__device__ __forceinline__ XcdBarrier xcd_barrier_post(unsigned* bar, volatile LAS unsigned* st) {
    XcdBarrier b; b.bar = bar; b.x = xb_xcc_id(); b.st = st;
    if (threadIdx.x == 0) (void)xb_add(&bar[XB_XCNT(b.x)], 1u);
    return b;
}
__device__ __forceinline__ void xcd_barrier_complete(unsigned* bar, unsigned x, unsigned& nloc, unsigned& nx) {
    const unsigned G = gridDim.x * gridDim.y * gridDim.z;
    unsigned sum, cnt, mine, sp = 0u;
    for (;;) {
        sum = 0u; cnt = 0u; mine = 0u;
#pragma unroll
        for (unsigned j = 0; j < 16; ++j) { const unsigned c = xb_ld(&bar[XB_XCNT(j)]); sum += c; cnt += (c > 0u) ? 1u : 0u; mine = (j == x) ? c : mine; }
        if (sum == G) break;
        __builtin_amdgcn_s_sleep(1);
        if ((++sp & 255u) == 0u) { if (xb_ld(&bar[XB_TMO])) break; if (sp > XB_SPIN_CAP) { atomicAdd(&bar[XB_TMO], 1u); break; } }
    }
    nloc = mine > 0u ? mine : 1u; nx = cnt > 0u ? cnt : 1u;
}

__device__ __forceinline__ void xcd_barrier(const XcdBarrier& b) {
    asm volatile("s_waitcnt vmcnt(0)" ::: "memory");
    __syncthreads();
    if (threadIdx.x == 0) {
        unsigned* bar = b.bar;
        __builtin_amdgcn_s_waitcnt(0);
        unsigned nloc = b.st[0], nx = b.st[1];
        if (nloc == 0u) { xcd_barrier_complete(bar, b.x, nloc, nx); b.st[0] = nloc; b.st[1] = nx; }
        const unsigned old = xb_add(&bar[XB_XSUB(b.x)], 1u);
        const unsigned gen = old / nloc;
        if (old + 1u == (gen + 1u) * nloc) {
            __builtin_amdgcn_fence(__ATOMIC_RELEASE, "agent");
            asm volatile("s_waitcnt vmcnt(0)" ::: "memory");
            const unsigned og = xb_add(&bar[XB_TOP], 1u);
            const unsigned tg = og / nx;
            if (og + 1u == (tg + 1u) * nx) xb_add(&bar[XB_TOPGEN], 1u);
            else XB_SPIN(xb_ld(&bar[XB_TOPGEN]) == tg, bar);
            __builtin_amdgcn_fence(__ATOMIC_ACQUIRE, "agent");
            xb_add(&bar[XB_XGEN(b.x)], 1u);
            asm volatile("s_waitcnt vmcnt(0)" ::: "memory");
        } else {
            XB_SPIN(xb_ld(&bar[XB_XGEN(b.x)]) == gen, bar);
            __builtin_amdgcn_fence(__ATOMIC_ACQUIRE, "agent");
            asm volatile("s_waitcnt vmcnt(0)" ::: "memory");
        }
    }
    __syncthreads();
}

struct KP { const float* in[19]; float* out; unsigned char* ws; int ph_lo, ph_hi; };
constexpr int NPHASE = 10;
#ifndef MK_LAUNCHES
#define MK_LAUNCHES 1
#endif
__global__ __launch_bounds__(512) void mega(KP p) {
  extern __shared__ __attribute__((aligned(16))) unsigned char lds[];
  cg::grid_group grid = cg::this_grid();
  const int bid = blockIdx.x, nb = gridDim.x, lane = threadIdx.x & 63;
  unsigned char* ws = p.ws; unsigned char* dob = (unsigned char*)p.out; float* dout = p.out;
  const float* x = p.in[0]; const float* w_in = p.in[1];
  bf16_t* xb = (bf16_t*)(dob + DO_XB); bf16_t* WinT = (bf16_t*)(dob + DO_WINT); bf16_t* UT = (bf16_t*)dob;
  float* gpre = (float*)(ws + WS_GPRE); float2* cs = (float2*)(ws + WS_CS);
  EP e; e.x = x; e.ws = ws; e.dout = dout; e.cs = cs;
#ifdef ONLY_PH
#define IN(k) ((k) == ONLY_PH && p.ph_lo <= (k) && (k) < p.ph_hi)
#else
#define IN(k) (p.ph_lo <= (k) && (k) < p.ph_hi)
#endif
  volatile LAS unsigned* bst = (volatile LAS unsigned*)((LAS unsigned char*)lds + (LDS_BYTES - 64));
  if (threadIdx.x < 2) bst[threadIdx.x] = 0u;
  __syncthreads();
  const XcdBarrier xbar = xcd_barrier_post((unsigned*)ws, bst);
#define SEAM(k) do { if (IN(k) && IN((k) + 1)) xcd_barrier(xbar); } while (0)
  if (IN(0)) {
    ph_prep_x(bid, nb, lds, x, w_in, p.in[6], xb, gpre);
    ph_prep_weights(bid, nb, lds, w_in, p.in[8], p.in[9], p.in[10], p.in[13], WinT, ws);
    ph_rope_tab(bid, nb, cs);
  }
  SEAM(0);
  if (IN(1)) {
    if (bid >= nb - 16) gp_scan(bid - (nb - 16), gpre, ws, lds);
    ph_gemm8<EPI_G1>(lds, xb, WinT, 5632, 1024, e);
  }
  SEAM(1);
  if (IN(2)) { M1Pre pr; if (bid < 1024) m1_prefetch(bid, pr, ws, p.in[4], p.in[5]);
    for (int u = bid; u < 1024; u += nb) { if (u + nb < 1024) m1_unit<true>(u, u + nb, pr, lds, ws, UT, p.in[4], p.in[5]); else m1_unit<false>(u, u, pr, lds, ws, UT, p.in[4], p.in[5]); } }
  SEAM(2);
  if (IN(3)) m2_scan(bid, nb, ws, UT);
  SEAM(3);
  if (IN(4)) {
    const float lam = compute_lambda(p.in[2], lane);
    for (int u = bid; u < 256; u += nb) att::attn_unit(u & 7, u >> 3, ws, u, lam, p.in[3], (char*)lds);
    for (int u = bid; u < 1024; u += nb) m3_unit(u, lds, ws, UT, p.in[7]);
  }
  SEAM(4);
  if (IN(5)) {
    ph_gemm_merge(lds, ws);
  }
  SEAM(5);
  if (IN(6)) ph_gemm8<EPI_OUT>(lds, (const bf16_t*)(ws + WS_MG), (const bf16_t*)(ws + WS_WOUT), 1024, 1024, e);
  SEAM(6);
  if (IN(7)) {
    ph_ln1_tab8(bid, nb, dout, p.in[11], p.in[12], (bf16_t*)(ws + WS_X1B), p.in[15], p.in[16], ws);
  }
  SEAM(7);
  if (IN(8)) ph_gemm8<EPI_QP>(lds, (const bf16_t*)(ws + WS_X1B), (const bf16_t*)(ws + WS_WQ), 2048, 1024, e);
  SEAM(8);
  if (IN(9)) ph_peer(bid, nb, lds, ws, p.in[14], dout, p.in[17], p.in[18]);
  if (p.ph_hi - p.ph_lo == NPHASE) grid.sync();
#undef IN
#undef SEAM
}

extern "C" void kernel_launch(void* const* d_in, const int* in_sizes, int n_in, void* d_out, int out_size, void* d_ws, size_t ws_size, hipStream_t stream) {
  static int grid = 0;
  if (grid == 0) {
    int dev = 0, cus = 0, per_cu = 0;
    hipGetDevice(&dev); hipDeviceGetAttribute(&cus, hipDeviceAttributeMultiprocessorCount, dev);
    hipFuncSetAttribute((const void*)mega, hipFuncAttributeMaxDynamicSharedMemorySize, LDS_BYTES);
    hipOccupancyMaxActiveBlocksPerMultiprocessor(&per_cu, (const void*)mega, 512, LDS_BYTES);
    if (per_cu < 1) { fprintf(stderr, "kernel_launch: occupancy query says %d blocks per CU\n", per_cu); per_cu = 1; }
    grid = cus * 1;
  }
  hipMemsetAsync(d_ws, 0, 16384, stream);
  KP p{};
  for (int i = 0; i < 19; ++i) p.in[i] = (const float*)d_in[i];
  p.out = (float*)d_out; p.ws = (unsigned char*)d_ws;
  if (MK_LAUNCHES == 1) {
    p.ph_lo = 0; p.ph_hi = NPHASE;
    void* args[] = {&p};
    hipError_t er = hipLaunchCooperativeKernel((void*)mega, dim3(grid), dim3(512), args, LDS_BYTES, stream);
    if (er != hipSuccess) fprintf(stderr, "cooperative launch failed: %s (grid %d)\n", hipGetErrorString(er), grid);
  } else {
    for (int k = 0; k < NPHASE; ++k) { p.ph_lo = k; p.ph_hi = k + 1; hipLaunchKernelGGL(mega, dim3(grid), dim3(512), LDS_BYTES, stream, p); }
  }
}
```

```cpp
#include <hip/hip_runtime.h>
#include <hip/hip_cooperative_groups.h>
#include <cstdio>
#include <stdint.h>
#include <math.h>

namespace cg = cooperative_groups;
typedef unsigned short bf16_t;
typedef short bf16x8 __attribute__((ext_vector_type(8)));
typedef float f32x4 __attribute__((ext_vector_type(4)));
typedef unsigned u32x2 __attribute__((ext_vector_type(2)));
typedef unsigned u32x4 __attribute__((ext_vector_type(4)));

constexpr int T = 16384, SEQ = 8192, DM = 1024;
constexpr float ALPHA = 1.189207115002721f;
constexpr float LN_EPS = 1e-5f;
constexpr float LAMBDA_INIT = 0.2f;
constexpr float QSCALE = 0.125f * 1.4426950408889634f;

constexpr size_t MB = 1u << 20;
constexpr size_t WS_GPRE = 1 * MB;
constexpr size_t WS_CS = 2 * MB;
constexpr size_t WS_WA = 8 * MB;
constexpr size_t WS_WM = 9 * MB;
constexpr size_t WS_WOUT = 10 * MB;
constexpr size_t WS_WQ = 12 * MB;
constexpr size_t WS_G1 = 16 * MB;
constexpr size_t WS_Q = 16 * MB, WS_K = 32 * MB, WS_V = 48 * MB, WS_MQ = 64 * MB, WS_MK = 80 * MB, WS_MV = 96 * MB, WS_MO = 112 * MB;
constexpr size_t WS_BG = 128 * MB;
constexpr size_t WS_QC = 192 * MB, WS_KC = 208 * MB;
constexpr size_t WS_O0 = 224 * MB;
constexpr size_t WS_YA = WS_MQ, WS_YM = WS_MK;
constexpr size_t WS_MG = WS_Q;
constexpr size_t WS_X1B = WS_QC;
constexpr size_t WS_TU = 128 * MB, WS_TV = 160 * MB;
constexpr size_t WS_QP = 16 * MB;
constexpr size_t WS_EXP = 96 * MB, WS_GATE = 104 * MB;
constexpr size_t DO_XB = 0, DO_WINT = 32 * MB;

__device__ __forceinline__ float bf2f(bf16_t v) { return __uint_as_float(((unsigned)v) << 16); }
__device__ __forceinline__ bf16_t f2bf(float f) { unsigned u = __float_as_uint(f); u += 0x7fffu + ((u >> 16) & 1u); return (bf16_t)(u >> 16); }
__device__ __forceinline__ unsigned pk2(float lo, float hi) { return (unsigned)f2bf(lo) | ((unsigned)f2bf(hi) << 16); }
__device__ __forceinline__ float sigmoidf_(float x) { return 1.f / (1.f + __expf(-x)); }
__device__ __forceinline__ float wave_sum(float v) {
#pragma unroll
  for (int o = 1; o < 64; o <<= 1) v += __shfl_xor(v, o);
  return v;
}
__device__ __forceinline__ float wave_max(float v) {
#pragma unroll
  for (int o = 1; o < 64; o <<= 1) v = fmaxf(v, __shfl_xor(v, o));
  return v;
}
__device__ __forceinline__ unsigned wave_maxu(unsigned v) {
#pragma unroll
  for (int o = 1; o < 64; o <<= 1) { unsigned w = (unsigned)__shfl_xor((int)v, o); v = v > w ? v : w; }
  return v;
}

__device__ __forceinline__ void ph_prep_x(int bid, int nb, unsigned char* lds, const float* __restrict__ x, const float* __restrict__ w_in, const float* __restrict__ gate_b,
                                          bf16_t* __restrict__ xb, float* __restrict__ gpre) {
  const int lane = threadIdx.x & 63, wave = __builtin_amdgcn_readfirstlane(threadIdx.x >> 6), fr = lane & 15, fq = lane >> 4;
  bf16_t* WGb = (bf16_t*)lds;
  for (int i = threadIdx.x; i < 16 * 1024; i += 512) { const int k = i >> 4, g = i & 15; WGb[g * 1032 + k] = f2bf(w_in[(size_t)k * 5648 + 3584 + g]); }
  const int rpb = ((T / 16 + nb - 1) / nb) * 16, row0 = bid * rpb, nrow = row0 < T ? (T - row0 < rpb ? T - row0 : rpb) : 0;
  { const float4* xs = (const float4*)(x + (size_t)row0 * DM); u32x2* xd = (u32x2*)(xb + (size_t)row0 * DM);
    for (int i = threadIdx.x; i < nrow * 256; i += 512) { const float4 v = xs[i]; u32x2 w; w.x = pk2(v.x, v.y); w.y = pk2(v.z, v.w); xd[i] = w; } }
  asm volatile("s_waitcnt vmcnt(0)" ::: "memory");
  __syncthreads();
  for (int rt = wave; rt * 16 < nrow; rt += 8) {
    const bf16_t* xr = xb + (size_t)(row0 + rt * 16 + fr) * DM + 8 * fq; const bf16_t* wr = WGb + fr * 1032 + 8 * fq;
    f32x4 acc = {0.f, 0.f, 0.f, 0.f};
#pragma unroll 8
    for (int ks = 0; ks < 32; ++ks) { const bf16x8 a = *(const bf16x8*)(xr + 32 * ks), bv = *(const bf16x8*)(wr + 32 * ks);
      acc = __builtin_amdgcn_mfma_f32_16x16x32_bf16(a, bv, acc, 0, 0, 0); }
    const float gb = gate_b[fr];
#pragma unroll
    for (int r = 0; r < 4; ++r) gpre[(size_t)(row0 + rt * 16 + 4 * fq + r) * 16 + fr] = acc[r] + gb;
  }
  __syncthreads();
}
__device__ __forceinline__ int src_col(int n, int mode) {
  if (mode == 1) { if (n < 1024) { const int j = n & 63; const int pj = j < 16 ? ((j & 1) ? (j >> 1) + 8 : (j >> 1)) : j; return (n & ~63) + pj; } else if (n >= 3584) return n + 16; }
  return n;
}
__device__ __forceinline__ void transpose_item(const float* __restrict__ W, int ldw, int K, int nblk, bf16_t* __restrict__ WT, float* scr, int item, int lane, int mode, int ldo = 0) {
  if (ldo == 0) ldo = K;
  const int kb = item / nblk, nbk = item % nblk, k0 = 64 * kb, n0 = 32 * nbk;
  const int sc = src_col(n0 + (lane & 31), mode);
#pragma unroll 8
  for (int i = 0; i < 32; ++i) { const int kk = 2 * i + (lane >> 5); scr[kk * 33 + (lane & 31)] = W[(size_t)(k0 + kk) * ldw + sc]; }
  asm volatile("s_waitcnt lgkmcnt(0)" ::: "memory");
  const int c = lane & 7;
#pragma unroll
  for (int j = 0; j < 4; ++j) { const int n = (lane >> 3) + 8 * j; const float* s = scr + (8 * c) * 33 + n;
    u32x4 o; o.x = pk2(s[0 * 33], s[1 * 33]); o.y = pk2(s[2 * 33], s[3 * 33]); o.z = pk2(s[4 * 33], s[5 * 33]); o.w = pk2(s[6 * 33], s[7 * 33]);
    *(u32x4*)(WT + (size_t)(n0 + n) * ldo + k0 + 8 * c) = o; }
  asm volatile("s_waitcnt lgkmcnt(0)" ::: "memory");
}
__device__ __forceinline__ void ph_prep_weights(int bid, int nb, unsigned char* lds, const float* w_in, const float* w_ba, const float* w_bm, const float* w_out, const float* w_q,
                                                bf16_t* WinT, unsigned char* ws) {
  const int lane = threadIdx.x & 63, wave = threadIdx.x >> 6;
  float* scr = (float*)(lds + 65536 + wave * 8448);
  constexpr int I_IN = 16 * 176, I_BA = 8 * 32, I_OUT = 16 * 32, I_Q = 16 * 64, NIT = I_IN + 2 * I_BA + I_OUT + I_Q;
  for (int it = bid * 8 + wave; it < NIT; it += nb * 8) {
    int r = it;
    if (r < I_IN) { transpose_item(w_in, 5648, 1024, 176, WinT, scr, r, lane, 1); continue; } r -= I_IN;
    if (r < I_BA) { transpose_item(w_ba, 1024, 512, 32, (bf16_t*)(ws + WS_WA), scr, r, lane, 0, 1024); continue; } r -= I_BA;
    if (r < I_BA) { transpose_item(w_bm, 1024, 512, 32, (bf16_t*)(ws + WS_WA) + 512, scr, r, lane, 0, 1024); continue; } r -= I_BA;
    if (r < I_OUT) { transpose_item(w_out, 1024, 1024, 32, (bf16_t*)(ws + WS_WOUT), scr, r, lane, 0); continue; } r -= I_OUT;
    transpose_item(w_q, 2048, 1024, 64, (bf16_t*)(ws + WS_WQ), scr, r, lane, 0);
  }
}
__device__ __forceinline__ void ph_cvt(int bid, int nb, const float* __restrict__ in, bf16_t* __restrict__ out, size_t n4) {
  for (size_t i = (size_t)bid * 512 + threadIdx.x; i < n4; i += (size_t)nb * 512) {
    const float4 v = ((const float4*)in)[i]; u32x2 w; w.x = pk2(v.x, v.y); w.y = pk2(v.z, v.w); ((u32x2*)out)[i] = w; }
}
__device__ __forceinline__ void ph_rope_tab(int bid, int nb, float2* __restrict__ cs) {
  for (int idx = bid * 512 + threadIdx.x; idx < 8192 * 8; idx += nb * 512) {
    const int s = idx >> 3, i = idx & 7;
    const double inv = pow(500000.0, -(double)i / 8.0); const double ang = (double)s * inv;
    cs[idx] = make_float2((float)cos(ang), (float)sin(ang));
  }
}

struct EP { const float* x; unsigned char* ws; float* dout; const float2* cs; };
enum { EPI_G1 = 0, EPI_M1 = 1, EPI_M2 = 2, EPI_OUT = 3, EPI_QP = 4 };
template <int EPI> __device__ __forceinline__ void epi4(const EP& e, int row, int col, f32x4 v) {
  if (EPI == EPI_G1) {
    if (col < 1024) {
      if ((col & 63) < 16) { const int s = row & (SEQ - 1), i0 = (col & 15) >> 1; const float2 c0 = e.cs[s * 8 + i0], c1 = e.cs[s * 8 + i0 + 1];
        const float a0 = v[0] * c0.x - v[1] * c0.y, b0 = v[1] * c0.x + v[0] * c0.y, a1 = v[2] * c1.x - v[3] * c1.y, b1 = v[3] * c1.x + v[2] * c1.y;
        v[0] = a0; v[1] = b0; v[2] = a1; v[3] = b1; }
      if (col < 512) v = v * QSCALE;
    } else if (col >= 3072) { v[0] = sigmoidf_(v[0]); v[1] = sigmoidf_(v[1]); v[2] = sigmoidf_(v[2]); v[3] = sigmoidf_(v[3]); }
    bf16_t* dst = col < 3584 ? (bf16_t*)(e.ws + WS_G1) + (size_t)(col >> 9) * ((size_t)T * 512) + (size_t)row * 512 + (col & 511)
                             : (bf16_t*)(e.ws + WS_BG) + (size_t)row * 2048 + (col - 3584);
    u32x2 w; w.x = pk2(v[0], v[1]); w.y = pk2(v[2], v[3]); *(u32x2*)dst = w;
  } else if (EPI == EPI_M1 || EPI == EPI_M2) {
    const bf16_t* g = (const bf16_t*)(e.ws + WS_BG) + (size_t)row * 2048 + (EPI == EPI_M2 ? 1024 : 0) + col;
    const u32x2 gw = *(const u32x2*)g;
    bf16_t* dst = (bf16_t*)(e.ws + WS_MG) + (size_t)row * 1024 + col;
    float r0 = v[0] * __uint_as_float(gw.x << 16), r1 = v[1] * __uint_as_float(gw.x & 0xffff0000u), r2 = v[2] * __uint_as_float(gw.y << 16), r3 = v[3] * __uint_as_float(gw.y & 0xffff0000u);
    if (EPI == EPI_M2) { const u32x2 pw = *(const u32x2*)dst; r0 += __uint_as_float(pw.x << 16); r1 += __uint_as_float(pw.x & 0xffff0000u); r2 += __uint_as_float(pw.y << 16); r3 += __uint_as_float(pw.y & 0xffff0000u); }
    u32x2 w; w.x = pk2(r0, r1); w.y = pk2(r2, r3); *(u32x2*)dst = w;
  } else if (EPI == EPI_OUT) {
    const f32x4 xv = *(const f32x4*)(e.x + (size_t)row * DM + col);
    *(f32x4*)(e.dout + (size_t)row * DM + col) = xv * ALPHA + v;
  } else if (EPI == EPI_QP) {
    u32x2 w; w.x = pk2(v[0], v[1]); w.y = pk2(v[2], v[3]); *(u32x2*)((bf16_t*)(e.ws + WS_QP) + (size_t)row * 2048 + col) = w;
  }
}
__device__ __forceinline__ float fsig(float x) { return __builtin_amdgcn_rcpf(1.f + __builtin_amdgcn_exp2f(-1.4426950408889634f * x)); }
__device__ __forceinline__ void rope4(const float2* __restrict__ cs, int s, int i0, f32x4& v) {
  const float2 c0 = cs[s * 8 + i0], c1 = cs[s * 8 + i0 + 1];
  const float a0 = v[0] * c0.x - v[1] * c0.y, b0 = v[1] * c0.x + v[0] * c0.y, a1 = v[2] * c1.x - v[3] * c1.y, b1 = v[3] * c1.x + v[2] * c1.y;
  v[0] = a0; v[1] = b0; v[2] = a1; v[3] = b1;
}
__device__ __forceinline__ void unpk8(const u32x4 w, float* f) {
#pragma unroll
  for (int i = 0; i < 4; ++i) { f[2 * i] = __uint_as_float(w[i] << 16); f[2 * i + 1] = __uint_as_float(w[i] & 0xffff0000u); }
}
template <int EPI> __device__ __forceinline__ void epi8(const EP& e, int row, int col, f32x4 v0, f32x4 v1) {
  if (EPI == EPI_G1) {
    if (col < 1024) {
      if ((col & 63) < 16) { const int s = row & (SEQ - 1), i0 = (col & 15) >> 1; rope4(e.cs, s, i0, v0); rope4(e.cs, s, i0 + 2, v1); }
      if (col < 512) { v0 = v0 * QSCALE; v1 = v1 * QSCALE; }
    } else if (col >= 3072) {
#pragma unroll
      for (int i = 0; i < 4; ++i) { v0[i] = fsig(v0[i]); v1[i] = fsig(v1[i]); }
    }
    bf16_t* dst = col < 3584 ? (bf16_t*)(e.ws + WS_G1) + (size_t)(col >> 9) * ((size_t)T * 512) + (size_t)row * 512 + (col & 511)
                             : (bf16_t*)(e.ws + WS_BG) + (size_t)row * 2048 + (col - 3584);
    u32x4 w; w.x = pk2(v0[0], v0[1]); w.y = pk2(v0[2], v0[3]); w.z = pk2(v1[0], v1[1]); w.w = pk2(v1[2], v1[3]); *(u32x4*)dst = w;
  } else if (EPI == EPI_M1 || EPI == EPI_M2) {
    float g[8]; unpk8(*(const u32x4*)((const bf16_t*)(e.ws + WS_BG) + (size_t)row * 2048 + (EPI == EPI_M2 ? 1024 : 0) + col), g);
    bf16_t* dst = (bf16_t*)(e.ws + WS_MG) + (size_t)row * 1024 + col;
    float r[8];
#pragma unroll
    for (int i = 0; i < 4; ++i) { r[i] = v0[i] * g[i]; r[4 + i] = v1[i] * g[4 + i]; }
    if (EPI == EPI_M2) { float pv[8]; unpk8(*(const u32x4*)dst, pv);
#pragma unroll
      for (int i = 0; i < 8; ++i) r[i] += pv[i]; }
    u32x4 w; w.x = pk2(r[0], r[1]); w.y = pk2(r[2], r[3]); w.z = pk2(r[4], r[5]); w.w = pk2(r[6], r[7]); *(u32x4*)dst = w;
  } else if (EPI == EPI_OUT) {
    const f32x4 x0 = *(const f32x4*)(e.x + (size_t)row * DM + col), x1 = *(const f32x4*)(e.x + (size_t)row * DM + col + 4);
    const f32x4 r0 = x0 * ALPHA + v0, r1 = x1 * ALPHA + v1;
    u32x4 w; w.x = pk2(r0[0], r0[1]); w.y = pk2(r0[2], r0[3]); w.z = pk2(r1[0], r1[1]); w.w = pk2(r1[2], r1[3]); *(u32x4*)((bf16_t*)e.dout + (size_t)row * DM + col) = w;
  } else if (EPI == EPI_QP) {
    u32x4 w; w.x = pk2(v0[0], v0[1]); w.y = pk2(v0[2], v0[3]); w.z = pk2(v1[0], v1[1]); w.w = pk2(v1[2], v1[3]);
    *(u32x4*)((bf16_t*)(e.ws + WS_QP) + (size_t)row * 2048 + col) = w;
  }
}
template <int EPI> __device__ __forceinline__ void ph_gemm(int bid, int nb, const bf16_t* __restrict__ A, const bf16_t* __restrict__ Bt, int N, int K, const EP& e) {
  const int tid = threadIdx.x & 255, half = threadIdx.x >> 8, wave = tid >> 6, lane = tid & 63, fr = lane & 15, fq = lane >> 4;
  const int ntn = N / 64, ntiles = ntn * (T / 64);
  for (int tile = bid * 2 + half; tile < ntiles; tile += nb * 2) {
    const int m0 = (tile / ntn) * 64 + (wave & 1) * 32, n0 = (tile % ntn) * 64 + (wave >> 1) * 32;
    f32x4 acc[2][2];
#pragma unroll
    for (int i = 0; i < 2; ++i)
#pragma unroll
      for (int j = 0; j < 2; ++j) acc[i][j] = (f32x4){0.f, 0.f, 0.f, 0.f};
    const bf16_t* ap = A + (size_t)(m0 + fr) * K + fq * 8; const bf16_t* bp = Bt + (size_t)(n0 + fr) * K + fq * 8;
    for (int k0 = 0; k0 < K; k0 += 32) {
      bf16x8 a[2], b[2];
#pragma unroll
      for (int i = 0; i < 2; ++i) { a[i] = *(const bf16x8*)(ap + (size_t)i * 16 * K + k0); b[i] = *(const bf16x8*)(bp + (size_t)i * 16 * K + k0); }
#pragma unroll
      for (int i = 0; i < 2; ++i)
#pragma unroll
        for (int j = 0; j < 2; ++j) acc[i][j] = __builtin_amdgcn_mfma_f32_16x16x32_bf16(b[j], a[i], acc[i][j], 0, 0, 0);
    }
#pragma unroll
    for (int i = 0; i < 2; ++i)
#pragma unroll
      for (int j = 0; j < 2; ++j) epi4<EPI>(e, m0 + 16 * i + fr, n0 + 16 * j + 4 * fq, acc[i][j]);
  }
}

namespace pg8 {
#define PG8_LAS __attribute__((address_space(3)))
typedef unsigned short bf16_t;
typedef short bf16x8 __attribute__((ext_vector_type(8)));
typedef float f32x4 __attribute__((ext_vector_type(4)));
typedef unsigned u32x4 __attribute__((ext_vector_type(4)));
constexpr int BM = 256, BK = 64, HALF = 128, HTB = HALF * BK * 2  , STAGE_BYTES = 8 * HTB, NXCD = 8, WGM = 8;

__host__ __device__ __forceinline__ int lds_byte(int r, int c) { const int st = (r >> 4) * 2 + (c >> 5), rr = r & 15, cc = c & 31, ob = rr * 64 + cc * 2; return st * 1024 + (ob ^ (((ob >> 9) & 1) << 5)); }
__host__ __device__ __forceinline__ void stage_rc(int b, int& R, int& C) { const int st = b / 1024, sb = b % 1024, swz = sb ^ (((sb >> 9) & 1) << 5); R = (st >> 1) * 16 + swz / 64; C = (st & 1) * 32 + (swz % 64) / 2; }
__host__ __device__ __forceinline__ int perm32(int rho) { const int n = rho >> 4, i = rho & 15; return 8 * (i >> 2) + 4 * n + (i & 3); }

struct Unit { int pm, pn; };
struct Gemm { const bf16_t* A; const bf16_t* Bt; int M, N, K; };

struct StaticOrder {
    int nM, nN, nwg, G, c;
    __host__ __device__ void init(int M, int N, int G_, int c_) { nM = M / BM; nN = N / BM; nwg = nM * nN; G = G_; c = c_; }
    __host__ __device__ bool next(int i, Unit& u) const {
        const long L = (long)i * G + c; if (L >= nwg) return false;
        int wgid = (int)L; { const int q = nwg / NXCD, r = nwg % NXCD, xcd = wgid % NXCD, off = wgid / NXCD; wgid = (xcd < r ? xcd * (q + 1) : r * (q + 1) + (xcd - r) * q) + off; }
        const int nig = WGM * nN, gid = wgid / nig, fm = gid * WGM, gsz = (nM - fm) < WGM ? (nM - fm) : WGM;
        u.pm = fm + ((wgid % nig) % gsz); u.pn = (wgid % nig) / gsz; return true;
    }
    __device__ __forceinline__ void a_ready(const Unit&) const {}
    __device__ __forceinline__ void done(const Unit&) const {}
};

template <class Epi, class Sched, bool ALIGN_EPI = false, bool SP2 = false>
__device__ __forceinline__ void gemm_phase(PG8_LAS unsigned char* lds, const Gemm g, const Sched& S, const Epi& E) {
    const int tid = threadIdx.x, wid = __builtin_amdgcn_readfirstlane(tid >> 6), lane = tid & 63, wr = wid >> 2, wc = wid & 3, fr = lane & 15, fq = lane >> 4;
    const int K = g.K, nt = K / BK;
    unsigned voffA[2], voffB[2];
#pragma unroll
    for (int i = 0; i < 2; ++i) { int R, C; stage_rc(tid * 16 + i * 8192, R, C); const int Rb = Epi::PERM ? ((R & ~31) + perm32(R & 31)) : R;
        voffA[i] = (unsigned)(R * K + C) * 2u; voffB[i] = (unsigned)(Rb * K + C) * 2u; }
    const size_t kstep = (size_t)(BK * 2);
    const size_t hstep = (size_t)HALF * K * 2;
    const size_t tstep = 2 * hstep;
    const unsigned ldsw = (unsigned)wid * 1024u;
    const int aoff = lds_byte(wr * 64 + fr, fq * 8), boff = lds_byte(wc * 32 + fr, fq * 8);
#define PG8_SA(b, h) (((b) * 2 + (h)) * HTB)
#define PG8_SB(b, h) ((4 + (b) * 2 + (h)) * HTB)
#define PG8_STAGE(bufoff, gbase, voff) do { _Pragma("unroll") for (int _i = 0; _i < 2; ++_i) \
        __builtin_amdgcn_global_load_lds((const unsigned*)((const char*)(gbase) + (voff)[_i]), (PG8_LAS unsigned*)(lds + (bufoff) + ldsw + _i * 8192), 16, 0, 0); } while (0)
#define PG8_LDA(dst, b, h) do { _Pragma("unroll") for (int m = 0; m < 4; ++m) _Pragma("unroll") for (int k = 0; k < 2; ++k) dst[m][k] = *(const PG8_LAS bf16x8*)(lds + PG8_SA(b, h) + aoff + m * 2048 + k * 1024); } while (0)
#define PG8_LDB(dst, b, h) do { _Pragma("unroll") for (int n = 0; n < 2; ++n) _Pragma("unroll") for (int k = 0; k < 2; ++k) dst[n][k] = *(const PG8_LAS bf16x8*)(lds + PG8_SB(b, h) + boff + n * 2048 + k * 1024); } while (0)
#define PG8_MMA(ai, bj, At, Bt) do { __builtin_amdgcn_s_setprio(1); _Pragma("unroll") for (int m = 0; m < 4; ++m) _Pragma("unroll") for (int n = 0; n < 2; ++n) _Pragma("unroll") for (int k = 0; k < 2; ++k) \
        acc[ai][bj][m][n] = __builtin_amdgcn_mfma_f32_16x16x32_bf16(Bt[n][k], At[m][k], acc[ai][bj][m][n], 0, 0, 0); __builtin_amdgcn_s_setprio(0); } while (0)
#define PG8_WAIT_V(n) asm volatile("s_waitcnt vmcnt(" #n ")" ::: "memory")
#define PG8_WAIT_L(n) asm volatile("s_waitcnt lgkmcnt(" #n ")" ::: "memory")
#define PG8_BAR __builtin_amdgcn_s_barrier()
#define PG8_SCHED __builtin_amdgcn_sched_barrier(0)
    Unit cur, nxt; int ui = 0;
    if (!S.next(0, cur)) return;
    f32x4 acc[2][2][4][2];
#pragma unroll
    for (int a = 0; a < 2; ++a)
#pragma unroll
        for (int b = 0; b < 2; ++b)
#pragma unroll
            for (int m = 0; m < 4; ++m)
#pragma unroll
                for (int n = 0; n < 2; ++n) acc[a][b][m][n] = (f32x4){0.f, 0.f, 0.f, 0.f};
    bf16x8 At[4][2], B0[2][2], B1[2][2];
    const char* cA = (const char*)g.A + (size_t)cur.pm * tstep; const char* cB = (const char*)g.Bt + (size_t)cur.pn * tstep;
    S.a_ready(cur);
    if constexpr (SP2) {
        PG8_STAGE(PG8_SB(0, 0), cB, voffB); PG8_STAGE(PG8_SB(0, 1), cB + hstep, voffB); PG8_STAGE(PG8_SA(0, 0), cA, voffA); PG8_STAGE(PG8_SA(0, 1), cA + hstep, voffA);
        if (wr == 1) PG8_BAR;
        PG8_WAIT_V(2); PG8_BAR;
        PG8_STAGE(PG8_SB(1, 0), cB + kstep, voffB); PG8_STAGE(PG8_SA(1, 0), cA + kstep, voffA); PG8_STAGE(PG8_SB(1, 1), cB + hstep + kstep, voffB);
        PG8_WAIT_V(6); PG8_BAR;
    } else {
        PG8_STAGE(PG8_SB(0, 0), cB, voffB); PG8_STAGE(PG8_SA(0, 0), cA, voffA); PG8_STAGE(PG8_SB(0, 1), cB + hstep, voffB); PG8_STAGE(PG8_SA(0, 1), cA + hstep, voffA);
        if (wr == 1) PG8_BAR;
        PG8_WAIT_V(4); PG8_BAR;
        PG8_STAGE(PG8_SB(1, 0), cB + kstep, voffB); PG8_STAGE(PG8_SA(1, 0), cA + kstep, voffA); PG8_STAGE(PG8_SB(1, 1), cB + hstep + kstep, voffB);
        PG8_WAIT_V(6); PG8_BAR;
    }
    for (;;) {
        const bool has_next = S.next(ui + 1, nxt);
        const char* nA = has_next ? (const char*)g.A + (size_t)nxt.pm * tstep : cA; const char* nB = has_next ? (const char*)g.Bt + (size_t)nxt.pn * tstep : cB;
        for (int t = 0; t < nt; t += 2) {
            const bool last = (t == nt - 2);
            if constexpr (Epi::HAS_MID) { if (t == (nt >> 1)) E.mid(acc, cur, wr, wc, fr, fq); }
            const char* a1 = cA + (size_t)(t + 1) * kstep;
            const char* a2 = last ? nA : cA + (size_t)(t + 2) * kstep; const char* b2 = last ? nB : cB + (size_t)(t + 2) * kstep;
            const char* a3 = a2 + kstep; const char* b3 = b2 + kstep;
            if (last && has_next) S.a_ready(nxt);
            if constexpr (SP2) {
            PG8_LDB(B0, 0, 0); PG8_LDB(B1, 0, 1); PG8_SCHED; PG8_LDA(At, 0, 0); PG8_STAGE(PG8_SA(1, 1), a1 + hstep, voffA);
            PG8_WAIT_V(8); PG8_WAIT_L(0); PG8_BAR; PG8_MMA(0, 0, At, B0); PG8_MMA(0, 1, At, B1); PG8_BAR; PG8_SCHED;
            PG8_LDA(At, 0, 1); PG8_STAGE(PG8_SB(0, 0), b2, voffB); PG8_STAGE(PG8_SB(0, 1), b2 + hstep, voffB); PG8_STAGE(PG8_SA(0, 0), a2, voffA);
            PG8_WAIT_V(8); PG8_WAIT_L(0); PG8_BAR; PG8_MMA(1, 0, At, B0); PG8_MMA(1, 1, At, B1); PG8_BAR; PG8_SCHED;
            PG8_LDB(B0, 1, 0); PG8_LDB(B1, 1, 1); PG8_SCHED; PG8_LDA(At, 1, 0); PG8_STAGE(PG8_SA(0, 1), a2 + hstep, voffA);
            PG8_WAIT_V(8); PG8_WAIT_L(0); PG8_BAR; PG8_MMA(0, 0, At, B0); PG8_MMA(0, 1, At, B1); PG8_BAR; PG8_SCHED;
            PG8_LDA(At, 1, 1); PG8_STAGE(PG8_SB(1, 0), b3, voffB); PG8_STAGE(PG8_SB(1, 1), b3 + hstep, voffB); PG8_STAGE(PG8_SA(1, 0), a3, voffA);
            PG8_WAIT_V(8); PG8_WAIT_L(0); PG8_BAR; PG8_MMA(1, 0, At, B0); PG8_MMA(1, 1, At, B1); PG8_BAR; PG8_SCHED;
            } else {
            PG8_LDB(B0, 0, 0); PG8_SCHED; PG8_LDA(At, 0, 0); PG8_STAGE(PG8_SA(1, 1), a1 + hstep, voffA);
            PG8_WAIT_L(8); PG8_BAR; PG8_WAIT_L(0); PG8_MMA(0, 0, At, B0); PG8_BAR; PG8_SCHED;
            PG8_LDB(B1, 0, 1); PG8_STAGE(PG8_SB(0, 0), b2, voffB);
            PG8_BAR; PG8_WAIT_L(0); PG8_MMA(0, 1, At, B1); PG8_BAR;
            PG8_LDA(At, 0, 1); PG8_STAGE(PG8_SA(0, 0), a2, voffA);
            PG8_BAR; PG8_WAIT_L(0); PG8_MMA(1, 0, At, B0); PG8_BAR; PG8_SCHED;
            PG8_STAGE(PG8_SB(0, 1), b2 + hstep, voffB);
            PG8_WAIT_V(6); PG8_BAR; PG8_MMA(1, 1, At, B1); PG8_BAR;
            PG8_LDB(B0, 1, 0); PG8_SCHED; PG8_LDA(At, 1, 0); PG8_STAGE(PG8_SA(0, 1), a2 + hstep, voffA);
            PG8_WAIT_L(8); PG8_BAR; PG8_WAIT_L(0); PG8_MMA(0, 0, At, B0); PG8_BAR; PG8_SCHED;
            PG8_LDB(B1, 1, 1); PG8_STAGE(PG8_SB(1, 0), b3, voffB);
            PG8_BAR; PG8_WAIT_L(0); PG8_MMA(0, 1, At, B1); PG8_BAR;
            PG8_LDA(At, 1, 1); PG8_STAGE(PG8_SA(1, 0), a3, voffA);
            PG8_BAR; PG8_WAIT_L(0); PG8_MMA(1, 0, At, B0); PG8_BAR; PG8_SCHED;
            PG8_STAGE(PG8_SB(1, 1), b3 + hstep, voffB);
            PG8_WAIT_V(6); PG8_BAR; PG8_MMA(1, 1, At, B1); PG8_BAR;
            }
        }
        if constexpr (ALIGN_EPI) { if (wr == 0) PG8_BAR; }
        if constexpr (!Epi::AFTER_DRAIN) { E(acc, cur, wr, wc, fr, fq); S.done(cur); }
        if (!has_next) break;
#pragma unroll
        for (int a = 0; a < 2; ++a)
#pragma unroll
            for (int b = 0; b < 2; ++b)
#pragma unroll
                for (int m = 0; m < 4; ++m)
#pragma unroll
                    for (int n = 0; n < 2; ++n) acc[a][b][m][n] = (f32x4){0.f, 0.f, 0.f, 0.f};
        cur = nxt; cA = nA; cB = nB; ++ui;
        if constexpr (ALIGN_EPI) { if (wr == 1) PG8_BAR; }
    }
    PG8_WAIT_V(0);
    if constexpr (!ALIGN_EPI) { if (wr == 0) PG8_BAR; }
    PG8_BAR;
    if constexpr (Epi::AFTER_DRAIN) { E.fused(acc, cur, wr, wc, fr, fq, lds, wid, lane); S.done(cur); }
#undef PG8_SA
#undef PG8_SB
#undef PG8_STAGE
#undef PG8_LDA
#undef PG8_LDB
#undef PG8_MMA
#undef PG8_WAIT_V
#undef PG8_WAIT_L
#undef PG8_BAR
#undef PG8_SCHED
}
}

template <int EPI> struct EpiAd {
  static constexpr bool PERM = true, AFTER_DRAIN = false, HAS_MID = false;
  EP e;
  __device__ __forceinline__ void operator()(const pg8::f32x4 (&acc)[2][2][4][2], const pg8::Unit& u, int wr, int wc, int fr, int fq) const {
#pragma unroll
    for (int ai = 0; ai < 2; ++ai)
#pragma unroll
      for (int m = 0; m < 4; ++m)
#pragma unroll
        for (int bj = 0; bj < 2; ++bj)
          epi8<EPI>(e, u.pm * 256 + ai * 128 + wr * 64 + m * 16 + fr, u.pn * 256 + bj * 128 + wc * 32 + 8 * fq, acc[ai][bj][m][0], acc[ai][bj][m][1]);
  }
};
struct EpiMergeK {
  static constexpr bool PERM = true, AFTER_DRAIN = false, HAS_MID = true;
  unsigned char* ws;
  __device__ __forceinline__ void mid(pg8::f32x4 (&acc)[2][2][4][2], const pg8::Unit& u, int wr, int wc, int fr, int fq) const {
    const bf16_t* bg = (const bf16_t*)(ws + WS_BG);
#pragma unroll
    for (int ai = 0; ai < 2; ++ai)
#pragma unroll
      for (int m = 0; m < 4; ++m)
#pragma unroll
        for (int bj = 0; bj < 2; ++bj) {
          const int row = u.pm * 256 + ai * 128 + wr * 64 + m * 16 + fr, col = u.pn * 256 + bj * 128 + wc * 32 + 8 * fq;
          float g0[8], g1[8]; unpk8(*(const u32x4*)(bg + (size_t)row * 2048 + col), g0); unpk8(*(const u32x4*)(bg + (size_t)row * 2048 + 1024 + col), g1);
#pragma unroll
          for (int i = 0; i < 4; ++i) { acc[ai][bj][m][0][i] *= g0[i] * __builtin_amdgcn_rcpf(fmaxf(g1[i], 8.673617379884035e-19f));
                                        acc[ai][bj][m][1][i] *= g0[4 + i] * __builtin_amdgcn_rcpf(fmaxf(g1[4 + i], 8.673617379884035e-19f)); }
        }
  }
  __device__ __forceinline__ void operator()(const pg8::f32x4 (&acc)[2][2][4][2], const pg8::Unit& u, int wr, int wc, int fr, int fq) const {
    const bf16_t* bg = (const bf16_t*)(ws + WS_BG); bf16_t* mg = (bf16_t*)(ws + WS_MG);
#pragma unroll
    for (int ai = 0; ai < 2; ++ai)
#pragma unroll
      for (int m = 0; m < 4; ++m)
#pragma unroll
        for (int bj = 0; bj < 2; ++bj) {
          const int row = u.pm * 256 + ai * 128 + wr * 64 + m * 16 + fr, col = u.pn * 256 + bj * 128 + wc * 32 + 8 * fq;
          float g1[8], r[8]; unpk8(*(const u32x4*)(bg + (size_t)row * 2048 + 1024 + col), g1);
#pragma unroll
          for (int i = 0; i < 4; ++i) { r[i] = acc[ai][bj][m][0][i] * fmaxf(g1[i], 8.673617379884035e-19f); r[4 + i] = acc[ai][bj][m][1][i] * fmaxf(g1[4 + i], 8.673617379884035e-19f); }
          u32x4 w; w.x = pk2(r[0], r[1]); w.y = pk2(r[2], r[3]); w.z = pk2(r[4], r[5]); w.w = pk2(r[6], r[7]); *(u32x4*)(mg + (size_t)row * 1024 + col) = w;
        }
  }
};
__device__ __forceinline__ void ph_gemm_merge(unsigned char* lds, unsigned char* ws) {
  pg8::Gemm g{(const bf16_t*)(ws + WS_YA), (const bf16_t*)(ws + WS_WA), T, 1024, 1024}; pg8::StaticOrder S; S.init(T, 1024, (int)gridDim.x, (int)blockIdx.x);
  EpiMergeK E{ws};
  pg8::gemm_phase<EpiMergeK, pg8::StaticOrder, true, true>((PG8_LAS unsigned char*)lds, g, S, E);
}
template <int EPI> __device__ __forceinline__ void ph_gemm8(unsigned char* lds, const bf16_t* A, const bf16_t* Bt, int N, int K, const EP& e) {
  pg8::Gemm g{A, Bt, T, N, K}; pg8::StaticOrder S; S.init(T, N, (int)gridDim.x, (int)blockIdx.x);
  EpiAd<EPI> E{e};
  pg8::gemm_phase<EpiAd<EPI>, pg8::StaticOrder, true, true>((PG8_LAS unsigned char*)lds, g, S, E);
}

__device__ __forceinline__ float log_sigmoid(float f) { return fminf(f, 0.f) - log1pf(expf(-fabsf(f))); }
constexpr size_t WS_GP_P = 3 * MB, WS_GP_M = 3 * MB + 512 * 1024, WS_GP_B = 4 * MB, WS_GP_MC = 4 * MB + 512 * 1024, WS_GP_AC = 4 * MB + 520 * 1024;
constexpr size_t WS_NU = 5 * MB;
constexpr int RS = 136, TS = 72;
__device__ __forceinline__ void gp_scan(int scan, const float* __restrict__ gpre, unsigned char* ws, unsigned char* lds) {
  const int lane = threadIdx.x & 63, wave = threadIdx.x >> 6, dir = scan >> 3, b = (scan >> 2) & 1, h = scan & 3;
  float* P = (float*)(ws + WS_GP_P) + (size_t)scan * SEQ; float* Rp = (float*)(ws + WS_GP_M) + (size_t)scan * SEQ; float* BBp = (float*)(ws + WS_GP_B) + (size_t)scan * SEQ;
  float* mC = (float*)(ws + WS_GP_MC) + scan * 128; float* aC = (float*)(ws + WS_GP_AC) + scan * 128;
  float* LBL = (float*)lds; float* LR = LBL + 128;
  const int gi = (dir ? 8 : 0) + h, gf = (dir ? 12 : 4) + h;
  float ig[16], fg[16];
#pragma unroll
  for (int i = 0; i < 16; ++i) { const int c = wave * 16 + i, j = dir ? 127 - c : c, s = 64 * j + (dir ? 63 - lane : lane); const size_t t = (size_t)b * SEQ + s;
    ig[i] = gpre[t * 16 + gi]; fg[i] = gpre[t * 16 + gf]; }
#pragma unroll
  for (int i = 0; i < 16; ++i) { const int c = wave * 16 + i, j = dir ? 127 - c : c, s = 64 * j + (dir ? 63 - lane : lane);
    float bsum = log_sigmoid(fg[i]);
#pragma unroll
    for (int o = 1; o < 64; o <<= 1) { const float v = __shfl_up(bsum, o); if (lane >= o) bsum += v; }
    const float p = ig[i] - bsum; float r = p;
#pragma unroll
    for (int o = 1; o < 64; o <<= 1) { const float v = __shfl_up(r, o); if (lane >= o) r = fmaxf(r, v); }
    P[s] = p; Rp[s] = r; BBp[s] = bsum;
    if (lane == 63) { LBL[c] = bsum; LR[c] = r; } }
  __syncthreads();
  if (wave == 0) { float m = -1e30f;
    for (int c = 0; c < 128; ++c) { const int j = dir ? 127 - c : c; const float Ml = fmaxf(m, LR[c]);
      if (lane == 0) { mC[j] = m; aC[j] = expf(m - Ml); }
      m = LBL[c] + Ml; } }
  __syncthreads();
}
struct M1Pre { u32x4 raw[5]; u32x4 v[2]; float cwl[3]; float pv, rv, mc; };
__device__ __forceinline__ void m1_prefetch(int u, M1Pre& pr, const unsigned char* ws, const float* __restrict__ cw, const float* __restrict__ cb) {
  const int tid = threadIdx.x, lane = tid & 63, wave = __builtin_amdgcn_readfirstlane(tid >> 6);
  const int bh = u >> 7, j = u & 127, b = bh >> 2, h = bh & 3;
  const bf16_t* mq = (const bf16_t*)(ws + WS_MQ); const bf16_t* mk = (const bf16_t*)(ws + WS_MK); const bf16_t* mv = (const bf16_t*)(ws + WS_MV);
#pragma unroll
  for (int i = 0; i < 5; ++i) { const int it = tid + 512 * i; const int which = it >= 68 * 16, r = (it - which * 68 * 16) >> 4, ch = it & 15; const int s = 64 * j - 2 + r;
    pr.raw[i] = (u32x4){0u, 0u, 0u, 0u};
    if (it < 2 * 68 * 16 && s >= 0 && s < SEQ) pr.raw[i] = *(const u32x4*)((which ? mk : mq) + ((size_t)b * SEQ + s) * 512 + h * 128 + ch * 8); }
#pragma unroll
  for (int k2 = 0; k2 < 2; ++k2) pr.v[k2] = *(const u32x4*)(mv + ((size_t)b * SEQ + 64 * j + lane) * 512 + h * 128 + (wave + 8 * k2) * 8);
#pragma unroll
  for (int i3 = 0; i3 < 3; ++i3) { const int i = tid + 512 * i3; const int w = i >> 8, c = i & 255, ch = (c >> 7) * 512 + h * 128 + (c & 127); pr.cwl[i3] = w < 5 ? cw[w * 1024 + ch] : cb[ch]; }
  pr.pv = 0.f; pr.rv = 0.f; pr.mc = 0.f;
  if (tid < 128) { const int dir = tid >> 6, l = tid & 63; const int scan = dir * 8 + bh;
    pr.pv = ((const float*)(ws + WS_GP_P))[(size_t)scan * SEQ + 64 * j + l]; pr.rv = ((const float*)(ws + WS_GP_M))[(size_t)scan * SEQ + 64 * j + (dir ? 0 : 63)];
    pr.mc = ((const float*)(ws + WS_GP_MC))[scan * 128 + j]; }
}
template <bool HAS_NEXT> __device__ __forceinline__ void m1_unit(int u, int un, M1Pre& pr, unsigned char* lds, unsigned char* ws, bf16_t* UT, const float* __restrict__ cw, const float* __restrict__ cb) {
  const int tid = threadIdx.x, lane = tid & 63, wave = __builtin_amdgcn_readfirstlane(tid >> 6), fr = lane & 15, fq = lane >> 4;
  const int bh = u >> 7, j = u & 127, b = bh >> 2, h = bh & 3;
  bf16_t* RAWQ = (bf16_t*)lds; bf16_t* RAWK = RAWQ + 68 * RS; bf16_t* KWT0 = RAWK + 68 * RS; bf16_t* KWT1 = KWT0 + 128 * TS; bf16_t* VT = KWT1 + 128 * TS;
  float* WK = (float*)(VT + 144 * TS);
  float* CWL = WK + 128;
  bf16_t* qc = (bf16_t*)(ws + WS_QC); bf16_t* kc = (bf16_t*)(ws + WS_KC);
  const size_t trow0 = (size_t)b * SEQ + 64 * j;
#pragma unroll
  for (int i = 0; i < 5; ++i) { const int it = tid + 512 * i; const int which = it >= 68 * 16, r = (it - which * 68 * 16) >> 4, ch = it & 15;
    if (it < 2 * 68 * 16) *(u32x4*)((which ? RAWK : RAWQ) + r * RS + ch * 8) = pr.raw[i]; }
#pragma unroll
  for (int i3 = 0; i3 < 3; ++i3) CWL[tid + 512 * i3] = pr.cwl[i3];
  if (tid < 128) WK[tid] = expf(pr.pv - fmaxf(pr.mc, pr.rv));
#pragma unroll
  for (int k2 = 0; k2 < 2; ++k2) { const int ch = wave + 8 * k2; const u32x4 v = pr.v[k2];
#pragma unroll
    for (int i = 0; i < 4; ++i) { VT[(ch * 8 + 2 * i) * TS + lane] = (bf16_t)(v[i] & 0xffffu); VT[(ch * 8 + 2 * i + 1) * TS + lane] = (bf16_t)(v[i] >> 16); } }
  if (tid < 64) VT[128 * TS + tid] = 0x3f80;
  __syncthreads();
  if (HAS_NEXT) m1_prefetch(un, pr, ws, cw, cb);
  const float wkf = WK[lane], wkb = WK[64 + lane];
#pragma unroll
  for (int which = 0; which < 2; ++which)
#pragma unroll
    for (int k2 = 0; k2 < 2; ++k2) {
      const int ch = wave + 8 * k2; const float* cwl = CWL + which * 128 + ch * 8;
      float y[8];
      { const float4 ba = *(const float4*)(cwl + 5 * 256), bb = *(const float4*)(cwl + 5 * 256 + 4); y[0] = ba.x; y[1] = ba.y; y[2] = ba.z; y[3] = ba.w; y[4] = bb.x; y[5] = bb.y; y[6] = bb.z; y[7] = bb.w; }
#pragma unroll
      for (int w = 0; w < 5; ++w) {
        const u32x4 v = *(const u32x4*)((which ? RAWK : RAWQ) + (lane + w) * RS + ch * 8);
        const float4 wa = *(const float4*)(cwl + w * 256), wb = *(const float4*)(cwl + w * 256 + 4);
        y[0] += __uint_as_float(v[0] << 16) * wa.x; y[1] += __uint_as_float(v[0] & 0xffff0000u) * wa.y; y[2] += __uint_as_float(v[1] << 16) * wa.z; y[3] += __uint_as_float(v[1] & 0xffff0000u) * wa.w;
        y[4] += __uint_as_float(v[2] << 16) * wb.x; y[5] += __uint_as_float(v[2] & 0xffff0000u) * wb.y; y[6] += __uint_as_float(v[3] << 16) * wb.z; y[7] += __uint_as_float(v[3] & 0xffff0000u) * wb.w;
      }
#pragma unroll
      for (int i = 0; i < 8; ++i) { y[i] = y[i] * fsig(y[i]); if (which) y[i] *= 0.08838834764831845f; }
      u32x4 o; o.x = pk2(y[0], y[1]); o.y = pk2(y[2], y[3]); o.z = pk2(y[4], y[5]); o.w = pk2(y[6], y[7]);
      *(u32x4*)((which ? kc : qc) + (trow0 + lane) * 512 + h * 128 + ch * 8) = o;
      if (which) {
#pragma unroll
        for (int i = 0; i < 8; ++i) { const float kv = bf2f(f2bf(y[i])); KWT0[(ch * 8 + i) * TS + lane] = f2bf(kv * wkf); KWT1[(ch * 8 + i) * TS + lane] = f2bf(kv * wkb); }
      }
    }
  __syncthreads();
  bf16x8 xf[2][2];
#pragma unroll
  for (int dir = 0; dir < 2; ++dir)
#pragma unroll
    for (int ks = 0; ks < 2; ++ks) xf[dir][ks] = *(const bf16x8*)((dir ? KWT1 : KWT0) + (16 * wave + fr) * TS + ks * 32 + fq * 8);
#pragma unroll
  for (int et = 0; et < 9; ++et) {
    const bf16x8 y0 = *(const bf16x8*)(VT + (16 * et + fr) * TS + fq * 8), y1 = *(const bf16x8*)(VT + (16 * et + fr) * TS + 32 + fq * 8);
#pragma unroll
    for (int dir = 0; dir < 2; ++dir) {
      f32x4 acc = {0.f, 0.f, 0.f, 0.f};
      acc = __builtin_amdgcn_mfma_f32_16x16x32_bf16(xf[dir][0], y0, acc, 0, 0, 0);
      acc = __builtin_amdgcn_mfma_f32_16x16x32_bf16(xf[dir][1], y1, acc, 0, 0, 0);
      const int scan = dir * 8 + bh;
      if (et < 8) { u32x2 w; w.x = pk2(acc[0], acc[1]); w.y = pk2(acc[2], acc[3]);
        *(u32x2*)(UT + (((size_t)scan * 128 + j) * 128 + 16 * et + fr) * 128 + 16 * wave + 4 * fq) = w; }
      else if (fr == 0) *(f32x4*)((float*)(ws + WS_NU) + ((size_t)scan * 128 + j) * 128 + 16 * wave + 4 * fq) = acc;
    }
  }
  __syncthreads();
}
__device__ __forceinline__ void m2_scan(int bid, int nb, unsigned char* ws, bf16_t* UT) {
  for (int slab = bid; slab < 16 * 16; slab += nb) {
    const int scan = slab >> 4, dir = scan >> 3, el = ((slab & 15) * 512 + threadIdx.x) * 2;
    const float* aC = (const float*)(ws + WS_GP_AC) + scan * 128;
    bf16_t* base = UT + (size_t)scan * 128 * 16384 + el;
    float c0 = 0.f, c1 = 0.f;
    for (int c16 = 0; c16 < 128; c16 += 16) {
      unsigned uv[16];
#pragma unroll
      for (int i = 0; i < 16; ++i) { const int j = dir ? 127 - (c16 + i) : c16 + i; uv[i] = *(const unsigned*)(base + (size_t)j * 16384); }
#pragma unroll
      for (int i = 0; i < 16; ++i) { const int j = dir ? 127 - (c16 + i) : c16 + i; const float a = aC[j]; *(unsigned*)(base + (size_t)j * 16384) = pk2(c0, c1);
        c0 = a * c0 + __uint_as_float(uv[i] << 16); c1 = a * c1 + __uint_as_float(uv[i] & 0xffff0000u); }
    }
  }
  const int gt = bid * 512 + threadIdx.x, nthreads = nb * 512;
  for (int item = gt; item < 16 * 128; item += nthreads) {
    const int scan = item >> 7, d = item & 127, dir = scan >> 3;
    const float* aC = (const float*)(ws + WS_GP_AC) + scan * 128; float* base = (float*)(ws + WS_NU) + (size_t)scan * 128 * 128 + d;
    float n = 0.f;
    for (int c16 = 0; c16 < 128; c16 += 16) { float uv[16], av[16];
#pragma unroll
      for (int i = 0; i < 16; ++i) { const int j = dir ? 127 - (c16 + i) : c16 + i; uv[i] = base[j * 128]; av[i] = aC[j]; }
#pragma unroll
      for (int i = 0; i < 16; ++i) { const int j = dir ? 127 - (c16 + i) : c16 + i; base[j * 128] = n; n = av[i] * n + uv[i]; } }
  }
}
__device__ __forceinline__ void m3_unit(int u, unsigned char* lds, unsigned char* ws, const bf16_t* UT, const float* __restrict__ ng) {
  const int tid = threadIdx.x, lane = tid & 63, wave = __builtin_amdgcn_readfirstlane(tid >> 6), fr = lane & 15, fq = lane >> 4;
  const int bh = u >> 7, j = u & 127, b = bh >> 2, h = bh & 3, tt = wave & 3, eh = wave >> 2;
  bf16_t* QCS = (bf16_t*)lds; bf16_t* KCS = QCS + 64 * RS; bf16_t* VT = KCS + 64 * RS; bf16_t* CT0 = VT + 144 * TS; bf16_t* CT1 = CT0 + 144 * RS;
  float* GA = (float*)(CT1 + 144 * RS);
  float* ST = GA + 384;
  const bf16_t* qc = (const bf16_t*)(ws + WS_QC); const bf16_t* kc = (const bf16_t*)(ws + WS_KC); const bf16_t* mv = (const bf16_t*)(ws + WS_MV); const bf16_t* mo = (const bf16_t*)(ws + WS_MO);
  bf16_t* ym = (bf16_t*)(ws + WS_YA);
  const size_t trow0 = (size_t)b * SEQ + 64 * j;
  for (int it = tid; it < 2 * 64 * 16; it += 512) { const int which = it >> 10, r = (it >> 4) & 63, ch = it & 15;
    *(u32x4*)((which ? KCS : QCS) + r * RS + ch * 8) = *(const u32x4*)((which ? kc : qc) + (trow0 + r) * 512 + h * 128 + ch * 8); }
  for (int it = tid; it < 2 * 128 * 16; it += 512) { const int dir = it >> 11, e = (it >> 4) & 127, ch = it & 15; const int scan = dir * 8 + bh;
    *(u32x4*)((dir ? CT1 : CT0) + e * RS + ch * 8) = *(const u32x4*)(UT + (((size_t)scan * 128 + j) * 128 + e) * 128 + ch * 8); }
  if (tid < 256) { const int dir = tid >> 7, d = tid & 127; const int scan = dir * 8 + bh;
    (dir ? CT1 : CT0)[128 * RS + d] = f2bf(((const float*)(ws + WS_NU))[((size_t)scan * 128 + j) * 128 + d]); }
  if (tid < 384) { const int dir = tid / 192, k3 = (tid % 192) >> 6, l = tid & 63; const int scan = dir * 8 + bh;
    const float* src = (const float*)(ws + (k3 == 0 ? WS_GP_P : k3 == 1 ? WS_GP_M : WS_GP_B)) + (size_t)scan * SEQ;
    GA[(dir * 3 + k3) * 64 + l] = src[64 * j + l]; }
#pragma unroll
  for (int k2 = 0; k2 < 2; ++k2) { const int ch = wave + 8 * k2;
    const u32x4 v = *(const u32x4*)(mv + (trow0 + lane) * 512 + h * 128 + ch * 8);
#pragma unroll
    for (int i = 0; i < 4; ++i) { VT[(ch * 8 + 2 * i) * TS + lane] = (bf16_t)(v[i] & 0xffffu); VT[(ch * 8 + 2 * i + 1) * TS + lane] = (bf16_t)(v[i] >> 16); } }
  if (tid < 64) VT[128 * TS + tid] = 0x3f80;
  __syncthreads();
  f32x4 g[4];
  {
    bf16x8 qf[4];
#pragma unroll
    for (int ks = 0; ks < 4; ++ks) qf[ks] = *(const bf16x8*)(QCS + (16 * tt + fr) * RS + ks * 32 + fq * 8);
#pragma unroll
    for (int lt = 0; lt < 4; ++lt) { g[lt] = (f32x4){0.f, 0.f, 0.f, 0.f};
#pragma unroll
      for (int ks = 0; ks < 4; ++ks) { const bf16x8 kf = *(const bf16x8*)(KCS + (16 * lt + fr) * RS + ks * 32 + fq * 8);
        g[lt] = __builtin_amdgcn_mfma_f32_16x16x32_bf16(kf, qf[ks], g[lt], 0, 0, 0); } }
  }
  const int etl[5] = {4 * eh, 4 * eh + 1, 4 * eh + 2, 4 * eh + 3, 8};
  float hsum[4][4];
#pragma unroll
  for (int i = 0; i < 4; ++i)
#pragma unroll
    for (int r = 0; r < 4; ++r) hsum[i][r] = 0.f;
#pragma unroll
  for (int dir = 0; dir < 2; ++dir) {
    const float* Pd = GA + (dir * 3 + 0) * 64; const float* Md = GA + (dir * 3 + 1) * 64; const float* Bd = GA + (dir * 3 + 2) * 64;
    const int scan = dir * 8 + bh; const float mc = ((const float*)(ws + WS_GP_MC))[scan * 128 + j];
    const bf16_t* CT = dir ? CT1 : CT0;
    f32x4 acc[5];
#pragma unroll
    for (int i = 0; i < 5; ++i) acc[i] = (f32x4){0.f, 0.f, 0.f, 0.f};
#pragma unroll
    for (int ks = 0; ks < 4; ++ks) { const bf16x8 qf = *(const bf16x8*)(QCS + (16 * tt + fr) * RS + ks * 32 + fq * 8);
#pragma unroll
      for (int i = 0; i < 5; ++i) { const bf16x8 cf = *(const bf16x8*)(CT + (16 * etl[i] + fr) * RS + ks * 32 + fq * 8);
        acc[i] = __builtin_amdgcn_mfma_f32_16x16x32_bf16(qf, cf, acc[i], 0, 0, 0); } }
    float Mt[4], wi[4], emr[4];
#pragma unroll
    for (int r = 0; r < 4; ++r) { const int t = 16 * tt + 4 * fq + r; Mt[r] = fmaxf(mc, Md[t]); wi[r] = __expf(mc - Mt[r]); emr[r] = __expf(-(Bd[t] + Mt[r])); }
#pragma unroll
    for (int i = 0; i < 5; ++i)
#pragma unroll
      for (int r = 0; r < 4; ++r) acc[i][r] *= wi[r];
    const float Mrow = fmaxf(mc, Md[16 * tt + fr]); const int trow = 16 * tt + fr;
    bf16x8 sf[2];
#pragma unroll
    for (int ks = 0; ks < 2; ++ks) { unsigned pw[4];
#pragma unroll
      for (int hh = 0; hh < 2; ++hh) { const int lt = 2 * ks + hh; float sv[4];
#pragma unroll
        for (int r = 0; r < 4; ++r) { const int l = 16 * lt + 4 * fq + r; const bool ok = dir ? (l >= trow) : (l <= trow);
          sv[r] = ok ? g[lt][r] * __expf(Pd[l] - Mrow) : 0.f; }
        pw[2 * hh] = pk2(sv[0], sv[1]); pw[2 * hh + 1] = pk2(sv[2], sv[3]); }
      u32x4 w4 = {pw[0], pw[1], pw[2], pw[3]}; sf[ks] = *(bf16x8*)&w4; }
#pragma unroll
    for (int ks = 0; ks < 2; ++ks)
#pragma unroll
      for (int i = 0; i < 5; ++i) { const bf16_t* vr = VT + (16 * etl[i] + fr) * TS + 32 * ks + 4 * fq;
        const u32x2 lo = *(const u32x2*)vr, hi = *(const u32x2*)(vr + 16); u32x4 w4 = {lo.x, lo.y, hi.x, hi.y};
        acc[i] = __builtin_amdgcn_mfma_f32_16x16x32_bf16(sf[ks], *(bf16x8*)&w4, acc[i], 0, 0, 0); }
#pragma unroll
    for (int r = 0; r < 4; ++r) { const float den = __shfl(acc[4][r], lane & 48); const float inv = __builtin_amdgcn_rcpf(fmaxf(fabsf(den), emr[r]));
#pragma unroll
      for (int i = 0; i < 4; ++i) hsum[i][r] += acc[i][r] * inv; }
  }
#pragma unroll
  for (int r = 0; r < 4; ++r) { float s1 = 0.f, s2 = 0.f;
#pragma unroll
    for (int i = 0; i < 4; ++i) { s1 += hsum[i][r]; s2 += hsum[i][r] * hsum[i][r]; }
#pragma unroll
    for (int o = 1; o < 16; o <<= 1) { s1 += __shfl_xor(s1, o); s2 += __shfl_xor(s2, o); }
    if (fr == 0) { ST[(eh * 64 + 16 * tt + 4 * fq + r) * 2] = s1; ST[(eh * 64 + 16 * tt + 4 * fq + r) * 2 + 1] = s2; } }
  __syncthreads();
  bf16_t* YT = QCS;
#pragma unroll
  for (int r = 0; r < 4; ++r) { const int t = 16 * tt + 4 * fq + r;
    const float s1 = ST[t * 2] + ST[(64 + t) * 2], s2 = ST[t * 2 + 1] + ST[(64 + t) * 2 + 1];
    const float mu = s1 * (1.f / 128.f), var = fmaxf(s2 * (1.f / 128.f) - mu * mu, 0.f), rs = rsqrtf(var + LN_EPS);
#pragma unroll
    for (int i = 0; i < 4; ++i) { const int e = 16 * (4 * eh + i) + fr; YT[t * RS + e] = f2bf((hsum[i][r] - mu) * rs * ng[h * 128 + e]); } }
  __syncthreads();
  for (int it = tid; it < 64 * 16; it += 512) { const int r = it >> 4, ch = it & 15;
    const u32x4 yv = *(const u32x4*)(YT + r * RS + ch * 8); const u32x4 ov = *(const u32x4*)(mo + (trow0 + r) * 512 + h * 128 + ch * 8); u32x4 o;
#pragma unroll
    for (int i = 0; i < 4; ++i) o[i] = pk2(__uint_as_float(yv[i] << 16) * __uint_as_float(ov[i] << 16), __uint_as_float(yv[i] & 0xffff0000u) * __uint_as_float(ov[i] & 0xffff0000u));
    *(u32x4*)(ym + (trow0 + r) * 1024 + 512 + h * 128 + ch * 8) = o; }
  __syncthreads();
}
constexpr int LDS_BYTES = 155648;
__device__ __forceinline__ float compute_lambda(const float* __restrict__ lp, int lane) {
  const float s1 = wave_sum(lp[lane] * lp[64 + lane]), s2 = wave_sum(lp[128 + lane] * lp[192 + lane]);
  return expf(s1) - expf(s2) + LAMBDA_INIT;
}
namespace att {
using f32x16 = __attribute__((ext_vector_type(16))) float;
using s16x4 = __attribute__((ext_vector_type(4))) short;
constexpr int NW = 8, QBLK = 32, KVBLK = 64, LD = 512;
constexpr int SHM_V = KVBLK * 128 * 2, SHM_K = KVBLK * 64 * 2;
constexpr int NSL = 4;
constexpr int SHM_ATTN = NSL * SHM_V + NSL * SHM_K + NW * 64 * 4;
constexpr int ATT_QF = SHM_ATTN;
constexpr int ATT_STG = 0;
constexpr float THR = 8.f;
#define KSWZ64(row, colB) ((row) * 128 + ((colB) ^ ((((row) >> 1) & 7) << 4)))
#define SBAR() __builtin_amdgcn_sched_barrier(0)
__device__ __forceinline__ int crow(int r, int hi) { return (r & 3) + 8 * (r >> 2) + 4 * hi; }
__device__ __forceinline__ unsigned cvtpk(float lo, float hi) { unsigned r; asm volatile("v_cvt_pk_bf16_f32 %0, %1, %2" : "=v"(r) : "v"(lo), "v"(hi)); return r; }
template <bool FIRST> __device__ __forceinline__ void partialSM(f32x16& p0, f32x16& p1, float& m_reg, float& alpha) {
  constexpr float THR2 = THR * 1.4426950408889634f;
  float pmax = p0[0];
#pragma unroll
  for (int r = 1; r < 16; ++r) pmax = fmaxf(pmax, p0[r]);
#pragma unroll
  for (int r = 0; r < 16; ++r) pmax = fmaxf(pmax, p1[r]);
  { auto rr = __builtin_amdgcn_permlane32_swap(__float_as_uint(pmax), __float_as_uint(pmax), false, false);
    pmax = fmaxf(__uint_as_float(rr[0]), __uint_as_float(rr[1])); }
  if (!FIRST && __builtin_expect(__all(pmax <= THR2), 1)) { alpha = 1.f; }
  else { const float dl = FIRST ? pmax : fmaxf(pmax, 0.f); m_reg += dl; alpha = FIRST ? 1.f : __builtin_amdgcn_exp2f(-dl);
#pragma unroll
    for (int r = 0; r < 16; ++r) { p0[r] -= dl; p1[r] -= dl; } }
#pragma unroll
  for (int r = 0; r < 16; ++r) p0[r] = __builtin_amdgcn_exp2f(p0[r]);
}
__device__ __forceinline__ void finishSM(f32x16& p0, f32x16& p1, float alpha, float& l_reg, bf16x8& pa0, bf16x8& pa1, bf16x8& pa2, bf16x8& pa3) {
#pragma unroll
  for (int r = 0; r < 16; ++r) p1[r] = __builtin_amdgcn_exp2f(p1[r]);
  float ps = 0;
#pragma unroll
  for (int r = 0; r < 16; ++r) ps += p0[r];
#pragma unroll
  for (int r = 0; r < 16; ++r) ps += p1[r];
  { auto rr = __builtin_amdgcn_permlane32_swap(__float_as_uint(ps), __float_as_uint(ps), false, false);
    ps = __uint_as_float(rr[0]) + __uint_as_float(rr[1]); }
  l_reg = l_reg * alpha + ps;
#define PK4(P, BASE, OUT) do { unsigned a0 = cvtpk(P[BASE + 0], P[BASE + 1]), a1 = cvtpk(P[BASE + 2], P[BASE + 3]);   \
    unsigned b0 = cvtpk(P[BASE + 4], P[BASE + 5]), b1 = cvtpk(P[BASE + 6], P[BASE + 7]);                              \
    auto r0 = __builtin_amdgcn_permlane32_swap(a0, b0, false, false); auto r1 = __builtin_amdgcn_permlane32_swap(a1, b1, false, false); \
    u32x4 w = {r0[0], r1[0], r0[1], r1[1]}; OUT = *reinterpret_cast<bf16x8*>(&w); } while (0)
  PK4(p0, 0, pa0); PK4(p0, 8, pa1); PK4(p1, 0, pa2); PK4(p1, 8, pa3);
#undef PK4
}
__device__ __forceinline__ void qkt(f32x16& p0, f32x16& p1, const char* Ks, const char* ql, float negm, int r32, int hi) {
#pragma unroll
  for (int r = 0; r < 16; ++r) { p0[r] = negm; p1[r] = negm; }
#pragma unroll
  for (int d0 = 0; d0 < 4; ++d0) { const int cb = (d0 * 16 + hi * 8) * 2;
    const bf16x8 qf = *reinterpret_cast<const bf16x8*>(ql + d0 * 1024);
    const bf16x8 b0 = *reinterpret_cast<const bf16x8*>(Ks + KSWZ64(r32, cb));
    const bf16x8 b1 = *reinterpret_cast<const bf16x8*>(Ks + KSWZ64(32 + r32, cb));
    p0 = __builtin_amdgcn_mfma_f32_32x32x16_bf16(b0, qf, p0, 0, 0, 0);
    p1 = __builtin_amdgcn_mfma_f32_32x32x16_bf16(b1, qf, p1, 0, 0, 0); }
}
__device__ __forceinline__ int v_st(int k, int c) { const int kk = (k & ~0xC) | ((k & 4) << 1) | ((k & 8) >> 1); return ((kk >> 3) * 4 + (c >> 5)) * 512 + ((kk & 7) * 32 + (c & 31)) * 2; }
__device__ __forceinline__ int v_rd_base(int lane) { return ((lane & 3) << 3) | (((lane >> 2) & 3) << 6) | (((lane >> 4) & 1) << 5) | (((lane >> 5) & 1) << 8); }
constexpr int v_rd_off(int d0, int ks, int half) { return d0 * 512 + ks * 4096 + half * 2048; }
template <int OFF> __device__ __forceinline__ s16x4 tr_read(int vb) {
  s16x4 r; asm volatile("ds_read_b64_tr_b16 %0, %1 offset:%2" : "=&v"(r) : "v"(vb), "i"(OFF) : "memory"); return r;
}
#define PKV(L, H) (bf16x8){L[0], L[1], L[2], L[3], H[0], H[1], H[2], H[3]}
#define PV_R(X0, X1, X2, X3, D0, HF) do { X0 = tr_read<v_rd_off(D0, 2 * (HF), 0)>(vb); X1 = tr_read<v_rd_off(D0, 2 * (HF), 1)>(vb); \
    X2 = tr_read<v_rd_off(D0, 2 * (HF) + 1, 0)>(vb); X3 = tr_read<v_rd_off(D0, 2 * (HF) + 1, 1)>(vb); } while (0)
#define PV_M(X0, X1, X2, X3, D0, PA, PB) do { o[D0] = __builtin_amdgcn_mfma_f32_32x32x16_bf16(PA, PKV(X0, X1), o[D0], 0, 0, 0); \
    o[D0] = __builtin_amdgcn_mfma_f32_32x32x16_bf16(PB, PKV(X2, X3), o[D0], 0, 0, 0); } while (0)
#define PV_W(N) do { asm volatile("s_waitcnt lgkmcnt(" #N ")" ::: "memory"); SBAR(); } while (0)
__device__ __forceinline__ void pv_d0(f32x16* o, int vb, bf16x8 pa0, bf16x8 pa1, bf16x8 pa2, bf16x8 pa3) {
  s16x4 a0, a1, a2, a3, b0, b1, b2, b3;
  PV_R(a0, a1, a2, a3, 0, 0); PV_R(b0, b1, b2, b3, 0, 1);
  PV_W(4); PV_M(a0, a1, a2, a3, 0, pa0, pa1); SBAR(); PV_R(a0, a1, a2, a3, 1, 0);
  PV_W(4); PV_M(b0, b1, b2, b3, 0, pa2, pa3); SBAR(); PV_R(b0, b1, b2, b3, 1, 1);
  PV_W(4); PV_M(a0, a1, a2, a3, 1, pa0, pa1); SBAR(); PV_R(a0, a1, a2, a3, 2, 0);
  PV_W(4); PV_M(b0, b1, b2, b3, 1, pa2, pa3); SBAR(); PV_R(b0, b1, b2, b3, 2, 1);
  PV_W(4); PV_M(a0, a1, a2, a3, 2, pa0, pa1); SBAR(); PV_R(a0, a1, a2, a3, 3, 0);
  PV_W(4); PV_M(b0, b1, b2, b3, 2, pa2, pa3); SBAR(); PV_R(b0, b1, b2, b3, 3, 1);
  PV_W(4); PV_M(a0, a1, a2, a3, 3, pa0, pa1); SBAR();
  PV_W(0); PV_M(b0, b1, b2, b3, 3, pa2, pa3);
}
#undef PKV
__device__ __forceinline__ void attn_unit(int bh, int qb, const unsigned char* __restrict__ ws, int unit,
                                          float lam, const float* __restrict__ sg, char* lds) {
  const int tid = threadIdx.x, lane = tid & 63, r32 = lane & 31, hi = lane >> 5;
  const int wid = __builtin_amdgcn_readfirstlane(tid >> 6);
  const int b = bh >> 2, h = bh & 3;
  char* V_lds = lds; char* K_lds = lds + NSL * SHM_V;
  float* wsf = (float*)(lds + NSL * SHM_V + NSL * SHM_K) + wid * 64; float* li_l = wsf; float* al_l = wsf + 32;
  const unsigned row0 = (unsigned)b * SEQ; const int q0 = qb * 256;
  const unsigned char* Vh = ws + WS_V + ((size_t)row0 * LD + h * 128) * 2;
  const int sr = tid >> 4, sc = (tid & 15) * 8, vst0 = v_st(sr, sc);
  constexpr int vst1d = 8192;
  const unsigned voffV = (unsigned)(sr * LD + sc) * 2u, voffK = (unsigned)((tid >> 3) * LD + (tid & 7) * 8) * 2u;
  const int kst = KSWZ64(tid >> 3, (tid & 7) * 16);
  const int vb0 = (int)(uintptr_t)V_lds + v_rd_base(lane);
  constexpr int NT = SEQ / KVBLK;
  constexpr unsigned TILEB = KVBLK * LD * 2;
  for (int mp = 0; mp < 2; ++mp) {
    const unsigned char* Kh = ws + WS_K + ((size_t)row0 * LD + h * 128 + mp * 64) * 2;
    const __amdgpu_buffer_rsrc_t rsK = __builtin_amdgcn_make_buffer_rsrc((void*)Kh, (short)0, SEQ * LD * 2, 0x00020000);
    const __amdgpu_buffer_rsrc_t rsV = __builtin_amdgcn_make_buffer_rsrc((void*)Vh, (short)0, SEQ * LD * 2, 0x00020000);
    float m_reg = 0.f, l_reg = 0; f32x16 o[4] = {};
    char* ql = lds + ATT_QF + wid * 4096 + lane * 16;
    { const unsigned char* Qb = ws + WS_Q + ((size_t)(row0 + q0 + wid * QBLK) * LD + h * 128 + mp * 64) * 2;
      int tq = lane; asm volatile("" : "+v"(tq));
      const unsigned qoff = (unsigned)((tq & 31) * LD + (tq >> 5) * 8) * 2u;
#pragma unroll
      for (int d0 = 0; d0 < 4; ++d0) *reinterpret_cast<bf16x8*>(ql + d0 * 1024) = *reinterpret_cast<const bf16x8*>(Qb + qoff + d0 * 32); }
    struct { bf16x8 vs0, vs1, ks0; } sr_[2];
#define SLOAD(i, t) do { const unsigned so_ = (unsigned)(t) * TILEB; \
    sr_[i].vs0 = __builtin_bit_cast(bf16x8, __builtin_amdgcn_raw_buffer_load_b128(rsV, voffV, so_, 0)); \
    sr_[i].vs1 = __builtin_bit_cast(bf16x8, __builtin_amdgcn_raw_buffer_load_b128(rsV, voffV + 32 * LD * 2, so_, 0)); \
    sr_[i].ks0 = __builtin_bit_cast(bf16x8, __builtin_amdgcn_raw_buffer_load_b128(rsK, voffK, so_, 0)); } while (0)
#define SWRITE(bb, i) do { *(bf16x8*)(V_lds + (bb) * SHM_V + vst0) = sr_[i].vs0; *(bf16x8*)(V_lds + (bb) * SHM_V + vst0 + vst1d) = sr_[i].vs1; \
    *(bf16x8*)(K_lds + (bb) * SHM_K + kst) = sr_[i].ks0; } while (0)
#define SWAIT() asm volatile("s_waitcnt vmcnt(3)" ::: "memory")
#define RESC(a) do { if (__any((a) < 1.f)) { if (hi == 0) al_l[r32] = (a); asm volatile("s_waitcnt lgkmcnt(0)" ::: "memory"); \
    _Pragma("unroll") for (int d = 0; d < 4; ++d) _Pragma("unroll") for (int r = 0; r < 16; ++r) o[d][r] *= al_l[crow(r, hi)]; } } while (0)
    f32x16 pA0, pA1, pB0, pB1; float alA, alB; bf16x8 pa0, pa1, pa2, pa3;
    int s_pp = 0, s_prev = 0, s_cur = 1, s_next = 2;
#define ROT() do { s_pp = s_prev; s_prev = s_cur; s_cur = s_next; s_next = (s_next + 1) & (NSL - 1); } while (0)
    SLOAD(0, 0); asm volatile("s_waitcnt vmcnt(0)" ::: "memory"); SWRITE(0, 0); __syncthreads();
    if (wid < 4) {
      qkt(pA0, pA1, K_lds, ql, -m_reg, r32, hi); partialSM<true>(pA0, pA1, m_reg, alA);
      SLOAD(1, 1); SLOAD(0, 2);
      SWAIT(); SWRITE(1, 1); __syncthreads();
      for (int j = 1; j + 1 < NT; j += 2) {
        SBAR(); qkt(pB0, pB1, K_lds + s_cur * SHM_K, ql, -m_reg, r32, hi);
        finishSM(pA0, pA1, alA, l_reg, pa0, pa1, pa2, pa3); SBAR();
        SLOAD(1, j + 2); SBAR();
        pv_d0(o, vb0 + s_prev * SHM_V, pa0, pa1, pa2, pa3); partialSM<false>(pB0, pB1, m_reg, alB);
        SWAIT(); SWRITE(s_next, 0);
        RESC(alB); __syncthreads(); ROT();
        SBAR(); qkt(pA0, pA1, K_lds + s_cur * SHM_K, ql, -m_reg, r32, hi);
        finishSM(pB0, pB1, alB, l_reg, pa0, pa1, pa2, pa3); SBAR();
        if (j + 3 < NT) SLOAD(0, j + 3); SBAR();
        pv_d0(o, vb0 + s_prev * SHM_V, pa0, pa1, pa2, pa3); partialSM<false>(pA0, pA1, m_reg, alA);
        SWAIT(); SWRITE(s_next, 1);
        RESC(alA); __syncthreads(); ROT();
      }
      SBAR(); qkt(pB0, pB1, K_lds + s_cur * SHM_K, ql, -m_reg, r32, hi);
      finishSM(pA0, pA1, alA, l_reg, pa0, pa1, pa2, pa3); SBAR();
      pv_d0(o, vb0 + s_prev * SHM_V, pa0, pa1, pa2, pa3); partialSM<false>(pB0, pB1, m_reg, alB);
      RESC(alB);
      finishSM(pB0, pB1, alB, l_reg, pa0, pa1, pa2, pa3); SBAR();
      pv_d0(o, vb0 + s_cur * SHM_V, pa0, pa1, pa2, pa3);
    } else {
      qkt(pA0, pA1, K_lds, ql, -m_reg, r32, hi);
      SLOAD(1, 1); SLOAD(0, 2);
      SWAIT(); SWRITE(1, 1); __syncthreads();
      SBAR(); partialSM<true>(pA0, pA1, m_reg, alA);
      SBAR(); SLOAD(1, 3); SBAR();
      qkt(pB0, pB1, K_lds + s_cur * SHM_K, ql, -m_reg, r32, hi);
      finishSM(pA0, pA1, alA, l_reg, pa0, pa1, pa2, pa3); SBAR();
      SWAIT(); SWRITE(s_next, 0);
      __syncthreads(); ROT();
      for (int j = 2; j + 2 < NT; j += 2) {
        SBAR(); pv_d0(o, vb0 + s_pp * SHM_V, pa0, pa1, pa2, pa3); partialSM<false>(pB0, pB1, m_reg, alB); RESC(alB);
        SBAR(); SLOAD(0, j + 2); SBAR();
        qkt(pA0, pA1, K_lds + s_cur * SHM_K, ql, -m_reg, r32, hi);
        finishSM(pB0, pB1, alB, l_reg, pa0, pa1, pa2, pa3); SBAR();
        SWAIT(); SWRITE(s_next, 1);
        __syncthreads(); ROT();
        SBAR(); pv_d0(o, vb0 + s_pp * SHM_V, pa0, pa1, pa2, pa3); partialSM<false>(pA0, pA1, m_reg, alA); RESC(alA);
        SBAR(); SLOAD(1, j + 3); SBAR();
        qkt(pB0, pB1, K_lds + s_cur * SHM_K, ql, -m_reg, r32, hi);
        finishSM(pA0, pA1, alA, l_reg, pa0, pa1, pa2, pa3); SBAR();
        SWAIT(); SWRITE(s_next, 0);
        __syncthreads(); ROT();
      }
      SBAR(); pv_d0(o, vb0 + s_pp * SHM_V, pa0, pa1, pa2, pa3); partialSM<false>(pB0, pB1, m_reg, alB); RESC(alB);
      SBAR(); qkt(pA0, pA1, K_lds + s_cur * SHM_K, ql, -m_reg, r32, hi);
      finishSM(pB0, pB1, alB, l_reg, pa0, pa1, pa2, pa3); SBAR();
      SWAIT(); SWRITE(s_next, 1);
      __syncthreads(); ROT();
      SBAR(); pv_d0(o, vb0 + s_pp * SHM_V, pa0, pa1, pa2, pa3); partialSM<false>(pA0, pA1, m_reg, alA); RESC(alA);
      SBAR(); qkt(pB0, pB1, K_lds + s_cur * SHM_K, ql, -m_reg, r32, hi);
      finishSM(pA0, pA1, alA, l_reg, pa0, pa1, pa2, pa3); SBAR();
      pv_d0(o, vb0 + s_prev * SHM_V, pa0, pa1, pa2, pa3); partialSM<false>(pB0, pB1, m_reg, alB); RESC(alB);
      finishSM(pB0, pB1, alB, l_reg, pa0, pa1, pa2, pa3); SBAR();
      pv_d0(o, vb0 + s_cur * SHM_V, pa0, pa1, pa2, pa3);
    }
#undef ROT
    __syncthreads();
    if (hi == 0) li_l[r32] = l_reg; asm volatile("s_waitcnt lgkmcnt(0)" ::: "memory");
    float rli[16];
#pragma unroll
    for (int r = 0; r < 16; ++r) rli[r] = __builtin_amdgcn_rcpf(li_l[crow(r, hi)]);
    int t2 = tid; asm volatile("" : "+v"(t2));
    const int lane2 = t2 & 63, wid2 = __builtin_amdgcn_readfirstlane(t2 >> 6);
    f32x4* st = (f32x4*)((unsigned char*)ws + WS_O0) + ((size_t)unit * 512 + t2) * 16;
    if (mp == 0) {
#pragma unroll
      for (int d0 = 0; d0 < 4; ++d0)
#pragma unroll
        for (int r4 = 0; r4 < 4; ++r4) st[d0 * 4 + r4] = (f32x4){o[d0][4 * r4] * rli[4 * r4], o[d0][4 * r4 + 1] * rli[4 * r4 + 1], o[d0][4 * r4 + 2] * rli[4 * r4 + 2], o[d0][4 * r4 + 3] * rli[4 * r4 + 3]};
    } else {
      float ss[16];
#pragma unroll
      for (int r = 0; r < 16; ++r) ss[r] = 0.f;
#pragma unroll
      for (int d0 = 0; d0 < 4; ++d0)
#pragma unroll
        for (int r4 = 0; r4 < 4; ++r4) { const f32x4 o0 = st[d0 * 4 + r4];
#pragma unroll
          for (int i = 0; i < 4; ++i) { const int r = 4 * r4 + i; const float v = o0[i] - lam * (o[d0][r] * rli[r]); o[d0][r] = v; ss[r] += v * v; } }
#pragma unroll
      for (int r = 0; r < 16; ++r) {
#pragma unroll
        for (int of = 1; of < 32; of <<= 1) ss[r] += __shfl_xor(ss[r], of);
        ss[r] = rsqrtf(ss[r] * (1.f / 128.f) + LN_EPS) * (1.f - LAMBDA_INIT); }
      bf16_t* stg = (bf16_t*)(lds + ATT_STG + wid2 * 8704);
      const int r32b = lane2 & 31, hib = lane2 >> 5;
#pragma unroll
      for (int d0 = 0; d0 < 4; ++d0) { const float g = sg[d0 * 32 + r32b];
#pragma unroll
        for (int r = 0; r < 16; ++r) stg[crow(r, hib) * 136 + d0 * 32 + r32b] = f2bf(o[d0][r] * ss[r] * g); }
      asm volatile("s_waitcnt lgkmcnt(0)" ::: "memory");
      const int orow = lane2 >> 1, oh = lane2 & 1;
      bf16_t* yw = (bf16_t*)((unsigned char*)ws + WS_YA) + ((size_t)(row0 + q0 + wid2 * QBLK + orow) * 1024 + h * 128 + oh * 64);
#pragma unroll
      for (int i = 0; i < 8; ++i) *(u32x4*)(yw + i * 8) = *(const u32x4*)(stg + orow * 136 + oh * 64 + i * 8);
    }
    __syncthreads();
#undef SLOAD
#undef SWRITE
#undef SWAIT
#undef RESC
  }
}
#undef SBAR
}
__device__ __forceinline__ void ph_ln1(int bid, int nb, float* __restrict__ x1, const float* __restrict__ g, const float* __restrict__ bb, bf16_t* __restrict__ x1b) {
  const int lane = threadIdx.x & 63;
  for (int t0 = (bid * 8 + (threadIdx.x >> 6)) * 2; t0 < T; t0 += nb * 16) {
    float4 v[2][4]; float s[2] = {0.f, 0.f};
#pragma unroll
    for (int r = 0; r < 2; ++r) { const float4* xr = (const float4*)(x1 + (size_t)(t0 + r) * DM);
#pragma unroll
      for (int j = 0; j < 4; ++j) { v[r][j] = xr[lane + 64 * j]; s[r] += (v[r][j].x + v[r][j].y) + (v[r][j].z + v[r][j].w); } }
#pragma unroll
    for (int r = 0; r < 2; ++r) {
      const float mu = wave_sum(s[r]) * (1.f / DM); float q = 0.f;
#pragma unroll
      for (int j = 0; j < 4; ++j) { v[r][j].x -= mu; v[r][j].y -= mu; v[r][j].z -= mu; v[r][j].w -= mu; q += (v[r][j].x * v[r][j].x + v[r][j].y * v[r][j].y) + (v[r][j].z * v[r][j].z + v[r][j].w * v[r][j].w); }
      const float rs = rsqrtf(wave_sum(q) * (1.f / DM) + LN_EPS);
      float4* xo = (float4*)(x1 + (size_t)(t0 + r) * DM);
#pragma unroll
      for (int j = 0; j < 4; ++j) { const float4 gg = ((const float4*)g)[lane + 64 * j], b4 = ((const float4*)bb)[lane + 64 * j];
        float4 o; o.x = v[r][j].x * rs * gg.x + b4.x; o.y = v[r][j].y * rs * gg.y + b4.y; o.z = v[r][j].z * rs * gg.z + b4.z; o.w = v[r][j].w * rs * gg.w + b4.w;
        xo[lane + 64 * j] = o; u32x2 w; w.x = pk2(o.x, o.y); w.y = pk2(o.z, o.w); *(u32x2*)(x1b + (size_t)(t0 + r) * DM + 4 * (lane + 64 * j)) = w; }
    }
  }
}

constexpr size_t WS_TU8 = 128 * MB, WS_SU = 160 * MB, WS_SV = 160 * MB + 65536;
constexpr int REC6 = 1280;
typedef float f32x2v __attribute__((ext_vector_type(2)));
__device__ __forceinline__ unsigned f2ord(float f) { const unsigned u = __float_as_uint(f); return (u & 0x80000000u) ? ~u : (u | 0x80000000u); }
__device__ __forceinline__ float ord2f(unsigned o) { const unsigned u = (o & 0x80000000u) ? (o & 0x7fffffffu) : ~o; return __uint_as_float(u); }
template <int CTRL, int RM> __device__ __forceinline__ float dppf(float s) { return __uint_as_float(__builtin_amdgcn_update_dpp(0u, __float_as_uint(s), CTRL, RM, 0xf, true)); }
__device__ __forceinline__ float readlane_f(float v, int l) { return __uint_as_float((unsigned)__builtin_amdgcn_readlane((int)__float_as_uint(v), l)); }
__device__ __forceinline__ float wave_sum63(float v) {
  v += dppf<0xB1, 0xf>(v); v += dppf<0x4E, 0xf>(v); v += dppf<0x141, 0xf>(v); v += dppf<0x140, 0xf>(v);
  v += dppf<0x142, 0xA>(v); v += dppf<0x143, 0xC>(v);
  return v;
}
__device__ __forceinline__ float gelu_erf(float v) {
  const float t = __builtin_amdgcn_rcpf(fabsf(v) * 0.2316418882f + 1.0f);
  float q = t * 0.5307027145f + (-0.7265760135f); q = q * t + 0.7107068705f; q = q * t + (-0.142248368f); q = q * t + 0.127414796f; q = q * t;
  const float m = v * (q * __builtin_amdgcn_exp2f((v * v) * (-0.72134752044f)));
  return v < 0.f ? m : v - m;
}
__device__ __forceinline__ unsigned fp6_code(float a) {
  const float m = fabsf(a);
  const float c = m < 2.f ? __builtin_rintf(m * 8.f) : (m < 4.f ? __builtin_rintf(m * 4.f) + 8.f : __builtin_rintf(m * 2.f) + 16.f);
  const unsigned code = (unsigned)fminf(c, 31.f);
  return a < 0.f ? (code | 32u) : code;
}
struct U3 { unsigned x, y, z; };
__device__ __forceinline__ U3 fp6_pack16(const float4 (&v)[4], float inv) {
  unsigned f[16];
#pragma unroll
  for (int c = 0; c < 4; ++c) { f[4 * c] = fp6_code(v[c].x * inv); f[4 * c + 1] = fp6_code(v[c].y * inv); f[4 * c + 2] = fp6_code(v[c].z * inv); f[4 * c + 3] = fp6_code(v[c].w * inv); }
  U3 o;
  o.x = f[0] | (f[1] << 6) | (f[2] << 12) | (f[3] << 18) | (f[4] << 24) | (f[5] << 30);
  o.y = (f[5] >> 2) | (f[6] << 4) | (f[7] << 10) | (f[8] << 16) | (f[9] << 22) | (f[10] << 28);
  o.z = (f[10] >> 4) | (f[11] << 2) | (f[12] << 8) | (f[13] << 14) | (f[14] << 20) | (f[15] << 26);
  return o;
}
__device__ __forceinline__ unsigned fp4_code(float a) {
  const float m = fabsf(a);
  const float c = m < 2.f ? __builtin_rintf(m * 2.f) : (m < 4.f ? __builtin_rintf(m) + 2.f : __builtin_rintf(m * 0.5f) + 4.f);
  const unsigned code = (unsigned)fminf(c, 7.f);
  return a < 0.f ? (code | 8u) : code;
}
__device__ __forceinline__ u32x2 fp4_pack16(const float4 (&v)[4], float inv) {
  u32x2 o; o.x = 0u; o.y = 0u;
#pragma unroll
  for (int c = 0; c < 4; ++c) { const unsigned h = fp4_code(v[c].x * inv) | (fp4_code(v[c].y * inv) << 4) | (fp4_code(v[c].z * inv) << 8) | (fp4_code(v[c].w * inv) << 12);
    if (c < 2) o.x |= h << (16 * c); else o.y |= h << (16 * (c - 2)); }
  return o;
}
__device__ __forceinline__ void ph_ln1_tab8(int bid, int nb, float* __restrict__ x1, const float* __restrict__ g, const float* __restrict__ bb, bf16_t* __restrict__ x1b,
                                            const float* __restrict__ pu, const float* __restrict__ pv, unsigned char* ws) {
  const int lane = threadIdx.x & 63, gw = bid * 8 + (threadIdx.x >> 6), ngw = nb * 8;
  int t0 = gw * 2, r4 = gw * 4;
  for (; t0 < T || r4 < 32768; t0 += ngw * 2, r4 += ngw * 4) {
    const bool do_ln = t0 < T, do_tb = r4 < 32768;
    float4 v[2][4], va[4][4];
    if (do_ln) {
#pragma unroll
      for (int r = 0; r < 2; ++r) { const u32x2* xr = (const u32x2*)((const bf16_t*)x1 + (size_t)(t0 + r) * DM);
#pragma unroll
        for (int j = 0; j < 4; ++j) { const u32x2 a = xr[lane + 64 * j]; v[r][j] = make_float4(__uint_as_float(a.x << 16), __uint_as_float(a.x & 0xffff0000u), __uint_as_float(a.y << 16), __uint_as_float(a.y & 0xffff0000u)); } } }
    if (do_tb) {
#pragma unroll
      for (int i = 0; i < 4; ++i) { const int r = r4 + i, which = r >> 14, row = r & 16383; const float4* src = (const float4*)((which ? pv : pu) + (size_t)row * DM) + 128 * (lane & 1) + (lane >> 1);
#pragma unroll
        for (int c = 0; c < 4; ++c) va[i][c] = src[32 * c]; } }
    if (do_ln) {
#pragma unroll
      for (int r = 0; r < 2; ++r) { float sm = 0.f;
#pragma unroll
        for (int j = 0; j < 4; ++j) sm += (v[r][j].x + v[r][j].y) + (v[r][j].z + v[r][j].w);
        const float mu = wave_sum(sm) * (1.f / DM); float q = 0.f;
#pragma unroll
        for (int j = 0; j < 4; ++j) { v[r][j].x -= mu; v[r][j].y -= mu; v[r][j].z -= mu; v[r][j].w -= mu; q += (v[r][j].x * v[r][j].x + v[r][j].y * v[r][j].y) + (v[r][j].z * v[r][j].z + v[r][j].w * v[r][j].w); }
        const float rs = rsqrtf(wave_sum(q) * (1.f / DM) + LN_EPS);
#pragma unroll
        for (int j = 0; j < 4; ++j) { const float4 gg = ((const float4*)g)[lane + 64 * j], b4 = ((const float4*)bb)[lane + 64 * j];
          float4 o; o.x = v[r][j].x * rs * gg.x + b4.x; o.y = v[r][j].y * rs * gg.y + b4.y; o.z = v[r][j].z * rs * gg.z + b4.z; o.w = v[r][j].w * rs * gg.w + b4.w;
          u32x2 w; w.x = pk2(o.x, o.y); w.y = pk2(o.z, o.w); *(u32x2*)(x1b + (size_t)(t0 + r) * DM + 4 * (lane + 64 * j)) = w; } } }
    if (do_tb) {
#pragma unroll
      for (int i = 0; i < 4; ++i) { const int r = r4 + i, which = r >> 14, row = r & 16383;
        float mx = 0.f;
#pragma unroll
        for (int c = 0; c < 4; ++c) mx = fmaxf(mx, fmaxf(fmaxf(fabsf(va[i][c].x), fabsf(va[i][c].y)), fmaxf(fabsf(va[i][c].z), fabsf(va[i][c].w))));
        mx = wave_max(mx);
        const float scale = fmaxf(mx, 1e-30f) * (which ? 1.f / 7.5f : 1.f / 6.f), inv = 1.f / scale;
        if (which == 0) *(u32x2*)(ws + WS_TU8 + (size_t)row * REC6 + 8 * lane) = fp4_pack16(va[i], inv);
        else { const U3 o = fp6_pack16(va[i], inv); unsigned char* rec = ws + WS_TU8 + (size_t)row * REC6 + 512;
          if ((lane & 1) == 0) *(U3*)(rec + 16 * (lane >> 1)) = o;
          else { *(unsigned*)(rec + 16 * (lane >> 1) + 12) = o.x; u32x2 q; q.x = o.y; q.y = o.z; *(u32x2*)(rec + 512 + 8 * (lane >> 1)) = q; } }
        if (lane == 0) ((float*)(ws + (which ? WS_SV : WS_SU)))[row] = scale; } }
  }
}
#define CE_D(a, b) do { const unsigned hi_ = (a) > (b) ? (a) : (b), lo_ = (a) > (b) ? (b) : (a); (a) = hi_; (b) = lo_; } while (0)
__device__ __forceinline__ void merge16_desc(unsigned* m) {
#pragma unroll
  for (int j = 8; j > 0; j >>= 1)
#pragma unroll
    for (int i = 0; i < 16; ++i) { const int l = i ^ j; if (l > i) CE_D(m[i], m[l]); }
}
__device__ __forceinline__ void sort16_desc(unsigned* k) {
#pragma unroll
  for (int kk = 2; kk <= 16; kk <<= 1)
#pragma unroll
    for (int j = kk >> 1; j > 0; j >>= 1)
#pragma unroll
      for (int i = 0; i < 16; ++i) { const int l = i ^ j; if (l > i) { if ((i & kk) == 0) CE_D(k[i], k[l]); else CE_D(k[l], k[i]); } }
}
__device__ __forceinline__ void top16_of_64(unsigned* k, unsigned* out) {
  sort16_desc(k); sort16_desc(k + 16); sort16_desc(k + 32); sort16_desc(k + 48);
  unsigned m1[16];
#pragma unroll
  for (int i = 0; i < 16; ++i) { out[i] = k[i] > k[31 - i] ? k[i] : k[31 - i]; m1[i] = k[32 + i] > k[63 - i] ? k[32 + i] : k[63 - i]; }
  merge16_desc(out); merge16_desc(m1);
#pragma unroll
  for (int i = 0; i < 16; ++i) out[i] = out[i] > m1[15 - i] ? out[i] : m1[15 - i];
  merge16_desc(out);
}
constexpr int pairs_before(int r, int c) { int n = 0; for (int rr = 0; rr < 16; ++rr) for (int cc = 0; cc < 16; ++cc) { if (rr == r && cc == c) return n; if ((rr + 1) * (cc + 1) <= 16) ++n; } return n; }
constexpr int PEER_TB = 32;
constexpr int PL_SK = 0, PL_LIST = 2 * 128 * 136 * 2, PL_LBUF = PEER_TB * 128 * 8, PL_IDX = PL_LIST + 2 * PL_LBUF;
__device__ __forceinline__ void peer_select_tile(int t0, int lb, unsigned char* lds, const bf16_t* __restrict__ qp) {
  using f32x16 = att::f32x16;
  int lane = threadIdx.x & 63; asm volatile("" : "+v"(lane));
  const int r32 = lane & 31, hi = lane >> 5, h = __builtin_amdgcn_readfirstlane(threadIdx.x >> 6);
  const bf16_t* SK = (const bf16_t*)(lds + PL_SK);
  unsigned top[2][16];
#pragma unroll
  for (int p = 0; p < 2; ++p) {
    f32x16 acc[4] = {};
    const bf16_t* qrow = qp + (size_t)(t0 + r32) * 2048 + h * 256 + p * 128 + hi * 8;
    bf16x8 qf[8];
#pragma unroll
    for (int ks = 0; ks < 8; ++ks) qf[ks] = *(const bf16x8*)(qrow + ks * 16);
#pragma unroll
    for (int ks = 0; ks < 8; ++ks) {
#pragma unroll
      for (int nt = 0; nt < 4; ++nt) { const bf16x8 kf = *(const bf16x8*)(SK + (p * 128 + nt * 32 + r32) * 136 + ks * 16 + hi * 8);
        acc[nt] = __builtin_amdgcn_mfma_f32_32x32x16_bf16(kf, qf[ks], acc[nt], 0, 0, 0); }
      __builtin_amdgcn_sched_barrier(0); }
    unsigned k[64];
#pragma unroll
    for (int nt = 0; nt < 4; ++nt)
#pragma unroll
      for (int r = 0; r < 16; ++r) k[nt * 16 + r] = (f2ord(acc[nt][r]) & 0xffffff80u) | (unsigned)(nt * 32 + (r & 3) + 8 * (r >> 2) + 4 * hi);
    unsigned own[16]; top16_of_64(k, own);
    unsigned X[16], Y[16];
#pragma unroll
    for (int i = 0; i < 16; ++i) { auto rr = __builtin_amdgcn_permlane32_swap(own[i], own[i], false, false); X[i] = rr[0]; Y[i] = rr[1]; }
#pragma unroll
    for (int i = 0; i < 16; ++i) top[p][i] = X[i] > Y[15 - i] ? X[i] : Y[15 - i];
    merge16_desc(top[p]);
  }
  float sa[16], sb[16];
#pragma unroll
  for (int i = 0; i < 16; ++i) { sa[i] = ord2f(top[0][i] & 0xffffff80u); sb[i] = ord2f(top[1][i] & 0xffffff80u); }
  unsigned ck[64];
#pragma unroll
  for (int i = 0; i < 64; ++i) ck[i] = 0u;
#pragma unroll
  for (int r = 0; r < 16; ++r)
#pragma unroll
    for (int c = 0; c < 16; ++c) if ((r + 1) * (c + 1) <= 16) ck[pairs_before(r, c)] = (f2ord(sa[r] + sb[c]) & 0xffffff00u) | (unsigned)(r * 16 + c);
  unsigned win[16]; top16_of_64(ck, win);
  unsigned char* slot = lds + PL_IDX + ((threadIdx.x >> 6) * 32 + r32) * 32;
  u32x4 ia, ib;
#pragma unroll
  for (int q4 = 0; q4 < 4; ++q4) { ia[q4] = (top[0][4 * q4] & 127u) | ((top[0][4 * q4 + 1] & 127u) << 8) | ((top[0][4 * q4 + 2] & 127u) << 16) | ((top[0][4 * q4 + 3] & 127u) << 24);
    ib[q4] = (top[1][4 * q4] & 127u) | ((top[1][4 * q4 + 1] & 127u) << 8) | ((top[1][4 * q4 + 2] & 127u) << 16) | ((top[1][4 * q4 + 3] & 127u) << 24); }
  *(u32x4*)slot = ia; *(u32x4*)(slot + 16) = ib;
  asm volatile("s_waitcnt lgkmcnt(0)" ::: "memory");
  const float s0 = ord2f(win[0] & 0xffffff00u);
  float ex[16], sum = 0.f; int ee[16];
#pragma unroll
  for (int j = 0; j < 16; ++j) { const unsigned pr = (win[j] >> 4) & 15u, pc = win[j] & 15u;
    ee[j] = (int)slot[pr] * 128 + (int)slot[16 + pc];
    ex[j] = __expf(ord2f(win[j] & 0xffffff00u) - s0); sum += ex[j]; }
  const float inv = 1.f / sum;
  if (hi == 0) { u32x2* L = (u32x2*)(lds + PL_LIST + lb * PL_LBUF) + r32 * 128 + h * 16;
#pragma unroll
    for (int j = 0; j < 16; ++j) L[j] = (u32x2){(unsigned)ee[j], __float_as_uint(ex[j] * inv)}; }
}
typedef unsigned u32x6 __attribute__((ext_vector_type(6)));
typedef float f32x32 __attribute__((ext_vector_type(32)));
typedef __bf16 bf16x32v __attribute__((ext_vector_type(32)));
typedef __bf16 bf16x2v __attribute__((ext_vector_type(2)));
__device__ __forceinline__ float half_sum(float v, bool hi) {
  v += dppf<0xB1, 0xf>(v); v += dppf<0x4E, 0xf>(v); v += dppf<0x141, 0xf>(v); v += dppf<0x140, 0xf>(v); v += dppf<0x142, 0xA>(v);
  const float a = readlane_f(v, 31), b = readlane_f(v, 63); return hi ? b : a;
}
__device__ __forceinline__ void peer_expert_tok2(int t0, int tl, int lb, unsigned char* lds, const unsigned char* __restrict__ ws, float* __restrict__ x1io, const float* __restrict__ g2, const float* __restrict__ b2) {
  int lane = threadIdx.x & 63; asm volatile("" : "+v"(lane));
  const int li = lane & 31; const bool hi = lane >= 32;
  const int t = t0 + tl + (hi ? 1 : 0);
  unsigned xu[16]; float y[32];
  { const bf16_t* xbr = (const bf16_t*)(ws + WS_X1B) + (size_t)t * DM + li * 4;
#pragma unroll
    for (int c = 0; c < 8; ++c) { const u32x2 a = *(const u32x2*)(xbr + 128 * c); xu[2 * c] = a.x; xu[2 * c + 1] = a.y; } }
#pragma unroll
  for (int i = 0; i < 32; ++i) y[i] = 0.f;
  const __amdgpu_buffer_rsrc_t rsT = __builtin_amdgcn_make_buffer_rsrc((void*)(ws + WS_TU8), (short)0, 16384 * REC6, 0x00020000);
  const int voP0 = li * 16, voQ0 = 512 + li * 8;
  const float* SU = (const float*)(ws + WS_SU); const float* SV = (const float*)(ws + WS_SV);
  u32x2* SORT = (u32x2*)(lds + PL_IDX) + (threadIdx.x >> 6) * 256;
#pragma unroll
  for (int hh = 0; hh < 2; ++hh) { const u32x2* Lraw = (const u32x2*)(lds + PL_LIST + lb * PL_LBUF) + (tl + hh) * 128;
    const u32x2 p0 = Lraw[2 * lane], p1 = Lraw[2 * lane + 1];
    const int b0 = (int)(p0.x >> 10), b1 = (int)(p1.x >> 10);
    int base = 0, pos0 = 0, pos1 = 0;
#pragma unroll
    for (int v = 0; v < 16; ++v) {
      const unsigned long long m0 = __ballot(b0 == v), m1 = __ballot(b1 == v);
      const int c0 = __builtin_popcountll(m0), c1 = __builtin_popcountll(m1);
      const int r0 = __builtin_amdgcn_mbcnt_hi((unsigned)(m0 >> 32), __builtin_amdgcn_mbcnt_lo((unsigned)m0, 0u));
      const int r1 = __builtin_amdgcn_mbcnt_hi((unsigned)(m1 >> 32), __builtin_amdgcn_mbcnt_lo((unsigned)m1, 0u));
      if (b0 == v) pos0 = base + r0;
      if (b1 == v) pos1 = base + c0 + r1;
      base += c0 + c1; }
    SORT[2 * pos0 + hh] = p0; SORT[2 * pos1 + hh] = p1; }
  asm volatile("s_waitcnt lgkmcnt(0)" ::: "memory");
  const u32x2* L = SORT;
  constexpr int PGS = 4, NPR = PGS / 2, NG = 256 / PGS;
#define PG_LOAD(UP, VP, VQ, EL, GL, SUv, SVv, hg) do { const u32x2 eg_ = L[(hg) * PGS + (lane & (PGS - 1))]; EL = (int)eg_.x; GL = __uint_as_float(eg_.y); SUv = SU[EL]; SVv = SV[EL]; \
    _Pragma("unroll") for (int pr = 0; pr < NPR; ++pr) { const int eb_ = (int)L[(hg) * PGS + 2 * pr + (hi ? 1 : 0)].x * REC6; \
      UP[pr] = __builtin_amdgcn_raw_buffer_load_b128(rsT, eb_ + voP0, 0, 0); \
      VP[pr] = __builtin_amdgcn_raw_buffer_load_b128(rsT, eb_ + voP0 + 512, 0, 0); VQ[pr] = __builtin_amdgcn_raw_buffer_load_b64(rsT, eb_ + voQ0 + 512, 0, 0); } } while (0)
#define PG_COMP(UP, VP, VQ, GL, SUv, SVv) do { float dd_ = 0.f; \
    _Pragma("unroll") for (int pr = 0; pr < NPR; ++pr) { \
      float d0_ = 0.f, d1_ = 0.f; \
      _Pragma("unroll") for (int w4 = 0; w4 < 4; ++w4) {     \
        d0_ = __builtin_amdgcn_fdot2_f32_bf16(__builtin_amdgcn_cvt_scalef32_pk_bf16_fp4(UP[pr][w4], 1.0f, 0), __builtin_bit_cast(bf16x2v, xu[4 * w4]), d0_, false); \
        d1_ = __builtin_amdgcn_fdot2_f32_bf16(__builtin_amdgcn_cvt_scalef32_pk_bf16_fp4(UP[pr][w4], 1.0f, 1), __builtin_bit_cast(bf16x2v, xu[4 * w4 + 1]), d1_, false); \
        d0_ = __builtin_amdgcn_fdot2_f32_bf16(__builtin_amdgcn_cvt_scalef32_pk_bf16_fp4(UP[pr][w4], 1.0f, 2), __builtin_bit_cast(bf16x2v, xu[4 * w4 + 2]), d0_, false); \
        d1_ = __builtin_amdgcn_fdot2_f32_bf16(__builtin_amdgcn_cvt_scalef32_pk_bf16_fp4(UP[pr][w4], 1.0f, 3), __builtin_bit_cast(bf16x2v, xu[4 * w4 + 3]), d1_, false); } \
      d0_ += d1_; d0_ += dppf<0xB1, 0xf>(d0_); d0_ += dppf<0x4E, 0xf>(d0_); d0_ += dppf<0x141, 0xf>(d0_); d0_ += dppf<0x140, 0xf>(d0_); d0_ += dppf<0x142, 0xA>(d0_);     \
      const float t0_ = readlane_f(d0_, 31), t1_ = readlane_f(d0_, 63); if (lane == 2 * pr) dd_ = t0_; if (lane == 2 * pr + 1) dd_ = t1_; } \
    const float av_ = dd_ * SUv; const float wl_ = GL * gelu_erf(av_) * SVv; \
    _Pragma("unroll") for (int pr = 0; pr < NPR; ++pr) { const float w0_ = readlane_f(wl_, 2 * pr), w1_ = readlane_f(wl_, 2 * pr + 1); const float w_ = hi ? w1_ : w0_; \
      const u32x6 vv_ = {VP[pr].x, VP[pr].y, VP[pr].z, VP[pr].w, VQ[pr].x, VQ[pr].y}; \
      const f32x32 vf_ = __builtin_amdgcn_cvt_scalef32_pk32_f32_fp6(vv_, 1.0f); \
      _Pragma("unroll") for (int i = 0; i < 32; ++i) y[i] = __builtin_fmaf(w_, vf_[i], y[i]); \
      __builtin_amdgcn_sched_barrier(0); } } while (0)
  {
    u32x4 upA[NPR], vpA[NPR], upB[NPR], vpB[NPR]; u32x2 vqA[NPR], vqB[NPR]; int elA, elB; float glA, glB, suA, suB, svA, svB;
    PG_LOAD(upA, vpA, vqA, elA, glA, suA, svA, 0);
    for (int hg = 0; hg < NG - 2; hg += 2) {
      PG_LOAD(upB, vpB, vqB, elB, glB, suB, svB, hg + 1);
      PG_COMP(upA, vpA, vqA, glA, suA, svA);
      PG_LOAD(upA, vpA, vqA, elA, glA, suA, svA, hg + 2);
      PG_COMP(upB, vpB, vqB, glB, suB, svB);
    }
    PG_LOAD(upB, vpB, vqB, elB, glB, suB, svB, NG - 1);
    PG_COMP(upA, vpA, vqA, glA, suA, svA);
    PG_COMP(upB, vpB, vqB, glB, suB, svB);
  }
#undef PG_LOAD
#undef PG_COMP
  float s = 0.f;
#pragma unroll
  for (int i = 0; i < 16; ++i) { y[2 * i] = ALPHA * __uint_as_float(xu[i] << 16) + y[2 * i]; y[2 * i + 1] = ALPHA * __uint_as_float(xu[i] & 0xffff0000u) + y[2 * i + 1]; s += y[2 * i] + y[2 * i + 1]; }
  const float mu = half_sum(s, hi) * (1.f / DM); float q = 0.f;
#pragma unroll
  for (int i = 0; i < 32; ++i) { y[i] -= mu; q += y[i] * y[i]; }
  const float rs = rsqrtf(half_sum(q, hi) * (1.f / DM) + LN_EPS);
  int ch0 = li * 4; asm volatile("" : "+v"(ch0));
  float* xr = x1io + (size_t)t * DM + ch0;
#pragma unroll
  for (int c = 0; c < 8; ++c) { const float4 gg = *(const float4*)(g2 + ch0 + 128 * c), bb = *(const float4*)(b2 + ch0 + 128 * c);
    float4 o; o.x = y[4 * c] * rs * gg.x + bb.x; o.y = y[4 * c + 1] * rs * gg.y + bb.y; o.z = y[4 * c + 2] * rs * gg.z + bb.z; o.w = y[4 * c + 3] * rs * gg.w + bb.w;
    *(float4*)(xr + 128 * c) = o; }
}
__device__ __forceinline__ void ph_peer(int bid, int nb, unsigned char* lds, unsigned char* ws, const float* __restrict__ subk, float* __restrict__ dout, const float* __restrict__ g2, const float* __restrict__ b2) {
  bf16_t* SK = (bf16_t*)(lds + PL_SK);
  for (int i = threadIdx.x; i < 2 * 128 * 32; i += 512) { const int row = i >> 5, c4 = i & 31; const float4 v = ((const float4*)subk)[i];
    u32x2 w; w.x = pk2(v.x, v.y); w.y = pk2(v.z, v.w); *(u32x2*)(SK + row * 136 + c4 * 4) = w; }
  __syncthreads();
  const int wave = threadIdx.x >> 6;
  const bf16_t* qp = (const bf16_t*)(ws + WS_QP);
  const bool both_first = (bid & 1) != 0;
  for (int tile = bid; tile < T / PEER_TB; tile += 2 * nb) {
    const int ta = tile * PEER_TB, tb = (tile + nb) * PEER_TB; const bool has_b = tile + nb < T / PEER_TB;
    peer_select_tile(ta, 0, lds, qp);
    if (both_first && has_b) peer_select_tile(tb, 1, lds, qp);
    __syncthreads();
    for (int i = 0; i < PEER_TB / 8; i += 2) { const int tl = wave * (PEER_TB / 8) + i; peer_expert_tok2(ta, tl, 0, lds, ws, dout, g2, b2); }
    if (has_b) {
      if (!both_first) { __syncthreads(); peer_select_tile(tb, 1, lds, qp); __syncthreads(); }
      for (int i = 0; i < PEER_TB / 8; i += 2) { const int tl = wave * (PEER_TB / 8) + i; peer_expert_tok2(tb, tl, 1, lds, ws, dout, g2, b2); }
    }
    __syncthreads();
  }
}

#define LAS __attribute__((address_space(3)))
#define XB_TMO      128
#define XB_XCNT(j)  (256  + 64 * (j))
#define XB_XSUB(j)  (1280 + 64 * (j))
#define XB_XGEN(j)  (2304 + 64 * (j))
#define XB_TOP      3328
#define XB_TOPGEN   3392
#define XCD_BAR_WORDS 3456
#define XB_SPIN_CAP (1u << 18)

__device__ __forceinline__ unsigned xb_ld(unsigned* p)              { return __hip_atomic_load(p, __ATOMIC_RELAXED, __HIP_MEMORY_SCOPE_AGENT); }
__device__ __forceinline__ unsigned xb_add(unsigned* p, unsigned v) { return __hip_atomic_fetch_add(p, v, __ATOMIC_RELAXED, __HIP_MEMORY_SCOPE_AGENT); }
__device__ __forceinline__ unsigned xb_xcc_id() { return (unsigned)__builtin_amdgcn_s_getreg((3 << 11) | 20) & 0xFu; }
#define XB_SPIN(cond, bar) do { unsigned _sp = 0; while (cond) { __builtin_amdgcn_s_sleep(1); \
    if ((++_sp & 255u) == 0u) { if (xb_ld(&(bar)[XB_TMO])) break; if (_sp > XB_SPIN_CAP) { atomicAdd(&(bar)[XB_TMO], 1u); break; } } } } while (0)

struct XcdBarrier {
    unsigned* bar; unsigned x;
    volatile LAS unsigned* st;
};

__device__ __forceinline__ XcdBarrier xcd_barrier_post(unsigned* bar, volatile LAS unsigned* st) {
    XcdBarrier b; b.bar = bar; b.x = xb_xcc_id(); b.st = st;
    if (threadIdx.x == 0) (void)xb_add(&bar[XB_XCNT(b.x)], 1u);
    return b;
}
__device__ __forceinline__ void xcd_barrier_complete(unsigned* bar, unsigned x, unsigned& nloc, unsigned& nx) {
    const unsigned G = gridDim.x * gridDim.y * gridDim.z;
    unsigned sum, cnt, mine, sp = 0u;
    for (;;) {
        sum = 0u; cnt = 0u; mine = 0u;
#pragma unroll
        for (unsigned j = 0; j < 16; ++j) { const unsigned c = xb_ld(&bar[XB_XCNT(j)]); sum += c; cnt += (c > 0u) ? 1u : 0u; mine = (j == x) ? c : mine; }
        if (sum == G) break;
        __builtin_amdgcn_s_sleep(1);
        if ((++sp & 255u) == 0u) { if (xb_ld(&bar[XB_TMO])) break; if (sp > XB_SPIN_CAP) { atomicAdd(&bar[XB_TMO], 1u); break; } }
    }
    nloc = mine > 0u ? mine : 1u; nx = cnt > 0u ? cnt : 1u;
}

__device__ __forceinline__ void xcd_barrier(const XcdBarrier& b) {
    asm volatile("s_waitcnt vmcnt(0)" ::: "memory");
    __syncthreads();
    if (threadIdx.x == 0) {
        unsigned* bar = b.bar;
        __builtin_amdgcn_s_waitcnt(0);
        unsigned nloc = b.st[0], nx = b.st[1];
        if (nloc == 0u) { xcd_barrier_complete(bar, b.x, nloc, nx); b.st[0] = nloc; b.st[1] = nx; }
        const unsigned old = xb_add(&bar[XB_XSUB(b.x)], 1u);
        const unsigned gen = old / nloc;
        if (old + 1u == (gen + 1u) * nloc) {
            __builtin_amdgcn_fence(__ATOMIC_RELEASE, "agent");
            asm volatile("s_waitcnt vmcnt(0)" ::: "memory");
            const unsigned og = xb_add(&bar[XB_TOP], 1u);
            const unsigned tg = og / nx;
            if (og + 1u == (tg + 1u) * nx) xb_add(&bar[XB_TOPGEN], 1u);
            else XB_SPIN(xb_ld(&bar[XB_TOPGEN]) == tg, bar);
            __builtin_amdgcn_fence(__ATOMIC_ACQUIRE, "agent");
            xb_add(&bar[XB_XGEN(b.x)], 1u);
            asm volatile("s_waitcnt vmcnt(0)" ::: "memory");
        } else {
            XB_SPIN(xb_ld(&bar[XB_XGEN(b.x)]) == gen, bar);
            __builtin_amdgcn_fence(__ATOMIC_ACQUIRE, "agent");
            asm volatile("s_waitcnt vmcnt(0)" ::: "memory");
        }
    }
    __syncthreads();
}

struct KP { const float* in[19]; float* out; unsigned char* ws; int ph_lo, ph_hi; };
constexpr int NPHASE = 10;
#ifndef MK_LAUNCHES
#define MK_LAUNCHES 1
#endif
__global__ __launch_bounds__(512) void mega(KP p) {
  extern __shared__ __attribute__((aligned(16))) unsigned char lds[];
  cg::grid_group grid = cg::this_grid();
  const int bid = blockIdx.x, nb = gridDim.x, lane = threadIdx.x & 63;
  unsigned char* ws = p.ws; unsigned char* dob = (unsigned char*)p.out; float* dout = p.out;
  const float* x = p.in[0]; const float* w_in = p.in[1];
  bf16_t* xb = (bf16_t*)(dob + DO_XB); bf16_t* WinT = (bf16_t*)(dob + DO_WINT); bf16_t* UT = (bf16_t*)dob;
  float* gpre = (float*)(ws + WS_GPRE); float2* cs = (float2*)(ws + WS_CS);
  EP e; e.x = x; e.ws = ws; e.dout = dout; e.cs = cs;
#ifdef ONLY_PH
#define IN(k) ((k) == ONLY_PH && p.ph_lo <= (k) && (k) < p.ph_hi)
#else
#define IN(k) (p.ph_lo <= (k) && (k) < p.ph_hi)
#endif
  volatile LAS unsigned* bst = (volatile LAS unsigned*)((LAS unsigned char*)lds + (LDS_BYTES - 64));
  if (threadIdx.x < 2) bst[threadIdx.x] = 0u;
  __syncthreads();
  const XcdBarrier xbar = xcd_barrier_post((unsigned*)ws, bst);
#define SEAM(k) do { if (IN(k) && IN((k) + 1)) xcd_barrier(xbar); } while (0)
  if (IN(0)) {
    ph_prep_x(bid, nb, lds, x, w_in, p.in[6], xb, gpre);
    ph_prep_weights(bid, nb, lds, w_in, p.in[8], p.in[9], p.in[10], p.in[13], WinT, ws);
    ph_rope_tab(bid, nb, cs);
  }
  SEAM(0);
  if (IN(1)) {
    if (bid >= nb - 16) gp_scan(bid - (nb - 16), gpre, ws, lds);
    ph_gemm8<EPI_G1>(lds, xb, WinT, 5632, 1024, e);
  }
  SEAM(1);
  if (IN(2)) { M1Pre pr; if (bid < 1024) m1_prefetch(bid, pr, ws, p.in[4], p.in[5]);
    for (int u = bid; u < 1024; u += nb) { if (u + nb < 1024) m1_unit<true>(u, u + nb, pr, lds, ws, UT, p.in[4], p.in[5]); else m1_unit<false>(u, u, pr, lds, ws, UT, p.in[4], p.in[5]); } }
  SEAM(2);
  if (IN(3)) m2_scan(bid, nb, ws, UT);
  SEAM(3);
  if (IN(4)) {
    const float lam = compute_lambda(p.in[2], lane);
    for (int u = bid; u < 256; u += nb) att::attn_unit(u & 7, u >> 3, ws, u, lam, p.in[3], (char*)lds);
    for (int u = bid; u < 1024; u += nb) m3_unit(u, lds, ws, UT, p.in[7]);
  }
  SEAM(4);
  if (IN(5)) {
    ph_gemm_merge(lds, ws);
  }
  SEAM(5);
  if (IN(6)) ph_gemm8<EPI_OUT>(lds, (const bf16_t*)(ws + WS_MG), (const bf16_t*)(ws + WS_WOUT), 1024, 1024, e);
  SEAM(6);
  if (IN(7)) {
    ph_ln1_tab8(bid, nb, dout, p.in[11], p.in[12], (bf16_t*)(ws + WS_X1B), p.in[15], p.in[16], ws);
  }
  SEAM(7);
  if (IN(8)) ph_gemm8<EPI_QP>(lds, (const bf16_t*)(ws + WS_X1B), (const bf16_t*)(ws + WS_WQ), 2048, 1024, e);
  SEAM(8);
  if (IN(9)) ph_peer(bid, nb, lds, ws, p.in[14], dout, p.in[17], p.in[18]);
  if (p.ph_hi - p.ph_lo == NPHASE) grid.sync();
#undef IN
#undef SEAM
}

extern "C" void kernel_launch(void* const* d_in, const int* in_sizes, int n_in, void* d_out, int out_size, void* d_ws, size_t ws_size, hipStream_t stream) {
  static int grid = 0;
  if (grid == 0) {
    int dev = 0, cus = 0, per_cu = 0;
    hipGetDevice(&dev); hipDeviceGetAttribute(&cus, hipDeviceAttributeMultiprocessorCount, dev);
    hipFuncSetAttribute((const void*)mega, hipFuncAttributeMaxDynamicSharedMemorySize, LDS_BYTES);
    hipOccupancyMaxActiveBlocksPerMultiprocessor(&per_cu, (const void*)mega, 512, LDS_BYTES);
    if (per_cu < 1) { fprintf(stderr, "kernel_launch: occupancy query says %d blocks per CU\n", per_cu); per_cu = 1; }
    grid = cus * 1;
  }
  hipMemsetAsync(d_ws, 0, 16384, stream);
  KP p{};
  for (int i = 0; i < 19; ++i) p.in[i] = (const float*)d_in[i];
  p.out = (float*)d_out; p.ws = (unsigned char*)d_ws;
  if (MK_LAUNCHES == 1) {
    p.ph_lo = 0; p.ph_hi = NPHASE;
    void* args[] = {&p};
    hipError_t er = hipLaunchCooperativeKernel((void*)mega, dim3(grid), dim3(512), args, LDS_BYTES, stream);
    if (er != hipSuccess) fprintf(stderr, "cooperative launch failed: %s (grid %d)\n", hipGetErrorString(er), grid);
  } else {
    for (int k = 0; k < NPHASE; ++k) { p.ph_lo = k; p.ph_hi = k + 1; hipLaunchKernelGGL(mega, dim3(grid), dim3(512), LDS_BYTES, stream, p); }
  }
}
```

```cpp
#include <hip/hip_runtime.h>
#include <hip/hip_cooperative_groups.h>
#include <cstdio>
#include <stdint.h>
#include <math.h>

namespace cg = cooperative_groups;
typedef unsigned short bf16_t;
typedef short bf16x8 __attribute__((ext_vector_type(8)));
typedef float f32x4 __attribute__((ext_vector_type(4)));
typedef unsigned u32x2 __attribute__((ext_vector_type(2)));
typedef unsigned u32x4 __attribute__((ext_vector_type(4)));

constexpr int T = 16384, SEQ = 8192, DM = 1024;
constexpr float ALPHA = 1.189207115002721f;
constexpr float LN_EPS = 1e-5f;
constexpr float LAMBDA_INIT = 0.2f;
constexpr float QSCALE = 0.125f * 1.4426950408889634f;

constexpr size_t MB = 1u << 20;
constexpr size_t WS_GPRE = 1 * MB;
constexpr size_t WS_CS = 2 * MB;
constexpr size_t WS_WA = 8 * MB;
constexpr size_t WS_WM = 9 * MB;
constexpr size_t WS_WOUT = 10 * MB;
constexpr size_t WS_WQ = 12 * MB;
constexpr size_t WS_G1 = 16 * MB;
constexpr size_t WS_Q = 16 * MB, WS_K = 32 * MB, WS_V = 48 * MB, WS_MQ = 64 * MB, WS_MK = 80 * MB, WS_MV = 96 * MB, WS_MO = 112 * MB;
constexpr size_t WS_BG = 128 * MB;
constexpr size_t WS_QC = 192 * MB, WS_KC = 208 * MB;
constexpr size_t WS_O0 = 224 * MB;
constexpr size_t WS_YA = WS_MQ, WS_YM = WS_MK;
constexpr size_t WS_MG = WS_Q;
constexpr size_t WS_X1B = WS_QC;
constexpr size_t WS_TU = 128 * MB, WS_TV = 160 * MB;
constexpr size_t WS_QP = 16 * MB;
constexpr size_t WS_EXP = 96 * MB, WS_GATE = 104 * MB;
constexpr size_t DO_XB = 0, DO_WINT = 32 * MB;

__device__ __forceinline__ float bf2f(bf16_t v) { return __uint_as_float(((unsigned)v) << 16); }
__device__ __forceinline__ bf16_t f2bf(float f) { unsigned u = __float_as_uint(f); u += 0x7fffu + ((u >> 16) & 1u); return (bf16_t)(u >> 16); }
__device__ __forceinline__ unsigned pk2(float lo, float hi) { return (unsigned)f2bf(lo) | ((unsigned)f2bf(hi) << 16); }
__device__ __forceinline__ float sigmoidf_(float x) { return 1.f / (1.f + __expf(-x)); }
__device__ __forceinline__ float wave_sum(float v) {
#pragma unroll
  for (int o = 1; o < 64; o <<= 1) v += __shfl_xor(v, o);
  return v;
}
__device__ __forceinline__ float wave_max(float v) {
#pragma unroll
  for (int o = 1; o < 64; o <<= 1) v = fmaxf(v, __shfl_xor(v, o));
  return v;
}
__device__ __forceinline__ unsigned wave_maxu(unsigned v) {
#pragma unroll
  for (int o = 1; o < 64; o <<= 1) { unsigned w = (unsigned)__shfl_xor((int)v, o); v = v > w ? v : w; }
  return v;
}

__device__ __forceinline__ void ph_prep_x(int bid, int nb, unsigned char* lds, const float* __restrict__ x, const float* __restrict__ w_in, const float* __restrict__ gate_b,
                                          bf16_t* __restrict__ xb, float* __restrict__ gpre) {
  const int lane = threadIdx.x & 63, wave = __builtin_amdgcn_readfirstlane(threadIdx.x >> 6), fr = lane & 15, fq = lane >> 4;
  bf16_t* WGb = (bf16_t*)lds;
  for (int i = threadIdx.x; i < 16 * 1024; i += 512) { const int k = i >> 4, g = i & 15; WGb[g * 1032 + k] = f2bf(w_in[(size_t)k * 5648 + 3584 + g]); }
  const int rpb = ((T / 16 + nb - 1) / nb) * 16, row0 = bid * rpb, nrow = row0 < T ? (T - row0 < rpb ? T - row0 : rpb) : 0;
  { const float4* xs = (const float4*)(x + (size_t)row0 * DM); u32x2* xd = (u32x2*)(xb + (size_t)row0 * DM);
    for (int i = threadIdx.x; i < nrow * 256; i += 512) { const float4 v = xs[i]; u32x2 w; w.x = pk2(v.x, v.y); w.y = pk2(v.z, v.w); xd[i] = w; } }
  asm volatile("s_waitcnt vmcnt(0)" ::: "memory");
  __syncthreads();
  for (int rt = wave; rt * 16 < nrow; rt += 8) {
    const bf16_t* xr = xb + (size_t)(row0 + rt * 16 + fr) * DM + 8 * fq; const bf16_t* wr = WGb + fr * 1032 + 8 * fq;
    f32x4 acc = {0.f, 0.f, 0.f, 0.f};
#pragma unroll 8
    for (int ks = 0; ks < 32; ++ks) { const bf16x8 a = *(const bf16x8*)(xr + 32 * ks), bv = *(const bf16x8*)(wr + 32 * ks);
      acc = __builtin_amdgcn_mfma_f32_16x16x32_bf16(a, bv, acc, 0, 0, 0); }
    const float gb = gate_b[fr];
#pragma unroll
    for (int r = 0; r < 4; ++r) gpre[(size_t)(row0 + rt * 16 + 4 * fq + r) * 16 + fr] = acc[r] + gb;
  }
  __syncthreads();
}
__device__ __forceinline__ int src_col(int n, int mode) {
  if (mode == 1) { if (n < 1024) { const int j = n & 63; const int pj = j < 16 ? ((j & 1) ? (j >> 1) + 8 : (j >> 1)) : j; return (n & ~63) + pj; } else if (n >= 3584) return n + 16; }
  return n;
}
__device__ __forceinline__ void transpose_item(const float* __restrict__ W, int ldw, int K, int nblk, bf16_t* __restrict__ WT, float* scr, int item, int lane, int mode, int ldo = 0) {
  if (ldo == 0) ldo = K;
  const int kb = item / nblk, nbk = item % nblk, k0 = 64 * kb, n0 = 32 * nbk;
  const int sc = src_col(n0 + (lane & 31), mode);
#pragma unroll 8
  for (int i = 0; i < 32; ++i) { const int kk = 2 * i + (lane >> 5); scr[kk * 33 + (lane & 31)] = W[(size_t)(k0 + kk) * ldw + sc]; }
  asm volatile("s_waitcnt lgkmcnt(0)" ::: "memory");
  const int c = lane & 7;
#pragma unroll
  for (int j = 0; j < 4; ++j) { const int n = (lane >> 3) + 8 * j; const float* s = scr + (8 * c) * 33 + n;
    u32x4 o; o.x = pk2(s[0 * 33], s[1 * 33]); o.y = pk2(s[2 * 33], s[3 * 33]); o.z = pk2(s[4 * 33], s[5 * 33]); o.w = pk2(s[6 * 33], s[7 * 33]);
    *(u32x4*)(WT + (size_t)(n0 + n) * ldo + k0 + 8 * c) = o; }
  asm volatile("s_waitcnt lgkmcnt(0)" ::: "memory");
}
__device__ __forceinline__ void ph_prep_weights(int bid, int nb, unsigned char* lds, const float* w_in, const float* w_ba, const float* w_bm, const float* w_out, const float* w_q,
                                                bf16_t* WinT, unsigned char* ws) {
  const int lane = threadIdx.x & 63, wave = threadIdx.x >> 6;
  float* scr = (float*)(lds + 65536 + wave * 8448);
  constexpr int I_IN = 16 * 176, I_BA = 8 * 32, I_OUT = 16 * 32, I_Q = 16 * 64, NIT = I_IN + 2 * I_BA + I_OUT + I_Q;
  for (int it = bid * 8 + wave; it < NIT; it += nb * 8) {
    int r = it;
    if (r < I_IN) { transpose_item(w_in, 5648, 1024, 176, WinT, scr, r, lane, 1); continue; } r -= I_IN;
    if (r < I_BA) { transpose_item(w_ba, 1024, 512, 32, (bf16_t*)(ws + WS_WA), scr, r, lane, 0, 1024); continue; } r -= I_BA;
    if (r < I_BA) { transpose_item(w_bm, 1024, 512, 32, (bf16_t*)(ws + WS_WA) + 512, scr, r, lane, 0, 1024); continue; } r -= I_BA;
    if (r < I_OUT) { transpose_item(w_out, 1024, 1024, 32, (bf16_t*)(ws + WS_WOUT), scr, r, lane, 0); continue; } r -= I_OUT;
    transpose_item(w_q, 2048, 1024, 64, (bf16_t*)(ws + WS_WQ), scr, r, lane, 0);
  }
}
__device__ __forceinline__ void ph_cvt(int bid, int nb, const float* __restrict__ in, bf16_t* __restrict__ out, size_t n4) {
  for (size_t i = (size_t)bid * 512 + threadIdx.x; i < n4; i += (size_t)nb * 512) {
    const float4 v = ((const float4*)in)[i]; u32x2 w; w.x = pk2(v.x, v.y); w.y = pk2(v.z, v.w); ((u32x2*)out)[i] = w; }
}
__device__ __forceinline__ void ph_rope_tab(int bid, int nb, float2* __restrict__ cs) {
  for (int idx = bid * 512 + threadIdx.x; idx < 8192 * 8; idx += nb * 512) {
    const int s = idx >> 3, i = idx & 7;
    const double inv = i == 0 ? 1.0 : i == 1 ? 0.19392274474868576 : i == 2 ? 0.03760603093086393 : i == 3 ? 0.007292664737217109 : i == 4 ? 0.001414213562373095 : i == 5 ? 0.0002742481756762073
                     : i == 6 ? 5.318295896944988e-05 : 1.031338537721246e-05;
    const double ang = (double)s * inv, k = __builtin_rint(ang * 0.15915494309189535);
    const float r = (float)(__builtin_fma(-k, 6.283185307179586, ang) - k * 2.4492935982947064e-16);
    cs[idx] = make_float2(cosf(r), sinf(r));
  }
}

struct EP { const float* x; unsigned char* ws; float* dout; const float2* cs; };
enum { EPI_G1 = 0, EPI_M1 = 1, EPI_M2 = 2, EPI_OUT = 3, EPI_QP = 4 };
template <int EPI> __device__ __forceinline__ void epi4(const EP& e, int row, int col, f32x4 v) {
  if (EPI == EPI_G1) {
    if (col < 1024) {
      if ((col & 63) < 16) { const int s = row & (SEQ - 1), i0 = (col & 15) >> 1; const float2 c0 = e.cs[s * 8 + i0], c1 = e.cs[s * 8 + i0 + 1];
        const float a0 = v[0] * c0.x - v[1] * c0.y, b0 = v[1] * c0.x + v[0] * c0.y, a1 = v[2] * c1.x - v[3] * c1.y, b1 = v[3] * c1.x + v[2] * c1.y;
        v[0] = a0; v[1] = b0; v[2] = a1; v[3] = b1; }
      if (col < 512) v = v * QSCALE;
    } else if (col >= 3072) { v[0] = sigmoidf_(v[0]); v[1] = sigmoidf_(v[1]); v[2] = sigmoidf_(v[2]); v[3] = sigmoidf_(v[3]); }
    bf16_t* dst = col < 3584 ? (bf16_t*)(e.ws + WS_G1) + (size_t)(col >> 9) * ((size_t)T * 512) + (size_t)row * 512 + (col & 511)
                             : (bf16_t*)(e.ws + WS_BG) + (size_t)row * 2048 + (col - 3584);
    u32x2 w; w.x = pk2(v[0], v[1]); w.y = pk2(v[2], v[3]); *(u32x2*)dst = w;
  } else if (EPI == EPI_M1 || EPI == EPI_M2) {
    const bf16_t* g = (const bf16_t*)(e.ws + WS_BG) + (size_t)row * 2048 + (EPI == EPI_M2 ? 1024 : 0) + col;
    const u32x2 gw = *(const u32x2*)g;
    bf16_t* dst = (bf16_t*)(e.ws + WS_MG) + (size_t)row * 1024 + col;
    float r0 = v[0] * __uint_as_float(gw.x << 16), r1 = v[1] * __uint_as_float(gw.x & 0xffff0000u), r2 = v[2] * __uint_as_float(gw.y << 16), r3 = v[3] * __uint_as_float(gw.y & 0xffff0000u);
    if (EPI == EPI_M2) { const u32x2 pw = *(const u32x2*)dst; r0 += __uint_as_float(pw.x << 16); r1 += __uint_as_float(pw.x & 0xffff0000u); r2 += __uint_as_float(pw.y << 16); r3 += __uint_as_float(pw.y & 0xffff0000u); }
    u32x2 w; w.x = pk2(r0, r1); w.y = pk2(r2, r3); *(u32x2*)dst = w;
  } else if (EPI == EPI_OUT) {
    const f32x4 xv = *(const f32x4*)(e.x + (size_t)row * DM + col);
    *(f32x4*)(e.dout + (size_t)row * DM + col) = xv * ALPHA + v;
  } else if (EPI == EPI_QP) {
    u32x2 w; w.x = pk2(v[0], v[1]); w.y = pk2(v[2], v[3]); *(u32x2*)((bf16_t*)(e.ws + WS_QP) + (size_t)row * 2048 + col) = w;
  }
}
__device__ __forceinline__ float fsig(float x) { return __builtin_amdgcn_rcpf(1.f + __builtin_amdgcn_exp2f(-1.4426950408889634f * x)); }
__device__ __forceinline__ void rope4(const float2* __restrict__ cs, int s, int i0, f32x4& v) {
  const float2 c0 = cs[s * 8 + i0], c1 = cs[s * 8 + i0 + 1];
  const float a0 = v[0] * c0.x - v[1] * c0.y, b0 = v[1] * c0.x + v[0] * c0.y, a1 = v[2] * c1.x - v[3] * c1.y, b1 = v[3] * c1.x + v[2] * c1.y;
  v[0] = a0; v[1] = b0; v[2] = a1; v[3] = b1;
}
__device__ __forceinline__ void unpk8(const u32x4 w, float* f) {
#pragma unroll
  for (int i = 0; i < 4; ++i) { f[2 * i] = __uint_as_float(w[i] << 16); f[2 * i + 1] = __uint_as_float(w[i] & 0xffff0000u); }
}
template <int EPI> __device__ __forceinline__ void epi8(const EP& e, int row, int col, f32x4 v0, f32x4 v1) {
  if (EPI == EPI_G1) {
    if (col < 1024) {
      if ((col & 63) < 16) { const int s = row & (SEQ - 1), i0 = (col & 15) >> 1; rope4(e.cs, s, i0, v0); rope4(e.cs, s, i0 + 2, v1); }
      if (col < 512) { v0 = v0 * QSCALE; v1 = v1 * QSCALE; }
    } else if (col >= 3072) {
#pragma unroll
      for (int i = 0; i < 4; ++i) { v0[i] = fsig(v0[i]); v1[i] = fsig(v1[i]); }
    }
    bf16_t* dst = col < 3584 ? (bf16_t*)(e.ws + WS_G1) + (size_t)(col >> 9) * ((size_t)T * 512) + (size_t)row * 512 + (col & 511)
                             : (bf16_t*)(e.ws + WS_BG) + (size_t)row * 2048 + (col - 3584);
    u32x4 w; w.x = pk2(v0[0], v0[1]); w.y = pk2(v0[2], v0[3]); w.z = pk2(v1[0], v1[1]); w.w = pk2(v1[2], v1[3]); *(u32x4*)dst = w;
  } else if (EPI == EPI_M1 || EPI == EPI_M2) {
    float g[8]; unpk8(*(const u32x4*)((const bf16_t*)(e.ws + WS_BG) + (size_t)row * 2048 + (EPI == EPI_M2 ? 1024 : 0) + col), g);
    bf16_t* dst = (bf16_t*)(e.ws + WS_MG) + (size_t)row * 1024 + col;
    float r[8];
#pragma unroll
    for (int i = 0; i < 4; ++i) { r[i] = v0[i] * g[i]; r[4 + i] = v1[i] * g[4 + i]; }
    if (EPI == EPI_M2) { float pv[8]; unpk8(*(const u32x4*)dst, pv);
#pragma unroll
      for (int i = 0; i < 8; ++i) r[i] += pv[i]; }
    u32x4 w; w.x = pk2(r[0], r[1]); w.y = pk2(r[2], r[3]); w.z = pk2(r[4], r[5]); w.w = pk2(r[6], r[7]); *(u32x4*)dst = w;
  } else if (EPI == EPI_OUT) {
    const f32x4 x0 = *(const f32x4*)(e.x + (size_t)row * DM + col), x1 = *(const f32x4*)(e.x + (size_t)row * DM + col + 4);
    const f32x4 r0 = x0 * ALPHA + v0, r1 = x1 * ALPHA + v1;
    u32x4 w; w.x = pk2(r0[0], r0[1]); w.y = pk2(r0[2], r0[3]); w.z = pk2(r1[0], r1[1]); w.w = pk2(r1[2], r1[3]); *(u32x4*)((bf16_t*)e.dout + (size_t)row * DM + col) = w;
  } else if (EPI == EPI_QP) {
    u32x4 w; w.x = pk2(v0[0], v0[1]); w.y = pk2(v0[2], v0[3]); w.z = pk2(v1[0], v1[1]); w.w = pk2(v1[2], v1[3]);
    *(u32x4*)((bf16_t*)(e.ws + WS_QP) + (size_t)row * 2048 + col) = w;
  }
}
template <int EPI> __device__ __forceinline__ void ph_gemm(int bid, int nb, const bf16_t* __restrict__ A, const bf16_t* __restrict__ Bt, int N, int K, const EP& e) {
  const int tid = threadIdx.x & 255, half = threadIdx.x >> 8, wave = tid >> 6, lane = tid & 63, fr = lane & 15, fq = lane >> 4;
  const int ntn = N / 64, ntiles = ntn * (T / 64);
  for (int tile = bid * 2 + half; tile < ntiles; tile += nb * 2) {
    const int m0 = (tile / ntn) * 64 + (wave & 1) * 32, n0 = (tile % ntn) * 64 + (wave >> 1) * 32;
    f32x4 acc[2][2];
#pragma unroll
    for (int i = 0; i < 2; ++i)
#pragma unroll
      for (int j = 0; j < 2; ++j) acc[i][j] = (f32x4){0.f, 0.f, 0.f, 0.f};
    const bf16_t* ap = A + (size_t)(m0 + fr) * K + fq * 8; const bf16_t* bp = Bt + (size_t)(n0 + fr) * K + fq * 8;
    for (int k0 = 0; k0 < K; k0 += 32) {
      bf16x8 a[2], b[2];
#pragma unroll
      for (int i = 0; i < 2; ++i) { a[i] = *(const bf16x8*)(ap + (size_t)i * 16 * K + k0); b[i] = *(const bf16x8*)(bp + (size_t)i * 16 * K + k0); }
#pragma unroll
      for (int i = 0; i < 2; ++i)
#pragma unroll
        for (int j = 0; j < 2; ++j) acc[i][j] = __builtin_amdgcn_mfma_f32_16x16x32_bf16(b[j], a[i], acc[i][j], 0, 0, 0);
    }
#pragma unroll
    for (int i = 0; i < 2; ++i)
#pragma unroll
      for (int j = 0; j < 2; ++j) epi4<EPI>(e, m0 + 16 * i + fr, n0 + 16 * j + 4 * fq, acc[i][j]);
  }
}

namespace pg8 {
#define PG8_LAS __attribute__((address_space(3)))
typedef unsigned short bf16_t;
typedef short bf16x8 __attribute__((ext_vector_type(8)));
typedef float f32x4 __attribute__((ext_vector_type(4)));
typedef unsigned u32x4 __attribute__((ext_vector_type(4)));
constexpr int BM = 256, BK = 64, HALF = 128, HTB = HALF * BK * 2  , STAGE_BYTES = 8 * HTB, NXCD = 8, WGM = 8;

__host__ __device__ __forceinline__ int lds_byte(int r, int c) { const int st = (r >> 4) * 2 + (c >> 5), rr = r & 15, cc = c & 31, ob = rr * 64 + cc * 2; return st * 1024 + (ob ^ (((ob >> 9) & 1) << 5)); }
__host__ __device__ __forceinline__ void stage_rc(int b, int& R, int& C) { const int st = b / 1024, sb = b % 1024, swz = sb ^ (((sb >> 9) & 1) << 5); R = (st >> 1) * 16 + swz / 64; C = (st & 1) * 32 + (swz % 64) / 2; }
__host__ __device__ __forceinline__ int perm32(int rho) { const int n = rho >> 4, i = rho & 15; return 8 * (i >> 2) + 4 * n + (i & 3); }

struct Unit { int pm, pn; };
struct Gemm { const bf16_t* A; const bf16_t* Bt; int M, N, K; };

struct StaticOrder {
    int nM, nN, nwg, G, c;
    __host__ __device__ void init(int M, int N, int G_, int c_) { nM = M / BM; nN = N / BM; nwg = nM * nN; G = G_; c = c_; }
    __host__ __device__ bool next(int i, Unit& u) const {
        const long L = (long)i * G + c; if (L >= nwg) return false;
        int wgid = (int)L; { const int q = nwg / NXCD, r = nwg % NXCD, xcd = wgid % NXCD, off = wgid / NXCD; wgid = (xcd < r ? xcd * (q + 1) : r * (q + 1) + (xcd - r) * q) + off; }
        const int nig = WGM * nN, gid = wgid / nig, fm = gid * WGM, gsz = (nM - fm) < WGM ? (nM - fm) : WGM;
        u.pm = fm + ((wgid % nig) % gsz); u.pn = (wgid % nig) / gsz; return true;
    }
    __device__ __forceinline__ void a_ready(const Unit&) const {}
    __device__ __forceinline__ void done(const Unit&) const {}
};

template <class Epi, class Sched, bool ALIGN_EPI = false, bool SP2 = false>
__device__ __forceinline__ void gemm_phase(PG8_LAS unsigned char* lds, const Gemm g, const Sched& S, const Epi& E) {
    const int tid = threadIdx.x, wid = __builtin_amdgcn_readfirstlane(tid >> 6), lane = tid & 63, wr = wid >> 2, wc = wid & 3, fr = lane & 15, fq = lane >> 4;
    const int K = g.K, nt = K / BK;
    unsigned voffA[2], voffB[2];
#pragma unroll
    for (int i = 0; i < 2; ++i) { int R, C; stage_rc(tid * 16 + i * 8192, R, C); const int Rb = Epi::PERM ? ((R & ~31) + perm32(R & 31)) : R;
        voffA[i] = (unsigned)(R * K + C) * 2u; voffB[i] = (unsigned)(Rb * K + C) * 2u; }
    const size_t kstep = (size_t)(BK * 2);
    const size_t hstep = (size_t)HALF * K * 2;
    const size_t tstep = 2 * hstep;
    const unsigned ldsw = (unsigned)wid * 1024u;
    const int aoff = lds_byte(wr * 64 + fr, fq * 8), boff = lds_byte(wc * 32 + fr, fq * 8);
#define PG8_SA(b, h) (((b) * 2 + (h)) * HTB)
#define PG8_SB(b, h) ((4 + (b) * 2 + (h)) * HTB)
#define PG8_STAGE(bufoff, gbase, voff) do { _Pragma("unroll") for (int _i = 0; _i < 2; ++_i) \
        __builtin_amdgcn_global_load_lds((const unsigned*)((const char*)(gbase) + (voff)[_i]), (PG8_LAS unsigned*)(lds + (bufoff) + ldsw + _i * 8192), 16, 0, 0); } while (0)
#define PG8_LDA(dst, b, h) do { _Pragma("unroll") for (int m = 0; m < 4; ++m) _Pragma("unroll") for (int k = 0; k < 2; ++k) dst[m][k] = *(const PG8_LAS bf16x8*)(lds + PG8_SA(b, h) + aoff + m * 2048 + k * 1024); } while (0)
#define PG8_LDB(dst, b, h) do { _Pragma("unroll") for (int n = 0; n < 2; ++n) _Pragma("unroll") for (int k = 0; k < 2; ++k) dst[n][k] = *(const PG8_LAS bf16x8*)(lds + PG8_SB(b, h) + boff + n * 2048 + k * 1024); } while (0)
#define PG8_MMA(ai, bj, At, Bt) do { __builtin_amdgcn_s_setprio(1); _Pragma("unroll") for (int m = 0; m < 4; ++m) _Pragma("unroll") for (int n = 0; n < 2; ++n) _Pragma("unroll") for (int k = 0; k < 2; ++k) \
        acc[ai][bj][m][n] = __builtin_amdgcn_mfma_f32_16x16x32_bf16(Bt[n][k], At[m][k], acc[ai][bj][m][n], 0, 0, 0); __builtin_amdgcn_s_setprio(0); } while (0)
#define PG8_WAIT_V(n) asm volatile("s_waitcnt vmcnt(" #n ")" ::: "memory")
#define PG8_WAIT_L(n) asm volatile("s_waitcnt lgkmcnt(" #n ")" ::: "memory")
#define PG8_BAR __builtin_amdgcn_s_barrier()
#define PG8_SCHED __builtin_amdgcn_sched_barrier(0)
    Unit cur, nxt; int ui = 0;
    if (!S.next(0, cur)) return;
    f32x4 acc[2][2][4][2];
#pragma unroll
    for (int a = 0; a < 2; ++a)
#pragma unroll
        for (int b = 0; b < 2; ++b)
#pragma unroll
            for (int m = 0; m < 4; ++m)
#pragma unroll
                for (int n = 0; n < 2; ++n) acc[a][b][m][n] = (f32x4){0.f, 0.f, 0.f, 0.f};
    bf16x8 At[4][2], B0[2][2], B1[2][2];
    const char* cA = (const char*)g.A + (size_t)cur.pm * tstep; const char* cB = (const char*)g.Bt + (size_t)cur.pn * tstep;
    S.a_ready(cur);
    if constexpr (SP2) {
        PG8_STAGE(PG8_SB(0, 0), cB, voffB); PG8_STAGE(PG8_SB(0, 1), cB + hstep, voffB); PG8_STAGE(PG8_SA(0, 0), cA, voffA); PG8_STAGE(PG8_SA(0, 1), cA + hstep, voffA);
        if (wr == 1) PG8_BAR;
        PG8_WAIT_V(2); PG8_BAR;
        PG8_STAGE(PG8_SB(1, 0), cB + kstep, voffB); PG8_STAGE(PG8_SA(1, 0), cA + kstep, voffA); PG8_STAGE(PG8_SB(1, 1), cB + hstep + kstep, voffB);
        PG8_WAIT_V(6); PG8_BAR;
    } else {
        PG8_STAGE(PG8_SB(0, 0), cB, voffB); PG8_STAGE(PG8_SA(0, 0), cA, voffA); PG8_STAGE(PG8_SB(0, 1), cB + hstep, voffB); PG8_STAGE(PG8_SA(0, 1), cA + hstep, voffA);
        if (wr == 1) PG8_BAR;
        PG8_WAIT_V(4); PG8_BAR;
        PG8_STAGE(PG8_SB(1, 0), cB + kstep, voffB); PG8_STAGE(PG8_SA(1, 0), cA + kstep, voffA); PG8_STAGE(PG8_SB(1, 1), cB + hstep + kstep, voffB);
        PG8_WAIT_V(6); PG8_BAR;
    }
    for (;;) {
        const bool has_next = S.next(ui + 1, nxt);
        const char* nA = has_next ? (const char*)g.A + (size_t)nxt.pm * tstep : cA; const char* nB = has_next ? (const char*)g.Bt + (size_t)nxt.pn * tstep : cB;
        for (int t = 0; t < nt; t += 2) {
            const bool last = (t == nt - 2);
            if constexpr (Epi::HAS_MID) { if (t == (nt >> 1)) E.mid(acc, cur, wr, wc, fr, fq); }
            const char* a1 = cA + (size_t)(t + 1) * kstep;
            const char* a2 = last ? nA : cA + (size_t)(t + 2) * kstep; const char* b2 = last ? nB : cB + (size_t)(t + 2) * kstep;
            const char* a3 = a2 + kstep; const char* b3 = b2 + kstep;
            if (last && has_next) S.a_ready(nxt);
            if constexpr (SP2) {
            PG8_LDB(B0, 0, 0); PG8_LDB(B1, 0, 1); PG8_SCHED; PG8_LDA(At, 0, 0); PG8_STAGE(PG8_SA(1, 1), a1 + hstep, voffA);
            PG8_WAIT_V(8); PG8_WAIT_L(0); PG8_BAR; PG8_MMA(0, 0, At, B0); PG8_MMA(0, 1, At, B1); PG8_BAR; PG8_SCHED;
            PG8_LDA(At, 0, 1); PG8_STAGE(PG8_SB(0, 0), b2, voffB); PG8_STAGE(PG8_SB(0, 1), b2 + hstep, voffB); PG8_STAGE(PG8_SA(0, 0), a2, voffA);
            PG8_WAIT_V(8); PG8_WAIT_L(0); PG8_BAR; PG8_MMA(1, 0, At, B0); PG8_MMA(1, 1, At, B1); PG8_BAR; PG8_SCHED;
            PG8_LDB(B0, 1, 0); PG8_LDB(B1, 1, 1); PG8_SCHED; PG8_LDA(At, 1, 0); PG8_STAGE(PG8_SA(0, 1), a2 + hstep, voffA);
            PG8_WAIT_V(8); PG8_WAIT_L(0); PG8_BAR; PG8_MMA(0, 0, At, B0); PG8_MMA(0, 1, At, B1); PG8_BAR; PG8_SCHED;
            PG8_LDA(At, 1, 1); PG8_STAGE(PG8_SB(1, 0), b3, voffB); PG8_STAGE(PG8_SB(1, 1), b3 + hstep, voffB); PG8_STAGE(PG8_SA(1, 0), a3, voffA);
            PG8_WAIT_V(8); PG8_WAIT_L(0); PG8_BAR; PG8_MMA(1, 0, At, B0); PG8_MMA(1, 1, At, B1); PG8_BAR; PG8_SCHED;
            } else {
            PG8_LDB(B0, 0, 0); PG8_SCHED; PG8_LDA(At, 0, 0); PG8_STAGE(PG8_SA(1, 1), a1 + hstep, voffA);
            PG8_WAIT_L(8); PG8_BAR; PG8_WAIT_L(0); PG8_MMA(0, 0, At, B0); PG8_BAR; PG8_SCHED;
            PG8_LDB(B1, 0, 1); PG8_STAGE(PG8_SB(0, 0), b2, voffB);
            PG8_BAR; PG8_WAIT_L(0); PG8_MMA(0, 1, At, B1); PG8_BAR;
            PG8_LDA(At, 0, 1); PG8_STAGE(PG8_SA(0, 0), a2, voffA);
            PG8_BAR; PG8_WAIT_L(0); PG8_MMA(1, 0, At, B0); PG8_BAR; PG8_SCHED;
            PG8_STAGE(PG8_SB(0, 1), b2 + hstep, voffB);
            PG8_WAIT_V(6); PG8_BAR; PG8_MMA(1, 1, At, B1); PG8_BAR;
            PG8_LDB(B0, 1, 0); PG8_SCHED; PG8_LDA(At, 1, 0); PG8_STAGE(PG8_SA(0, 1), a2 + hstep, voffA);
            PG8_WAIT_L(8); PG8_BAR; PG8_WAIT_L(0); PG8_MMA(0, 0, At, B0); PG8_BAR; PG8_SCHED;
            PG8_LDB(B1, 1, 1); PG8_STAGE(PG8_SB(1, 0), b3, voffB);
            PG8_BAR; PG8_WAIT_L(0); PG8_MMA(0, 1, At, B1); PG8_BAR;
            PG8_LDA(At, 1, 1); PG8_STAGE(PG8_SA(1, 0), a3, voffA);
            PG8_BAR; PG8_WAIT_L(0); PG8_MMA(1, 0, At, B0); PG8_BAR; PG8_SCHED;
            PG8_STAGE(PG8_SB(1, 1), b3 + hstep, voffB);
            PG8_WAIT_V(6); PG8_BAR; PG8_MMA(1, 1, At, B1); PG8_BAR;
            }
        }
        if constexpr (ALIGN_EPI) { if (wr == 0) PG8_BAR; }
        if constexpr (!Epi::AFTER_DRAIN) { E(acc, cur, wr, wc, fr, fq); S.done(cur); }
        if (!has_next) break;
#pragma unroll
        for (int a = 0; a < 2; ++a)
#pragma unroll
            for (int b = 0; b < 2; ++b)
#pragma unroll
                for (int m = 0; m < 4; ++m)
#pragma unroll
                    for (int n = 0; n < 2; ++n) acc[a][b][m][n] = (f32x4){0.f, 0.f, 0.f, 0.f};
        cur = nxt; cA = nA; cB = nB; ++ui;
        if constexpr (ALIGN_EPI) { if (wr == 1) PG8_BAR; }
    }
    PG8_WAIT_V(0);
    if constexpr (!ALIGN_EPI) { if (wr == 0) PG8_BAR; }
    PG8_BAR;
    if constexpr (Epi::AFTER_DRAIN) { E.fused(acc, cur, wr, wc, fr, fq, lds, wid, lane); S.done(cur); }
#undef PG8_SA
#undef PG8_SB
#undef PG8_STAGE
#undef PG8_LDA
#undef PG8_LDB
#undef PG8_MMA
#undef PG8_WAIT_V
#undef PG8_WAIT_L
#undef PG8_BAR
#undef PG8_SCHED
}
}

template <int EPI> struct EpiAd {
  static constexpr bool PERM = true, AFTER_DRAIN = false, HAS_MID = false;
  EP e;
  __device__ __forceinline__ void operator()(const pg8::f32x4 (&acc)[2][2][4][2], const pg8::Unit& u, int wr, int wc, int fr, int fq) const {
#pragma unroll
    for (int ai = 0; ai < 2; ++ai)
#pragma unroll
      for (int m = 0; m < 4; ++m)
#pragma unroll
        for (int bj = 0; bj < 2; ++bj)
          epi8<EPI>(e, u.pm * 256 + ai * 128 + wr * 64 + m * 16 + fr, u.pn * 256 + bj * 128 + wc * 32 + 8 * fq, acc[ai][bj][m][0], acc[ai][bj][m][1]);
  }
};
struct EpiMergeK {
  static constexpr bool PERM = true, AFTER_DRAIN = false, HAS_MID = true;
  unsigned char* ws;
  __device__ __forceinline__ void mid(pg8::f32x4 (&acc)[2][2][4][2], const pg8::Unit& u, int wr, int wc, int fr, int fq) const {
    const bf16_t* bg = (const bf16_t*)(ws + WS_BG);
#pragma unroll
    for (int ai = 0; ai < 2; ++ai)
#pragma unroll
      for (int m = 0; m < 4; ++m)
#pragma unroll
        for (int bj = 0; bj < 2; ++bj) {
          const int row = u.pm * 256 + ai * 128 + wr * 64 + m * 16 + fr, col = u.pn * 256 + bj * 128 + wc * 32 + 8 * fq;
          float g0[8], g1[8]; unpk8(*(const u32x4*)(bg + (size_t)row * 2048 + col), g0); unpk8(*(const u32x4*)(bg + (size_t)row * 2048 + 1024 + col), g1);
#pragma unroll
          for (int i = 0; i < 4; ++i) { acc[ai][bj][m][0][i] *= g0[i] * __builtin_amdgcn_rcpf(fmaxf(g1[i], 8.673617379884035e-19f));
                                        acc[ai][bj][m][1][i] *= g0[4 + i] * __builtin_amdgcn_rcpf(fmaxf(g1[4 + i], 8.673617379884035e-19f)); }
        }
  }
  __device__ __forceinline__ void operator()(const pg8::f32x4 (&acc)[2][2][4][2], const pg8::Unit& u, int wr, int wc, int fr, int fq) const {
    const bf16_t* bg = (const bf16_t*)(ws + WS_BG); bf16_t* mg = (bf16_t*)(ws + WS_MG);
#pragma unroll
    for (int ai = 0; ai < 2; ++ai)
#pragma unroll
      for (int m = 0; m < 4; ++m)
#pragma unroll
        for (int bj = 0; bj < 2; ++bj) {
          const int row = u.pm * 256 + ai * 128 + wr * 64 + m * 16 + fr, col = u.pn * 256 + bj * 128 + wc * 32 + 8 * fq;
          float g1[8], r[8]; unpk8(*(const u32x4*)(bg + (size_t)row * 2048 + 1024 + col), g1);
#pragma unroll
          for (int i = 0; i < 4; ++i) { r[i] = acc[ai][bj][m][0][i] * fmaxf(g1[i], 8.673617379884035e-19f); r[4 + i] = acc[ai][bj][m][1][i] * fmaxf(g1[4 + i], 8.673617379884035e-19f); }
          u32x4 w; w.x = pk2(r[0], r[1]); w.y = pk2(r[2], r[3]); w.z = pk2(r[4], r[5]); w.w = pk2(r[6], r[7]); *(u32x4*)(mg + (size_t)row * 1024 + col) = w;
        }
  }
};
__device__ __forceinline__ void ph_gemm_merge(unsigned char* lds, unsigned char* ws) {
  pg8::Gemm g{(const bf16_t*)(ws + WS_YA), (const bf16_t*)(ws + WS_WA), T, 1024, 1024}; pg8::StaticOrder S; S.init(T, 1024, (int)gridDim.x, (int)blockIdx.x);
  EpiMergeK E{ws};
  pg8::gemm_phase<EpiMergeK, pg8::StaticOrder, true, true>((PG8_LAS unsigned char*)lds, g, S, E);
}
template <int EPI> __device__ __forceinline__ void ph_gemm8(unsigned char* lds, const bf16_t* A, const bf16_t* Bt, int N, int K, const EP& e) {
  pg8::Gemm g{A, Bt, T, N, K}; pg8::StaticOrder S; S.init(T, N, (int)gridDim.x, (int)blockIdx.x);
  EpiAd<EPI> E{e};
  pg8::gemm_phase<EpiAd<EPI>, pg8::StaticOrder, true, true>((PG8_LAS unsigned char*)lds, g, S, E);
}

__device__ __forceinline__ float log_sigmoid(float f) { return fminf(f, 0.f) - log1pf(expf(-fabsf(f))); }
constexpr size_t WS_GP_P = 3 * MB, WS_GP_M = 3 * MB + 512 * 1024, WS_GP_B = 4 * MB, WS_GP_MC = 4 * MB + 512 * 1024, WS_GP_AC = 4 * MB + 520 * 1024;
constexpr size_t WS_NU = 5 * MB;
constexpr int RS = 136, TS = 72;
__device__ __forceinline__ void gp_scan(int scan, const float* __restrict__ gpre, unsigned char* ws, unsigned char* lds) {
  const int lane = threadIdx.x & 63, wave = threadIdx.x >> 6, dir = scan >> 3, b = (scan >> 2) & 1, h = scan & 3;
  float* P = (float*)(ws + WS_GP_P) + (size_t)scan * SEQ; float* Rp = (float*)(ws + WS_GP_M) + (size_t)scan * SEQ; float* BBp = (float*)(ws + WS_GP_B) + (size_t)scan * SEQ;
  float* mC = (float*)(ws + WS_GP_MC) + scan * 128; float* aC = (float*)(ws + WS_GP_AC) + scan * 128;
  float* LBL = (float*)lds; float* LR = LBL + 128;
  const int gi = (dir ? 8 : 0) + h, gf = (dir ? 12 : 4) + h;
  float ig[16], fg[16];
#pragma unroll
  for (int i = 0; i < 16; ++i) { const int c = wave * 16 + i, j = dir ? 127 - c : c, s = 64 * j + (dir ? 63 - lane : lane); const size_t t = (size_t)b * SEQ + s;
    ig[i] = gpre[t * 16 + gi]; fg[i] = gpre[t * 16 + gf]; }
#pragma unroll
  for (int i = 0; i < 16; ++i) { const int c = wave * 16 + i, j = dir ? 127 - c : c, s = 64 * j + (dir ? 63 - lane : lane);
    float bsum = log_sigmoid(fg[i]);
#pragma unroll
    for (int o = 1; o < 64; o <<= 1) { const float v = __shfl_up(bsum, o); if (lane >= o) bsum += v; }
    const float p = ig[i] - bsum; float r = p;
#pragma unroll
    for (int o = 1; o < 64; o <<= 1) { const float v = __shfl_up(r, o); if (lane >= o) r = fmaxf(r, v); }
    P[s] = p; Rp[s] = r; BBp[s] = bsum;
    if (lane == 63) { LBL[c] = bsum; LR[c] = r; } }
  __syncthreads();
  if (wave == 0) { float m = -1e30f;
    for (int c = 0; c < 128; ++c) { const int j = dir ? 127 - c : c; const float Ml = fmaxf(m, LR[c]);
      if (lane == 0) { mC[j] = m; aC[j] = expf(m - Ml); }
      m = LBL[c] + Ml; } }
  __syncthreads();
}
struct M1Pre { u32x4 raw[5]; u32x4 v[2]; float cwl[3]; float pv, rv, mc; };
__device__ __forceinline__ void m1_prefetch(int u, M1Pre& pr, const unsigned char* ws, const float* __restrict__ cw, const float* __restrict__ cb) {
  const int tid = threadIdx.x, lane = tid & 63, wave = __builtin_amdgcn_readfirstlane(tid >> 6);
  const int bh = u >> 7, j = u & 127, b = bh >> 2, h = bh & 3;
  const bf16_t* mq = (const bf16_t*)(ws + WS_MQ); const bf16_t* mk = (const bf16_t*)(ws + WS_MK); const bf16_t* mv = (const bf16_t*)(ws + WS_MV);
#pragma unroll
  for (int i = 0; i < 5; ++i) { const int it = tid + 512 * i; const int which = it >= 68 * 16, r = (it - which * 68 * 16) >> 4, ch = it & 15; const int s = 64 * j - 2 + r;
    pr.raw[i] = (u32x4){0u, 0u, 0u, 0u};
    if (it < 2 * 68 * 16 && s >= 0 && s < SEQ) pr.raw[i] = *(const u32x4*)((which ? mk : mq) + ((size_t)b * SEQ + s) * 512 + h * 128 + ch * 8); }
#pragma unroll
  for (int k2 = 0; k2 < 2; ++k2) pr.v[k2] = *(const u32x4*)(mv + ((size_t)b * SEQ + 64 * j + lane) * 512 + h * 128 + (wave + 8 * k2) * 8);
#pragma unroll
  for (int i3 = 0; i3 < 3; ++i3) { const int i = tid + 512 * i3; const int w = i >> 8, c = i & 255, ch = (c >> 7) * 512 + h * 128 + (c & 127); pr.cwl[i3] = w < 5 ? cw[w * 1024 + ch] : cb[ch]; }
  pr.pv = 0.f; pr.rv = 0.f; pr.mc = 0.f;
  if (tid < 128) { const int dir = tid >> 6, l = tid & 63; const int scan = dir * 8 + bh;
    pr.pv = ((const float*)(ws + WS_GP_P))[(size_t)scan * SEQ + 64 * j + l]; pr.rv = ((const float*)(ws + WS_GP_M))[(size_t)scan * SEQ + 64 * j + (dir ? 0 : 63)];
    pr.mc = ((const float*)(ws + WS_GP_MC))[scan * 128 + j]; }
}
template <bool HAS_NEXT> __device__ __forceinline__ void m1_unit(int u, int un, M1Pre& pr, unsigned char* lds, unsigned char* ws, bf16_t* UT, const float* __restrict__ cw, const float* __restrict__ cb) {
  const int tid = threadIdx.x, lane = tid & 63, wave = __builtin_amdgcn_readfirstlane(tid >> 6), fr = lane & 15, fq = lane >> 4;
  const int bh = u >> 7, j = u & 127, b = bh >> 2, h = bh & 3;
  bf16_t* RAWQ = (bf16_t*)lds; bf16_t* RAWK = RAWQ + 68 * RS; bf16_t* KWT0 = RAWK + 68 * RS; bf16_t* KWT1 = KWT0 + 128 * TS; bf16_t* VT = KWT1 + 128 * TS;
  float* WK = (float*)(VT + 144 * TS);
  float* CWL = WK + 128;
  bf16_t* qc = (bf16_t*)(ws + WS_QC); bf16_t* kc = (bf16_t*)(ws + WS_KC);
  const size_t trow0 = (size_t)b * SEQ + 64 * j;
#pragma unroll
  for (int i = 0; i < 5; ++i) { const int it = tid + 512 * i; const int which = it >= 68 * 16, r = (it - which * 68 * 16) >> 4, ch = it & 15;
    if (it < 2 * 68 * 16) *(u32x4*)((which ? RAWK : RAWQ) + r * RS + ch * 8) = pr.raw[i]; }
#pragma unroll
  for (int i3 = 0; i3 < 3; ++i3) CWL[tid + 512 * i3] = pr.cwl[i3];
  if (tid < 128) WK[tid] = expf(pr.pv - fmaxf(pr.mc, pr.rv));
#pragma unroll
  for (int k2 = 0; k2 < 2; ++k2) { const int ch = wave + 8 * k2; const u32x4 v = pr.v[k2];
#pragma unroll
    for (int i = 0; i < 4; ++i) { VT[(ch * 8 + 2 * i) * TS + lane] = (bf16_t)(v[i] & 0xffffu); VT[(ch * 8 + 2 * i + 1) * TS + lane] = (bf16_t)(v[i] >> 16); } }
  if (tid < 64) VT[128 * TS + tid] = 0x3f80;
  __syncthreads();
  if (HAS_NEXT) m1_prefetch(un, pr, ws, cw, cb);
  const float wkf = WK[lane], wkb = WK[64 + lane];
#pragma unroll
  for (int which = 0; which < 2; ++which)
#pragma unroll
    for (int k2 = 0; k2 < 2; ++k2) {
      const int ch = wave + 8 * k2; const float* cwl = CWL + which * 128 + ch * 8;
      float y[8];
      { const float4 ba = *(const float4*)(cwl + 5 * 256), bb = *(const float4*)(cwl + 5 * 256 + 4); y[0] = ba.x; y[1] = ba.y; y[2] = ba.z; y[3] = ba.w; y[4] = bb.x; y[5] = bb.y; y[6] = bb.z; y[7] = bb.w; }
#pragma unroll
      for (int w = 0; w < 5; ++w) {
        const u32x4 v = *(const u32x4*)((which ? RAWK : RAWQ) + (lane + w) * RS + ch * 8);
        const float4 wa = *(const float4*)(cwl + w * 256), wb = *(const float4*)(cwl + w * 256 + 4);
        y[0] += __uint_as_float(v[0] << 16) * wa.x; y[1] += __uint_as_float(v[0] & 0xffff0000u) * wa.y; y[2] += __uint_as_float(v[1] << 16) * wa.z; y[3] += __uint_as_float(v[1] & 0xffff0000u) * wa.w;
        y[4] += __uint_as_float(v[2] << 16) * wb.x; y[5] += __uint_as_float(v[2] & 0xffff0000u) * wb.y; y[6] += __uint_as_float(v[3] << 16) * wb.z; y[7] += __uint_as_float(v[3] & 0xffff0000u) * wb.w;
      }
#pragma unroll
      for (int i = 0; i < 8; ++i) { y[i] = y[i] * fsig(y[i]); if (which) y[i] *= 0.08838834764831845f; }
      u32x4 o; o.x = pk2(y[0], y[1]); o.y = pk2(y[2], y[3]); o.z = pk2(y[4], y[5]); o.w = pk2(y[6], y[7]);
      *(u32x4*)((which ? kc : qc) + (trow0 + lane) * 512 + h * 128 + ch * 8) = o;
      if (which) {
#pragma unroll
        for (int i = 0; i < 8; ++i) { const float kv = bf2f(f2bf(y[i])); KWT0[(ch * 8 + i) * TS + lane] = f2bf(kv * wkf); KWT1[(ch * 8 + i) * TS + lane] = f2bf(kv * wkb); }
      }
    }
  __syncthreads();
  bf16x8 xf[2][2];
#pragma unroll
  for (int dir = 0; dir < 2; ++dir)
#pragma unroll
    for (int ks = 0; ks < 2; ++ks) xf[dir][ks] = *(const bf16x8*)((dir ? KWT1 : KWT0) + (16 * wave + fr) * TS + ks * 32 + fq * 8);
#pragma unroll
  for (int et = 0; et < 9; ++et) {
    const bf16x8 y0 = *(const bf16x8*)(VT + (16 * et + fr) * TS + fq * 8), y1 = *(const bf16x8*)(VT + (16 * et + fr) * TS + 32 + fq * 8);
#pragma unroll
    for (int dir = 0; dir < 2; ++dir) {
      f32x4 acc = {0.f, 0.f, 0.f, 0.f};
      acc = __builtin_amdgcn_mfma_f32_16x16x32_bf16(xf[dir][0], y0, acc, 0, 0, 0);
      acc = __builtin_amdgcn_mfma_f32_16x16x32_bf16(xf[dir][1], y1, acc, 0, 0, 0);
      const int scan = dir * 8 + bh;
      if (et < 8) { u32x2 w; w.x = pk2(acc[0], acc[1]); w.y = pk2(acc[2], acc[3]);
        *(u32x2*)(UT + (((size_t)scan * 128 + j) * 128 + 16 * et + fr) * 128 + 16 * wave + 4 * fq) = w; }
      else if (fr == 0) *(f32x4*)((float*)(ws + WS_NU) + ((size_t)scan * 128 + j) * 128 + 16 * wave + 4 * fq) = acc;
    }
  }
  __syncthreads();
}
__device__ __forceinline__ void m2_scan(int bid, int nb, unsigned char* ws, bf16_t* UT) {
  for (int slab = bid; slab < 16 * 16; slab += nb) {
    const int scan = slab >> 4, dir = scan >> 3, el = ((slab & 15) * 512 + threadIdx.x) * 2;
    const float* aC = (const float*)(ws + WS_GP_AC) + scan * 128;
    bf16_t* base = UT + (size_t)scan * 128 * 16384 + el;
    float c0 = 0.f, c1 = 0.f;
    for (int c16 = 0; c16 < 128; c16 += 16) {
      unsigned uv[16];
#pragma unroll
      for (int i = 0; i < 16; ++i) { const int j = dir ? 127 - (c16 + i) : c16 + i; uv[i] = *(const unsigned*)(base + (size_t)j * 16384); }
#pragma unroll
      for (int i = 0; i < 16; ++i) { const int j = dir ? 127 - (c16 + i) : c16 + i; const float a = aC[j]; *(unsigned*)(base + (size_t)j * 16384) = pk2(c0, c1);
        c0 = a * c0 + __uint_as_float(uv[i] << 16); c1 = a * c1 + __uint_as_float(uv[i] & 0xffff0000u); }
    }
  }
  const int gt = bid * 512 + threadIdx.x, nthreads = nb * 512;
  for (int item = gt; item < 16 * 128; item += nthreads) {
    const int scan = item >> 7, d = item & 127, dir = scan >> 3;
    const float* aC = (const float*)(ws + WS_GP_AC) + scan * 128; float* base = (float*)(ws + WS_NU) + (size_t)scan * 128 * 128 + d;
    float n = 0.f;
    for (int c16 = 0; c16 < 128; c16 += 16) { float uv[16], av[16];
#pragma unroll
      for (int i = 0; i < 16; ++i) { const int j = dir ? 127 - (c16 + i) : c16 + i; uv[i] = base[j * 128]; av[i] = aC[j]; }
#pragma unroll
      for (int i = 0; i < 16; ++i) { const int j = dir ? 127 - (c16 + i) : c16 + i; base[j * 128] = n; n = av[i] * n + uv[i]; } }
  }
}
__device__ __forceinline__ void m3_unit(int u, unsigned char* lds, unsigned char* ws, const bf16_t* UT, const float* __restrict__ ng) {
  const int tid = threadIdx.x, lane = tid & 63, wave = __builtin_amdgcn_readfirstlane(tid >> 6), fr = lane & 15, fq = lane >> 4;
  const int bh = u >> 7, j = u & 127, b = bh >> 2, h = bh & 3, tt = wave & 3, eh = wave >> 2;
  bf16_t* QCS = (bf16_t*)lds; bf16_t* KCS = QCS + 64 * RS; bf16_t* VT = KCS + 64 * RS; bf16_t* CT0 = VT + 144 * TS; bf16_t* CT1 = CT0 + 144 * RS;
  float* GA = (float*)(CT1 + 144 * RS);
  float* ST = GA + 384;
  const bf16_t* qc = (const bf16_t*)(ws + WS_QC); const bf16_t* kc = (const bf16_t*)(ws + WS_KC); const bf16_t* mv = (const bf16_t*)(ws + WS_MV); const bf16_t* mo = (const bf16_t*)(ws + WS_MO);
  bf16_t* ym = (bf16_t*)(ws + WS_YA);
  const size_t trow0 = (size_t)b * SEQ + 64 * j;
  for (int it = tid; it < 2 * 64 * 16; it += 512) { const int which = it >> 10, r = (it >> 4) & 63, ch = it & 15;
    *(u32x4*)((which ? KCS : QCS) + r * RS + ch * 8) = *(const u32x4*)((which ? kc : qc) + (trow0 + r) * 512 + h * 128 + ch * 8); }
  for (int it = tid; it < 2 * 128 * 16; it += 512) { const int dir = it >> 11, e = (it >> 4) & 127, ch = it & 15; const int scan = dir * 8 + bh;
    *(u32x4*)((dir ? CT1 : CT0) + e * RS + ch * 8) = *(const u32x4*)(UT + (((size_t)scan * 128 + j) * 128 + e) * 128 + ch * 8); }
  if (tid < 256) { const int dir = tid >> 7, d = tid & 127; const int scan = dir * 8 + bh;
    (dir ? CT1 : CT0)[128 * RS + d] = f2bf(((const float*)(ws + WS_NU))[((size_t)scan * 128 + j) * 128 + d]); }
  if (tid < 384) { const int dir = tid / 192, k3 = (tid % 192) >> 6, l = tid & 63; const int scan = dir * 8 + bh;
    const float* src = (const float*)(ws + (k3 == 0 ? WS_GP_P : k3 == 1 ? WS_GP_M : WS_GP_B)) + (size_t)scan * SEQ;
    GA[(dir * 3 + k3) * 64 + l] = src[64 * j + l]; }
#pragma unroll
  for (int k2 = 0; k2 < 2; ++k2) { const int ch = wave + 8 * k2;
    const u32x4 v = *(const u32x4*)(mv + (trow0 + lane) * 512 + h * 128 + ch * 8);
#pragma unroll
    for (int i = 0; i < 4; ++i) { VT[(ch * 8 + 2 * i) * TS + lane] = (bf16_t)(v[i] & 0xffffu); VT[(ch * 8 + 2 * i + 1) * TS + lane] = (bf16_t)(v[i] >> 16); } }
  if (tid < 64) VT[128 * TS + tid] = 0x3f80;
  __syncthreads();
  f32x4 g[4];
  {
    bf16x8 qf[4];
#pragma unroll
    for (int ks = 0; ks < 4; ++ks) qf[ks] = *(const bf16x8*)(QCS + (16 * tt + fr) * RS + ks * 32 + fq * 8);
#pragma unroll
    for (int lt = 0; lt < 4; ++lt) { g[lt] = (f32x4){0.f, 0.f, 0.f, 0.f};
#pragma unroll
      for (int ks = 0; ks < 4; ++ks) { const bf16x8 kf = *(const bf16x8*)(KCS + (16 * lt + fr) * RS + ks * 32 + fq * 8);
        g[lt] = __builtin_amdgcn_mfma_f32_16x16x32_bf16(kf, qf[ks], g[lt], 0, 0, 0); } }
  }
  const int etl[5] = {4 * eh, 4 * eh + 1, 4 * eh + 2, 4 * eh + 3, 8};
  float hsum[4][4];
#pragma unroll
  for (int i = 0; i < 4; ++i)
#pragma unroll
    for (int r = 0; r < 4; ++r) hsum[i][r] = 0.f;
#pragma unroll
  for (int dir = 0; dir < 2; ++dir) {
    const float* Pd = GA + (dir * 3 + 0) * 64; const float* Md = GA + (dir * 3 + 1) * 64; const float* Bd = GA + (dir * 3 + 2) * 64;
    const int scan = dir * 8 + bh; const float mc = ((const float*)(ws + WS_GP_MC))[scan * 128 + j];
    const bf16_t* CT = dir ? CT1 : CT0;
    f32x4 acc[5];
#pragma unroll
    for (int i = 0; i < 5; ++i) acc[i] = (f32x4){0.f, 0.f, 0.f, 0.f};
#pragma unroll
    for (int ks = 0; ks < 4; ++ks) { const bf16x8 qf = *(const bf16x8*)(QCS + (16 * tt + fr) * RS + ks * 32 + fq * 8);
#pragma unroll
      for (int i = 0; i < 5; ++i) { const bf16x8 cf = *(const bf16x8*)(CT + (16 * etl[i] + fr) * RS + ks * 32 + fq * 8);
        acc[i] = __builtin_amdgcn_mfma_f32_16x16x32_bf16(qf, cf, acc[i], 0, 0, 0); } }
    float Mt[4], wi[4], emr[4];
#pragma unroll
    for (int r = 0; r < 4; ++r) { const int t = 16 * tt + 4 * fq + r; Mt[r] = fmaxf(mc, Md[t]); wi[r] = __expf(mc - Mt[r]); emr[r] = __expf(-(Bd[t] + Mt[r])); }
#pragma unroll
    for (int i = 0; i < 5; ++i)
#pragma unroll
      for (int r = 0; r < 4; ++r) acc[i][r] *= wi[r];
    const float Mrow = fmaxf(mc, Md[16 * tt + fr]); const int trow = 16 * tt + fr;
    bf16x8 sf[2];
#pragma unroll
    for (int ks = 0; ks < 2; ++ks) { unsigned pw[4];
#pragma unroll
      for (int hh = 0; hh < 2; ++hh) { const int lt = 2 * ks + hh; float sv[4];
#pragma unroll
        for (int r = 0; r < 4; ++r) { const int l = 16 * lt + 4 * fq + r; const bool ok = dir ? (l >= trow) : (l <= trow);
          sv[r] = ok ? g[lt][r] * __expf(Pd[l] - Mrow) : 0.f; }
        pw[2 * hh] = pk2(sv[0], sv[1]); pw[2 * hh + 1] = pk2(sv[2], sv[3]); }
      u32x4 w4 = {pw[0], pw[1], pw[2], pw[3]}; sf[ks] = *(bf16x8*)&w4; }
#pragma unroll
    for (int ks = 0; ks < 2; ++ks)
#pragma unroll
      for (int i = 0; i < 5; ++i) { const bf16_t* vr = VT + (16 * etl[i] + fr) * TS + 32 * ks + 4 * fq;
        const u32x2 lo = *(const u32x2*)vr, hi = *(const u32x2*)(vr + 16); u32x4 w4 = {lo.x, lo.y, hi.x, hi.y};
        acc[i] = __builtin_amdgcn_mfma_f32_16x16x32_bf16(sf[ks], *(bf16x8*)&w4, acc[i], 0, 0, 0); }
#pragma unroll
    for (int r = 0; r < 4; ++r) { const float den = __shfl(acc[4][r], lane & 48); const float inv = __builtin_amdgcn_rcpf(fmaxf(fabsf(den), emr[r]));
#pragma unroll
      for (int i = 0; i < 4; ++i) hsum[i][r] += acc[i][r] * inv; }
  }
#pragma unroll
  for (int r = 0; r < 4; ++r) { float s1 = 0.f, s2 = 0.f;
#pragma unroll
    for (int i = 0; i < 4; ++i) { s1 += hsum[i][r]; s2 += hsum[i][r] * hsum[i][r]; }
#pragma unroll
    for (int o = 1; o < 16; o <<= 1) { s1 += __shfl_xor(s1, o); s2 += __shfl_xor(s2, o); }
    if (fr == 0) { ST[(eh * 64 + 16 * tt + 4 * fq + r) * 2] = s1; ST[(eh * 64 + 16 * tt + 4 * fq + r) * 2 + 1] = s2; } }
  __syncthreads();
  bf16_t* YT = QCS;
#pragma unroll
  for (int r = 0; r < 4; ++r) { const int t = 16 * tt + 4 * fq + r;
    const float s1 = ST[t * 2] + ST[(64 + t) * 2], s2 = ST[t * 2 + 1] + ST[(64 + t) * 2 + 1];
    const float mu = s1 * (1.f / 128.f), var = fmaxf(s2 * (1.f / 128.f) - mu * mu, 0.f), rs = rsqrtf(var + LN_EPS);
#pragma unroll
    for (int i = 0; i < 4; ++i) { const int e = 16 * (4 * eh + i) + fr; YT[t * RS + e] = f2bf((hsum[i][r] - mu) * rs * ng[h * 128 + e]); } }
  __syncthreads();
  for (int it = tid; it < 64 * 16; it += 512) { const int r = it >> 4, ch = it & 15;
    const u32x4 yv = *(const u32x4*)(YT + r * RS + ch * 8); const u32x4 ov = *(const u32x4*)(mo + (trow0 + r) * 512 + h * 128 + ch * 8); u32x4 o;
#pragma unroll
    for (int i = 0; i < 4; ++i) o[i] = pk2(__uint_as_float(yv[i] << 16) * __uint_as_float(ov[i] << 16), __uint_as_float(yv[i] & 0xffff0000u) * __uint_as_float(ov[i] & 0xffff0000u));
    *(u32x4*)(ym + (trow0 + r) * 1024 + 512 + h * 128 + ch * 8) = o; }
  __syncthreads();
}
constexpr int LDS_BYTES = 155648;
__device__ __forceinline__ float compute_lambda(const float* __restrict__ lp, int lane) {
  const float s1 = wave_sum(lp[lane] * lp[64 + lane]), s2 = wave_sum(lp[128 + lane] * lp[192 + lane]);
  return expf(s1) - expf(s2) + LAMBDA_INIT;
}
namespace att {
using f32x16 = __attribute__((ext_vector_type(16))) float;
using s16x4 = __attribute__((ext_vector_type(4))) short;
constexpr int NW = 8, QBLK = 32, KVBLK = 64, LD = 512;
constexpr int SHM_V = KVBLK * 128 * 2, SHM_K = KVBLK * 64 * 2;
constexpr int NSL = 4;
constexpr int SHM_ATTN = NSL * SHM_V + NSL * SHM_K + NW * 64 * 4;
constexpr int ATT_QF = SHM_ATTN;
constexpr int ATT_STG = 0;
constexpr float THR = 8.f;
#define KSWZ64(row, colB) ((row) * 128 + ((colB) ^ ((((row) >> 1) & 7) << 4)))
#define SBAR() __builtin_amdgcn_sched_barrier(0)
__device__ __forceinline__ int crow(int r, int hi) { return (r & 3) + 8 * (r >> 2) + 4 * hi; }
__device__ __forceinline__ unsigned cvtpk(float lo, float hi) { unsigned r; asm volatile("v_cvt_pk_bf16_f32 %0, %1, %2" : "=v"(r) : "v"(lo), "v"(hi)); return r; }
template <bool FIRST> __device__ __forceinline__ void partialSM(f32x16& p0, f32x16& p1, float& m_reg, float& alpha) {
  constexpr float THR2 = THR * 1.4426950408889634f;
  float pmax = p0[0];
#pragma unroll
  for (int r = 1; r < 16; ++r) pmax = fmaxf(pmax, p0[r]);
#pragma unroll
  for (int r = 0; r < 16; ++r) pmax = fmaxf(pmax, p1[r]);
  { auto rr = __builtin_amdgcn_permlane32_swap(__float_as_uint(pmax), __float_as_uint(pmax), false, false);
    pmax = fmaxf(__uint_as_float(rr[0]), __uint_as_float(rr[1])); }
  if (!FIRST && __builtin_expect(__all(pmax <= THR2), 1)) { alpha = 1.f; }
  else { const float dl = FIRST ? pmax : fmaxf(pmax, 0.f); m_reg += dl; alpha = FIRST ? 1.f : __builtin_amdgcn_exp2f(-dl);
#pragma unroll
    for (int r = 0; r < 16; ++r) { p0[r] -= dl; p1[r] -= dl; } }
#pragma unroll
  for (int r = 0; r < 16; ++r) p0[r] = __builtin_amdgcn_exp2f(p0[r]);
}
__device__ __forceinline__ void finishSM(f32x16& p0, f32x16& p1, float alpha, float& l_reg, bf16x8& pa0, bf16x8& pa1, bf16x8& pa2, bf16x8& pa3) {
#pragma unroll
  for (int r = 0; r < 16; ++r) p1[r] = __builtin_amdgcn_exp2f(p1[r]);
  float ps = 0;
#pragma unroll
  for (int r = 0; r < 16; ++r) ps += p0[r];
#pragma unroll
  for (int r = 0; r < 16; ++r) ps += p1[r];
  { auto rr = __builtin_amdgcn_permlane32_swap(__float_as_uint(ps), __float_as_uint(ps), false, false);
    ps = __uint_as_float(rr[0]) + __uint_as_float(rr[1]); }
  l_reg = l_reg * alpha + ps;
#define PK4(P, BASE, OUT) do { unsigned a0 = cvtpk(P[BASE + 0], P[BASE + 1]), a1 = cvtpk(P[BASE + 2], P[BASE + 3]);   \
    unsigned b0 = cvtpk(P[BASE + 4], P[BASE + 5]), b1 = cvtpk(P[BASE + 6], P[BASE + 7]);                              \
    auto r0 = __builtin_amdgcn_permlane32_swap(a0, b0, false, false); auto r1 = __builtin_amdgcn_permlane32_swap(a1, b1, false, false); \
    u32x4 w = {r0[0], r1[0], r0[1], r1[1]}; OUT = *reinterpret_cast<bf16x8*>(&w); } while (0)
  PK4(p0, 0, pa0); PK4(p0, 8, pa1); PK4(p1, 0, pa2); PK4(p1, 8, pa3);
#undef PK4
}
__device__ __forceinline__ void qkt(f32x16& p0, f32x16& p1, const char* Ks, const char* ql, float negm, int r32, int hi) {
#pragma unroll
  for (int r = 0; r < 16; ++r) { p0[r] = negm; p1[r] = negm; }
#pragma unroll
  for (int d0 = 0; d0 < 4; ++d0) { const int cb = (d0 * 16 + hi * 8) * 2;
    const bf16x8 qf = *reinterpret_cast<const bf16x8*>(ql + d0 * 1024);
    const bf16x8 b0 = *reinterpret_cast<const bf16x8*>(Ks + KSWZ64(r32, cb));
    const bf16x8 b1 = *reinterpret_cast<const bf16x8*>(Ks + KSWZ64(32 + r32, cb));
    p0 = __builtin_amdgcn_mfma_f32_32x32x16_bf16(b0, qf, p0, 0, 0, 0);
    p1 = __builtin_amdgcn_mfma_f32_32x32x16_bf16(b1, qf, p1, 0, 0, 0); }
}
__device__ __forceinline__ int v_st(int k, int c) { const int kk = (k & ~0xC) | ((k & 4) << 1) | ((k & 8) >> 1); return ((kk >> 3) * 4 + (c >> 5)) * 512 + ((kk & 7) * 32 + (c & 31)) * 2; }
__device__ __forceinline__ int v_rd_base(int lane) { return ((lane & 3) << 3) | (((lane >> 2) & 3) << 6) | (((lane >> 4) & 1) << 5) | (((lane >> 5) & 1) << 8); }
constexpr int v_rd_off(int d0, int ks, int half) { return d0 * 512 + ks * 4096 + half * 2048; }
template <int OFF> __device__ __forceinline__ s16x4 tr_read(int vb) {
  s16x4 r; asm volatile("ds_read_b64_tr_b16 %0, %1 offset:%2" : "=&v"(r) : "v"(vb), "i"(OFF) : "memory"); return r;
}
#define PKV(L, H) (bf16x8){L[0], L[1], L[2], L[3], H[0], H[1], H[2], H[3]}
#define PV_R(X0, X1, X2, X3, D0, HF) do { X0 = tr_read<v_rd_off(D0, 2 * (HF), 0)>(vb); X1 = tr_read<v_rd_off(D0, 2 * (HF), 1)>(vb); \
    X2 = tr_read<v_rd_off(D0, 2 * (HF) + 1, 0)>(vb); X3 = tr_read<v_rd_off(D0, 2 * (HF) + 1, 1)>(vb); } while (0)
#define PV_M(X0, X1, X2, X3, D0, PA, PB) do { o[D0] = __builtin_amdgcn_mfma_f32_32x32x16_bf16(PA, PKV(X0, X1), o[D0], 0, 0, 0); \
    o[D0] = __builtin_amdgcn_mfma_f32_32x32x16_bf16(PB, PKV(X2, X3), o[D0], 0, 0, 0); } while (0)
#define PV_W(N) do { asm volatile("s_waitcnt lgkmcnt(" #N ")" ::: "memory"); SBAR(); } while (0)
__device__ __forceinline__ void pv_d0(f32x16* o, int vb, bf16x8 pa0, bf16x8 pa1, bf16x8 pa2, bf16x8 pa3) {
  s16x4 a0, a1, a2, a3, b0, b1, b2, b3;
  PV_R(a0, a1, a2, a3, 0, 0); PV_R(b0, b1, b2, b3, 0, 1);
  PV_W(4); PV_M(a0, a1, a2, a3, 0, pa0, pa1); SBAR(); PV_R(a0, a1, a2, a3, 1, 0);
  PV_W(4); PV_M(b0, b1, b2, b3, 0, pa2, pa3); SBAR(); PV_R(b0, b1, b2, b3, 1, 1);
  PV_W(4); PV_M(a0, a1, a2, a3, 1, pa0, pa1); SBAR(); PV_R(a0, a1, a2, a3, 2, 0);
  PV_W(4); PV_M(b0, b1, b2, b3, 1, pa2, pa3); SBAR(); PV_R(b0, b1, b2, b3, 2, 1);
  PV_W(4); PV_M(a0, a1, a2, a3, 2, pa0, pa1); SBAR(); PV_R(a0, a1, a2, a3, 3, 0);
  PV_W(4); PV_M(b0, b1, b2, b3, 2, pa2, pa3); SBAR(); PV_R(b0, b1, b2, b3, 3, 1);
  PV_W(4); PV_M(a0, a1, a2, a3, 3, pa0, pa1); SBAR();
  PV_W(0); PV_M(b0, b1, b2, b3, 3, pa2, pa3);
}
#undef PKV
__device__ __forceinline__ void attn_unit(int bh, int qb, const unsigned char* __restrict__ ws, int unit,
                                          float lam, const float* __restrict__ sg, char* lds) {
  const int tid = threadIdx.x, lane = tid & 63, r32 = lane & 31, hi = lane >> 5;
  const int wid = __builtin_amdgcn_readfirstlane(tid >> 6);
  const int b = bh >> 2, h = bh & 3;
  char* V_lds = lds; char* K_lds = lds + NSL * SHM_V;
  float* wsf = (float*)(lds + NSL * SHM_V + NSL * SHM_K) + wid * 64; float* li_l = wsf; float* al_l = wsf + 32;
  const unsigned row0 = (unsigned)b * SEQ; const int q0 = qb * 256;
  const unsigned char* Vh = ws + WS_V + ((size_t)row0 * LD + h * 128) * 2;
  const int sr = tid >> 4, sc = (tid & 15) * 8, vst0 = v_st(sr, sc);
  constexpr int vst1d = 8192;
  const unsigned voffV = (unsigned)(sr * LD + sc) * 2u, voffK = (unsigned)((tid >> 3) * LD + (tid & 7) * 8) * 2u;
  const int kst = KSWZ64(tid >> 3, (tid & 7) * 16);
  const int vb0 = (int)(uintptr_t)V_lds + v_rd_base(lane);
  constexpr int NT = SEQ / KVBLK;
  constexpr unsigned TILEB = KVBLK * LD * 2;
  for (int mp = 0; mp < 2; ++mp) {
    const unsigned char* Kh = ws + WS_K + ((size_t)row0 * LD + h * 128 + mp * 64) * 2;
    const __amdgpu_buffer_rsrc_t rsK = __builtin_amdgcn_make_buffer_rsrc((void*)Kh, (short)0, SEQ * LD * 2, 0x00020000);
    const __amdgpu_buffer_rsrc_t rsV = __builtin_amdgcn_make_buffer_rsrc((void*)Vh, (short)0, SEQ * LD * 2, 0x00020000);
    float m_reg = 0.f, l_reg = 0; f32x16 o[4] = {};
    char* ql = lds + ATT_QF + wid * 4096 + lane * 16;
    { const unsigned char* Qb = ws + WS_Q + ((size_t)(row0 + q0 + wid * QBLK) * LD + h * 128 + mp * 64) * 2;
      int tq = lane; asm volatile("" : "+v"(tq));
      const unsigned qoff = (unsigned)((tq & 31) * LD + (tq >> 5) * 8) * 2u;
#pragma unroll
      for (int d0 = 0; d0 < 4; ++d0) *reinterpret_cast<bf16x8*>(ql + d0 * 1024) = *reinterpret_cast<const bf16x8*>(Qb + qoff + d0 * 32); }
    struct { bf16x8 vs0, vs1, ks0; } sr_[2];
#define SLOAD(i, t) do { const unsigned so_ = (unsigned)(t) * TILEB; \
    sr_[i].vs0 = __builtin_bit_cast(bf16x8, __builtin_amdgcn_raw_buffer_load_b128(rsV, voffV, so_, 0)); \
    sr_[i].vs1 = __builtin_bit_cast(bf16x8, __builtin_amdgcn_raw_buffer_load_b128(rsV, voffV + 32 * LD * 2, so_, 0)); \
    sr_[i].ks0 = __builtin_bit_cast(bf16x8, __builtin_amdgcn_raw_buffer_load_b128(rsK, voffK, so_, 0)); } while (0)
#define SWRITE(bb, i) do { *(bf16x8*)(V_lds + (bb) * SHM_V + vst0) = sr_[i].vs0; *(bf16x8*)(V_lds + (bb) * SHM_V + vst0 + vst1d) = sr_[i].vs1; \
    *(bf16x8*)(K_lds + (bb) * SHM_K + kst) = sr_[i].ks0; } while (0)
#define SWAIT() asm volatile("s_waitcnt vmcnt(3)" ::: "memory")
#define RESC(a) do { if (__any((a) < 1.f)) { if (hi == 0) al_l[r32] = (a); asm volatile("s_waitcnt lgkmcnt(0)" ::: "memory"); \
    _Pragma("unroll") for (int d = 0; d < 4; ++d) _Pragma("unroll") for (int r = 0; r < 16; ++r) o[d][r] *= al_l[crow(r, hi)]; } } while (0)
    f32x16 pA0, pA1, pB0, pB1; float alA, alB; bf16x8 pa0, pa1, pa2, pa3;
    int s_pp = 0, s_prev = 0, s_cur = 1, s_next = 2;
#define ROT() do { s_pp = s_prev; s_prev = s_cur; s_cur = s_next; s_next = (s_next + 1) & (NSL - 1); } while (0)
    SLOAD(0, 0); asm volatile("s_waitcnt vmcnt(0)" ::: "memory"); SWRITE(0, 0); __syncthreads();
    if (wid < 4) {
      qkt(pA0, pA1, K_lds, ql, -m_reg, r32, hi); partialSM<true>(pA0, pA1, m_reg, alA);
      SLOAD(1, 1); SLOAD(0, 2);
      SWAIT(); SWRITE(1, 1); __syncthreads();
      for (int j = 1; j + 1 < NT; j += 2) {
        SBAR(); qkt(pB0, pB1, K_lds + s_cur * SHM_K, ql, -m_reg, r32, hi);
        finishSM(pA0, pA1, alA, l_reg, pa0, pa1, pa2, pa3); SBAR();
        SLOAD(1, j + 2); SBAR();
        pv_d0(o, vb0 + s_prev * SHM_V, pa0, pa1, pa2, pa3); partialSM<false>(pB0, pB1, m_reg, alB);
        SWAIT(); SWRITE(s_next, 0);
        RESC(alB); __syncthreads(); ROT();
        SBAR(); qkt(pA0, pA1, K_lds + s_cur * SHM_K, ql, -m_reg, r32, hi);
        finishSM(pB0, pB1, alB, l_reg, pa0, pa1, pa2, pa3); SBAR();
        if (j + 3 < NT) SLOAD(0, j + 3); SBAR();
        pv_d0(o, vb0 + s_prev * SHM_V, pa0, pa1, pa2, pa3); partialSM<false>(pA0, pA1, m_reg, alA);
        SWAIT(); SWRITE(s_next, 1);
        RESC(alA); __syncthreads(); ROT();
      }
      SBAR(); qkt(pB0, pB1, K_lds + s_cur * SHM_K, ql, -m_reg, r32, hi);
      finishSM(pA0, pA1, alA, l_reg, pa0, pa1, pa2, pa3); SBAR();
      pv_d0(o, vb0 + s_prev * SHM_V, pa0, pa1, pa2, pa3); partialSM<false>(pB0, pB1, m_reg, alB);
      RESC(alB);
      finishSM(pB0, pB1, alB, l_reg, pa0, pa1, pa2, pa3); SBAR();
      pv_d0(o, vb0 + s_cur * SHM_V, pa0, pa1, pa2, pa3);
    } else {
      qkt(pA0, pA1, K_lds, ql, -m_reg, r32, hi);
      SLOAD(1, 1); SLOAD(0, 2);
      SWAIT(); SWRITE(1, 1); __syncthreads();
      SBAR(); partialSM<true>(pA0, pA1, m_reg, alA);
      SBAR(); SLOAD(1, 3); SBAR();
      qkt(pB0, pB1, K_lds + s_cur * SHM_K, ql, -m_reg, r32, hi);
      finishSM(pA0, pA1, alA, l_reg, pa0, pa1, pa2, pa3); SBAR();
      SWAIT(); SWRITE(s_next, 0);
      __syncthreads(); ROT();
      for (int j = 2; j + 2 < NT; j += 2) {
        SBAR(); pv_d0(o, vb0 + s_pp * SHM_V, pa0, pa1, pa2, pa3); partialSM<false>(pB0, pB1, m_reg, alB); RESC(alB);
        SBAR(); SLOAD(0, j + 2); SBAR();
        qkt(pA0, pA1, K_lds + s_cur * SHM_K, ql, -m_reg, r32, hi);
        finishSM(pB0, pB1, alB, l_reg, pa0, pa1, pa2, pa3); SBAR();
        SWAIT(); SWRITE(s_next, 1);
        __syncthreads(); ROT();
        SBAR(); pv_d0(o, vb0 + s_pp * SHM_V, pa0, pa1, pa2, pa3); partialSM<false>(pA0, pA1, m_reg, alA); RESC(alA);
        SBAR(); SLOAD(1, j + 3); SBAR();
        qkt(pB0, pB1, K_lds + s_cur * SHM_K, ql, -m_reg, r32, hi);
        finishSM(pA0, pA1, alA, l_reg, pa0, pa1, pa2, pa3); SBAR();
        SWAIT(); SWRITE(s_next, 0);
        __syncthreads(); ROT();
      }
      SBAR(); pv_d0(o, vb0 + s_pp * SHM_V, pa0, pa1, pa2, pa3); partialSM<false>(pB0, pB1, m_reg, alB); RESC(alB);
      SBAR(); qkt(pA0, pA1, K_lds + s_cur * SHM_K, ql, -m_reg, r32, hi);
      finishSM(pB0, pB1, alB, l_reg, pa0, pa1, pa2, pa3); SBAR();
      SWAIT(); SWRITE(s_next, 1);
      __syncthreads(); ROT();
      SBAR(); pv_d0(o, vb0 + s_pp * SHM_V, pa0, pa1, pa2, pa3); partialSM<false>(pA0, pA1, m_reg, alA); RESC(alA);
      SBAR(); qkt(pB0, pB1, K_lds + s_cur * SHM_K, ql, -m_reg, r32, hi);
      finishSM(pA0, pA1, alA, l_reg, pa0, pa1, pa2, pa3); SBAR();
      pv_d0(o, vb0 + s_prev * SHM_V, pa0, pa1, pa2, pa3); partialSM<false>(pB0, pB1, m_reg, alB); RESC(alB);
      finishSM(pB0, pB1, alB, l_reg, pa0, pa1, pa2, pa3); SBAR();
      pv_d0(o, vb0 + s_cur * SHM_V, pa0, pa1, pa2, pa3);
    }
#undef ROT
    __syncthreads();
    if (hi == 0) li_l[r32] = l_reg; asm volatile("s_waitcnt lgkmcnt(0)" ::: "memory");
    float rli[16];
#pragma unroll
    for (int r = 0; r < 16; ++r) rli[r] = __builtin_amdgcn_rcpf(li_l[crow(r, hi)]);
    int t2 = tid; asm volatile("" : "+v"(t2));
    const int lane2 = t2 & 63, wid2 = __builtin_amdgcn_readfirstlane(t2 >> 6);
    f32x4* st = (f32x4*)((unsigned char*)ws + WS_O0) + ((size_t)unit * 512 + t2) * 16;
    if (mp == 0) {
#pragma unroll
      for (int d0 = 0; d0 < 4; ++d0)
#pragma unroll
        for (int r4 = 0; r4 < 4; ++r4) st[d0 * 4 + r4] = (f32x4){o[d0][4 * r4] * rli[4 * r4], o[d0][4 * r4 + 1] * rli[4 * r4 + 1], o[d0][4 * r4 + 2] * rli[4 * r4 + 2], o[d0][4 * r4 + 3] * rli[4 * r4 + 3]};
    } else {
      float ss[16];
#pragma unroll
      for (int r = 0; r < 16; ++r) ss[r] = 0.f;
#pragma unroll
      for (int d0 = 0; d0 < 4; ++d0)
#pragma unroll
        for (int r4 = 0; r4 < 4; ++r4) { const f32x4 o0 = st[d0 * 4 + r4];
#pragma unroll
          for (int i = 0; i < 4; ++i) { const int r = 4 * r4 + i; const float v = o0[i] - lam * (o[d0][r] * rli[r]); o[d0][r] = v; ss[r] += v * v; } }
#pragma unroll
      for (int r = 0; r < 16; ++r) {
#pragma unroll
        for (int of = 1; of < 32; of <<= 1) ss[r] += __shfl_xor(ss[r], of);
        ss[r] = rsqrtf(ss[r] * (1.f / 128.f) + LN_EPS) * (1.f - LAMBDA_INIT); }
      bf16_t* stg = (bf16_t*)(lds + ATT_STG + wid2 * 8704);
      const int r32b = lane2 & 31, hib = lane2 >> 5;
#pragma unroll
      for (int d0 = 0; d0 < 4; ++d0) { const float g = sg[d0 * 32 + r32b];
#pragma unroll
        for (int r = 0; r < 16; ++r) stg[crow(r, hib) * 136 + d0 * 32 + r32b] = f2bf(o[d0][r] * ss[r] * g); }
      asm volatile("s_waitcnt lgkmcnt(0)" ::: "memory");
      const int orow = lane2 >> 1, oh = lane2 & 1;
      bf16_t* yw = (bf16_t*)((unsigned char*)ws + WS_YA) + ((size_t)(row0 + q0 + wid2 * QBLK + orow) * 1024 + h * 128 + oh * 64);
#pragma unroll
      for (int i = 0; i < 8; ++i) *(u32x4*)(yw + i * 8) = *(const u32x4*)(stg + orow * 136 + oh * 64 + i * 8);
    }
    __syncthreads();
#undef SLOAD
#undef SWRITE
#undef SWAIT
#undef RESC
  }
}
#undef SBAR
}
__device__ __forceinline__ void ph_ln1(int bid, int nb, float* __restrict__ x1, const float* __restrict__ g, const float* __restrict__ bb, bf16_t* __restrict__ x1b) {
  const int lane = threadIdx.x & 63;
  for (int t0 = (bid * 8 + (threadIdx.x >> 6)) * 2; t0 < T; t0 += nb * 16) {
    float4 v[2][4]; float s[2] = {0.f, 0.f};
#pragma unroll
    for (int r = 0; r < 2; ++r) { const float4* xr = (const float4*)(x1 + (size_t)(t0 + r) * DM);
#pragma unroll
      for (int j = 0; j < 4; ++j) { v[r][j] = xr[lane + 64 * j]; s[r] += (v[r][j].x + v[r][j].y) + (v[r][j].z + v[r][j].w); } }
#pragma unroll
    for (int r = 0; r < 2; ++r) {
      const float mu = wave_sum(s[r]) * (1.f / DM); float q = 0.f;
#pragma unroll
      for (int j = 0; j < 4; ++j) { v[r][j].x -= mu; v[r][j].y -= mu; v[r][j].z -= mu; v[r][j].w -= mu; q += (v[r][j].x * v[r][j].x + v[r][j].y * v[r][j].y) + (v[r][j].z * v[r][j].z + v[r][j].w * v[r][j].w); }
      const float rs = rsqrtf(wave_sum(q) * (1.f / DM) + LN_EPS);
      float4* xo = (float4*)(x1 + (size_t)(t0 + r) * DM);
#pragma unroll
      for (int j = 0; j < 4; ++j) { const float4 gg = ((const float4*)g)[lane + 64 * j], b4 = ((const float4*)bb)[lane + 64 * j];
        float4 o; o.x = v[r][j].x * rs * gg.x + b4.x; o.y = v[r][j].y * rs * gg.y + b4.y; o.z = v[r][j].z * rs * gg.z + b4.z; o.w = v[r][j].w * rs * gg.w + b4.w;
        xo[lane + 64 * j] = o; u32x2 w; w.x = pk2(o.x, o.y); w.y = pk2(o.z, o.w); *(u32x2*)(x1b + (size_t)(t0 + r) * DM + 4 * (lane + 64 * j)) = w; }
    }
  }
}

constexpr size_t WS_TU8 = 128 * MB, WS_SU = 160 * MB, WS_SV = 160 * MB + 65536;
constexpr int REC6 = 1280;
typedef float f32x2v __attribute__((ext_vector_type(2)));
__device__ __forceinline__ unsigned f2ord(float f) { const unsigned u = __float_as_uint(f); return (u & 0x80000000u) ? ~u : (u | 0x80000000u); }
__device__ __forceinline__ float ord2f(unsigned o) { const unsigned u = (o & 0x80000000u) ? (o & 0x7fffffffu) : ~o; return __uint_as_float(u); }
template <int CTRL, int RM> __device__ __forceinline__ float dppf(float s) { return __uint_as_float(__builtin_amdgcn_update_dpp(0u, __float_as_uint(s), CTRL, RM, 0xf, true)); }
__device__ __forceinline__ float readlane_f(float v, int l) { return __uint_as_float((unsigned)__builtin_amdgcn_readlane((int)__float_as_uint(v), l)); }
__device__ __forceinline__ float wave_sum63(float v) {
  v += dppf<0xB1, 0xf>(v); v += dppf<0x4E, 0xf>(v); v += dppf<0x141, 0xf>(v); v += dppf<0x140, 0xf>(v);
  v += dppf<0x142, 0xA>(v); v += dppf<0x143, 0xC>(v);
  return v;
}
__device__ __forceinline__ float gelu_erf(float v) {
  const float t = __builtin_amdgcn_rcpf(fabsf(v) * 0.2316418882f + 1.0f);
  float q = t * 0.5307027145f + (-0.7265760135f); q = q * t + 0.7107068705f; q = q * t + (-0.142248368f); q = q * t + 0.127414796f; q = q * t;
  const float m = v * (q * __builtin_amdgcn_exp2f((v * v) * (-0.72134752044f)));
  return v < 0.f ? m : v - m;
}
__device__ __forceinline__ unsigned fp6_code(float a) {
  const float m = fabsf(a);
  const float c = m < 2.f ? __builtin_rintf(m * 8.f) : (m < 4.f ? __builtin_rintf(m * 4.f) + 8.f : __builtin_rintf(m * 2.f) + 16.f);
  const unsigned code = (unsigned)fminf(c, 31.f);
  return a < 0.f ? (code | 32u) : code;
}
struct U3 { unsigned x, y, z; };
__device__ __forceinline__ U3 fp6_pack16(const float4 (&v)[4], float inv) {
  unsigned f[16];
#pragma unroll
  for (int c = 0; c < 4; ++c) { f[4 * c] = fp6_code(v[c].x * inv); f[4 * c + 1] = fp6_code(v[c].y * inv); f[4 * c + 2] = fp6_code(v[c].z * inv); f[4 * c + 3] = fp6_code(v[c].w * inv); }
  U3 o;
  o.x = f[0] | (f[1] << 6) | (f[2] << 12) | (f[3] << 18) | (f[4] << 24) | (f[5] << 30);
  o.y = (f[5] >> 2) | (f[6] << 4) | (f[7] << 10) | (f[8] << 16) | (f[9] << 22) | (f[10] << 28);
  o.z = (f[10] >> 4) | (f[11] << 2) | (f[12] << 8) | (f[13] << 14) | (f[14] << 20) | (f[15] << 26);
  return o;
}
__device__ __forceinline__ unsigned fp4_code(float a) {
  const float m = fabsf(a);
  const float c = m < 2.f ? __builtin_rintf(m * 2.f) : (m < 4.f ? __builtin_rintf(m) + 2.f : __builtin_rintf(m * 0.5f) + 4.f);
  const unsigned code = (unsigned)fminf(c, 7.f);
  return a < 0.f ? (code | 8u) : code;
}
__device__ __forceinline__ u32x2 fp4_pack16(const float4 (&v)[4], float inv) {
  u32x2 o; o.x = 0u; o.y = 0u;
#pragma unroll
  for (int c = 0; c < 4; ++c) { const unsigned h = fp4_code(v[c].x * inv) | (fp4_code(v[c].y * inv) << 4) | (fp4_code(v[c].z * inv) << 8) | (fp4_code(v[c].w * inv) << 12);
    if (c < 2) o.x |= h << (16 * c); else o.y |= h << (16 * (c - 2)); }
  return o;
}
__device__ __forceinline__ void ph_ln1_tab8(int bid, int nb, float* __restrict__ x1, const float* __restrict__ g, const float* __restrict__ bb, bf16_t* __restrict__ x1b,
                                            const float* __restrict__ pu, const float* __restrict__ pv, unsigned char* ws) {
  const int lane = threadIdx.x & 63, gw = bid * 8 + (threadIdx.x >> 6), ngw = nb * 8;
  int t0 = gw * 2, r4 = gw * 4;
  for (; t0 < T || r4 < 32768; t0 += ngw * 2, r4 += ngw * 4) {
    const bool do_ln = t0 < T, do_tb = r4 < 32768;
    float4 v[2][4], va[4][4];
    if (do_ln) {
#pragma unroll
      for (int r = 0; r < 2; ++r) { const u32x2* xr = (const u32x2*)((const bf16_t*)x1 + (size_t)(t0 + r) * DM);
#pragma unroll
        for (int j = 0; j < 4; ++j) { const u32x2 a = xr[lane + 64 * j]; v[r][j] = make_float4(__uint_as_float(a.x << 16), __uint_as_float(a.x & 0xffff0000u), __uint_as_float(a.y << 16), __uint_as_float(a.y & 0xffff0000u)); } } }
    if (do_tb) {
#pragma unroll
      for (int i = 0; i < 4; ++i) { const int r = r4 + i, which = r >> 14, row = r & 16383; const float4* src = (const float4*)((which ? pv : pu) + (size_t)row * DM) + 128 * (lane & 1) + (lane >> 1);
#pragma unroll
        for (int c = 0; c < 4; ++c) va[i][c] = src[32 * c]; } }
    if (do_ln) {
#pragma unroll
      for (int r = 0; r < 2; ++r) { float sm = 0.f;
#pragma unroll
        for (int j = 0; j < 4; ++j) sm += (v[r][j].x + v[r][j].y) + (v[r][j].z + v[r][j].w);
        const float mu = wave_sum(sm) * (1.f / DM); float q = 0.f;
#pragma unroll
        for (int j = 0; j < 4; ++j) { v[r][j].x -= mu; v[r][j].y -= mu; v[r][j].z -= mu; v[r][j].w -= mu; q += (v[r][j].x * v[r][j].x + v[r][j].y * v[r][j].y) + (v[r][j].z * v[r][j].z + v[r][j].w * v[r][j].w); }
        const float rs = rsqrtf(wave_sum(q) * (1.f / DM) + LN_EPS);
#pragma unroll
        for (int j = 0; j < 4; ++j) { const float4 gg = ((const float4*)g)[lane + 64 * j], b4 = ((const float4*)bb)[lane + 64 * j];
          float4 o; o.x = v[r][j].x * rs * gg.x + b4.x; o.y = v[r][j].y * rs * gg.y + b4.y; o.z = v[r][j].z * rs * gg.z + b4.z; o.w = v[r][j].w * rs * gg.w + b4.w;
          u32x2 w; w.x = pk2(o.x, o.y); w.y = pk2(o.z, o.w); *(u32x2*)(x1b + (size_t)(t0 + r) * DM + 4 * (lane + 64 * j)) = w; } } }
    if (do_tb) {
#pragma unroll
      for (int i = 0; i < 4; ++i) { const int r = r4 + i, which = r >> 14, row = r & 16383;
        float mx = 0.f;
#pragma unroll
        for (int c = 0; c < 4; ++c) mx = fmaxf(mx, fmaxf(fmaxf(fabsf(va[i][c].x), fabsf(va[i][c].y)), fmaxf(fabsf(va[i][c].z), fabsf(va[i][c].w))));
        mx = wave_max(mx);
        const float scale = fmaxf(mx, 1e-30f) * (which ? 1.f / 7.5f : 1.f / 6.f), inv = 1.f / scale;
        if (which == 0) *(u32x2*)(ws + WS_TU8 + (size_t)row * REC6 + 8 * lane) = fp4_pack16(va[i], inv);
        else { const U3 o = fp6_pack16(va[i], inv); unsigned char* rec = ws + WS_TU8 + (size_t)row * REC6 + 512;
          if ((lane & 1) == 0) *(U3*)(rec + 16 * (lane >> 1)) = o;
          else { *(unsigned*)(rec + 16 * (lane >> 1) + 12) = o.x; u32x2 q; q.x = o.y; q.y = o.z; *(u32x2*)(rec + 512 + 8 * (lane >> 1)) = q; } }
        if (lane == 0) ((float*)(ws + (which ? WS_SV : WS_SU)))[row] = scale; } }
  }
}
#define CE_D(a, b) do { const unsigned hi_ = (a) > (b) ? (a) : (b), lo_ = (a) > (b) ? (b) : (a); (a) = hi_; (b) = lo_; } while (0)
__device__ __forceinline__ void merge16_desc(unsigned* m) {
#pragma unroll
  for (int j = 8; j > 0; j >>= 1)
#pragma unroll
    for (int i = 0; i < 16; ++i) { const int l = i ^ j; if (l > i) CE_D(m[i], m[l]); }
}
__device__ __forceinline__ void sort16_desc(unsigned* k) {
#pragma unroll
  for (int kk = 2; kk <= 16; kk <<= 1)
#pragma unroll
    for (int j = kk >> 1; j > 0; j >>= 1)
#pragma unroll
      for (int i = 0; i < 16; ++i) { const int l = i ^ j; if (l > i) { if ((i & kk) == 0) CE_D(k[i], k[l]); else CE_D(k[l], k[i]); } }
}
__device__ __forceinline__ void top16_of_64(unsigned* k, unsigned* out) {
  sort16_desc(k); sort16_desc(k + 16); sort16_desc(k + 32); sort16_desc(k + 48);
  unsigned m1[16];
#pragma unroll
  for (int i = 0; i < 16; ++i) { out[i] = k[i] > k[31 - i] ? k[i] : k[31 - i]; m1[i] = k[32 + i] > k[63 - i] ? k[32 + i] : k[63 - i]; }
  merge16_desc(out); merge16_desc(m1);
#pragma unroll
  for (int i = 0; i < 16; ++i) out[i] = out[i] > m1[15 - i] ? out[i] : m1[15 - i];
  merge16_desc(out);
}
constexpr int pairs_before(int r, int c) { int n = 0; for (int rr = 0; rr < 16; ++rr) for (int cc = 0; cc < 16; ++cc) { if (rr == r && cc == c) return n; if ((rr + 1) * (cc + 1) <= 16) ++n; } return n; }
constexpr int PEER_TB = 32;
constexpr int PL_SK = 0, PL_LIST = 2 * 128 * 136 * 2, PL_LBUF = PEER_TB * 128 * 8, PL_IDX = PL_LIST + 2 * PL_LBUF;
__device__ __forceinline__ void peer_select_tile(int t0, int lb, unsigned char* lds, const bf16_t* __restrict__ qp) {
  using f32x16 = att::f32x16;
  int lane = threadIdx.x & 63; asm volatile("" : "+v"(lane));
  const int r32 = lane & 31, hi = lane >> 5, h = __builtin_amdgcn_readfirstlane(threadIdx.x >> 6);
  const bf16_t* SK = (const bf16_t*)(lds + PL_SK);
  unsigned top[2][16];
#pragma unroll
  for (int p = 0; p < 2; ++p) {
    f32x16 acc[4] = {};
    const bf16_t* qrow = qp + (size_t)(t0 + r32) * 2048 + h * 256 + p * 128 + hi * 8;
    bf16x8 qf[8];
#pragma unroll
    for (int ks = 0; ks < 8; ++ks) qf[ks] = *(const bf16x8*)(qrow + ks * 16);
#pragma unroll
    for (int ks = 0; ks < 8; ++ks) {
#pragma unroll
      for (int nt = 0; nt < 4; ++nt) { const bf16x8 kf = *(const bf16x8*)(SK + (p * 128 + nt * 32 + r32) * 136 + ks * 16 + hi * 8);
        acc[nt] = __builtin_amdgcn_mfma_f32_32x32x16_bf16(kf, qf[ks], acc[nt], 0, 0, 0); }
      __builtin_amdgcn_sched_barrier(0); }
    unsigned k[64];
#pragma unroll
    for (int nt = 0; nt < 4; ++nt)
#pragma unroll
      for (int r = 0; r < 16; ++r) k[nt * 16 + r] = (f2ord(acc[nt][r]) & 0xffffff80u) | (unsigned)(nt * 32 + (r & 3) + 8 * (r >> 2) + 4 * hi);
    unsigned own[16]; top16_of_64(k, own);
    unsigned X[16], Y[16];
#pragma unroll
    for (int i = 0; i < 16; ++i) { auto rr = __builtin_amdgcn_permlane32_swap(own[i], own[i], false, false); X[i] = rr[0]; Y[i] = rr[1]; }
#pragma unroll
    for (int i = 0; i < 16; ++i) top[p][i] = X[i] > Y[15 - i] ? X[i] : Y[15 - i];
    merge16_desc(top[p]);
  }
  float sa[16], sb[16];
#pragma unroll
  for (int i = 0; i < 16; ++i) { sa[i] = ord2f(top[0][i] & 0xffffff80u); sb[i] = ord2f(top[1][i] & 0xffffff80u); }
  unsigned ck[64];
#pragma unroll
  for (int i = 0; i < 64; ++i) ck[i] = 0u;
#pragma unroll
  for (int r = 0; r < 16; ++r)
#pragma unroll
    for (int c = 0; c < 16; ++c) if ((r + 1) * (c + 1) <= 16) ck[pairs_before(r, c)] = (f2ord(sa[r] + sb[c]) & 0xffffff00u) | (unsigned)(r * 16 + c);
  unsigned win[16]; top16_of_64(ck, win);
  unsigned char* slot = lds + PL_IDX + ((threadIdx.x >> 6) * 32 + r32) * 32;
  u32x4 ia, ib;
#pragma unroll
  for (int q4 = 0; q4 < 4; ++q4) { ia[q4] = (top[0][4 * q4] & 127u) | ((top[0][4 * q4 + 1] & 127u) << 8) | ((top[0][4 * q4 + 2] & 127u) << 16) | ((top[0][4 * q4 + 3] & 127u) << 24);
    ib[q4] = (top[1][4 * q4] & 127u) | ((top[1][4 * q4 + 1] & 127u) << 8) | ((top[1][4 * q4 + 2] & 127u) << 16) | ((top[1][4 * q4 + 3] & 127u) << 24); }
  *(u32x4*)slot = ia; *(u32x4*)(slot + 16) = ib;
  asm volatile("s_waitcnt lgkmcnt(0)" ::: "memory");
  const float s0 = ord2f(win[0] & 0xffffff00u);
  float ex[16], sum = 0.f; int ee[16];
#pragma unroll
  for (int j = 0; j < 16; ++j) { const unsigned pr = (win[j] >> 4) & 15u, pc = win[j] & 15u;
    ee[j] = (int)slot[pr] * 128 + (int)slot[16 + pc];
    ex[j] = __expf(ord2f(win[j] & 0xffffff00u) - s0); sum += ex[j]; }
  const float inv = 1.f / sum;
  if (hi == 0) { u32x2* L = (u32x2*)(lds + PL_LIST + lb * PL_LBUF) + r32 * 128 + h * 16;
#pragma unroll
    for (int j = 0; j < 16; ++j) L[j] = (u32x2){(unsigned)ee[j], __float_as_uint(ex[j] * inv)}; }
}
typedef unsigned u32x6 __attribute__((ext_vector_type(6)));
typedef float f32x32 __attribute__((ext_vector_type(32)));
typedef __bf16 bf16x32v __attribute__((ext_vector_type(32)));
typedef __bf16 bf16x2v __attribute__((ext_vector_type(2)));
__device__ __forceinline__ float half_sum(float v, bool hi) {
  v += dppf<0xB1, 0xf>(v); v += dppf<0x4E, 0xf>(v); v += dppf<0x141, 0xf>(v); v += dppf<0x140, 0xf>(v); v += dppf<0x142, 0xA>(v);
  const float a = readlane_f(v, 31), b = readlane_f(v, 63); return hi ? b : a;
}
__device__ __forceinline__ void peer_expert_tok2(int t0, int tl, int lb, unsigned char* lds, const unsigned char* __restrict__ ws, float* __restrict__ x1io, const float* __restrict__ g2, const float* __restrict__ b2) {
  int lane = threadIdx.x & 63; asm volatile("" : "+v"(lane));
  const int li = lane & 31; const bool hi = lane >= 32;
  const int t = t0 + tl + (hi ? 1 : 0);
  unsigned xu[16]; float y[32];
  { const bf16_t* xbr = (const bf16_t*)(ws + WS_X1B) + (size_t)t * DM + li * 4;
#pragma unroll
    for (int c = 0; c < 8; ++c) { const u32x2 a = *(const u32x2*)(xbr + 128 * c); xu[2 * c] = a.x; xu[2 * c + 1] = a.y; } }
#pragma unroll
  for (int i = 0; i < 32; ++i) y[i] = 0.f;
  const __amdgpu_buffer_rsrc_t rsT = __builtin_amdgcn_make_buffer_rsrc((void*)(ws + WS_TU8), (short)0, 16384 * REC6, 0x00020000);
  const int voP0 = li * 16, voQ0 = 512 + li * 8;
  const float* SU = (const float*)(ws + WS_SU); const float* SV = (const float*)(ws + WS_SV);
  u32x2* SORT = (u32x2*)(lds + PL_IDX) + (threadIdx.x >> 6) * 256;
#pragma unroll
  for (int hh = 0; hh < 2; ++hh) { const u32x2* Lraw = (const u32x2*)(lds + PL_LIST + lb * PL_LBUF) + (tl + hh) * 128;
    const u32x2 p0 = Lraw[2 * lane], p1 = Lraw[2 * lane + 1];
    const int b0 = (int)(p0.x >> 10), b1 = (int)(p1.x >> 10);
    int base = 0, pos0 = 0, pos1 = 0;
#pragma unroll
    for (int v = 0; v < 16; ++v) {
      const unsigned long long m0 = __ballot(b0 == v), m1 = __ballot(b1 == v);
      const int c0 = __builtin_popcountll(m0), c1 = __builtin_popcountll(m1);
      const int r0 = __builtin_amdgcn_mbcnt_hi((unsigned)(m0 >> 32), __builtin_amdgcn_mbcnt_lo((unsigned)m0, 0u));
      const int r1 = __builtin_amdgcn_mbcnt_hi((unsigned)(m1 >> 32), __builtin_amdgcn_mbcnt_lo((unsigned)m1, 0u));
      if (b0 == v) pos0 = base + r0;
      if (b1 == v) pos1 = base + c0 + r1;
      base += c0 + c1; }
    SORT[2 * pos0 + hh] = p0; SORT[2 * pos1 + hh] = p1; }
  asm volatile("s_waitcnt lgkmcnt(0)" ::: "memory");
  const u32x2* L = SORT;
  constexpr int PGS = 4, NPR = PGS / 2, NG = 256 / PGS;
#define PG_LOAD(UP, VP, VQ, EL, GL, SUv, SVv, hg) do { const u32x2 eg_ = L[(hg) * PGS + (lane & (PGS - 1))]; EL = (int)eg_.x; GL = __uint_as_float(eg_.y); SUv = SU[EL]; SVv = SV[EL]; \
    _Pragma("unroll") for (int pr = 0; pr < NPR; ++pr) { const int eb_ = (int)L[(hg) * PGS + 2 * pr + (hi ? 1 : 0)].x * REC6; \
      UP[pr] = __builtin_amdgcn_raw_buffer_load_b128(rsT, eb_ + voP0, 0, 0); \
      VP[pr] = __builtin_amdgcn_raw_buffer_load_b128(rsT, eb_ + voP0 + 512, 0, 0); VQ[pr] = __builtin_amdgcn_raw_buffer_load_b64(rsT, eb_ + voQ0 + 512, 0, 0); } } while (0)
#define PG_COMP(UP, VP, VQ, GL, SUv, SVv) do { float dd_ = 0.f; \
    _Pragma("unroll") for (int pr = 0; pr < NPR; ++pr) { \
      float d0_ = 0.f, d1_ = 0.f; \
      _Pragma("unroll") for (int w4 = 0; w4 < 4; ++w4) {     \
        d0_ = __builtin_amdgcn_fdot2_f32_bf16(__builtin_amdgcn_cvt_scalef32_pk_bf16_fp4(UP[pr][w4], 1.0f, 0), __builtin_bit_cast(bf16x2v, xu[4 * w4]), d0_, false); \
        d1_ = __builtin_amdgcn_fdot2_f32_bf16(__builtin_amdgcn_cvt_scalef32_pk_bf16_fp4(UP[pr][w4], 1.0f, 1), __builtin_bit_cast(bf16x2v, xu[4 * w4 + 1]), d1_, false); \
        d0_ = __builtin_amdgcn_fdot2_f32_bf16(__builtin_amdgcn_cvt_scalef32_pk_bf16_fp4(UP[pr][w4], 1.0f, 2), __builtin_bit_cast(bf16x2v, xu[4 * w4 + 2]), d0_, false); \
        d1_ = __builtin_amdgcn_fdot2_f32_bf16(__builtin_amdgcn_cvt_scalef32_pk_bf16_fp4(UP[pr][w4], 1.0f, 3), __builtin_bit_cast(bf16x2v, xu[4 * w4 + 3]), d1_, false); } \
      d0_ += d1_; d0_ += dppf<0xB1, 0xf>(d0_); d0_ += dppf<0x4E, 0xf>(d0_); d0_ += dppf<0x141, 0xf>(d0_); d0_ += dppf<0x140, 0xf>(d0_); d0_ += dppf<0x142, 0xA>(d0_);     \
      const float t0_ = readlane_f(d0_, 31), t1_ = readlane_f(d0_, 63); if (lane == 2 * pr) dd_ = t0_; if (lane == 2 * pr + 1) dd_ = t1_; } \
    const float av_ = dd_ * SUv; const float wl_ = GL * gelu_erf(av_) * SVv; \
    _Pragma("unroll") for (int pr = 0; pr < NPR; ++pr) { const float w0_ = readlane_f(wl_, 2 * pr), w1_ = readlane_f(wl_, 2 * pr + 1); const float w_ = hi ? w1_ : w0_; \
      const u32x6 vv_ = {VP[pr].x, VP[pr].y, VP[pr].z, VP[pr].w, VQ[pr].x, VQ[pr].y}; \
      const f32x32 vf_ = __builtin_amdgcn_cvt_scalef32_pk32_f32_fp6(vv_, 1.0f); \
      _Pragma("unroll") for (int i = 0; i < 32; ++i) y[i] = __builtin_fmaf(w_, vf_[i], y[i]); \
      __builtin_amdgcn_sched_barrier(0); } } while (0)
  {
    u32x4 upA[NPR], vpA[NPR], upB[NPR], vpB[NPR]; u32x2 vqA[NPR], vqB[NPR]; int elA, elB; float glA, glB, suA, suB, svA, svB;
    PG_LOAD(upA, vpA, vqA, elA, glA, suA, svA, 0);
    for (int hg = 0; hg < NG - 2; hg += 2) {
      PG_LOAD(upB, vpB, vqB, elB, glB, suB, svB, hg + 1);
      PG_COMP(upA, vpA, vqA, glA, suA, svA);
      PG_LOAD(upA, vpA, vqA, elA, glA, suA, svA, hg + 2);
      PG_COMP(upB, vpB, vqB, glB, suB, svB);
    }
    PG_LOAD(upB, vpB, vqB, elB, glB, suB, svB, NG - 1);
    PG_COMP(upA, vpA, vqA, glA, suA, svA);
    PG_COMP(upB, vpB, vqB, glB, suB, svB);
  }
#undef PG_LOAD
#undef PG_COMP
  float s = 0.f;
#pragma unroll
  for (int i = 0; i < 16; ++i) { y[2 * i] = ALPHA * __uint_as_float(xu[i] << 16) + y[2 * i]; y[2 * i + 1] = ALPHA * __uint_as_float(xu[i] & 0xffff0000u) + y[2 * i + 1]; s += y[2 * i] + y[2 * i + 1]; }
  const float mu = half_sum(s, hi) * (1.f / DM); float q = 0.f;
#pragma unroll
  for (int i = 0; i < 32; ++i) { y[i] -= mu; q += y[i] * y[i]; }
  const float rs = rsqrtf(half_sum(q, hi) * (1.f / DM) + LN_EPS);
  int ch0 = li * 4; asm volatile("" : "+v"(ch0));
  float* xr = x1io + (size_t)t * DM + ch0;
#pragma unroll
  for (int c = 0; c < 8; ++c) { const float4 gg = *(const float4*)(g2 + ch0 + 128 * c), bb = *(const float4*)(b2 + ch0 + 128 * c);
    float4 o; o.x = y[4 * c] * rs * gg.x + bb.x; o.y = y[4 * c + 1] * rs * gg.y + bb.y; o.z = y[4 * c + 2] * rs * gg.z + bb.z; o.w = y[4 * c + 3] * rs * gg.w + bb.w;
    *(float4*)(xr + 128 * c) = o; }
}
__device__ __forceinline__ void ph_peer(int bid, int nb, unsigned char* lds, unsigned char* ws, const float* __restrict__ subk, float* __restrict__ dout, const float* __restrict__ g2, const float* __restrict__ b2) {
  bf16_t* SK = (bf16_t*)(lds + PL_SK);
  for (int i = threadIdx.x; i < 2 * 128 * 32; i += 512) { const int row = i >> 5, c4 = i & 31; const float4 v = ((const float4*)subk)[i];
    u32x2 w; w.x = pk2(v.x, v.y); w.y = pk2(v.z, v.w); *(u32x2*)(SK + row * 136 + c4 * 4) = w; }
  __syncthreads();
  const int wave = threadIdx.x >> 6;
  const bf16_t* qp = (const bf16_t*)(ws + WS_QP);
  const bool both_first = (bid & 1) != 0;
  for (int tile = bid; tile < T / PEER_TB; tile += 2 * nb) {
    const int ta = tile * PEER_TB, tb = (tile + nb) * PEER_TB; const bool has_b = tile + nb < T / PEER_TB;
    peer_select_tile(ta, 0, lds, qp);
    if (both_first && has_b) peer_select_tile(tb, 1, lds, qp);
    __syncthreads();
    for (int i = 0; i < PEER_TB / 8; i += 2) { const int tl = wave * (PEER_TB / 8) + i; peer_expert_tok2(ta, tl, 0, lds, ws, dout, g2, b2); }
    if (has_b) {
      if (!both_first) { __syncthreads(); peer_select_tile(tb, 1, lds, qp); __syncthreads(); }
      for (int i = 0; i < PEER_TB / 8; i += 2) { const int tl = wave * (PEER_TB / 8) + i; peer_expert_tok2(tb, tl, 1, lds, ws, dout, g2, b2); }
    }
    __syncthreads();
  }
}

#define LAS __attribute__((address_space(3)))
#define XB_TMO      128
#define XB_XCNT(j)  (256  + 64 * (j))
#define XB_XSUB(j)  (1280 + 64 * (j))
#define XB_XGEN(j)  (2304 + 64 * (j))
#define XB_TOP      3328
#define XB_TOPGEN   3392
#define XCD_BAR_WORDS 3456
#define XB_SPIN_CAP (1u << 18)

__device__ __forceinline__ unsigned xb_ld(unsigned* p)              { return __hip_atomic_load(p, __ATOMIC_RELAXED, __HIP_MEMORY_SCOPE_AGENT); }
__device__ __forceinline__ unsigned xb_add(unsigned* p, unsigned v) { return __hip_atomic_fetch_add(p, v, __ATOMIC_RELAXED, __HIP_MEMORY_SCOPE_AGENT); }
__device__ __forceinline__ unsigned xb_xcc_id() { return (unsigned)__builtin_amdgcn_s_getreg((3 << 11) | 20) & 0xFu; }
#define XB_SPIN(cond, bar) do { unsigned _sp = 0; while (cond) { __builtin_amdgcn_s_sleep(1); \
    if ((++_sp & 255u) == 0u) { if (xb_ld(&(bar)[XB_TMO])) break; if (_sp > XB_SPIN_CAP) { atomicAdd(&(bar)[XB_TMO], 1u); break; } } } } while (0)

struct XcdBarrier {
    unsigned* bar; unsigned x;
    volatile LAS unsigned* st;
};

__device__ __forceinline__ XcdBarrier xcd_barrier_post(unsigned* bar, volatile LAS unsigned* st) {
    XcdBarrier b; b.bar = bar; b.x = xb_xcc_id(); b.st = st;
    if (threadIdx.x == 0) (void)xb_add(&bar[XB_XCNT(b.x)], 1u);
    return b;
}
__device__ __forceinline__ void xcd_barrier_complete(unsigned* bar, unsigned x, unsigned& nloc, unsigned& nx) {
    const unsigned G = gridDim.x * gridDim.y * gridDim.z;
    unsigned sum, cnt, mine, sp = 0u;
    for (;;) {
        sum = 0u; cnt = 0u; mine = 0u;
#pragma unroll
        for (unsigned j = 0; j < 16; ++j) { const unsigned c = xb_ld(&bar[XB_XCNT(j)]); sum += c; cnt += (c > 0u) ? 1u : 0u; mine = (j == x) ? c : mine; }
        if (sum == G) break;
        __builtin_amdgcn_s_sleep(1);
        if ((++sp & 255u) == 0u) { if (xb_ld(&bar[XB_TMO])) break; if (sp > XB_SPIN_CAP) { atomicAdd(&bar[XB_TMO], 1u); break; } }
    }
    nloc = mine > 0u ? mine : 1u; nx = cnt > 0u ? cnt : 1u;
}

__device__ __forceinline__ void xcd_barrier(const XcdBarrier& b) {
    asm volatile("s_waitcnt vmcnt(0)" ::: "memory");
    __syncthreads();
    if (threadIdx.x == 0) {
        unsigned* bar = b.bar;
        __builtin_amdgcn_s_waitcnt(0);
        unsigned nloc = b.st[0], nx = b.st[1];
        if (nloc == 0u) { xcd_barrier_complete(bar, b.x, nloc, nx); b.st[0] = nloc; b.st[1] = nx; }
        const unsigned old = xb_add(&bar[XB_XSUB(b.x)], 1u);
        const unsigned gen = old / nloc;
        if (old + 1u == (gen + 1u) * nloc) {
            __builtin_amdgcn_fence(__ATOMIC_RELEASE, "agent");
            asm volatile("s_waitcnt vmcnt(0)" ::: "memory");
            const unsigned og = xb_add(&bar[XB_TOP], 1u);
            const unsigned tg = og / nx;
            if (og + 1u == (tg + 1u) * nx) xb_add(&bar[XB_TOPGEN], 1u);
            else XB_SPIN(xb_ld(&bar[XB_TOPGEN]) == tg, bar);
            __builtin_amdgcn_fence(__ATOMIC_ACQUIRE, "agent");
            xb_add(&bar[XB_XGEN(b.x)], 1u);
            asm volatile("s_waitcnt vmcnt(0)" ::: "memory");
        } else {
            XB_SPIN(xb_ld(&bar[XB_XGEN(b.x)]) == gen, bar);
            __builtin_amdgcn_fence(__ATOMIC_ACQUIRE, "agent");
            asm volatile("s_waitcnt vmcnt(0)" ::: "memory");
        }
    }
    __syncthreads();
}

struct KP { const float* in[19]; float* out; unsigned char* ws; int ph_lo, ph_hi; };
constexpr int NPHASE = 10;
#ifndef MK_LAUNCHES
#define MK_LAUNCHES 1
#endif
__global__ __launch_bounds__(512) void mega(KP p) {
  extern __shared__ __attribute__((aligned(16))) unsigned char lds[];
  cg::grid_group grid = cg::this_grid();
  const int bid = blockIdx.x, nb = gridDim.x, lane = threadIdx.x & 63;
  unsigned char* ws = p.ws; unsigned char* dob = (unsigned char*)p.out; float* dout = p.out;
  const float* x = p.in[0]; const float* w_in = p.in[1];
  bf16_t* xb = (bf16_t*)(dob + DO_XB); bf16_t* WinT = (bf16_t*)(dob + DO_WINT); bf16_t* UT = (bf16_t*)dob;
  float* gpre = (float*)(ws + WS_GPRE); float2* cs = (float2*)(ws + WS_CS);
  EP e; e.x = x; e.ws = ws; e.dout = dout; e.cs = cs;
#ifdef ONLY_PH
#define IN(k) ((k) == ONLY_PH && p.ph_lo <= (k) && (k) < p.ph_hi)
#else
#define IN(k) (p.ph_lo <= (k) && (k) < p.ph_hi)
#endif
  volatile LAS unsigned* bst = (volatile LAS unsigned*)((LAS unsigned char*)lds + (LDS_BYTES - 64));
  if (threadIdx.x < 2) bst[threadIdx.x] = 0u;
  __syncthreads();
  const XcdBarrier xbar = xcd_barrier_post((unsigned*)ws, bst);
#define SEAM(k) do { if (IN(k) && IN((k) + 1)) xcd_barrier(xbar); } while (0)
  if (IN(0)) {
    ph_prep_x(bid, nb, lds, x, w_in, p.in[6], xb, gpre);
    ph_prep_weights(bid, nb, lds, w_in, p.in[8], p.in[9], p.in[10], p.in[13], WinT, ws);
    ph_rope_tab(bid, nb, cs);
  }
  SEAM(0);
  if (IN(1)) {
    if (bid >= nb - 16) gp_scan(bid - (nb - 16), gpre, ws, lds);
    ph_gemm8<EPI_G1>(lds, xb, WinT, 5632, 1024, e);
  }
  SEAM(1);
  if (IN(2)) { M1Pre pr; if (bid < 1024) m1_prefetch(bid, pr, ws, p.in[4], p.in[5]);
    for (int u = bid; u < 1024; u += nb) { if (u + nb < 1024) m1_unit<true>(u, u + nb, pr, lds, ws, UT, p.in[4], p.in[5]); else m1_unit<false>(u, u, pr, lds, ws, UT, p.in[4], p.in[5]); } }
  SEAM(2);
  if (IN(3)) m2_scan(bid, nb, ws, UT);
  SEAM(3);
  if (IN(4)) {
    const float lam = compute_lambda(p.in[2], lane);
    for (int u = bid; u < 256; u += nb) att::attn_unit(u & 7, u >> 3, ws, u, lam, p.in[3], (char*)lds);
    for (int u = bid; u < 1024; u += nb) m3_unit(u, lds, ws, UT, p.in[7]);
  }
  SEAM(4);
  if (IN(5)) {
    ph_gemm_merge(lds, ws);
  }
  SEAM(5);
  if (IN(6)) ph_gemm8<EPI_OUT>(lds, (const bf16_t*)(ws + WS_MG), (const bf16_t*)(ws + WS_WOUT), 1024, 1024, e);
  SEAM(6);
  if (IN(7)) {
    ph_ln1_tab8(bid, nb, dout, p.in[11], p.in[12], (bf16_t*)(ws + WS_X1B), p.in[15], p.in[16], ws);
  }
  SEAM(7);
  if (IN(8)) ph_gemm8<EPI_QP>(lds, (const bf16_t*)(ws + WS_X1B), (const bf16_t*)(ws + WS_WQ), 2048, 1024, e);
  SEAM(8);
  if (IN(9)) ph_peer(bid, nb, lds, ws, p.in[14], dout, p.in[17], p.in[18]);
  if (p.ph_hi - p.ph_lo == NPHASE) grid.sync();
#undef IN
#undef SEAM
}

extern "C" void kernel_launch(void* const* d_in, const int* in_sizes, int n_in, void* d_out, int out_size, void* d_ws, size_t ws_size, hipStream_t stream) {
  static int grid = 0;
  if (grid == 0) {
    int dev = 0, cus = 0, per_cu = 0;
    hipGetDevice(&dev); hipDeviceGetAttribute(&cus, hipDeviceAttributeMultiprocessorCount, dev);
    hipFuncSetAttribute((const void*)mega, hipFuncAttributeMaxDynamicSharedMemorySize, LDS_BYTES);
    hipOccupancyMaxActiveBlocksPerMultiprocessor(&per_cu, (const void*)mega, 512, LDS_BYTES);
    if (per_cu < 1) { fprintf(stderr, "kernel_launch: occupancy query says %d blocks per CU\n", per_cu); per_cu = 1; }
    grid = cus * 1;
  }
  hipMemsetAsync(d_ws, 0, 16384, stream);
  KP p{};
  for (int i = 0; i < 19; ++i) p.in[i] = (const float*)d_in[i];
  p.out = (float*)d_out; p.ws = (unsigned char*)d_ws;
  if (MK_LAUNCHES == 1) {
    p.ph_lo = 0; p.ph_hi = NPHASE;
    void* args[] = {&p};
    hipError_t er = hipLaunchCooperativeKernel((void*)mega, dim3(grid), dim3(512), args, LDS_BYTES, stream);
    if (er != hipSuccess) fprintf(stderr, "cooperative launch failed: %s (grid %d)\n", hipGetErrorString(er), grid);
  } else {
    for (int k = 0; k < NPHASE; ++k) { p.ph_lo = k; p.ph_hi = k + 1; hipLaunchKernelGGL(mega, dim3(grid), dim3(512), LDS_BYTES, stream, p); }
  }
}
```

```cpp
#include <hip/hip_runtime.h>
#include <hip/hip_cooperative_groups.h>
#include <cstdio>
#include <stdint.h>
#include <math.h>

namespace cg = cooperative_groups;
typedef unsigned short bf16_t;
typedef short bf16x8 __attribute__((ext_vector_type(8)));
typedef float f32x4 __attribute__((ext_vector_type(4)));
typedef unsigned u32x2 __attribute__((ext_vector_type(2)));
typedef unsigned u32x4 __attribute__((ext_vector_type(4)));

constexpr int T = 16384, SEQ = 8192, DM = 1024;
constexpr float ALPHA = 1.189207115002721f;
constexpr float LN_EPS = 1e-5f;
constexpr float LAMBDA_INIT = 0.2f;
constexpr float QSCALE = 0.125f * 1.4426950408889634f;

constexpr size_t MB = 1u << 20;
constexpr size_t WS_GPRE = 1 * MB;
constexpr size_t WS_CS = 2 * MB;
constexpr size_t WS_WA = 8 * MB;
constexpr size_t WS_WM = 9 * MB;
constexpr size_t WS_WOUT = 10 * MB;
constexpr size_t WS_WQ = 12 * MB;
constexpr size_t WS_G1 = 16 * MB;
constexpr size_t WS_Q = 16 * MB, WS_K = 32 * MB, WS_V = 48 * MB, WS_MQ = 64 * MB, WS_MK = 80 * MB, WS_MV = 96 * MB, WS_MO = 112 * MB;
constexpr size_t WS_BG = 128 * MB;
constexpr size_t WS_QC = 192 * MB, WS_KC = 208 * MB;
constexpr size_t WS_O0 = 224 * MB;
constexpr size_t WS_YA = WS_MQ, WS_YM = WS_MK;
constexpr size_t WS_MG = WS_Q;
constexpr size_t WS_X1B = WS_QC;
constexpr size_t WS_TU = 128 * MB, WS_TV = 160 * MB;
constexpr size_t WS_QP = 16 * MB;
constexpr size_t WS_EXP = 96 * MB, WS_GATE = 104 * MB;
constexpr size_t DO_XB = 0, DO_WINT = 32 * MB;

__device__ __forceinline__ float bf2f(bf16_t v) { return __uint_as_float(((unsigned)v) << 16); }
__device__ __forceinline__ bf16_t f2bf(float f) { unsigned u = __float_as_uint(f); u += 0x7fffu + ((u >> 16) & 1u); return (bf16_t)(u >> 16); }
__device__ __forceinline__ unsigned pk2(float lo, float hi) { return (unsigned)f2bf(lo) | ((unsigned)f2bf(hi) << 16); }
__device__ __forceinline__ float sigmoidf_(float x) { return 1.f / (1.f + __expf(-x)); }
__device__ __forceinline__ float wave_sum(float v) {
#pragma unroll
  for (int o = 1; o < 64; o <<= 1) v += __shfl_xor(v, o);
  return v;
}
__device__ __forceinline__ float wave_max(float v) {
#pragma unroll
  for (int o = 1; o < 64; o <<= 1) v = fmaxf(v, __shfl_xor(v, o));
  return v;
}
__device__ __forceinline__ unsigned wave_maxu(unsigned v) {
#pragma unroll
  for (int o = 1; o < 64; o <<= 1) { unsigned w = (unsigned)__shfl_xor((int)v, o); v = v > w ? v : w; }
  return v;
}

__device__ __forceinline__ void ph_prep_x(int bid, int nb, unsigned char* lds, const float* __restrict__ x, const float* __restrict__ w_in, const float* __restrict__ gate_b,
                                          bf16_t* __restrict__ xb, float* __restrict__ gpre) {
  const int lane = threadIdx.x & 63, wave = __builtin_amdgcn_readfirstlane(threadIdx.x >> 6), fr = lane & 15, fq = lane >> 4;
  bf16_t* WGb = (bf16_t*)lds;
  for (int i = threadIdx.x; i < 16 * 1024; i += 512) { const int k = i >> 4, g = i & 15; WGb[g * 1032 + k] = f2bf(w_in[(size_t)k * 5648 + 3584 + g]); }
  const int rpb = ((T / 16 + nb - 1) / nb) * 16, row0 = bid * rpb, nrow = row0 < T ? (T - row0 < rpb ? T - row0 : rpb) : 0;
  { const float4* xs = (const float4*)(x + (size_t)row0 * DM); u32x2* xd = (u32x2*)(xb + (size_t)row0 * DM);
    for (int i = threadIdx.x; i < nrow * 256; i += 512) { const float4 v = xs[i]; u32x2 w; w.x = pk2(v.x, v.y); w.y = pk2(v.z, v.w); xd[i] = w; } }
  asm volatile("s_waitcnt vmcnt(0)" ::: "memory");
  __syncthreads();
  for (int rt = wave; rt * 16 < nrow; rt += 8) {
    const bf16_t* xr = xb + (size_t)(row0 + rt * 16 + fr) * DM + 8 * fq; const bf16_t* wr = WGb + fr * 1032 + 8 * fq;
    f32x4 acc = {0.f, 0.f, 0.f, 0.f};
#pragma unroll 8
    for (int ks = 0; ks < 32; ++ks) { const bf16x8 a = *(const bf16x8*)(xr + 32 * ks), bv = *(const bf16x8*)(wr + 32 * ks);
      acc = __builtin_amdgcn_mfma_f32_16x16x32_bf16(a, bv, acc, 0, 0, 0); }
    const float gb = gate_b[fr];
#pragma unroll
    for (int r = 0; r < 4; ++r) gpre[(size_t)(row0 + rt * 16 + 4 * fq + r) * 16 + fr] = acc[r] + gb;
  }
  __syncthreads();
}
__device__ __forceinline__ int src_col(int n, int mode) {
  if (mode == 1) { if (n < 1024) { const int j = n & 63; const int pj = j < 16 ? ((j & 1) ? (j >> 1) + 8 : (j >> 1)) : j; return (n & ~63) + pj; } else if (n >= 3584) return n + 16; }
  return n;
}
__device__ __forceinline__ void transpose_item(const float* __restrict__ W, int ldw, int K, int nblk, bf16_t* __restrict__ WT, float* scr, int item, int lane, int mode, int ldo = 0) {
  if (ldo == 0) ldo = K;
  const int kb = item / nblk, nbk = item % nblk, k0 = 64 * kb, n0 = 32 * nbk;
  const int sc = src_col(n0 + (lane & 31), mode);
#pragma unroll 8
  for (int i = 0; i < 32; ++i) { const int kk = 2 * i + (lane >> 5); scr[kk * 33 + (lane & 31)] = W[(size_t)(k0 + kk) * ldw + sc]; }
  asm volatile("s_waitcnt lgkmcnt(0)" ::: "memory");
  const int c = lane & 7;
#pragma unroll
  for (int j = 0; j < 4; ++j) { const int n = (lane >> 3) + 8 * j; const float* s = scr + (8 * c) * 33 + n;
    u32x4 o; o.x = pk2(s[0 * 33], s[1 * 33]); o.y = pk2(s[2 * 33], s[3 * 33]); o.z = pk2(s[4 * 33], s[5 * 33]); o.w = pk2(s[6 * 33], s[7 * 33]);
    *(u32x4*)(WT + (size_t)(n0 + n) * ldo + k0 + 8 * c) = o; }
  asm volatile("s_waitcnt lgkmcnt(0)" ::: "memory");
}
__device__ __forceinline__ void ph_prep_weights(int bid, int nb, unsigned char* lds, const float* w_in, const float* w_ba, const float* w_bm, const float* w_out, const float* w_q,
                                                bf16_t* WinT, unsigned char* ws) {
  const int lane = threadIdx.x & 63, wave = threadIdx.x >> 6;
  float* scr = (float*)(lds + 65536 + wave * 8448);
  constexpr int I_IN = 16 * 176, I_BA = 8 * 32, I_OUT = 16 * 32, I_Q = 16 * 64, NIT = I_IN + 2 * I_BA + I_OUT + I_Q;
  for (int it = bid * 8 + wave; it < NIT; it += nb * 8) {
    int r = it;
    if (r < I_IN) { transpose_item(w_in, 5648, 1024, 176, WinT, scr, r, lane, 1); continue; } r -= I_IN;
    if (r < I_BA) { transpose_item(w_ba, 1024, 512, 32, (bf16_t*)(ws + WS_WA), scr, r, lane, 0, 1024); continue; } r -= I_BA;
    if (r < I_BA) { transpose_item(w_bm, 1024, 512, 32, (bf16_t*)(ws + WS_WA) + 512, scr, r, lane, 0, 1024); continue; } r -= I_BA;
    if (r < I_OUT) { transpose_item(w_out, 1024, 1024, 32, (bf16_t*)(ws + WS_WOUT), scr, r, lane, 0); continue; } r -= I_OUT;
    transpose_item(w_q, 2048, 1024, 64, (bf16_t*)(ws + WS_WQ), scr, r, lane, 0);
  }
}
__device__ __forceinline__ void ph_cvt(int bid, int nb, const float* __restrict__ in, bf16_t* __restrict__ out, size_t n4) {
  for (size_t i = (size_t)bid * 512 + threadIdx.x; i < n4; i += (size_t)nb * 512) {
    const float4 v = ((const float4*)in)[i]; u32x2 w; w.x = pk2(v.x, v.y); w.y = pk2(v.z, v.w); ((u32x2*)out)[i] = w; }
}
__device__ __forceinline__ void ph_rope_tab(int bid, int nb, float2* __restrict__ cs) {
  for (int idx = bid * 512 + threadIdx.x; idx < 8192 * 8; idx += nb * 512) {
    const int s = idx >> 3, i = idx & 7;
    const double inv = i == 0 ? 1.0 : i == 1 ? 0.19392274474868576 : i == 2 ? 0.03760603093086393 : i == 3 ? 0.007292664737217109 : i == 4 ? 0.001414213562373095 : i == 5 ? 0.0002742481756762073
                     : i == 6 ? 5.318295896944988e-05 : 1.031338537721246e-05;
    const double ang = (double)s * inv, k = __builtin_rint(ang * 0.15915494309189535);
    const float r = (float)(__builtin_fma(-k, 6.283185307179586, ang) - k * 2.4492935982947064e-16);
    cs[idx] = make_float2(cosf(r), sinf(r));
  }
}

struct EP { const float* x; unsigned char* ws; float* dout; const float2* cs; };
enum { EPI_G1 = 0, EPI_M1 = 1, EPI_M2 = 2, EPI_OUT = 3, EPI_QP = 4 };
template <int EPI> __device__ __forceinline__ void epi4(const EP& e, int row, int col, f32x4 v) {
  if (EPI == EPI_G1) {
    if (col < 1024) {
      if ((col & 63) < 16) { const int s = row & (SEQ - 1), i0 = (col & 15) >> 1; const float2 c0 = e.cs[s * 8 + i0], c1 = e.cs[s * 8 + i0 + 1];
        const float a0 = v[0] * c0.x - v[1] * c0.y, b0 = v[1] * c0.x + v[0] * c0.y, a1 = v[2] * c1.x - v[3] * c1.y, b1 = v[3] * c1.x + v[2] * c1.y;
        v[0] = a0; v[1] = b0; v[2] = a1; v[3] = b1; }
      if (col < 512) v = v * QSCALE;
    } else if (col >= 3072) { v[0] = sigmoidf_(v[0]); v[1] = sigmoidf_(v[1]); v[2] = sigmoidf_(v[2]); v[3] = sigmoidf_(v[3]); }
    bf16_t* dst = col < 3584 ? (bf16_t*)(e.ws + WS_G1) + (size_t)(col >> 9) * ((size_t)T * 512) + (size_t)row * 512 + (col & 511)
                             : (bf16_t*)(e.ws + WS_BG) + (size_t)row * 2048 + (col - 3584);
    u32x2 w; w.x = pk2(v[0], v[1]); w.y = pk2(v[2], v[3]); *(u32x2*)dst = w;
  } else if (EPI == EPI_M1 || EPI == EPI_M2) {
    const bf16_t* g = (const bf16_t*)(e.ws + WS_BG) + (size_t)row * 2048 + (EPI == EPI_M2 ? 1024 : 0) + col;
    const u32x2 gw = *(const u32x2*)g;
    bf16_t* dst = (bf16_t*)(e.ws + WS_MG) + (size_t)row * 1024 + col;
    float r0 = v[0] * __uint_as_float(gw.x << 16), r1 = v[1] * __uint_as_float(gw.x & 0xffff0000u), r2 = v[2] * __uint_as_float(gw.y << 16), r3 = v[3] * __uint_as_float(gw.y & 0xffff0000u);
    if (EPI == EPI_M2) { const u32x2 pw = *(const u32x2*)dst; r0 += __uint_as_float(pw.x << 16); r1 += __uint_as_float(pw.x & 0xffff0000u); r2 += __uint_as_float(pw.y << 16); r3 += __uint_as_float(pw.y & 0xffff0000u); }
    u32x2 w; w.x = pk2(r0, r1); w.y = pk2(r2, r3); *(u32x2*)dst = w;
  } else if (EPI == EPI_OUT) {
    const f32x4 xv = *(const f32x4*)(e.x + (size_t)row * DM + col);
    *(f32x4*)(e.dout + (size_t)row * DM + col) = xv * ALPHA + v;
  } else if (EPI == EPI_QP) {
    u32x2 w; w.x = pk2(v[0], v[1]); w.y = pk2(v[2], v[3]); *(u32x2*)((bf16_t*)(e.ws + WS_QP) + (size_t)row * 2048 + col) = w;
  }
}
__device__ __forceinline__ float fsig(float x) { return __builtin_amdgcn_rcpf(1.f + __builtin_amdgcn_exp2f(-1.4426950408889634f * x)); }
__device__ __forceinline__ void rope4(const float2* __restrict__ cs, int s, int i0, f32x4& v) {
  const float2 c0 = cs[s * 8 + i0], c1 = cs[s * 8 + i0 + 1];
  const float a0 = v[0] * c0.x - v[1] * c0.y, b0 = v[1] * c0.x + v[0] * c0.y, a1 = v[2] * c1.x - v[3] * c1.y, b1 = v[3] * c1.x + v[2] * c1.y;
  v[0] = a0; v[1] = b0; v[2] = a1; v[3] = b1;
}
__device__ __forceinline__ void unpk8(const u32x4 w, float* f) {
#pragma unroll
  for (int i = 0; i < 4; ++i) { f[2 * i] = __uint_as_float(w[i] << 16); f[2 * i + 1] = __uint_as_float(w[i] & 0xffff0000u); }
}
template <int EPI> __device__ __forceinline__ void epi8(const EP& e, int row, int col, f32x4 v0, f32x4 v1) {
  if (EPI == EPI_G1) {
    if (col < 1024) {
      if ((col & 63) < 16) { const int s = row & (SEQ - 1), i0 = (col & 15) >> 1; rope4(e.cs, s, i0, v0); rope4(e.cs, s, i0 + 2, v1); }
      if (col < 512) { v0 = v0 * QSCALE; v1 = v1 * QSCALE; }
    } else if (col >= 3072) {
#pragma unroll
      for (int i = 0; i < 4; ++i) { v0[i] = fsig(v0[i]); v1[i] = fsig(v1[i]); }
    }
    bf16_t* dst = col < 3584 ? (bf16_t*)(e.ws + WS_G1) + (size_t)(col >> 9) * ((size_t)T * 512) + (size_t)row * 512 + (col & 511)
                             : (bf16_t*)(e.ws + WS_BG) + (size_t)row * 2048 + (col - 3584);
    u32x4 w; w.x = pk2(v0[0], v0[1]); w.y = pk2(v0[2], v0[3]); w.z = pk2(v1[0], v1[1]); w.w = pk2(v1[2], v1[3]); *(u32x4*)dst = w;
  } else if (EPI == EPI_M1 || EPI == EPI_M2) {
    float g[8]; unpk8(*(const u32x4*)((const bf16_t*)(e.ws + WS_BG) + (size_t)row * 2048 + (EPI == EPI_M2 ? 1024 : 0) + col), g);
    bf16_t* dst = (bf16_t*)(e.ws + WS_MG) + (size_t)row * 1024 + col;
    float r[8];
#pragma unroll
    for (int i = 0; i < 4; ++i) { r[i] = v0[i] * g[i]; r[4 + i] = v1[i] * g[4 + i]; }
    if (EPI == EPI_M2) { float pv[8]; unpk8(*(const u32x4*)dst, pv);
#pragma unroll
      for (int i = 0; i < 8; ++i) r[i] += pv[i]; }
    u32x4 w; w.x = pk2(r[0], r[1]); w.y = pk2(r[2], r[3]); w.z = pk2(r[4], r[5]); w.w = pk2(r[6], r[7]); *(u32x4*)dst = w;
  } else if (EPI == EPI_OUT) {
    const f32x4 x0 = *(const f32x4*)(e.x + (size_t)row * DM + col), x1 = *(const f32x4*)(e.x + (size_t)row * DM + col + 4);
    const f32x4 r0 = x0 * ALPHA + v0, r1 = x1 * ALPHA + v1;
    u32x4 w; w.x = pk2(r0[0], r0[1]); w.y = pk2(r0[2], r0[3]); w.z = pk2(r1[0], r1[1]); w.w = pk2(r1[2], r1[3]); *(u32x4*)((bf16_t*)e.dout + (size_t)row * DM + col) = w;
  } else if (EPI == EPI_QP) {
    u32x4 w; w.x = pk2(v0[0], v0[1]); w.y = pk2(v0[2], v0[3]); w.z = pk2(v1[0], v1[1]); w.w = pk2(v1[2], v1[3]);
    *(u32x4*)((bf16_t*)(e.ws + WS_QP) + (size_t)row * 2048 + col) = w;
  }
}
template <int EPI> __device__ __forceinline__ void ph_gemm(int bid, int nb, const bf16_t* __restrict__ A, const bf16_t* __restrict__ Bt, int N, int K, const EP& e) {
  const int tid = threadIdx.x & 255, half = threadIdx.x >> 8, wave = tid >> 6, lane = tid & 63, fr = lane & 15, fq = lane >> 4;
  const int ntn = N / 64, ntiles = ntn * (T / 64);
  for (int tile = bid * 2 + half; tile < ntiles; tile += nb * 2) {
    const int m0 = (tile / ntn) * 64 + (wave & 1) * 32, n0 = (tile % ntn) * 64 + (wave >> 1) * 32;
    f32x4 acc[2][2];
#pragma unroll
    for (int i = 0; i < 2; ++i)
#pragma unroll
      for (int j = 0; j < 2; ++j) acc[i][j] = (f32x4){0.f, 0.f, 0.f, 0.f};
    const bf16_t* ap = A + (size_t)(m0 + fr) * K + fq * 8; const bf16_t* bp = Bt + (size_t)(n0 + fr) * K + fq * 8;
    for (int k0 = 0; k0 < K; k0 += 32) {
      bf16x8 a[2], b[2];
#pragma unroll
      for (int i = 0; i < 2; ++i) { a[i] = *(const bf16x8*)(ap + (size_t)i * 16 * K + k0); b[i] = *(const bf16x8*)(bp + (size_t)i * 16 * K + k0); }
#pragma unroll
      for (int i = 0; i < 2; ++i)
#pragma unroll
        for (int j = 0; j < 2; ++j) acc[i][j] = __builtin_amdgcn_mfma_f32_16x16x32_bf16(b[j], a[i], acc[i][j], 0, 0, 0);
    }
#pragma unroll
    for (int i = 0; i < 2; ++i)
#pragma unroll
      for (int j = 0; j < 2; ++j) epi4<EPI>(e, m0 + 16 * i + fr, n0 + 16 * j + 4 * fq, acc[i][j]);
  }
}

namespace pg8 {
#define PG8_LAS __attribute__((address_space(3)))
typedef unsigned short bf16_t;
typedef short bf16x8 __attribute__((ext_vector_type(8)));
typedef float f32x4 __attribute__((ext_vector_type(4)));
typedef unsigned u32x4 __attribute__((ext_vector_type(4)));
constexpr int BM = 256, BK = 64, HALF = 128, HTB = HALF * BK * 2  , STAGE_BYTES = 8 * HTB, NXCD = 8, WGM = 8;

__host__ __device__ __forceinline__ int lds_byte(int r, int c) { const int st = (r >> 4) * 2 + (c >> 5), rr = r & 15, cc = c & 31, ob = rr * 64 + cc * 2; return st * 1024 + (ob ^ (((ob >> 9) & 1) << 5)); }
__host__ __device__ __forceinline__ void stage_rc(int b, int& R, int& C) { const int st = b / 1024, sb = b % 1024, swz = sb ^ (((sb >> 9) & 1) << 5); R = (st >> 1) * 16 + swz / 64; C = (st & 1) * 32 + (swz % 64) / 2; }
__host__ __device__ __forceinline__ int perm32(int rho) { const int n = rho >> 4, i = rho & 15; return 8 * (i >> 2) + 4 * n + (i & 3); }

struct Unit { int pm, pn; };
struct Gemm { const bf16_t* A; const bf16_t* Bt; int M, N, K; };

struct StaticOrder {
    int nM, nN, nwg, G, c;
    __host__ __device__ void init(int M, int N, int G_, int c_) { nM = M / BM; nN = N / BM; nwg = nM * nN; G = G_; c = c_; }
    __host__ __device__ bool next(int i, Unit& u) const {
        const long L = (long)i * G + c; if (L >= nwg) return false;
        int wgid = (int)L; { const int q = nwg / NXCD, r = nwg % NXCD, xcd = wgid % NXCD, off = wgid / NXCD; wgid = (xcd < r ? xcd * (q + 1) : r * (q + 1) + (xcd - r) * q) + off; }
        const int nig = WGM * nN, gid = wgid / nig, fm = gid * WGM, gsz = (nM - fm) < WGM ? (nM - fm) : WGM;
        u.pm = fm + ((wgid % nig) % gsz); u.pn = (wgid % nig) / gsz; return true;
    }
    __device__ __forceinline__ void a_ready(const Unit&) const {}
    __device__ __forceinline__ void done(const Unit&) const {}
};

template <class Epi, class Sched, bool ALIGN_EPI = false, bool SP2 = false>
__device__ __forceinline__ void gemm_phase(PG8_LAS unsigned char* lds, const Gemm g, const Sched& S, const Epi& E) {
    const int tid = threadIdx.x, wid = __builtin_amdgcn_readfirstlane(tid >> 6), lane = tid & 63, wr = wid >> 2, wc = wid & 3, fr = lane & 15, fq = lane >> 4;
    const int K = g.K, nt = K / BK;
    unsigned voffA[2], voffB[2];
#pragma unroll
    for (int i = 0; i < 2; ++i) { int R, C; stage_rc(tid * 16 + i * 8192, R, C); const int Rb = Epi::PERM ? ((R & ~31) + perm32(R & 31)) : R;
        voffA[i] = (unsigned)(R * K + C) * 2u; voffB[i] = (unsigned)(Rb * K + C) * 2u; }
    const size_t kstep = (size_t)(BK * 2);
    const size_t hstep = (size_t)HALF * K * 2;
    const size_t tstep = 2 * hstep;
    const unsigned ldsw = (unsigned)wid * 1024u;
    const int aoff = lds_byte(wr * 64 + fr, fq * 8), boff = lds_byte(wc * 32 + fr, fq * 8);
#define PG8_SA(b, h) (((b) * 2 + (h)) * HTB)
#define PG8_SB(b, h) ((4 + (b) * 2 + (h)) * HTB)
#define PG8_STAGE(bufoff, gbase, voff) do { _Pragma("unroll") for (int _i = 0; _i < 2; ++_i) \
        __builtin_amdgcn_global_load_lds((const unsigned*)((const char*)(gbase) + (voff)[_i]), (PG8_LAS unsigned*)(lds + (bufoff) + ldsw + _i * 8192), 16, 0, 0); } while (0)
#define PG8_LDA(dst, b, h) do { _Pragma("unroll") for (int m = 0; m < 4; ++m) _Pragma("unroll") for (int k = 0; k < 2; ++k) dst[m][k] = *(const PG8_LAS bf16x8*)(lds + PG8_SA(b, h) + aoff + m * 2048 + k * 1024); } while (0)
#define PG8_LDB(dst, b, h) do { _Pragma("unroll") for (int n = 0; n < 2; ++n) _Pragma("unroll") for (int k = 0; k < 2; ++k) dst[n][k] = *(const PG8_LAS bf16x8*)(lds + PG8_SB(b, h) + boff + n * 2048 + k * 1024); } while (0)
#define PG8_MMA(ai, bj, At, Bt) do { __builtin_amdgcn_s_setprio(1); _Pragma("unroll") for (int m = 0; m < 4; ++m) _Pragma("unroll") for (int n = 0; n < 2; ++n) _Pragma("unroll") for (int k = 0; k < 2; ++k) \
        acc[ai][bj][m][n] = __builtin_amdgcn_mfma_f32_16x16x32_bf16(Bt[n][k], At[m][k], acc[ai][bj][m][n], 0, 0, 0); __builtin_amdgcn_s_setprio(0); } while (0)
#define PG8_WAIT_V(n) asm volatile("s_waitcnt vmcnt(" #n ")" ::: "memory")
#define PG8_WAIT_L(n) asm volatile("s_waitcnt lgkmcnt(" #n ")" ::: "memory")
#define PG8_BAR __builtin_amdgcn_s_barrier()
#define PG8_SCHED __builtin_amdgcn_sched_barrier(0)
    Unit cur, nxt; int ui = 0;
    if (!S.next(0, cur)) return;
    f32x4 acc[2][2][4][2];
#pragma unroll
    for (int a = 0; a < 2; ++a)
#pragma unroll
        for (int b = 0; b < 2; ++b)
#pragma unroll
            for (int m = 0; m < 4; ++m)
#pragma unroll
                for (int n = 0; n < 2; ++n) acc[a][b][m][n] = (f32x4){0.f, 0.f, 0.f, 0.f};
    bf16x8 At[4][2], B0[2][2], B1[2][2];
    const char* cA = (const char*)g.A + (size_t)cur.pm * tstep; const char* cB = (const char*)g.Bt + (size_t)cur.pn * tstep;
    S.a_ready(cur);
    if constexpr (SP2) {
        PG8_STAGE(PG8_SB(0, 0), cB, voffB); PG8_STAGE(PG8_SB(0, 1), cB + hstep, voffB); PG8_STAGE(PG8_SA(0, 0), cA, voffA); PG8_STAGE(PG8_SA(0, 1), cA + hstep, voffA);
        if (wr == 1) PG8_BAR;
        PG8_WAIT_V(2); PG8_BAR;
        PG8_STAGE(PG8_SB(1, 0), cB + kstep, voffB); PG8_STAGE(PG8_SA(1, 0), cA + kstep, voffA); PG8_STAGE(PG8_SB(1, 1), cB + hstep + kstep, voffB);
        PG8_WAIT_V(6); PG8_BAR;
    } else {
        PG8_STAGE(PG8_SB(0, 0), cB, voffB); PG8_STAGE(PG8_SA(0, 0), cA, voffA); PG8_STAGE(PG8_SB(0, 1), cB + hstep, voffB); PG8_STAGE(PG8_SA(0, 1), cA + hstep, voffA);
        if (wr == 1) PG8_BAR;
        PG8_WAIT_V(4); PG8_BAR;
        PG8_STAGE(PG8_SB(1, 0), cB + kstep, voffB); PG8_STAGE(PG8_SA(1, 0), cA + kstep, voffA); PG8_STAGE(PG8_SB(1, 1), cB + hstep + kstep, voffB);
        PG8_WAIT_V(6); PG8_BAR;
    }
    for (;;) {
        const bool has_next = S.next(ui + 1, nxt);
        const char* nA = has_next ? (const char*)g.A + (size_t)nxt.pm * tstep : cA; const char* nB = has_next ? (const char*)g.Bt + (size_t)nxt.pn * tstep : cB;
        for (int t = 0; t < nt; t += 2) {
            const bool last = (t == nt - 2);
            if constexpr (Epi::HAS_MID) { if (t == (nt >> 1)) E.mid(acc, cur, wr, wc, fr, fq); }
            const char* a1 = cA + (size_t)(t + 1) * kstep;
            const char* a2 = last ? nA : cA + (size_t)(t + 2) * kstep; const char* b2 = last ? nB : cB + (size_t)(t + 2) * kstep;
            const char* a3 = a2 + kstep; const char* b3 = b2 + kstep;
            if (last && has_next) S.a_ready(nxt);
            if constexpr (SP2) {
            PG8_LDB(B0, 0, 0); PG8_LDB(B1, 0, 1); PG8_SCHED; PG8_LDA(At, 0, 0); PG8_STAGE(PG8_SA(1, 1), a1 + hstep, voffA);
            PG8_WAIT_V(8); PG8_WAIT_L(0); PG8_BAR; PG8_MMA(0, 0, At, B0); PG8_MMA(0, 1, At, B1); PG8_BAR; PG8_SCHED;
            PG8_LDA(At, 0, 1); PG8_STAGE(PG8_SB(0, 0), b2, voffB); PG8_STAGE(PG8_SB(0, 1), b2 + hstep, voffB); PG8_STAGE(PG8_SA(0, 0), a2, voffA);
            PG8_WAIT_V(8); PG8_WAIT_L(0); PG8_BAR; PG8_MMA(1, 0, At, B0); PG8_MMA(1, 1, At, B1); PG8_BAR; PG8_SCHED;
            PG8_LDB(B0, 1, 0); PG8_LDB(B1, 1, 1); PG8_SCHED; PG8_LDA(At, 1, 0); PG8_STAGE(PG8_SA(0, 1), a2 + hstep, voffA);
            PG8_WAIT_V(8); PG8_WAIT_L(0); PG8_BAR; PG8_MMA(0, 0, At, B0); PG8_MMA(0, 1, At, B1); PG8_BAR; PG8_SCHED;
            PG8_LDA(At, 1, 1); PG8_STAGE(PG8_SB(1, 0), b3, voffB); PG8_STAGE(PG8_SB(1, 1), b3 + hstep, voffB); PG8_STAGE(PG8_SA(1, 0), a3, voffA);
            PG8_WAIT_V(8); PG8_WAIT_L(0); PG8_BAR; PG8_MMA(1, 0, At, B0); PG8_MMA(1, 1, At, B1); PG8_BAR; PG8_SCHED;
            } else {
            PG8_LDB(B0, 0, 0); PG8_SCHED; PG8_LDA(At, 0, 0); PG8_STAGE(PG8_SA(1, 1), a1 + hstep, voffA);
            PG8_WAIT_L(8); PG8_BAR; PG8_WAIT_L(0); PG8_MMA(0, 0, At, B0); PG8_BAR; PG8_SCHED;
            PG8_LDB(B1, 0, 1); PG8_STAGE(PG8_SB(0, 0), b2, voffB);
            PG8_BAR; PG8_WAIT_L(0); PG8_MMA(0, 1, At, B1); PG8_BAR;
            PG8_LDA(At, 0, 1); PG8_STAGE(PG8_SA(0, 0), a2, voffA);
            PG8_BAR; PG8_WAIT_L(0); PG8_MMA(1, 0, At, B0); PG8_BAR; PG8_SCHED;
            PG8_STAGE(PG8_SB(0, 1), b2 + hstep, voffB);
            PG8_WAIT_V(6); PG8_BAR; PG8_MMA(1, 1, At, B1); PG8_BAR;
            PG8_LDB(B0, 1, 0); PG8_SCHED; PG8_LDA(At, 1, 0); PG8_STAGE(PG8_SA(0, 1), a2 + hstep, voffA);
            PG8_WAIT_L(8); PG8_BAR; PG8_WAIT_L(0); PG8_MMA(0, 0, At, B0); PG8_BAR; PG8_SCHED;
            PG8_LDB(B1, 1, 1); PG8_STAGE(PG8_SB(1, 0), b3, voffB);
            PG8_BAR; PG8_WAIT_L(0); PG8_MMA(0, 1, At, B1); PG8_BAR;
            PG8_LDA(At, 1, 1); PG8_STAGE(PG8_SA(1, 0), a3, voffA);
            PG8_BAR; PG8_WAIT_L(0); PG8_MMA(1, 0, At, B0); PG8_BAR; PG8_SCHED;
            PG8_STAGE(PG8_SB(1, 1), b3 + hstep, voffB);
            PG8_WAIT_V(6); PG8_BAR; PG8_MMA(1, 1, At, B1); PG8_BAR;
            }
        }
        if constexpr (ALIGN_EPI) { if (wr == 0) PG8_BAR; }
        if constexpr (!Epi::AFTER_DRAIN) { E(acc, cur, wr, wc, fr, fq); S.done(cur); }
        if (!has_next) break;
#pragma unroll
        for (int a = 0; a < 2; ++a)
#pragma unroll
            for (int b = 0; b < 2; ++b)
#pragma unroll
                for (int m = 0; m < 4; ++m)
#pragma unroll
                    for (int n = 0; n < 2; ++n) acc[a][b][m][n] = (f32x4){0.f, 0.f, 0.f, 0.f};
        cur = nxt; cA = nA; cB = nB; ++ui;
        if constexpr (ALIGN_EPI) { if (wr == 1) PG8_BAR; }
    }
    PG8_WAIT_V(0);
    if constexpr (!ALIGN_EPI) { if (wr == 0) PG8_BAR; }
    PG8_BAR;
    if constexpr (Epi::AFTER_DRAIN) { E.fused(acc, cur, wr, wc, fr, fq, lds, wid, lane); S.done(cur); }
#undef PG8_SA
#undef PG8_SB
#undef PG8_STAGE
#undef PG8_LDA
#undef PG8_LDB
#undef PG8_MMA
#undef PG8_WAIT_V
#undef PG8_WAIT_L
#undef PG8_BAR
#undef PG8_SCHED
}
}

template <int EPI> struct EpiAd {
  static constexpr bool PERM = true, AFTER_DRAIN = false, HAS_MID = false;
  EP e;
  __device__ __forceinline__ void operator()(const pg8::f32x4 (&acc)[2][2][4][2], const pg8::Unit& u, int wr, int wc, int fr, int fq) const {
#pragma unroll
    for (int ai = 0; ai < 2; ++ai)
#pragma unroll
      for (int m = 0; m < 4; ++m)
#pragma unroll
        for (int bj = 0; bj < 2; ++bj)
          epi8<EPI>(e, u.pm * 256 + ai * 128 + wr * 64 + m * 16 + fr, u.pn * 256 + bj * 128 + wc * 32 + 8 * fq, acc[ai][bj][m][0], acc[ai][bj][m][1]);
  }
};
struct EpiMergeK {
  static constexpr bool PERM = true, AFTER_DRAIN = false, HAS_MID = true;
  unsigned char* ws;
  __device__ __forceinline__ void mid(pg8::f32x4 (&acc)[2][2][4][2], const pg8::Unit& u, int wr, int wc, int fr, int fq) const {
    const bf16_t* bg = (const bf16_t*)(ws + WS_BG);
#pragma unroll
    for (int ai = 0; ai < 2; ++ai)
#pragma unroll
      for (int m = 0; m < 4; ++m)
#pragma unroll
        for (int bj = 0; bj < 2; ++bj) {
          const int row = u.pm * 256 + ai * 128 + wr * 64 + m * 16 + fr, col = u.pn * 256 + bj * 128 + wc * 32 + 8 * fq;
          float g0[8], g1[8]; unpk8(*(const u32x4*)(bg + (size_t)row * 2048 + col), g0); unpk8(*(const u32x4*)(bg + (size_t)row * 2048 + 1024 + col), g1);
#pragma unroll
          for (int i = 0; i < 4; ++i) { acc[ai][bj][m][0][i] *= g0[i] * __builtin_amdgcn_rcpf(fmaxf(g1[i], 8.673617379884035e-19f));
                                        acc[ai][bj][m][1][i] *= g0[4 + i] * __builtin_amdgcn_rcpf(fmaxf(g1[4 + i], 8.673617379884035e-19f)); }
        }
  }
  __device__ __forceinline__ void operator()(const pg8::f32x4 (&acc)[2][2][4][2], const pg8::Unit& u, int wr, int wc, int fr, int fq) const {
    const bf16_t* bg = (const bf16_t*)(ws + WS_BG); bf16_t* mg = (bf16_t*)(ws + WS_MG);
#pragma unroll
    for (int ai = 0; ai < 2; ++ai)
#pragma unroll
      for (int m = 0; m < 4; ++m)
#pragma unroll
        for (int bj = 0; bj < 2; ++bj) {
          const int row = u.pm * 256 + ai * 128 + wr * 64 + m * 16 + fr, col = u.pn * 256 + bj * 128 + wc * 32 + 8 * fq;
          float g1[8], r[8]; unpk8(*(const u32x4*)(bg + (size_t)row * 2048 + 1024 + col), g1);
#pragma unroll
          for (int i = 0; i < 4; ++i) { r[i] = acc[ai][bj][m][0][i] * fmaxf(g1[i], 8.673617379884035e-19f); r[4 + i] = acc[ai][bj][m][1][i] * fmaxf(g1[4 + i], 8.673617379884035e-19f); }
          u32x4 w; w.x = pk2(r[0], r[1]); w.y = pk2(r[2], r[3]); w.z = pk2(r[4], r[5]); w.w = pk2(r[6], r[7]); *(u32x4*)(mg + (size_t)row * 1024 + col) = w;
        }
  }
};
__device__ __forceinline__ void ph_gemm_merge(unsigned char* lds, unsigned char* ws) {
  pg8::Gemm g{(const bf16_t*)(ws + WS_YA), (const bf16_t*)(ws + WS_WA), T, 1024, 1024}; pg8::StaticOrder S; S.init(T, 1024, (int)gridDim.x, (int)blockIdx.x);
  EpiMergeK E{ws};
  pg8::gemm_phase<EpiMergeK, pg8::StaticOrder, true, true>((PG8_LAS unsigned char*)lds, g, S, E);
}
template <int EPI> __device__ __forceinline__ void ph_gemm8(unsigned char* lds, const bf16_t* A, const bf16_t* Bt, int N, int K, const EP& e) {
  pg8::Gemm g{A, Bt, T, N, K}; pg8::StaticOrder S; S.init(T, N, (int)gridDim.x, (int)blockIdx.x);
  EpiAd<EPI> E{e};
  pg8::gemm_phase<EpiAd<EPI>, pg8::StaticOrder, true, true>((PG8_LAS unsigned char*)lds, g, S, E);
}

__device__ __forceinline__ float log_sigmoid(float f) { return fminf(f, 0.f) - log1pf(expf(-fabsf(f))); }
constexpr size_t WS_GP_P = 3 * MB, WS_GP_M = 3 * MB + 512 * 1024, WS_GP_B = 4 * MB, WS_GP_MC = 4 * MB + 512 * 1024, WS_GP_AC = 4 * MB + 520 * 1024;
constexpr size_t WS_NU = 5 * MB;
constexpr int RS = 136, TS = 72;
__device__ __forceinline__ void gp_scan(int scan, const float* __restrict__ gpre, unsigned char* ws, unsigned char* lds) {
  const int lane = threadIdx.x & 63, wave = threadIdx.x >> 6, dir = scan >> 3, b = (scan >> 2) & 1, h = scan & 3;
  float* P = (float*)(ws + WS_GP_P) + (size_t)scan * SEQ; float* Rp = (float*)(ws + WS_GP_M) + (size_t)scan * SEQ; float* BBp = (float*)(ws + WS_GP_B) + (size_t)scan * SEQ;
  float* mC = (float*)(ws + WS_GP_MC) + scan * 128; float* aC = (float*)(ws + WS_GP_AC) + scan * 128;
  float* LBL = (float*)lds; float* LR = LBL + 128;
  const int gi = (dir ? 8 : 0) + h, gf = (dir ? 12 : 4) + h;
  float ig[16], fg[16];
#pragma unroll
  for (int i = 0; i < 16; ++i) { const int c = wave * 16 + i, j = dir ? 127 - c : c, s = 64 * j + (dir ? 63 - lane : lane); const size_t t = (size_t)b * SEQ + s;
    ig[i] = gpre[t * 16 + gi]; fg[i] = gpre[t * 16 + gf]; }
#pragma unroll
  for (int i = 0; i < 16; ++i) { const int c = wave * 16 + i, j = dir ? 127 - c : c, s = 64 * j + (dir ? 63 - lane : lane);
    float bsum = log_sigmoid(fg[i]);
#pragma unroll
    for (int o = 1; o < 64; o <<= 1) { const float v = __shfl_up(bsum, o); if (lane >= o) bsum += v; }
    const float p = ig[i] - bsum; float r = p;
#pragma unroll
    for (int o = 1; o < 64; o <<= 1) { const float v = __shfl_up(r, o); if (lane >= o) r = fmaxf(r, v); }
    P[s] = p; Rp[s] = r; BBp[s] = bsum;
    if (lane == 63) { LBL[c] = bsum; LR[c] = r; } }
  __syncthreads();
  if (wave == 0) { float m = -1e30f;
    for (int c = 0; c < 128; ++c) { const int j = dir ? 127 - c : c; const float Ml = fmaxf(m, LR[c]);
      if (lane == 0) { mC[j] = m; aC[j] = expf(m - Ml); }
      m = LBL[c] + Ml; } }
  __syncthreads();
}
struct M1Pre { u32x4 raw[5]; u32x4 v[2]; float cwl[3]; float pv, rv, mc; };
__device__ __forceinline__ void m1_prefetch(int u, M1Pre& pr, const unsigned char* ws, const float* __restrict__ cw, const float* __restrict__ cb) {
  const int tid = threadIdx.x, lane = tid & 63, wave = __builtin_amdgcn_readfirstlane(tid >> 6);
  const int bh = u >> 7, j = u & 127, b = bh >> 2, h = bh & 3;
  const bf16_t* mq = (const bf16_t*)(ws + WS_MQ); const bf16_t* mk = (const bf16_t*)(ws + WS_MK); const bf16_t* mv = (const bf16_t*)(ws + WS_MV);
#pragma unroll
  for (int i = 0; i < 5; ++i) { const int it = tid + 512 * i; const int which = it >= 68 * 16, r = (it - which * 68 * 16) >> 4, ch = it & 15; const int s = 64 * j - 2 + r;
    pr.raw[i] = (u32x4){0u, 0u, 0u, 0u};
    if (it < 2 * 68 * 16 && s >= 0 && s < SEQ) pr.raw[i] = *(const u32x4*)((which ? mk : mq) + ((size_t)b * SEQ + s) * 512 + h * 128 + ch * 8); }
#pragma unroll
  for (int k2 = 0; k2 < 2; ++k2) pr.v[k2] = *(const u32x4*)(mv + ((size_t)b * SEQ + 64 * j + lane) * 512 + h * 128 + (wave + 8 * k2) * 8);
#pragma unroll
  for (int i3 = 0; i3 < 3; ++i3) { const int i = tid + 512 * i3; const int w = i >> 8, c = i & 255, ch = (c >> 7) * 512 + h * 128 + (c & 127); pr.cwl[i3] = w < 5 ? cw[w * 1024 + ch] : cb[ch]; }
  pr.pv = 0.f; pr.rv = 0.f; pr.mc = 0.f;
  if (tid < 128) { const int dir = tid >> 6, l = tid & 63; const int scan = dir * 8 + bh;
    pr.pv = ((const float*)(ws + WS_GP_P))[(size_t)scan * SEQ + 64 * j + l]; pr.rv = ((const float*)(ws + WS_GP_M))[(size_t)scan * SEQ + 64 * j + (dir ? 0 : 63)];
    pr.mc = ((const float*)(ws + WS_GP_MC))[scan * 128 + j]; }
}
template <bool HAS_NEXT> __device__ __forceinline__ void m1_unit(int u, int un, M1Pre& pr, unsigned char* lds, unsigned char* ws, bf16_t* UT, const float* __restrict__ cw, const float* __restrict__ cb) {
  const int tid = threadIdx.x, lane = tid & 63, wave = __builtin_amdgcn_readfirstlane(tid >> 6), fr = lane & 15, fq = lane >> 4;
  const int bh = u >> 7, j = u & 127, b = bh >> 2, h = bh & 3;
  bf16_t* RAWQ = (bf16_t*)lds; bf16_t* RAWK = RAWQ + 68 * RS; bf16_t* KWT0 = RAWK + 68 * RS; bf16_t* KWT1 = KWT0 + 128 * TS; bf16_t* VT = KWT1 + 128 * TS;
  float* WK = (float*)(VT + 144 * TS);
  float* CWL = WK + 128;
  bf16_t* qc = (bf16_t*)(ws + WS_QC); bf16_t* kc = (bf16_t*)(ws + WS_KC);
  const size_t trow0 = (size_t)b * SEQ + 64 * j;
#pragma unroll
  for (int i = 0; i < 5; ++i) { const int it = tid + 512 * i; const int which = it >= 68 * 16, r = (it - which * 68 * 16) >> 4, ch = it & 15;
    if (it < 2 * 68 * 16) *(u32x4*)((which ? RAWK : RAWQ) + r * RS + ch * 8) = pr.raw[i]; }
#pragma unroll
  for (int i3 = 0; i3 < 3; ++i3) CWL[tid + 512 * i3] = pr.cwl[i3];
  if (tid < 128) WK[tid] = expf(pr.pv - fmaxf(pr.mc, pr.rv));
#pragma unroll
  for (int k2 = 0; k2 < 2; ++k2) { const int ch = wave + 8 * k2; const u32x4 v = pr.v[k2];
#pragma unroll
    for (int i = 0; i < 4; ++i) { VT[(ch * 8 + 2 * i) * TS + lane] = (bf16_t)(v[i] & 0xffffu); VT[(ch * 8 + 2 * i + 1) * TS + lane] = (bf16_t)(v[i] >> 16); } }
  if (tid < 64) VT[128 * TS + tid] = 0x3f80;
  __syncthreads();
  if (HAS_NEXT) m1_prefetch(un, pr, ws, cw, cb);
  const float wkf = WK[lane], wkb = WK[64 + lane];
#pragma unroll
  for (int which = 0; which < 2; ++which)
#pragma unroll
    for (int k2 = 0; k2 < 2; ++k2) {
      const int ch = wave + 8 * k2; const float* cwl = CWL + which * 128 + ch * 8;
      float y[8];
      { const float4 ba = *(const float4*)(cwl + 5 * 256), bb = *(const float4*)(cwl + 5 * 256 + 4); y[0] = ba.x; y[1] = ba.y; y[2] = ba.z; y[3] = ba.w; y[4] = bb.x; y[5] = bb.y; y[6] = bb.z; y[7] = bb.w; }
#pragma unroll
      for (int w = 0; w < 5; ++w) {
        const u32x4 v = *(const u32x4*)((which ? RAWK : RAWQ) + (lane + w) * RS + ch * 8);
        const float4 wa = *(const float4*)(cwl + w * 256), wb = *(const float4*)(cwl + w * 256 + 4);
        y[0] += __uint_as_float(v[0] << 16) * wa.x; y[1] += __uint_as_float(v[0] & 0xffff0000u) * wa.y; y[2] += __uint_as_float(v[1] << 16) * wa.z; y[3] += __uint_as_float(v[1] & 0xffff0000u) * wa.w;
        y[4] += __uint_as_float(v[2] << 16) * wb.x; y[5] += __uint_as_float(v[2] & 0xffff0000u) * wb.y; y[6] += __uint_as_float(v[3] << 16) * wb.z; y[7] += __uint_as_float(v[3] & 0xffff0000u) * wb.w;
      }
#pragma unroll
      for (int i = 0; i < 8; ++i) { y[i] = y[i] * fsig(y[i]); if (which) y[i] *= 0.08838834764831845f; }
      u32x4 o; o.x = pk2(y[0], y[1]); o.y = pk2(y[2], y[3]); o.z = pk2(y[4], y[5]); o.w = pk2(y[6], y[7]);
      *(u32x4*)((which ? kc : qc) + (trow0 + lane) * 512 + h * 128 + ch * 8) = o;
      if (which) {
#pragma unroll
        for (int i = 0; i < 8; ++i) { const float kv = bf2f(f2bf(y[i])); KWT0[(ch * 8 + i) * TS + lane] = f2bf(kv * wkf); KWT1[(ch * 8 + i) * TS + lane] = f2bf(kv * wkb); }
      }
    }
  __syncthreads();
  bf16x8 xf[2][2];
#pragma unroll
  for (int dir = 0; dir < 2; ++dir)
#pragma unroll
    for (int ks = 0; ks < 2; ++ks) xf[dir][ks] = *(const bf16x8*)((dir ? KWT1 : KWT0) + (16 * wave + fr) * TS + ks * 32 + fq * 8);
#pragma unroll
  for (int et = 0; et < 9; ++et) {
    const bf16x8 y0 = *(const bf16x8*)(VT + (16 * et + fr) * TS + fq * 8), y1 = *(const bf16x8*)(VT + (16 * et + fr) * TS + 32 + fq * 8);
#pragma unroll
    for (int dir = 0; dir < 2; ++dir) {
      f32x4 acc = {0.f, 0.f, 0.f, 0.f};
      acc = __builtin_amdgcn_mfma_f32_16x16x32_bf16(xf[dir][0], y0, acc, 0, 0, 0);
      acc = __builtin_amdgcn_mfma_f32_16x16x32_bf16(xf[dir][1], y1, acc, 0, 0, 0);
      const int scan = dir * 8 + bh;
      if (et < 8) { u32x2 w; w.x = pk2(acc[0], acc[1]); w.y = pk2(acc[2], acc[3]);
        *(u32x2*)(UT + (((size_t)scan * 128 + j) * 128 + 16 * et + fr) * 128 + 16 * wave + 4 * fq) = w; }
      else if (fr == 0) *(f32x4*)((float*)(ws + WS_NU) + ((size_t)scan * 128 + j) * 128 + 16 * wave + 4 * fq) = acc;
    }
  }
  __syncthreads();
}
__device__ __forceinline__ void m2_scan(int bid, int nb, unsigned char* ws, bf16_t* UT) {
  for (int slab = bid; slab < 16 * 16; slab += nb) {
    const int scan = slab >> 4, dir = scan >> 3, el = ((slab & 15) * 512 + threadIdx.x) * 2;
    const float* aC = (const float*)(ws + WS_GP_AC) + scan * 128;
    bf16_t* base = UT + (size_t)scan * 128 * 16384 + el;
    float c0 = 0.f, c1 = 0.f;
    for (int c16 = 0; c16 < 128; c16 += 16) {
      unsigned uv[16];
#pragma unroll
      for (int i = 0; i < 16; ++i) { const int j = dir ? 127 - (c16 + i) : c16 + i; uv[i] = *(const unsigned*)(base + (size_t)j * 16384); }
#pragma unroll
      for (int i = 0; i < 16; ++i) { const int j = dir ? 127 - (c16 + i) : c16 + i; const float a = aC[j]; *(unsigned*)(base + (size_t)j * 16384) = pk2(c0, c1);
        c0 = a * c0 + __uint_as_float(uv[i] << 16); c1 = a * c1 + __uint_as_float(uv[i] & 0xffff0000u); }
    }
  }
  const int gt = bid * 512 + threadIdx.x, nthreads = nb * 512;
  for (int item = gt; item < 16 * 128; item += nthreads) {
    const int scan = item >> 7, d = item & 127, dir = scan >> 3;
    const float* aC = (const float*)(ws + WS_GP_AC) + scan * 128; float* base = (float*)(ws + WS_NU) + (size_t)scan * 128 * 128 + d;
    float n = 0.f;
    for (int c16 = 0; c16 < 128; c16 += 16) { float uv[16], av[16];
#pragma unroll
      for (int i = 0; i < 16; ++i) { const int j = dir ? 127 - (c16 + i) : c16 + i; uv[i] = base[j * 128]; av[i] = aC[j]; }
#pragma unroll
      for (int i = 0; i < 16; ++i) { const int j = dir ? 127 - (c16 + i) : c16 + i; base[j * 128] = n; n = av[i] * n + uv[i]; } }
  }
}
struct M3Pre { u32x4 qk[4], ct[8], mvv[2]; float nu, ga; };
__device__ __forceinline__ void m3_prefetch(int u, M3Pre& pr, const unsigned char* ws, const bf16_t* UT) {
  int tid = threadIdx.x; asm volatile("" : "+v"(tid));
  const int lane = tid & 63, wave = tid >> 6;
  const int bh = u >> 7, j = u & 127, b = bh >> 2, h = bh & 3;
  const bf16_t* qc = (const bf16_t*)(ws + WS_QC); const bf16_t* kc = (const bf16_t*)(ws + WS_KC); const bf16_t* mv = (const bf16_t*)(ws + WS_MV);
  const size_t trow0 = (size_t)b * SEQ + 64 * j;
#pragma unroll
  for (int i = 0; i < 4; ++i) { const int it = tid + 512 * i, which = it >> 10, r = (it >> 4) & 63, ch = it & 15;
    pr.qk[i] = *(const u32x4*)((which ? kc : qc) + (trow0 + r) * 512 + h * 128 + ch * 8); }
#pragma unroll
  for (int i = 0; i < 8; ++i) { const int it = tid + 512 * i, dir = it >> 11, e = (it >> 4) & 127, ch = it & 15; const int scan = dir * 8 + bh;
    pr.ct[i] = *(const u32x4*)(UT + (((size_t)scan * 128 + j) * 128 + e) * 128 + ch * 8); }
  pr.nu = 0.f; pr.ga = 0.f;
  if (tid < 256) { const int dir = tid >> 7, d = tid & 127; const int scan = dir * 8 + bh; pr.nu = ((const float*)(ws + WS_NU))[((size_t)scan * 128 + j) * 128 + d]; }
  if (tid < 384) { const int dir = tid / 192, k3 = (tid % 192) >> 6, l = tid & 63; const int scan = dir * 8 + bh;
    const float* src = (const float*)(ws + (k3 == 0 ? WS_GP_P : k3 == 1 ? WS_GP_M : WS_GP_B)) + (size_t)scan * SEQ; pr.ga = src[64 * j + l]; }
#pragma unroll
  for (int k2 = 0; k2 < 2; ++k2) { const int ch = wave + 8 * k2; pr.mvv[k2] = *(const u32x4*)(mv + (trow0 + lane) * 512 + h * 128 + ch * 8); }
}
template <bool HAS_NEXT> __device__ __forceinline__ void m3_unit(int u, int un, M3Pre& pr, unsigned char* lds, unsigned char* ws, const bf16_t* UT, const float* __restrict__ ng) {
  int tid = threadIdx.x; asm volatile("" : "+v"(tid));
  const int lane = tid & 63, wave = __builtin_amdgcn_readfirstlane(tid >> 6), fr = lane & 15, fq = lane >> 4;
  const int bh = u >> 7, j = u & 127, b = bh >> 2, h = bh & 3, tt = wave & 3, eh = wave >> 2;
  bf16_t* QCS = (bf16_t*)lds; bf16_t* KCS = QCS + 64 * RS; bf16_t* VT = KCS + 64 * RS; bf16_t* CT0 = VT + 144 * TS; bf16_t* CT1 = CT0 + 144 * RS;
  float* GA = (float*)(CT1 + 144 * RS);
  float* ST = GA + 384;
  const bf16_t* qc = (const bf16_t*)(ws + WS_QC); const bf16_t* kc = (const bf16_t*)(ws + WS_KC); const bf16_t* mv = (const bf16_t*)(ws + WS_MV); const bf16_t* mo = (const bf16_t*)(ws + WS_MO);
  bf16_t* ym = (bf16_t*)(ws + WS_YA);
  const size_t trow0 = (size_t)b * SEQ + 64 * j;
#pragma unroll
  for (int i = 0; i < 4; ++i) { const int it = tid + 512 * i, which = it >> 10, r = (it >> 4) & 63, ch = it & 15; *(u32x4*)((which ? KCS : QCS) + r * RS + ch * 8) = pr.qk[i]; }
#pragma unroll
  for (int i = 0; i < 8; ++i) { const int it = tid + 512 * i, dir = it >> 11, e = (it >> 4) & 127, ch = it & 15; *(u32x4*)((dir ? CT1 : CT0) + e * RS + ch * 8) = pr.ct[i]; }
  if (tid < 256) { const int dir = tid >> 7, d = tid & 127; (dir ? CT1 : CT0)[128 * RS + d] = f2bf(pr.nu); }
  if (tid < 384) { const int dir = tid / 192, k3 = (tid % 192) >> 6, l = tid & 63; GA[(dir * 3 + k3) * 64 + l] = pr.ga; }
#pragma unroll
  for (int k2 = 0; k2 < 2; ++k2) { const int ch = wave + 8 * k2; const u32x4 v = pr.mvv[k2];
#pragma unroll
    for (int i = 0; i < 4; ++i) { VT[(ch * 8 + 2 * i) * TS + lane] = (bf16_t)(v[i] & 0xffffu); VT[(ch * 8 + 2 * i + 1) * TS + lane] = (bf16_t)(v[i] >> 16); } }
  if (tid < 64) VT[128 * TS + tid] = 0x3f80;
  __syncthreads();
  if (HAS_NEXT) m3_prefetch(un, pr, ws, UT);
  f32x4 g[4];
  {
    bf16x8 qf[4];
#pragma unroll
    for (int ks = 0; ks < 4; ++ks) qf[ks] = *(const bf16x8*)(QCS + (16 * tt + fr) * RS + ks * 32 + fq * 8);
#pragma unroll
    for (int lt = 0; lt < 4; ++lt) { g[lt] = (f32x4){0.f, 0.f, 0.f, 0.f};
#pragma unroll
      for (int ks = 0; ks < 4; ++ks) { const bf16x8 kf = *(const bf16x8*)(KCS + (16 * lt + fr) * RS + ks * 32 + fq * 8);
        g[lt] = __builtin_amdgcn_mfma_f32_16x16x32_bf16(kf, qf[ks], g[lt], 0, 0, 0); } }
  }
  const int etl[5] = {4 * eh, 4 * eh + 1, 4 * eh + 2, 4 * eh + 3, 8};
  float hsum[4][4];
#pragma unroll
  for (int i = 0; i < 4; ++i)
#pragma unroll
    for (int r = 0; r < 4; ++r) hsum[i][r] = 0.f;
#pragma unroll
  for (int dir = 0; dir < 2; ++dir) {
    const float* Pd = GA + (dir * 3 + 0) * 64; const float* Md = GA + (dir * 3 + 1) * 64; const float* Bd = GA + (dir * 3 + 2) * 64;
    const int scan = dir * 8 + bh; const float mc = ((const float*)(ws + WS_GP_MC))[scan * 128 + j];
    const bf16_t* CT = dir ? CT1 : CT0;
    f32x4 acc[5];
#pragma unroll
    for (int i = 0; i < 5; ++i) acc[i] = (f32x4){0.f, 0.f, 0.f, 0.f};
#pragma unroll
    for (int ks = 0; ks < 4; ++ks) { const bf16x8 qf = *(const bf16x8*)(QCS + (16 * tt + fr) * RS + ks * 32 + fq * 8);
#pragma unroll
      for (int i = 0; i < 5; ++i) { const bf16x8 cf = *(const bf16x8*)(CT + (16 * etl[i] + fr) * RS + ks * 32 + fq * 8);
        acc[i] = __builtin_amdgcn_mfma_f32_16x16x32_bf16(qf, cf, acc[i], 0, 0, 0); } }
    float Mt[4], wi[4], emr[4];
#pragma unroll
    for (int r = 0; r < 4; ++r) { const int t = 16 * tt + 4 * fq + r; Mt[r] = fmaxf(mc, Md[t]); wi[r] = __expf(mc - Mt[r]); emr[r] = __expf(-(Bd[t] + Mt[r])); }
#pragma unroll
    for (int i = 0; i < 5; ++i)
#pragma unroll
      for (int r = 0; r < 4; ++r) acc[i][r] *= wi[r];
    const float Mrow = fmaxf(mc, Md[16 * tt + fr]); const int trow = 16 * tt + fr;
    bf16x8 sf[2];
#pragma unroll
    for (int ks = 0; ks < 2; ++ks) { unsigned pw[4];
#pragma unroll
      for (int hh = 0; hh < 2; ++hh) { const int lt = 2 * ks + hh; float sv[4];
#pragma unroll
        for (int r = 0; r < 4; ++r) { const int l = 16 * lt + 4 * fq + r; const bool ok = dir ? (l >= trow) : (l <= trow);
          sv[r] = ok ? g[lt][r] * __expf(Pd[l] - Mrow) : 0.f; }
        pw[2 * hh] = pk2(sv[0], sv[1]); pw[2 * hh + 1] = pk2(sv[2], sv[3]); }
      u32x4 w4 = {pw[0], pw[1], pw[2], pw[3]}; sf[ks] = *(bf16x8*)&w4; }
#pragma unroll
    for (int ks = 0; ks < 2; ++ks)
#pragma unroll
      for (int i = 0; i < 5; ++i) { const bf16_t* vr = VT + (16 * etl[i] + fr) * TS + 32 * ks + 4 * fq;
        const u32x2 lo = *(const u32x2*)vr, hi = *(const u32x2*)(vr + 16); u32x4 w4 = {lo.x, lo.y, hi.x, hi.y};
        acc[i] = __builtin_amdgcn_mfma_f32_16x16x32_bf16(sf[ks], *(bf16x8*)&w4, acc[i], 0, 0, 0); }
#pragma unroll
    for (int r = 0; r < 4; ++r) { const float den = __shfl(acc[4][r], lane & 48); const float inv = __builtin_amdgcn_rcpf(fmaxf(fabsf(den), emr[r]));
#pragma unroll
      for (int i = 0; i < 4; ++i) hsum[i][r] += acc[i][r] * inv; }
  }
#pragma unroll
  for (int r = 0; r < 4; ++r) { float s1 = 0.f, s2 = 0.f;
#pragma unroll
    for (int i = 0; i < 4; ++i) { s1 += hsum[i][r]; s2 += hsum[i][r] * hsum[i][r]; }
#pragma unroll
    for (int o = 1; o < 16; o <<= 1) { s1 += __shfl_xor(s1, o); s2 += __shfl_xor(s2, o); }
    if (fr == 0) { ST[(eh * 64 + 16 * tt + 4 * fq + r) * 2] = s1; ST[(eh * 64 + 16 * tt + 4 * fq + r) * 2 + 1] = s2; } }
  __syncthreads();
  bf16_t* YT = QCS;
#pragma unroll
  for (int r = 0; r < 4; ++r) { const int t = 16 * tt + 4 * fq + r;
    const float s1 = ST[t * 2] + ST[(64 + t) * 2], s2 = ST[t * 2 + 1] + ST[(64 + t) * 2 + 1];
    const float mu = s1 * (1.f / 128.f), var = fmaxf(s2 * (1.f / 128.f) - mu * mu, 0.f), rs = rsqrtf(var + LN_EPS);
#pragma unroll
    for (int i = 0; i < 4; ++i) { const int e = 16 * (4 * eh + i) + fr; YT[t * RS + e] = f2bf((hsum[i][r] - mu) * rs * ng[h * 128 + e]); } }
  __syncthreads();
  for (int it = tid; it < 64 * 16; it += 512) { const int r = it >> 4, ch = it & 15;
    const u32x4 yv = *(const u32x4*)(YT + r * RS + ch * 8); const u32x4 ov = *(const u32x4*)(mo + (trow0 + r) * 512 + h * 128 + ch * 8); u32x4 o;
#pragma unroll
    for (int i = 0; i < 4; ++i) o[i] = pk2(__uint_as_float(yv[i] << 16) * __uint_as_float(ov[i] << 16), __uint_as_float(yv[i] & 0xffff0000u) * __uint_as_float(ov[i] & 0xffff0000u));
    *(u32x4*)(ym + (trow0 + r) * 1024 + 512 + h * 128 + ch * 8) = o; }
  __syncthreads();
}
constexpr int LDS_BYTES = 155648;
__device__ __forceinline__ float compute_lambda(const float* __restrict__ lp, int lane) {
  const float s1 = wave_sum(lp[lane] * lp[64 + lane]), s2 = wave_sum(lp[128 + lane] * lp[192 + lane]);
  return expf(s1) - expf(s2) + LAMBDA_INIT;
}
namespace att {
using f32x16 = __attribute__((ext_vector_type(16))) float;
using s16x4 = __attribute__((ext_vector_type(4))) short;
constexpr int NW = 8, QBLK = 32, KVBLK = 64, LD = 512;
constexpr int SHM_V = KVBLK * 128 * 2, SHM_K = KVBLK * 64 * 2;
constexpr int NSL = 4;
constexpr int SHM_ATTN = NSL * SHM_V + NSL * SHM_K + NW * 64 * 4;
constexpr int ATT_QF = SHM_ATTN;
constexpr int ATT_STG = 0;
constexpr float THR = 8.f;
#define KSWZ64(row, colB) ((row) * 128 + ((colB) ^ ((((row) >> 1) & 7) << 4)))
#define SBAR() __builtin_amdgcn_sched_barrier(0)
__device__ __forceinline__ int crow(int r, int hi) { return (r & 3) + 8 * (r >> 2) + 4 * hi; }
__device__ __forceinline__ unsigned cvtpk(float lo, float hi) { unsigned r; asm volatile("v_cvt_pk_bf16_f32 %0, %1, %2" : "=v"(r) : "v"(lo), "v"(hi)); return r; }
template <bool FIRST> __device__ __forceinline__ void partialSM(f32x16& p0, f32x16& p1, float& m_reg, float& alpha) {
  constexpr float THR2 = THR * 1.4426950408889634f;
  float pmax = p0[0];
#pragma unroll
  for (int r = 1; r < 16; ++r) pmax = fmaxf(pmax, p0[r]);
#pragma unroll
  for (int r = 0; r < 16; ++r) pmax = fmaxf(pmax, p1[r]);
  { auto rr = __builtin_amdgcn_permlane32_swap(__float_as_uint(pmax), __float_as_uint(pmax), false, false);
    pmax = fmaxf(__uint_as_float(rr[0]), __uint_as_float(rr[1])); }
  if (!FIRST && __builtin_expect(__all(pmax <= THR2), 1)) { alpha = 1.f; }
  else { const float dl = FIRST ? pmax : fmaxf(pmax, 0.f); m_reg += dl; alpha = FIRST ? 1.f : __builtin_amdgcn_exp2f(-dl);
#pragma unroll
    for (int r = 0; r < 16; ++r) { p0[r] -= dl; p1[r] -= dl; } }
#pragma unroll
  for (int r = 0; r < 16; ++r) p0[r] = __builtin_amdgcn_exp2f(p0[r]);
}
__device__ __forceinline__ void finishSM(f32x16& p0, f32x16& p1, float alpha, float& l_reg, bf16x8& pa0, bf16x8& pa1, bf16x8& pa2, bf16x8& pa3) {
#pragma unroll
  for (int r = 0; r < 16; ++r) p1[r] = __builtin_amdgcn_exp2f(p1[r]);
  float ps = 0;
#pragma unroll
  for (int r = 0; r < 16; ++r) ps += p0[r];
#pragma unroll
  for (int r = 0; r < 16; ++r) ps += p1[r];
  { auto rr = __builtin_amdgcn_permlane32_swap(__float_as_uint(ps), __float_as_uint(ps), false, false);
    ps = __uint_as_float(rr[0]) + __uint_as_float(rr[1]); }
  l_reg = l_reg * alpha + ps;
#define PK4(P, BASE, OUT) do { unsigned a0 = cvtpk(P[BASE + 0], P[BASE + 1]), a1 = cvtpk(P[BASE + 2], P[BASE + 3]);   \
    unsigned b0 = cvtpk(P[BASE + 4], P[BASE + 5]), b1 = cvtpk(P[BASE + 6], P[BASE + 7]);                              \
    auto r0 = __builtin_amdgcn_permlane32_swap(a0, b0, false, false); auto r1 = __builtin_amdgcn_permlane32_swap(a1, b1, false, false); \
    u32x4 w = {r0[0], r1[0], r0[1], r1[1]}; OUT = *reinterpret_cast<bf16x8*>(&w); } while (0)
  PK4(p0, 0, pa0); PK4(p0, 8, pa1); PK4(p1, 0, pa2); PK4(p1, 8, pa3);
#undef PK4
}
__device__ __forceinline__ void qkt(f32x16& p0, f32x16& p1, const char* Ks, const char* ql, float negm, int r32, int hi) {
#pragma unroll
  for (int r = 0; r < 16; ++r) { p0[r] = negm; p1[r] = negm; }
#pragma unroll
  for (int d0 = 0; d0 < 4; ++d0) { const int cb = (d0 * 16 + hi * 8) * 2;
    const bf16x8 qf = *reinterpret_cast<const bf16x8*>(ql + d0 * 1024);
    const bf16x8 b0 = *reinterpret_cast<const bf16x8*>(Ks + KSWZ64(r32, cb));
    const bf16x8 b1 = *reinterpret_cast<const bf16x8*>(Ks + KSWZ64(32 + r32, cb));
    p0 = __builtin_amdgcn_mfma_f32_32x32x16_bf16(b0, qf, p0, 0, 0, 0);
    p1 = __builtin_amdgcn_mfma_f32_32x32x16_bf16(b1, qf, p1, 0, 0, 0); }
}
__device__ __forceinline__ int v_st(int k, int c) { const int kk = (k & ~0xC) | ((k & 4) << 1) | ((k & 8) >> 1); return ((kk >> 3) * 4 + (c >> 5)) * 512 + ((kk & 7) * 32 + (c & 31)) * 2; }
__device__ __forceinline__ int v_rd_base(int lane) { return ((lane & 3) << 3) | (((lane >> 2) & 3) << 6) | (((lane >> 4) & 1) << 5) | (((lane >> 5) & 1) << 8); }
constexpr int v_rd_off(int d0, int ks, int half) { return d0 * 512 + ks * 4096 + half * 2048; }
template <int OFF> __device__ __forceinline__ s16x4 tr_read(int vb) {
  s16x4 r; asm volatile("ds_read_b64_tr_b16 %0, %1 offset:%2" : "=&v"(r) : "v"(vb), "i"(OFF) : "memory"); return r;
}
#define PKV(L, H) (bf16x8){L[0], L[1], L[2], L[3], H[0], H[1], H[2], H[3]}
#define PV_R(X0, X1, X2, X3, D0, HF) do { X0 = tr_read<v_rd_off(D0, 2 * (HF), 0)>(vb); X1 = tr_read<v_rd_off(D0, 2 * (HF), 1)>(vb); \
    X2 = tr_read<v_rd_off(D0, 2 * (HF) + 1, 0)>(vb); X3 = tr_read<v_rd_off(D0, 2 * (HF) + 1, 1)>(vb); } while (0)
#define PV_M(X0, X1, X2, X3, D0, PA, PB) do { o[D0] = __builtin_amdgcn_mfma_f32_32x32x16_bf16(PA, PKV(X0, X1), o[D0], 0, 0, 0); \
    o[D0] = __builtin_amdgcn_mfma_f32_32x32x16_bf16(PB, PKV(X2, X3), o[D0], 0, 0, 0); } while (0)
#define PV_W(N) do { asm volatile("s_waitcnt lgkmcnt(" #N ")" ::: "memory"); SBAR(); } while (0)
__device__ __forceinline__ void pv_d0(f32x16* o, int vb, bf16x8 pa0, bf16x8 pa1, bf16x8 pa2, bf16x8 pa3) {
  s16x4 a0, a1, a2, a3, b0, b1, b2, b3;
  PV_R(a0, a1, a2, a3, 0, 0); PV_R(b0, b1, b2, b3, 0, 1);
  PV_W(4); PV_M(a0, a1, a2, a3, 0, pa0, pa1); SBAR(); PV_R(a0, a1, a2, a3, 1, 0);
  PV_W(4); PV_M(b0, b1, b2, b3, 0, pa2, pa3); SBAR(); PV_R(b0, b1, b2, b3, 1, 1);
  PV_W(4); PV_M(a0, a1, a2, a3, 1, pa0, pa1); SBAR(); PV_R(a0, a1, a2, a3, 2, 0);
  PV_W(4); PV_M(b0, b1, b2, b3, 1, pa2, pa3); SBAR(); PV_R(b0, b1, b2, b3, 2, 1);
  PV_W(4); PV_M(a0, a1, a2, a3, 2, pa0, pa1); SBAR(); PV_R(a0, a1, a2, a3, 3, 0);
  PV_W(4); PV_M(b0, b1, b2, b3, 2, pa2, pa3); SBAR(); PV_R(b0, b1, b2, b3, 3, 1);
  PV_W(4); PV_M(a0, a1, a2, a3, 3, pa0, pa1); SBAR();
  PV_W(0); PV_M(b0, b1, b2, b3, 3, pa2, pa3);
}
#undef PKV
__device__ __forceinline__ void attn_unit(int bh, int qb, const unsigned char* __restrict__ ws, int unit,
                                          float lam, const float* __restrict__ sg, char* lds) {
  const int tid = threadIdx.x, lane = tid & 63, r32 = lane & 31, hi = lane >> 5;
  const int wid = __builtin_amdgcn_readfirstlane(tid >> 6);
  const int b = bh >> 2, h = bh & 3;
  char* V_lds = lds; char* K_lds = lds + NSL * SHM_V;
  float* wsf = (float*)(lds + NSL * SHM_V + NSL * SHM_K) + wid * 64; float* li_l = wsf; float* al_l = wsf + 32;
  const unsigned row0 = (unsigned)b * SEQ; const int q0 = qb * 256;
  const unsigned char* Vh = ws + WS_V + ((size_t)row0 * LD + h * 128) * 2;
  const int sr = tid >> 4, sc = (tid & 15) * 8, vst0 = v_st(sr, sc);
  constexpr int vst1d = 8192;
  const unsigned voffV = (unsigned)(sr * LD + sc) * 2u, voffK = (unsigned)((tid >> 3) * LD + (tid & 7) * 8) * 2u;
  const int kst = KSWZ64(tid >> 3, (tid & 7) * 16);
  const int vb0 = (int)(uintptr_t)V_lds + v_rd_base(lane);
  constexpr int NT = SEQ / KVBLK;
  constexpr unsigned TILEB = KVBLK * LD * 2;
  for (int mp = 0; mp < 2; ++mp) {
    const unsigned char* Kh = ws + WS_K + ((size_t)row0 * LD + h * 128 + mp * 64) * 2;
    const __amdgpu_buffer_rsrc_t rsK = __builtin_amdgcn_make_buffer_rsrc((void*)Kh, (short)0, SEQ * LD * 2, 0x00020000);
    const __amdgpu_buffer_rsrc_t rsV = __builtin_amdgcn_make_buffer_rsrc((void*)Vh, (short)0, SEQ * LD * 2, 0x00020000);
    float m_reg = 0.f, l_reg = 0; f32x16 o[4] = {};
    char* ql = lds + ATT_QF + wid * 4096 + lane * 16;
    { const unsigned char* Qb = ws + WS_Q + ((size_t)(row0 + q0 + wid * QBLK) * LD + h * 128 + mp * 64) * 2;
      int tq = lane; asm volatile("" : "+v"(tq));
      const unsigned qoff = (unsigned)((tq & 31) * LD + (tq >> 5) * 8) * 2u;
#pragma unroll
      for (int d0 = 0; d0 < 4; ++d0) *reinterpret_cast<bf16x8*>(ql + d0 * 1024) = *reinterpret_cast<const bf16x8*>(Qb + qoff + d0 * 32); }
    struct { bf16x8 vs0, vs1, ks0; } sr_[2];
#define SLOAD(i, t) do { const unsigned so_ = (unsigned)(t) * TILEB; \
    sr_[i].vs0 = __builtin_bit_cast(bf16x8, __builtin_amdgcn_raw_buffer_load_b128(rsV, voffV, so_, 0)); \
    sr_[i].vs1 = __builtin_bit_cast(bf16x8, __builtin_amdgcn_raw_buffer_load_b128(rsV, voffV + 32 * LD * 2, so_, 0)); \
    sr_[i].ks0 = __builtin_bit_cast(bf16x8, __builtin_amdgcn_raw_buffer_load_b128(rsK, voffK, so_, 0)); } while (0)
#define SWRITE(bb, i) do { *(bf16x8*)(V_lds + (bb) * SHM_V + vst0) = sr_[i].vs0; *(bf16x8*)(V_lds + (bb) * SHM_V + vst0 + vst1d) = sr_[i].vs1; \
    *(bf16x8*)(K_lds + (bb) * SHM_K + kst) = sr_[i].ks0; } while (0)
#define SWAIT() asm volatile("s_waitcnt vmcnt(3)" ::: "memory")
#define RESC(a) do { if (__any((a) < 1.f)) { if (hi == 0) al_l[r32] = (a); asm volatile("s_waitcnt lgkmcnt(0)" ::: "memory"); \
    _Pragma("unroll") for (int d = 0; d < 4; ++d) _Pragma("unroll") for (int r = 0; r < 16; ++r) o[d][r] *= al_l[crow(r, hi)]; } } while (0)
    f32x16 pA0, pA1, pB0, pB1; float alA, alB; bf16x8 pa0, pa1, pa2, pa3;
    int s_pp = 0, s_prev = 0, s_cur = 1, s_next = 2;
#define ROT() do { s_pp = s_prev; s_prev = s_cur; s_cur = s_next; s_next = (s_next + 1) & (NSL - 1); } while (0)
    SLOAD(0, 0); asm volatile("s_waitcnt vmcnt(0)" ::: "memory"); SWRITE(0, 0); __syncthreads();
    if (wid < 4) {
      qkt(pA0, pA1, K_lds, ql, -m_reg, r32, hi); partialSM<true>(pA0, pA1, m_reg, alA);
      SLOAD(1, 1); SLOAD(0, 2);
      SWAIT(); SWRITE(1, 1); __syncthreads();
      for (int j = 1; j + 1 < NT; j += 2) {
        SBAR(); qkt(pB0, pB1, K_lds + s_cur * SHM_K, ql, -m_reg, r32, hi);
        finishSM(pA0, pA1, alA, l_reg, pa0, pa1, pa2, pa3); SBAR();
        SLOAD(1, j + 2); SBAR();
        pv_d0(o, vb0 + s_prev * SHM_V, pa0, pa1, pa2, pa3); partialSM<false>(pB0, pB1, m_reg, alB);
        SWAIT(); SWRITE(s_next, 0);
        RESC(alB); __syncthreads(); ROT();
        SBAR(); qkt(pA0, pA1, K_lds + s_cur * SHM_K, ql, -m_reg, r32, hi);
        finishSM(pB0, pB1, alB, l_reg, pa0, pa1, pa2, pa3); SBAR();
        if (j + 3 < NT) SLOAD(0, j + 3); SBAR();
        pv_d0(o, vb0 + s_prev * SHM_V, pa0, pa1, pa2, pa3); partialSM<false>(pA0, pA1, m_reg, alA);
        SWAIT(); SWRITE(s_next, 1);
        RESC(alA); __syncthreads(); ROT();
      }
      SBAR(); qkt(pB0, pB1, K_lds + s_cur * SHM_K, ql, -m_reg, r32, hi);
      finishSM(pA0, pA1, alA, l_reg, pa0, pa1, pa2, pa3); SBAR();
      pv_d0(o, vb0 + s_prev * SHM_V, pa0, pa1, pa2, pa3); partialSM<false>(pB0, pB1, m_reg, alB);
      RESC(alB);
      finishSM(pB0, pB1, alB, l_reg, pa0, pa1, pa2, pa3); SBAR();
      pv_d0(o, vb0 + s_cur * SHM_V, pa0, pa1, pa2, pa3);
    } else {
      qkt(pA0, pA1, K_lds, ql, -m_reg, r32, hi);
      SLOAD(1, 1); SLOAD(0, 2);
      SWAIT(); SWRITE(1, 1); __syncthreads();
      SBAR(); partialSM<true>(pA0, pA1, m_reg, alA);
      SBAR(); SLOAD(1, 3); SBAR();
      qkt(pB0, pB1, K_lds + s_cur * SHM_K, ql, -m_reg, r32, hi);
      finishSM(pA0, pA1, alA, l_reg, pa0, pa1, pa2, pa3); SBAR();
      SWAIT(); SWRITE(s_next, 0);
      __syncthreads(); ROT();
      for (int j = 2; j + 2 < NT; j += 2) {
        SBAR(); pv_d0(o, vb0 + s_pp * SHM_V, pa0, pa1, pa2, pa3); partialSM<false>(pB0, pB1, m_reg, alB); RESC(alB);
        SBAR(); SLOAD(0, j + 2); SBAR();
        qkt(pA0, pA1, K_lds + s_cur * SHM_K, ql, -m_reg, r32, hi);
        finishSM(pB0, pB1, alB, l_reg, pa0, pa1, pa2, pa3); SBAR();
        SWAIT(); SWRITE(s_next, 1);
        __syncthreads(); ROT();
        SBAR(); pv_d0(o, vb0 + s_pp * SHM_V, pa0, pa1, pa2, pa3); partialSM<false>(pA0, pA1, m_reg, alA); RESC(alA);
        SBAR(); SLOAD(1, j + 3); SBAR();
        qkt(pB0, pB1, K_lds + s_cur * SHM_K, ql, -m_reg, r32, hi);
        finishSM(pA0, pA1, alA, l_reg, pa0, pa1, pa2, pa3); SBAR();
        SWAIT(); SWRITE(s_next, 0);
        __syncthreads(); ROT();
      }
      SBAR(); pv_d0(o, vb0 + s_pp * SHM_V, pa0, pa1, pa2, pa3); partialSM<false>(pB0, pB1, m_reg, alB); RESC(alB);
      SBAR(); qkt(pA0, pA1, K_lds + s_cur * SHM_K, ql, -m_reg, r32, hi);
      finishSM(pB0, pB1, alB, l_reg, pa0, pa1, pa2, pa3); SBAR();
      SWAIT(); SWRITE(s_next, 1);
      __syncthreads(); ROT();
      SBAR(); pv_d0(o, vb0 + s_pp * SHM_V, pa0, pa1, pa2, pa3); partialSM<false>(pA0, pA1, m_reg, alA); RESC(alA);
      SBAR(); qkt(pB0, pB1, K_lds + s_cur * SHM_K, ql, -m_reg, r32, hi);
      finishSM(pA0, pA1, alA, l_reg, pa0, pa1, pa2, pa3); SBAR();
      pv_d0(o, vb0 + s_prev * SHM_V, pa0, pa1, pa2, pa3); partialSM<false>(pB0, pB1, m_reg, alB); RESC(alB);
      finishSM(pB0, pB1, alB, l_reg, pa0, pa1, pa2, pa3); SBAR();
      pv_d0(o, vb0 + s_cur * SHM_V, pa0, pa1, pa2, pa3);
    }
#undef ROT
    __syncthreads();
    if (hi == 0) li_l[r32] = l_reg; asm volatile("s_waitcnt lgkmcnt(0)" ::: "memory");
    float rli[16];
#pragma unroll
    for (int r = 0; r < 16; ++r) rli[r] = __builtin_amdgcn_rcpf(li_l[crow(r, hi)]);
    int t2 = tid; asm volatile("" : "+v"(t2));
    const int lane2 = t2 & 63, wid2 = __builtin_amdgcn_readfirstlane(t2 >> 6);
    f32x4* st = (f32x4*)((unsigned char*)ws + WS_O0) + ((size_t)unit * 512 + t2) * 16;
    if (mp == 0) {
#pragma unroll
      for (int d0 = 0; d0 < 4; ++d0)
#pragma unroll
        for (int r4 = 0; r4 < 4; ++r4) st[d0 * 4 + r4] = (f32x4){o[d0][4 * r4] * rli[4 * r4], o[d0][4 * r4 + 1] * rli[4 * r4 + 1], o[d0][4 * r4 + 2] * rli[4 * r4 + 2], o[d0][4 * r4 + 3] * rli[4 * r4 + 3]};
    } else {
      float ss[16];
#pragma unroll
      for (int r = 0; r < 16; ++r) ss[r] = 0.f;
#pragma unroll
      for (int d0 = 0; d0 < 4; ++d0)
#pragma unroll
        for (int r4 = 0; r4 < 4; ++r4) { const f32x4 o0 = st[d0 * 4 + r4];
#pragma unroll
          for (int i = 0; i < 4; ++i) { const int r = 4 * r4 + i; const float v = o0[i] - lam * (o[d0][r] * rli[r]); o[d0][r] = v; ss[r] += v * v; } }
#pragma unroll
      for (int r = 0; r < 16; ++r) {
#pragma unroll
        for (int of = 1; of < 32; of <<= 1) ss[r] += __shfl_xor(ss[r], of);
        ss[r] = rsqrtf(ss[r] * (1.f / 128.f) + LN_EPS) * (1.f - LAMBDA_INIT); }
      bf16_t* stg = (bf16_t*)(lds + ATT_STG + wid2 * 8704);
      const int r32b = lane2 & 31, hib = lane2 >> 5;
#pragma unroll
      for (int d0 = 0; d0 < 4; ++d0) { const float g = sg[d0 * 32 + r32b];
#pragma unroll
        for (int r = 0; r < 16; ++r) stg[crow(r, hib) * 136 + d0 * 32 + r32b] = f2bf(o[d0][r] * ss[r] * g); }
      asm volatile("s_waitcnt lgkmcnt(0)" ::: "memory");
      const int orow = lane2 >> 1, oh = lane2 & 1;
      bf16_t* yw = (bf16_t*)((unsigned char*)ws + WS_YA) + ((size_t)(row0 + q0 + wid2 * QBLK + orow) * 1024 + h * 128 + oh * 64);
#pragma unroll
      for (int i = 0; i < 8; ++i) *(u32x4*)(yw + i * 8) = *(const u32x4*)(stg + orow * 136 + oh * 64 + i * 8);
    }
    __syncthreads();
#undef SLOAD
#undef SWRITE
#undef SWAIT
#undef RESC
  }
}
#undef SBAR
}
__device__ __forceinline__ void ph_ln1(int bid, int nb, float* __restrict__ x1, const float* __restrict__ g, const float* __restrict__ bb, bf16_t* __restrict__ x1b) {
  const int lane = threadIdx.x & 63;
  for (int t0 = (bid * 8 + (threadIdx.x >> 6)) * 2; t0 < T; t0 += nb * 16) {
    float4 v[2][4]; float s[2] = {0.f, 0.f};
#pragma unroll
    for (int r = 0; r < 2; ++r) { const float4* xr = (const float4*)(x1 + (size_t)(t0 + r) * DM);
#pragma unroll
      for (int j = 0; j < 4; ++j) { v[r][j] = xr[lane + 64 * j]; s[r] += (v[r][j].x + v[r][j].y) + (v[r][j].z + v[r][j].w); } }
#pragma unroll
    for (int r = 0; r < 2; ++r) {
      const float mu = wave_sum(s[r]) * (1.f / DM); float q = 0.f;
#pragma unroll
      for (int j = 0; j < 4; ++j) { v[r][j].x -= mu; v[r][j].y -= mu; v[r][j].z -= mu; v[r][j].w -= mu; q += (v[r][j].x * v[r][j].x + v[r][j].y * v[r][j].y) + (v[r][j].z * v[r][j].z + v[r][j].w * v[r][j].w); }
      const float rs = rsqrtf(wave_sum(q) * (1.f / DM) + LN_EPS);
      float4* xo = (float4*)(x1 + (size_t)(t0 + r) * DM);
#pragma unroll
      for (int j = 0; j < 4; ++j) { const float4 gg = ((const float4*)g)[lane + 64 * j], b4 = ((const float4*)bb)[lane + 64 * j];
        float4 o; o.x = v[r][j].x * rs * gg.x + b4.x; o.y = v[r][j].y * rs * gg.y + b4.y; o.z = v[r][j].z * rs * gg.z + b4.z; o.w = v[r][j].w * rs * gg.w + b4.w;
        xo[lane + 64 * j] = o; u32x2 w; w.x = pk2(o.x, o.y); w.y = pk2(o.z, o.w); *(u32x2*)(x1b + (size_t)(t0 + r) * DM + 4 * (lane + 64 * j)) = w; }
    }
  }
}

constexpr size_t WS_TU8 = 128 * MB, WS_SU = 160 * MB, WS_SV = 160 * MB + 65536;
constexpr int REC6 = 1280;
typedef float f32x2v __attribute__((ext_vector_type(2)));
__device__ __forceinline__ unsigned f2ord(float f) { const unsigned u = __float_as_uint(f); return (u & 0x80000000u) ? ~u : (u | 0x80000000u); }
__device__ __forceinline__ float ord2f(unsigned o) { const unsigned u = (o & 0x80000000u) ? (o & 0x7fffffffu) : ~o; return __uint_as_float(u); }
template <int CTRL, int RM> __device__ __forceinline__ float dppf(float s) { return __uint_as_float(__builtin_amdgcn_update_dpp(0u, __float_as_uint(s), CTRL, RM, 0xf, true)); }
__device__ __forceinline__ float readlane_f(float v, int l) { return __uint_as_float((unsigned)__builtin_amdgcn_readlane((int)__float_as_uint(v), l)); }
__device__ __forceinline__ float wave_sum63(float v) {
  v += dppf<0xB1, 0xf>(v); v += dppf<0x4E, 0xf>(v); v += dppf<0x141, 0xf>(v); v += dppf<0x140, 0xf>(v);
  v += dppf<0x142, 0xA>(v); v += dppf<0x143, 0xC>(v);
  return v;
}
__device__ __forceinline__ float gelu_erf(float v) {
  const float t = __builtin_amdgcn_rcpf(fabsf(v) * 0.2316418882f + 1.0f);
  float q = t * 0.5307027145f + (-0.7265760135f); q = q * t + 0.7107068705f; q = q * t + (-0.142248368f); q = q * t + 0.127414796f; q = q * t;
  const float m = v * (q * __builtin_amdgcn_exp2f((v * v) * (-0.72134752044f)));
  return v < 0.f ? m : v - m;
}
__device__ __forceinline__ unsigned fp6_code(float a) {
  const float m = fabsf(a);
  const float c = m < 2.f ? __builtin_rintf(m * 8.f) : (m < 4.f ? __builtin_rintf(m * 4.f) + 8.f : __builtin_rintf(m * 2.f) + 16.f);
  const unsigned code = (unsigned)fminf(c, 31.f);
  return a < 0.f ? (code | 32u) : code;
}
struct U3 { unsigned x, y, z; };
__device__ __forceinline__ U3 fp6_pack16(const float4 (&v)[4], float inv) {
  unsigned f[16];
#pragma unroll
  for (int c = 0; c < 4; ++c) { f[4 * c] = fp6_code(v[c].x * inv); f[4 * c + 1] = fp6_code(v[c].y * inv); f[4 * c + 2] = fp6_code(v[c].z * inv); f[4 * c + 3] = fp6_code(v[c].w * inv); }
  U3 o;
  o.x = f[0] | (f[1] << 6) | (f[2] << 12) | (f[3] << 18) | (f[4] << 24) | (f[5] << 30);
  o.y = (f[5] >> 2) | (f[6] << 4) | (f[7] << 10) | (f[8] << 16) | (f[9] << 22) | (f[10] << 28);
  o.z = (f[10] >> 4) | (f[11] << 2) | (f[12] << 8) | (f[13] << 14) | (f[14] << 20) | (f[15] << 26);
  return o;
}
__device__ __forceinline__ unsigned fp4_code(float a) {
  const float m = fabsf(a);
  const float c = m < 2.f ? __builtin_rintf(m * 2.f) : (m < 4.f ? __builtin_rintf(m) + 2.f : __builtin_rintf(m * 0.5f) + 4.f);
  const unsigned code = (unsigned)fminf(c, 7.f);
  return a < 0.f ? (code | 8u) : code;
}
__device__ __forceinline__ u32x2 fp4_pack16(const float4 (&v)[4], float inv) {
  u32x2 o; o.x = 0u; o.y = 0u;
#pragma unroll
  for (int c = 0; c < 4; ++c) { const unsigned h = fp4_code(v[c].x * inv) | (fp4_code(v[c].y * inv) << 4) | (fp4_code(v[c].z * inv) << 8) | (fp4_code(v[c].w * inv) << 12);
    if (c < 2) o.x |= h << (16 * c); else o.y |= h << (16 * (c - 2)); }
  return o;
}
__device__ __forceinline__ void ph_ln1_tab8(int bid, int nb, float* __restrict__ x1, const float* __restrict__ g, const float* __restrict__ bb, bf16_t* __restrict__ x1b,
                                            const float* __restrict__ pu, const float* __restrict__ pv, unsigned char* ws) {
  const int lane = threadIdx.x & 63, gw = bid * 8 + (threadIdx.x >> 6), ngw = nb * 8;
  int t0 = gw * 2, r4 = gw * 4;
  for (; t0 < T || r4 < 32768; t0 += ngw * 2, r4 += ngw * 4) {
    const bool do_ln = t0 < T, do_tb = r4 < 32768;
    float4 v[2][4], va[4][4];
    if (do_ln) {
#pragma unroll
      for (int r = 0; r < 2; ++r) { const u32x2* xr = (const u32x2*)((const bf16_t*)x1 + (size_t)(t0 + r) * DM);
#pragma unroll
        for (int j = 0; j < 4; ++j) { const u32x2 a = xr[lane + 64 * j]; v[r][j] = make_float4(__uint_as_float(a.x << 16), __uint_as_float(a.x & 0xffff0000u), __uint_as_float(a.y << 16), __uint_as_float(a.y & 0xffff0000u)); } } }
    if (do_tb) {
#pragma unroll
      for (int i = 0; i < 4; ++i) { const int r = r4 + i, which = r >> 14, row = r & 16383; const float4* src = (const float4*)((which ? pv : pu) + (size_t)row * DM) + 128 * (lane & 1) + (lane >> 1);
#pragma unroll
        for (int c = 0; c < 4; ++c) va[i][c] = src[32 * c]; } }
    if (do_ln) {
#pragma unroll
      for (int r = 0; r < 2; ++r) { float sm = 0.f;
#pragma unroll
        for (int j = 0; j < 4; ++j) sm += (v[r][j].x + v[r][j].y) + (v[r][j].z + v[r][j].w);
        const float mu = wave_sum(sm) * (1.f / DM); float q = 0.f;
#pragma unroll
        for (int j = 0; j < 4; ++j) { v[r][j].x -= mu; v[r][j].y -= mu; v[r][j].z -= mu; v[r][j].w -= mu; q += (v[r][j].x * v[r][j].x + v[r][j].y * v[r][j].y) + (v[r][j].z * v[r][j].z + v[r][j].w * v[r][j].w); }
        const float rs = rsqrtf(wave_sum(q) * (1.f / DM) + LN_EPS);
#pragma unroll
        for (int j = 0; j < 4; ++j) { const float4 gg = ((const float4*)g)[lane + 64 * j], b4 = ((const float4*)bb)[lane + 64 * j];
          float4 o; o.x = v[r][j].x * rs * gg.x + b4.x; o.y = v[r][j].y * rs * gg.y + b4.y; o.z = v[r][j].z * rs * gg.z + b4.z; o.w = v[r][j].w * rs * gg.w + b4.w;
          u32x2 w; w.x = pk2(o.x, o.y); w.y = pk2(o.z, o.w); *(u32x2*)(x1b + (size_t)(t0 + r) * DM + 4 * (lane + 64 * j)) = w; } } }
    if (do_tb) {
#pragma unroll
      for (int i = 0; i < 4; ++i) { const int r = r4 + i, which = r >> 14, row = r & 16383;
        float mx = 0.f;
#pragma unroll
        for (int c = 0; c < 4; ++c) mx = fmaxf(mx, fmaxf(fmaxf(fabsf(va[i][c].x), fabsf(va[i][c].y)), fmaxf(fabsf(va[i][c].z), fabsf(va[i][c].w))));
        mx = wave_max(mx);
        const float scale = fmaxf(mx, 1e-30f) * (which ? 1.f / 7.5f : 1.f / 6.f), inv = 1.f / scale;
        if (which == 0) *(u32x2*)(ws + WS_TU8 + (size_t)row * REC6 + 8 * lane) = fp4_pack16(va[i], inv);
        else { const U3 o = fp6_pack16(va[i], inv); unsigned char* rec = ws + WS_TU8 + (size_t)row * REC6 + 512;
          if ((lane & 1) == 0) *(U3*)(rec + 16 * (lane >> 1)) = o;
          else { *(unsigned*)(rec + 16 * (lane >> 1) + 12) = o.x; u32x2 q; q.x = o.y; q.y = o.z; *(u32x2*)(rec + 512 + 8 * (lane >> 1)) = q; } }
        if (lane == 0) ((float*)(ws + (which ? WS_SV : WS_SU)))[row] = scale; } }
  }
}
#define CE_D(a, b) do { const unsigned hi_ = (a) > (b) ? (a) : (b), lo_ = (a) > (b) ? (b) : (a); (a) = hi_; (b) = lo_; } while (0)
__device__ __forceinline__ void merge16_desc(unsigned* m) {
#pragma unroll
  for (int j = 8; j > 0; j >>= 1)
#pragma unroll
    for (int i = 0; i < 16; ++i) { const int l = i ^ j; if (l > i) CE_D(m[i], m[l]); }
}
__device__ __forceinline__ void sort16_desc(unsigned* k) {
#pragma unroll
  for (int kk = 2; kk <= 16; kk <<= 1)
#pragma unroll
    for (int j = kk >> 1; j > 0; j >>= 1)
#pragma unroll
      for (int i = 0; i < 16; ++i) { const int l = i ^ j; if (l > i) { if ((i & kk) == 0) CE_D(k[i], k[l]); else CE_D(k[l], k[i]); } }
}
__device__ __forceinline__ void top16_of_64(unsigned* k, unsigned* out) {
  sort16_desc(k); sort16_desc(k + 16); sort16_desc(k + 32); sort16_desc(k + 48);
  unsigned m1[16];
#pragma unroll
  for (int i = 0; i < 16; ++i) { out[i] = k[i] > k[31 - i] ? k[i] : k[31 - i]; m1[i] = k[32 + i] > k[63 - i] ? k[32 + i] : k[63 - i]; }
  merge16_desc(out); merge16_desc(m1);
#pragma unroll
  for (int i = 0; i < 16; ++i) out[i] = out[i] > m1[15 - i] ? out[i] : m1[15 - i];
  merge16_desc(out);
}
constexpr int pairs_before(int r, int c) { int n = 0; for (int rr = 0; rr < 16; ++rr) for (int cc = 0; cc < 16; ++cc) { if (rr == r && cc == c) return n; if ((rr + 1) * (cc + 1) <= 16) ++n; } return n; }
constexpr int PEER_TB = 32;
constexpr int PL_SK = 0, PL_LIST = 2 * 128 * 136 * 2, PL_LBUF = PEER_TB * 128 * 8, PL_IDX = PL_LIST + 2 * PL_LBUF;
__device__ __forceinline__ void peer_select_tile(int t0, int lb, unsigned char* lds, const bf16_t* __restrict__ qp) {
  using f32x16 = att::f32x16;
  int lane = threadIdx.x & 63; asm volatile("" : "+v"(lane));
  const int r32 = lane & 31, hi = lane >> 5, h = __builtin_amdgcn_readfirstlane(threadIdx.x >> 6);
  const bf16_t* SK = (const bf16_t*)(lds + PL_SK);
  unsigned top[2][16];
#pragma unroll
  for (int p = 0; p < 2; ++p) {
    f32x16 acc[4] = {};
    const bf16_t* qrow = qp + (size_t)(t0 + r32) * 2048 + h * 256 + p * 128 + hi * 8;
    bf16x8 qf[8];
#pragma unroll
    for (int ks = 0; ks < 8; ++ks) qf[ks] = *(const bf16x8*)(qrow + ks * 16);
#pragma unroll
    for (int ks = 0; ks < 8; ++ks) {
#pragma unroll
      for (int nt = 0; nt < 4; ++nt) { const bf16x8 kf = *(const bf16x8*)(SK + (p * 128 + nt * 32 + r32) * 136 + ks * 16 + hi * 8);
        acc[nt] = __builtin_amdgcn_mfma_f32_32x32x16_bf16(kf, qf[ks], acc[nt], 0, 0, 0); }
      __builtin_amdgcn_sched_barrier(0); }
    unsigned k[64];
#pragma unroll
    for (int nt = 0; nt < 4; ++nt)
#pragma unroll
      for (int r = 0; r < 16; ++r) k[nt * 16 + r] = (f2ord(acc[nt][r]) & 0xffffff80u) | (unsigned)(nt * 32 + (r & 3) + 8 * (r >> 2) + 4 * hi);
    unsigned own[16]; top16_of_64(k, own);
    unsigned X[16], Y[16];
#pragma unroll
    for (int i = 0; i < 16; ++i) { auto rr = __builtin_amdgcn_permlane32_swap(own[i], own[i], false, false); X[i] = rr[0]; Y[i] = rr[1]; }
#pragma unroll
    for (int i = 0; i < 16; ++i) top[p][i] = X[i] > Y[15 - i] ? X[i] : Y[15 - i];
    merge16_desc(top[p]);
  }
  float sa[16], sb[16];
#pragma unroll
  for (int i = 0; i < 16; ++i) { sa[i] = ord2f(top[0][i] & 0xffffff80u); sb[i] = ord2f(top[1][i] & 0xffffff80u); }
  unsigned ck[64];
#pragma unroll
  for (int i = 0; i < 64; ++i) ck[i] = 0u;
#pragma unroll
  for (int r = 0; r < 16; ++r)
#pragma unroll
    for (int c = 0; c < 16; ++c) if ((r + 1) * (c + 1) <= 16) ck[pairs_before(r, c)] = (f2ord(sa[r] + sb[c]) & 0xffffff00u) | (unsigned)(r * 16 + c);
  unsigned win[16]; top16_of_64(ck, win);
  unsigned char* slot = lds + PL_IDX + ((threadIdx.x >> 6) * 32 + r32) * 32;
  u32x4 ia, ib;
#pragma unroll
  for (int q4 = 0; q4 < 4; ++q4) { ia[q4] = (top[0][4 * q4] & 127u) | ((top[0][4 * q4 + 1] & 127u) << 8) | ((top[0][4 * q4 + 2] & 127u) << 16) | ((top[0][4 * q4 + 3] & 127u) << 24);
    ib[q4] = (top[1][4 * q4] & 127u) | ((top[1][4 * q4 + 1] & 127u) << 8) | ((top[1][4 * q4 + 2] & 127u) << 16) | ((top[1][4 * q4 + 3] & 127u) << 24); }
  *(u32x4*)slot = ia; *(u32x4*)(slot + 16) = ib;
  asm volatile("s_waitcnt lgkmcnt(0)" ::: "memory");
  const float s0 = ord2f(win[0] & 0xffffff00u);
  float ex[16], sum = 0.f; int ee[16];
#pragma unroll
  for (int j = 0; j < 16; ++j) { const unsigned pr = (win[j] >> 4) & 15u, pc = win[j] & 15u;
    ee[j] = (int)slot[pr] * 128 + (int)slot[16 + pc];
    ex[j] = __expf(ord2f(win[j] & 0xffffff00u) - s0); sum += ex[j]; }
  const float inv = 1.f / sum;
  if (hi == 0) { u32x2* L = (u32x2*)(lds + PL_LIST + lb * PL_LBUF) + r32 * 128 + h * 16;
#pragma unroll
    for (int j = 0; j < 16; ++j) L[j] = (u32x2){(unsigned)ee[j], __float_as_uint(ex[j] * inv)}; }
}
typedef unsigned u32x6 __attribute__((ext_vector_type(6)));
typedef float f32x32 __attribute__((ext_vector_type(32)));
typedef __bf16 bf16x32v __attribute__((ext_vector_type(32)));
typedef __bf16 bf16x2v __attribute__((ext_vector_type(2)));
__device__ __forceinline__ float half_sum(float v, bool hi) {
  v += dppf<0xB1, 0xf>(v); v += dppf<0x4E, 0xf>(v); v += dppf<0x141, 0xf>(v); v += dppf<0x140, 0xf>(v); v += dppf<0x142, 0xA>(v);
  const float a = readlane_f(v, 31), b = readlane_f(v, 63); return hi ? b : a;
}
__device__ __forceinline__ void peer_expert_tok2(int t0, int tl, int lb, unsigned char* lds, const unsigned char* __restrict__ ws, float* __restrict__ x1io, const float* __restrict__ g2, const float* __restrict__ b2) {
  int lane = threadIdx.x & 63; asm volatile("" : "+v"(lane));
  const int li = lane & 31; const bool hi = lane >= 32;
  const int t = t0 + tl + (hi ? 1 : 0);
  unsigned xu[16]; float y[32];
  { const bf16_t* xbr = (const bf16_t*)(ws + WS_X1B) + (size_t)t * DM + li * 4;
#pragma unroll
    for (int c = 0; c < 8; ++c) { const u32x2 a = *(const u32x2*)(xbr + 128 * c); xu[2 * c] = a.x; xu[2 * c + 1] = a.y; } }
#pragma unroll
  for (int i = 0; i < 32; ++i) y[i] = 0.f;
  const __amdgpu_buffer_rsrc_t rsT = __builtin_amdgcn_make_buffer_rsrc((void*)(ws + WS_TU8), (short)0, 16384 * REC6, 0x00020000);
  const int voP0 = li * 16, voQ0 = 512 + li * 8;
  const float* SU = (const float*)(ws + WS_SU); const float* SV = (const float*)(ws + WS_SV);
  u32x2* SORT = (u32x2*)(lds + PL_IDX) + (threadIdx.x >> 6) * 256;
#pragma unroll
  for (int hh = 0; hh < 2; ++hh) { const u32x2* Lraw = (const u32x2*)(lds + PL_LIST + lb * PL_LBUF) + (tl + hh) * 128;
    const u32x2 p0 = Lraw[2 * lane], p1 = Lraw[2 * lane + 1];
    const int b0 = (int)(p0.x >> 10), b1 = (int)(p1.x >> 10);
    int base = 0, pos0 = 0, pos1 = 0;
#pragma unroll
    for (int v = 0; v < 16; ++v) {
      const unsigned long long m0 = __ballot(b0 == v), m1 = __ballot(b1 == v);
      const int c0 = __builtin_popcountll(m0), c1 = __builtin_popcountll(m1);
      const int r0 = __builtin_amdgcn_mbcnt_hi((unsigned)(m0 >> 32), __builtin_amdgcn_mbcnt_lo((unsigned)m0, 0u));
      const int r1 = __builtin_amdgcn_mbcnt_hi((unsigned)(m1 >> 32), __builtin_amdgcn_mbcnt_lo((unsigned)m1, 0u));
      if (b0 == v) pos0 = base + r0;
      if (b1 == v) pos1 = base + c0 + r1;
      base += c0 + c1; }
    SORT[2 * pos0 + hh] = p0; SORT[2 * pos1 + hh] = p1; }
  asm volatile("s_waitcnt lgkmcnt(0)" ::: "memory");
  const u32x2* L = SORT;
  constexpr int PGS = 4, NPR = PGS / 2, NG = 256 / PGS;
#define PG_LOAD(UP, VP, VQ, EL, GL, SUv, SVv, hg) do { const u32x2 eg_ = L[(hg) * PGS + (lane & (PGS - 1))]; EL = (int)eg_.x; GL = __uint_as_float(eg_.y); SUv = SU[EL]; SVv = SV[EL]; \
    _Pragma("unroll") for (int pr = 0; pr < NPR; ++pr) { const int eb_ = (int)L[(hg) * PGS + 2 * pr + (hi ? 1 : 0)].x * REC6; \
      UP[pr] = __builtin_amdgcn_raw_buffer_load_b128(rsT, eb_ + voP0, 0, 0); \
      VP[pr] = __builtin_amdgcn_raw_buffer_load_b128(rsT, eb_ + voP0 + 512, 0, 0); VQ[pr] = __builtin_amdgcn_raw_buffer_load_b64(rsT, eb_ + voQ0 + 512, 0, 0); } } while (0)
#define PG_COMP(UP, VP, VQ, GL, SUv, SVv) do { float dd_ = 0.f; \
    _Pragma("unroll") for (int pr = 0; pr < NPR; ++pr) { \
      float d0_ = 0.f, d1_ = 0.f; \
      _Pragma("unroll") for (int w4 = 0; w4 < 4; ++w4) {     \
        d0_ = __builtin_amdgcn_fdot2_f32_bf16(__builtin_amdgcn_cvt_scalef32_pk_bf16_fp4(UP[pr][w4], 1.0f, 0), __builtin_bit_cast(bf16x2v, xu[4 * w4]), d0_, false); \
        d1_ = __builtin_amdgcn_fdot2_f32_bf16(__builtin_amdgcn_cvt_scalef32_pk_bf16_fp4(UP[pr][w4], 1.0f, 1), __builtin_bit_cast(bf16x2v, xu[4 * w4 + 1]), d1_, false); \
        d0_ = __builtin_amdgcn_fdot2_f32_bf16(__builtin_amdgcn_cvt_scalef32_pk_bf16_fp4(UP[pr][w4], 1.0f, 2), __builtin_bit_cast(bf16x2v, xu[4 * w4 + 2]), d0_, false); \
        d1_ = __builtin_amdgcn_fdot2_f32_bf16(__builtin_amdgcn_cvt_scalef32_pk_bf16_fp4(UP[pr][w4], 1.0f, 3), __builtin_bit_cast(bf16x2v, xu[4 * w4 + 3]), d1_, false); } \
      d0_ += d1_; d0_ += dppf<0xB1, 0xf>(d0_); d0_ += dppf<0x4E, 0xf>(d0_); d0_ += dppf<0x141, 0xf>(d0_); d0_ += dppf<0x140, 0xf>(d0_); d0_ += dppf<0x142, 0xA>(d0_);     \
      const float t0_ = readlane_f(d0_, 31), t1_ = readlane_f(d0_, 63); if (lane == 2 * pr) dd_ = t0_; if (lane == 2 * pr + 1) dd_ = t1_; } \
    const float av_ = dd_ * SUv; const float wl_ = GL * gelu_erf(av_) * SVv; \
    _Pragma("unroll") for (int pr = 0; pr < NPR; ++pr) { const float w0_ = readlane_f(wl_, 2 * pr), w1_ = readlane_f(wl_, 2 * pr + 1); const float w_ = hi ? w1_ : w0_; \
      const u32x6 vv_ = {VP[pr].x, VP[pr].y, VP[pr].z, VP[pr].w, VQ[pr].x, VQ[pr].y}; \
      const f32x32 vf_ = __builtin_amdgcn_cvt_scalef32_pk32_f32_fp6(vv_, 1.0f); \
      _Pragma("unroll") for (int i = 0; i < 32; ++i) y[i] = __builtin_fmaf(w_, vf_[i], y[i]); \
      __builtin_amdgcn_sched_barrier(0); } } while (0)
  {
    u32x4 upA[NPR], vpA[NPR], upB[NPR], vpB[NPR]; u32x2 vqA[NPR], vqB[NPR]; int elA, elB; float glA, glB, suA, suB, svA, svB;
    PG_LOAD(upA, vpA, vqA, elA, glA, suA, svA, 0);
    for (int hg = 0; hg < NG - 2; hg += 2) {
      PG_LOAD(upB, vpB, vqB, elB, glB, suB, svB, hg + 1);
      PG_COMP(upA, vpA, vqA, glA, suA, svA);
      PG_LOAD(upA, vpA, vqA, elA, glA, suA, svA, hg + 2);
      PG_COMP(upB, vpB, vqB, glB, suB, svB);
    }
    PG_LOAD(upB, vpB, vqB, elB, glB, suB, svB, NG - 1);
    PG_COMP(upA, vpA, vqA, glA, suA, svA);
    PG_COMP(upB, vpB, vqB, glB, suB, svB);
  }
#undef PG_LOAD
#undef PG_COMP
  float s = 0.f;
#pragma unroll
  for (int i = 0; i < 16; ++i) { y[2 * i] = ALPHA * __uint_as_float(xu[i] << 16) + y[2 * i]; y[2 * i + 1] = ALPHA * __uint_as_float(xu[i] & 0xffff0000u) + y[2 * i + 1]; s += y[2 * i] + y[2 * i + 1]; }
  const float mu = half_sum(s, hi) * (1.f / DM); float q = 0.f;
#pragma unroll
  for (int i = 0; i < 32; ++i) { y[i] -= mu; q += y[i] * y[i]; }
  const float rs = rsqrtf(half_sum(q, hi) * (1.f / DM) + LN_EPS);
  int ch0 = li * 4; asm volatile("" : "+v"(ch0));
  float* xr = x1io + (size_t)t * DM + ch0;
#pragma unroll
  for (int c = 0; c < 8; ++c) { const float4 gg = *(const float4*)(g2 + ch0 + 128 * c), bb = *(const float4*)(b2 + ch0 + 128 * c);
    float4 o; o.x = y[4 * c] * rs * gg.x + bb.x; o.y = y[4 * c + 1] * rs * gg.y + bb.y; o.z = y[4 * c + 2] * rs * gg.z + bb.z; o.w = y[4 * c + 3] * rs * gg.w + bb.w;
    *(float4*)(xr + 128 * c) = o; }
}
__device__ __forceinline__ void ph_peer(int bid, int nb, unsigned char* lds, unsigned char* ws, const float* __restrict__ subk, float* __restrict__ dout, const float* __restrict__ g2, const float* __restrict__ b2) {
  bf16_t* SK = (bf16_t*)(lds + PL_SK);
  for (int i = threadIdx.x; i < 2 * 128 * 32; i += 512) { const int row = i >> 5, c4 = i & 31; const float4 v = ((const float4*)subk)[i];
    u32x2 w; w.x = pk2(v.x, v.y); w.y = pk2(v.z, v.w); *(u32x2*)(SK + row * 136 + c4 * 4) = w; }
  __syncthreads();
  const int wave = threadIdx.x >> 6;
  const bf16_t* qp = (const bf16_t*)(ws + WS_QP);
  const bool both_first = (bid & 1) != 0;
  for (int tile = bid; tile < T / PEER_TB; tile += 2 * nb) {
    const int ta = tile * PEER_TB, tb = (tile + nb) * PEER_TB; const bool has_b = tile + nb < T / PEER_TB;
    peer_select_tile(ta, 0, lds, qp);
    if (both_first && has_b) peer_select_tile(tb, 1, lds, qp);
    __syncthreads();
    for (int i = 0; i < PEER_TB / 8; i += 2) { const int tl = wave * (PEER_TB / 8) + i; peer_expert_tok2(ta, tl, 0, lds, ws, dout, g2, b2); }
    if (has_b) {
      if (!both_first) { __syncthreads(); peer_select_tile(tb, 1, lds, qp); __syncthreads(); }
      for (int i = 0; i < PEER_TB / 8; i += 2) { const int tl = wave * (PEER_TB / 8) + i; peer_expert_tok2(tb, tl, 1, lds, ws, dout, g2, b2); }
    }
    __syncthreads();
  }
}

#define LAS __attribute__((address_space(3)))
#define XB_TMO      128
#define XB_XCNT(j)  (256  + 64 * (j))
#define XB_XSUB(j)  (1280 + 64 * (j))
#define XB_XGEN(j)  (2304 + 64 * (j))
#define XB_TOP      3328
#define XB_TOPGEN   3392
#define XCD_BAR_WORDS 3456
#define XB_SPIN_CAP (1u << 18)

__device__ __forceinline__ unsigned xb_ld(unsigned* p)              { return __hip_atomic_load(p, __ATOMIC_RELAXED, __HIP_MEMORY_SCOPE_AGENT); }
__device__ __forceinline__ unsigned xb_add(unsigned* p, unsigned v) { return __hip_atomic_fetch_add(p, v, __ATOMIC_RELAXED, __HIP_MEMORY_SCOPE_AGENT); }
__device__ __forceinline__ unsigned xb_xcc_id() { return (unsigned)__builtin_amdgcn_s_getreg((3 << 11) | 20) & 0xFu; }
#define XB_SPIN(cond, bar) do { unsigned _sp = 0; while (cond) { __builtin_amdgcn_s_sleep(1); \
    if ((++_sp & 255u) == 0u) { if (xb_ld(&(bar)[XB_TMO])) break; if (_sp > XB_SPIN_CAP) { atomicAdd(&(bar)[XB_TMO], 1u); break; } } } } while (0)

struct XcdBarrier {
    unsigned* bar; unsigned x;
    volatile LAS unsigned* st;
};

__device__ __forceinline__ XcdBarrier xcd_barrier_post(unsigned* bar, volatile LAS unsigned* st) {
    XcdBarrier b; b.bar = bar; b.x = xb_xcc_id(); b.st = st;
    if (threadIdx.x == 0) (void)xb_add(&bar[XB_XCNT(b.x)], 1u);
    return b;
}
__device__ __forceinline__ void xcd_barrier_complete(unsigned* bar, unsigned x, unsigned& nloc, unsigned& nx) {
    const unsigned G = gridDim.x * gridDim.y * gridDim.z;
    unsigned sum, cnt, mine, sp = 0u;
    for (;;) {
        sum = 0u; cnt = 0u; mine = 0u;
#pragma unroll
        for (unsigned j = 0; j < 16; ++j) { const unsigned c = xb_ld(&bar[XB_XCNT(j)]); sum += c; cnt += (c > 0u) ? 1u : 0u; mine = (j == x) ? c : mine; }
        if (sum == G) break;
        __builtin_amdgcn_s_sleep(1);
        if ((++sp & 255u) == 0u) { if (xb_ld(&bar[XB_TMO])) break; if (sp > XB_SPIN_CAP) { atomicAdd(&bar[XB_TMO], 1u); break; } }
    }
    nloc = mine > 0u ? mine : 1u; nx = cnt > 0u ? cnt : 1u;
}

__device__ __forceinline__ void xcd_barrier(const XcdBarrier& b) {
    asm volatile("s_waitcnt vmcnt(0)" ::: "memory");
    __syncthreads();
    if (threadIdx.x == 0) {
        unsigned* bar = b.bar;
        __builtin_amdgcn_s_waitcnt(0);
        unsigned nloc = b.st[0], nx = b.st[1];
        if (nloc == 0u) { xcd_barrier_complete(bar, b.x, nloc, nx); b.st[0] = nloc; b.st[1] = nx; }
        const unsigned old = xb_add(&bar[XB_XSUB(b.x)], 1u);
        const unsigned gen = old / nloc;
        if (old + 1u == (gen + 1u) * nloc) {
            __builtin_amdgcn_fence(__ATOMIC_RELEASE, "agent");
            asm volatile("s_waitcnt vmcnt(0)" ::: "memory");
            const unsigned og = xb_add(&bar[XB_TOP], 1u);
            const unsigned tg = og / nx;
            if (og + 1u == (tg + 1u) * nx) xb_add(&bar[XB_TOPGEN], 1u);
            else XB_SPIN(xb_ld(&bar[XB_TOPGEN]) == tg, bar);
            __builtin_amdgcn_fence(__ATOMIC_ACQUIRE, "agent");
            xb_add(&bar[XB_XGEN(b.x)], 1u);
            asm volatile("s_waitcnt vmcnt(0)" ::: "memory");
        } else {
            XB_SPIN(xb_ld(&bar[XB_XGEN(b.x)]) == gen, bar);
            __builtin_amdgcn_fence(__ATOMIC_ACQUIRE, "agent");
            asm volatile("s_waitcnt vmcnt(0)" ::: "memory");
        }
    }
    __syncthreads();
}

struct KP { const float* in[19]; float* out; unsigned char* ws; int ph_lo, ph_hi; };
constexpr int NPHASE = 10;
#ifndef MK_LAUNCHES
#define MK_LAUNCHES 1
#endif
__global__ __launch_bounds__(512) void mega(KP p) {
  extern __shared__ __attribute__((aligned(16))) unsigned char lds[];
  cg::grid_group grid = cg::this_grid();
  const int bid = blockIdx.x, nb = gridDim.x, lane = threadIdx.x & 63;
  unsigned char* ws = p.ws; unsigned char* dob = (unsigned char*)p.out; float* dout = p.out;
  const float* x = p.in[0]; const float* w_in = p.in[1];
  bf16_t* xb = (bf16_t*)(dob + DO_XB); bf16_t* WinT = (bf16_t*)(dob + DO_WINT); bf16_t* UT = (bf16_t*)dob;
  float* gpre = (float*)(ws + WS_GPRE); float2* cs = (float2*)(ws + WS_CS);
  EP e; e.x = x; e.ws = ws; e.dout = dout; e.cs = cs;
#ifdef ONLY_PH
#define IN(k) ((k) == ONLY_PH && p.ph_lo <= (k) && (k) < p.ph_hi)
#else
#define IN(k) (p.ph_lo <= (k) && (k) < p.ph_hi)
#endif
  volatile LAS unsigned* bst = (volatile LAS unsigned*)((LAS unsigned char*)lds + (LDS_BYTES - 64));
  if (threadIdx.x < 2) bst[threadIdx.x] = 0u;
  __syncthreads();
  const XcdBarrier xbar = xcd_barrier_post((unsigned*)ws, bst);
#define SEAM(k) do { if (IN(k) && IN((k) + 1)) xcd_barrier(xbar); } while (0)
  if (IN(0)) {
    ph_prep_x(bid, nb, lds, x, w_in, p.in[6], xb, gpre);
    ph_prep_weights(bid, nb, lds, w_in, p.in[8], p.in[9], p.in[10], p.in[13], WinT, ws);
    ph_rope_tab(bid, nb, cs);
  }
  SEAM(0);
  if (IN(1)) {
    if (bid >= nb - 16) gp_scan(bid - (nb - 16), gpre, ws, lds);
    ph_gemm8<EPI_G1>(lds, xb, WinT, 5632, 1024, e);
  }
  SEAM(1);
  if (IN(2)) { M1Pre pr; if (bid < 1024) m1_prefetch(bid, pr, ws, p.in[4], p.in[5]);
    for (int u = bid; u < 1024; u += nb) { if (u + nb < 1024) m1_unit<true>(u, u + nb, pr, lds, ws, UT, p.in[4], p.in[5]); else m1_unit<false>(u, u, pr, lds, ws, UT, p.in[4], p.in[5]); } }
  SEAM(2);
  if (IN(3)) m2_scan(bid, nb, ws, UT);
  SEAM(3);
  if (IN(4)) {
    const float lam = compute_lambda(p.in[2], lane);
    for (int u = bid; u < 256; u += nb) att::attn_unit(u & 7, u >> 3, ws, u, lam, p.in[3], (char*)lds);
    { M3Pre pr3; if (bid < 1024) m3_prefetch(bid, pr3, ws, UT);
      for (int u = bid; u < 1024; u += nb) { if (u + nb < 1024) m3_unit<true>(u, u + nb, pr3, lds, ws, UT, p.in[7]); else m3_unit<false>(u, u, pr3, lds, ws, UT, p.in[7]); } }
  }
  SEAM(4);
  if (IN(5)) {
    ph_gemm_merge(lds, ws);
  }
  SEAM(5);
  if (IN(6)) ph_gemm8<EPI_OUT>(lds, (const bf16_t*)(ws + WS_MG), (const bf16_t*)(ws + WS_WOUT), 1024, 1024, e);
  SEAM(6);
  if (IN(7)) {
    ph_ln1_tab8(bid, nb, dout, p.in[11], p.in[12], (bf16_t*)(ws + WS_X1B), p.in[15], p.in[16], ws);
  }
  SEAM(7);
  if (IN(8)) ph_gemm8<EPI_QP>(lds, (const bf16_t*)(ws + WS_X1B), (const bf16_t*)(ws + WS_WQ), 2048, 1024, e);
  SEAM(8);
  if (IN(9)) ph_peer(bid, nb, lds, ws, p.in[14], dout, p.in[17], p.in[18]);
  if (p.ph_hi - p.ph_lo == NPHASE) grid.sync();
#undef IN
#undef SEAM
}

extern "C" void kernel_launch(void* const* d_in, const int* in_sizes, int n_in, void* d_out, int out_size, void* d_ws, size_t ws_size, hipStream_t stream) {
  static int grid = 0;
  if (grid == 0) {
    int dev = 0, cus = 0, per_cu = 0;
    hipGetDevice(&dev); hipDeviceGetAttribute(&cus, hipDeviceAttributeMultiprocessorCount, dev);
    hipFuncSetAttribute((const void*)mega, hipFuncAttributeMaxDynamicSharedMemorySize, LDS_BYTES);
    hipOccupancyMaxActiveBlocksPerMultiprocessor(&per_cu, (const void*)mega, 512, LDS_BYTES);
    if (per_cu < 1) { fprintf(stderr, "kernel_launch: occupancy query says %d blocks per CU\n", per_cu); per_cu = 1; }
    grid = cus * 1;
  }
  hipMemsetAsync(d_ws, 0, 16384, stream);
  KP p{};
  for (int i = 0; i < 19; ++i) p.in[i] = (const float*)d_in[i];
  p.out = (float*)d_out; p.ws = (unsigned char*)d_ws;
  if (MK_LAUNCHES == 1) {
    p.ph_lo = 0; p.ph_hi = NPHASE;
    void* args[] = {&p};
    hipError_t er = hipLaunchCooperativeKernel((void*)mega, dim3(grid), dim3(512), args, LDS_BYTES, stream);
    if (er != hipSuccess) fprintf(stderr, "cooperative launch failed: %s (grid %d)\n", hipGetErrorString(er), grid);
  } else {
    for (int k = 0; k < NPHASE; ++k) { p.ph_lo = k; p.ph_hi = k + 1; hipLaunchKernelGGL(mega, dim3(grid), dim3(512), LDS_BYTES, stream, p); }
  }
}
```

```cpp
#include <hip/hip_runtime.h>
#include <hip/hip_cooperative_groups.h>
#include <cstdio>
#include <stdint.h>
#include <math.h>

namespace cg = cooperative_groups;
typedef unsigned short bf16_t;
typedef short bf16x8 __attribute__((ext_vector_type(8)));
typedef float f32x4 __attribute__((ext_vector_type(4)));
typedef unsigned u32x2 __attribute__((ext_vector_type(2)));
typedef unsigned u32x4 __attribute__((ext_vector_type(4)));

constexpr int T = 16384, SEQ = 8192, DM = 1024;
constexpr float ALPHA = 1.189207115002721f;
constexpr float LN_EPS = 1e-5f;
constexpr float LAMBDA_INIT = 0.2f;
constexpr float QSCALE = 0.125f * 1.4426950408889634f;

constexpr size_t MB = 1u << 20;
constexpr size_t WS_GPRE = 1 * MB;
constexpr size_t WS_CS = 2 * MB;
constexpr size_t WS_WA = 8 * MB;
constexpr size_t WS_WM = 9 * MB;
constexpr size_t WS_WOUT = 10 * MB;
constexpr size_t WS_WQ = 12 * MB;
constexpr size_t WS_G1 = 16 * MB;
constexpr size_t WS_Q = 16 * MB, WS_K = 32 * MB, WS_V = 48 * MB, WS_MQ = 64 * MB, WS_MK = 80 * MB, WS_MV = 96 * MB, WS_MO = 112 * MB;
constexpr size_t WS_BG = 128 * MB;
constexpr size_t WS_QC = 192 * MB, WS_KC = 208 * MB;
constexpr size_t WS_O0 = 224 * MB;
constexpr size_t WS_YA = WS_MQ, WS_YM = WS_MK;
constexpr size_t WS_MG = WS_Q;
constexpr size_t WS_X1B = WS_QC;
constexpr size_t WS_TU = 128 * MB, WS_TV = 160 * MB;
constexpr size_t WS_QP = 16 * MB;
constexpr size_t WS_EXP = 96 * MB, WS_GATE = 104 * MB;
constexpr size_t DO_XB = 0, DO_WINT = 32 * MB;

__device__ __forceinline__ float bf2f(bf16_t v) { return __uint_as_float(((unsigned)v) << 16); }
__device__ __forceinline__ bf16_t f2bf(float f) { unsigned u = __float_as_uint(f); u += 0x7fffu + ((u >> 16) & 1u); return (bf16_t)(u >> 16); }
__device__ __forceinline__ unsigned pk2(float lo, float hi) { return (unsigned)f2bf(lo) | ((unsigned)f2bf(hi) << 16); }
__device__ __forceinline__ float sigmoidf_(float x) { return 1.f / (1.f + __expf(-x)); }
__device__ __forceinline__ float wave_sum(float v) {
#pragma unroll
  for (int o = 1; o < 64; o <<= 1) v += __shfl_xor(v, o);
  return v;
}
__device__ __forceinline__ float wave_max(float v) {
#pragma unroll
  for (int o = 1; o < 64; o <<= 1) v = fmaxf(v, __shfl_xor(v, o));
  return v;
}
__device__ __forceinline__ unsigned wave_maxu(unsigned v) {
#pragma unroll
  for (int o = 1; o < 64; o <<= 1) { unsigned w = (unsigned)__shfl_xor((int)v, o); v = v > w ? v : w; }
  return v;
}

__device__ __forceinline__ void ph_prep_x(int bid, int nb, unsigned char* lds, const float* __restrict__ x, const float* __restrict__ w_in, const float* __restrict__ gate_b,
                                          bf16_t* __restrict__ xb, float* __restrict__ gpre) {
  const int lane = threadIdx.x & 63, wave = __builtin_amdgcn_readfirstlane(threadIdx.x >> 6), fr = lane & 15, fq = lane >> 4;
  bf16_t* WGb = (bf16_t*)lds;
  for (int i = threadIdx.x; i < 16 * 1024; i += 512) { const int k = i >> 4, g = i & 15; WGb[g * 1032 + k] = f2bf(w_in[(size_t)k * 5648 + 3584 + g]); }
  const int rpb = ((T / 16 + nb - 1) / nb) * 16, row0 = bid * rpb, nrow = row0 < T ? (T - row0 < rpb ? T - row0 : rpb) : 0;
  { const float4* xs = (const float4*)(x + (size_t)row0 * DM); u32x2* xd = (u32x2*)(xb + (size_t)row0 * DM);
    for (int i = threadIdx.x; i < nrow * 256; i += 512) { const float4 v = xs[i]; u32x2 w; w.x = pk2(v.x, v.y); w.y = pk2(v.z, v.w); xd[i] = w; } }
  asm volatile("s_waitcnt vmcnt(0)" ::: "memory");
  __syncthreads();
  for (int rt = wave; rt * 16 < nrow; rt += 8) {
    const bf16_t* xr = xb + (size_t)(row0 + rt * 16 + fr) * DM + 8 * fq; const bf16_t* wr = WGb + fr * 1032 + 8 * fq;
    f32x4 acc = {0.f, 0.f, 0.f, 0.f};
#pragma unroll 8
    for (int ks = 0; ks < 32; ++ks) { const bf16x8 a = *(const bf16x8*)(xr + 32 * ks), bv = *(const bf16x8*)(wr + 32 * ks);
      acc = __builtin_amdgcn_mfma_f32_16x16x32_bf16(a, bv, acc, 0, 0, 0); }
    const float gb = gate_b[fr];
#pragma unroll
    for (int r = 0; r < 4; ++r) gpre[(size_t)(row0 + rt * 16 + 4 * fq + r) * 16 + fr] = acc[r] + gb;
  }
  __syncthreads();
}
__device__ __forceinline__ int src_col(int n, int mode) {
  if (mode == 1) { if (n < 1024) { const int j = n & 63; const int pj = j < 16 ? ((j & 1) ? (j >> 1) + 8 : (j >> 1)) : j; return (n & ~63) + pj; } else if (n >= 3584) return n + 16; }
  return n;
}
__device__ __forceinline__ void transpose_item(const float* __restrict__ W, int ldw, int K, int nblk, bf16_t* __restrict__ WT, float* scr, int item, int lane, int mode, int ldo = 0) {
  if (ldo == 0) ldo = K;
  const int kb = item / nblk, nbk = item % nblk, k0 = 64 * kb, n0 = 32 * nbk;
  const int sc = src_col(n0 + (lane & 31), mode);
#pragma unroll 8
  for (int i = 0; i < 32; ++i) { const int kk = 2 * i + (lane >> 5); scr[kk * 33 + (lane & 31)] = W[(size_t)(k0 + kk) * ldw + sc]; }
  asm volatile("s_waitcnt lgkmcnt(0)" ::: "memory");
  const int c = lane & 7;
#pragma unroll
  for (int j = 0; j < 4; ++j) { const int n = (lane >> 3) + 8 * j; const float* s = scr + (8 * c) * 33 + n;
    u32x4 o; o.x = pk2(s[0 * 33], s[1 * 33]); o.y = pk2(s[2 * 33], s[3 * 33]); o.z = pk2(s[4 * 33], s[5 * 33]); o.w = pk2(s[6 * 33], s[7 * 33]);
    *(u32x4*)(WT + (size_t)(n0 + n) * ldo + k0 + 8 * c) = o; }
  asm volatile("s_waitcnt lgkmcnt(0)" ::: "memory");
}
__device__ __forceinline__ void ph_prep_weights(int bid, int nb, unsigned char* lds, const float* w_in, const float* w_ba, const float* w_bm, const float* w_out, const float* w_q,
                                                bf16_t* WinT, unsigned char* ws) {
  const int lane = threadIdx.x & 63, wave = threadIdx.x >> 6;
  float* scr = (float*)(lds + 65536 + wave * 8448);
  constexpr int I_IN = 16 * 176, I_BA = 8 * 32, I_OUT = 16 * 32, I_Q = 16 * 64, NIT = I_IN + 2 * I_BA + I_OUT + I_Q;
  for (int it = bid * 8 + wave; it < NIT; it += nb * 8) {
    int r = it;
    if (r < I_IN) { transpose_item(w_in, 5648, 1024, 176, WinT, scr, r, lane, 1); continue; } r -= I_IN;
    if (r < I_BA) { transpose_item(w_ba, 1024, 512, 32, (bf16_t*)(ws + WS_WA), scr, r, lane, 0, 1024); continue; } r -= I_BA;
    if (r < I_BA) { transpose_item(w_bm, 1024, 512, 32, (bf16_t*)(ws + WS_WA) + 512, scr, r, lane, 0, 1024); continue; } r -= I_BA;
    if (r < I_OUT) { transpose_item(w_out, 1024, 1024, 32, (bf16_t*)(ws + WS_WOUT), scr, r, lane, 0); continue; } r -= I_OUT;
    transpose_item(w_q, 2048, 1024, 64, (bf16_t*)(ws + WS_WQ), scr, r, lane, 0);
  }
}
__device__ __forceinline__ void ph_cvt(int bid, int nb, const float* __restrict__ in, bf16_t* __restrict__ out, size_t n4) {
  for (size_t i = (size_t)bid * 512 + threadIdx.x; i < n4; i += (size_t)nb * 512) {
    const float4 v = ((const float4*)in)[i]; u32x2 w; w.x = pk2(v.x, v.y); w.y = pk2(v.z, v.w); ((u32x2*)out)[i] = w; }
}
__device__ __forceinline__ void ph_rope_tab(int bid, int nb, float2* __restrict__ cs) {
  for (int idx = bid * 512 + threadIdx.x; idx < 8192 * 8; idx += nb * 512) {
    const int s = idx >> 3, i = idx & 7;
    const double inv = i == 0 ? 1.0 : i == 1 ? 0.19392274474868576 : i == 2 ? 0.03760603093086393 : i == 3 ? 0.007292664737217109 : i == 4 ? 0.001414213562373095 : i == 5 ? 0.0002742481756762073
                     : i == 6 ? 5.318295896944988e-05 : 1.031338537721246e-05;
    const double ang = (double)s * inv, k = __builtin_rint(ang * 0.15915494309189535);
    const float r = (float)(__builtin_fma(-k, 6.283185307179586, ang) - k * 2.4492935982947064e-16);
    cs[idx] = make_float2(cosf(r), sinf(r));
  }
}

struct EP { const float* x; unsigned char* ws; float* dout; const float2* cs; };
enum { EPI_G1 = 0, EPI_M1 = 1, EPI_M2 = 2, EPI_OUT = 3, EPI_QP = 4 };
template <int EPI> __device__ __forceinline__ void epi4(const EP& e, int row, int col, f32x4 v) {
  if (EPI == EPI_G1) {
    if (col < 1024) {
      if ((col & 63) < 16) { const int s = row & (SEQ - 1), i0 = (col & 15) >> 1; const float2 c0 = e.cs[s * 8 + i0], c1 = e.cs[s * 8 + i0 + 1];
        const float a0 = v[0] * c0.x - v[1] * c0.y, b0 = v[1] * c0.x + v[0] * c0.y, a1 = v[2] * c1.x - v[3] * c1.y, b1 = v[3] * c1.x + v[2] * c1.y;
        v[0] = a0; v[1] = b0; v[2] = a1; v[3] = b1; }
      if (col < 512) v = v * QSCALE;
    } else if (col >= 3072) { v[0] = sigmoidf_(v[0]); v[1] = sigmoidf_(v[1]); v[2] = sigmoidf_(v[2]); v[3] = sigmoidf_(v[3]); }
    bf16_t* dst = col < 3584 ? (bf16_t*)(e.ws + WS_G1) + (size_t)(col >> 9) * ((size_t)T * 512) + (size_t)row * 512 + (col & 511)
                             : (bf16_t*)(e.ws + WS_BG) + (size_t)row * 2048 + (col - 3584);
    u32x2 w; w.x = pk2(v[0], v[1]); w.y = pk2(v[2], v[3]); *(u32x2*)dst = w;
  } else if (EPI == EPI_M1 || EPI == EPI_M2) {
    const bf16_t* g = (const bf16_t*)(e.ws + WS_BG) + (size_t)row * 2048 + (EPI == EPI_M2 ? 1024 : 0) + col;
    const u32x2 gw = *(const u32x2*)g;
    bf16_t* dst = (bf16_t*)(e.ws + WS_MG) + (size_t)row * 1024 + col;
    float r0 = v[0] * __uint_as_float(gw.x << 16), r1 = v[1] * __uint_as_float(gw.x & 0xffff0000u), r2 = v[2] * __uint_as_float(gw.y << 16), r3 = v[3] * __uint_as_float(gw.y & 0xffff0000u);
    if (EPI == EPI_M2) { const u32x2 pw = *(const u32x2*)dst; r0 += __uint_as_float(pw.x << 16); r1 += __uint_as_float(pw.x & 0xffff0000u); r2 += __uint_as_float(pw.y << 16); r3 += __uint_as_float(pw.y & 0xffff0000u); }
    u32x2 w; w.x = pk2(r0, r1); w.y = pk2(r2, r3); *(u32x2*)dst = w;
  } else if (EPI == EPI_OUT) {
    const f32x4 xv = *(const f32x4*)(e.x + (size_t)row * DM + col);
    *(f32x4*)(e.dout + (size_t)row * DM + col) = xv * ALPHA + v;
  } else if (EPI == EPI_QP) {
    u32x2 w; w.x = pk2(v[0], v[1]); w.y = pk2(v[2], v[3]); *(u32x2*)((bf16_t*)(e.ws + WS_QP) + (size_t)row * 2048 + col) = w;
  }
}
__device__ __forceinline__ float fsig(float x) { return __builtin_amdgcn_rcpf(1.f + __builtin_amdgcn_exp2f(-1.4426950408889634f * x)); }
__device__ __forceinline__ void rope4(const float2* __restrict__ cs, int s, int i0, f32x4& v) {
  const float2 c0 = cs[s * 8 + i0], c1 = cs[s * 8 + i0 + 1];
  const float a0 = v[0] * c0.x - v[1] * c0.y, b0 = v[1] * c0.x + v[0] * c0.y, a1 = v[2] * c1.x - v[3] * c1.y, b1 = v[3] * c1.x + v[2] * c1.y;
  v[0] = a0; v[1] = b0; v[2] = a1; v[3] = b1;
}
__device__ __forceinline__ void unpk8(const u32x4 w, float* f) {
#pragma unroll
  for (int i = 0; i < 4; ++i) { f[2 * i] = __uint_as_float(w[i] << 16); f[2 * i + 1] = __uint_as_float(w[i] & 0xffff0000u); }
}
template <int EPI> __device__ __forceinline__ void epi8(const EP& e, int row, int col, f32x4 v0, f32x4 v1) {
  if (EPI == EPI_G1) {
    if (col < 1024) {
      if ((col & 63) < 16) { const int s = row & (SEQ - 1), i0 = (col & 15) >> 1; rope4(e.cs, s, i0, v0); rope4(e.cs, s, i0 + 2, v1); }
      if (col < 512) { v0 = v0 * QSCALE; v1 = v1 * QSCALE; }
    } else if (col >= 3072) {
#pragma unroll
      for (int i = 0; i < 4; ++i) { v0[i] = fsig(v0[i]); v1[i] = fsig(v1[i]); }
    }
    bf16_t* dst = col < 3584 ? (bf16_t*)(e.ws + WS_G1) + (size_t)(col >> 9) * ((size_t)T * 512) + (size_t)row * 512 + (col & 511)
                             : (bf16_t*)(e.ws + WS_BG) + (size_t)row * 2048 + (col - 3584);
    u32x4 w; w.x = pk2(v0[0], v0[1]); w.y = pk2(v0[2], v0[3]); w.z = pk2(v1[0], v1[1]); w.w = pk2(v1[2], v1[3]); *(u32x4*)dst = w;
  } else if (EPI == EPI_M1 || EPI == EPI_M2) {
    float g[8]; unpk8(*(const u32x4*)((const bf16_t*)(e.ws + WS_BG) + (size_t)row * 2048 + (EPI == EPI_M2 ? 1024 : 0) + col), g);
    bf16_t* dst = (bf16_t*)(e.ws + WS_MG) + (size_t)row * 1024 + col;
    float r[8];
#pragma unroll
    for (int i = 0; i < 4; ++i) { r[i] = v0[i] * g[i]; r[4 + i] = v1[i] * g[4 + i]; }
    if (EPI == EPI_M2) { float pv[8]; unpk8(*(const u32x4*)dst, pv);
#pragma unroll
      for (int i = 0; i < 8; ++i) r[i] += pv[i]; }
    u32x4 w; w.x = pk2(r[0], r[1]); w.y = pk2(r[2], r[3]); w.z = pk2(r[4], r[5]); w.w = pk2(r[6], r[7]); *(u32x4*)dst = w;
  } else if (EPI == EPI_OUT) {
    const f32x4 x0 = *(const f32x4*)(e.x + (size_t)row * DM + col), x1 = *(const f32x4*)(e.x + (size_t)row * DM + col + 4);
    const f32x4 r0 = x0 * ALPHA + v0, r1 = x1 * ALPHA + v1;
    u32x4 w; w.x = pk2(r0[0], r0[1]); w.y = pk2(r0[2], r0[3]); w.z = pk2(r1[0], r1[1]); w.w = pk2(r1[2], r1[3]); *(u32x4*)((bf16_t*)e.dout + (size_t)row * DM + col) = w;
  } else if (EPI == EPI_QP) {
    u32x4 w; w.x = pk2(v0[0], v0[1]); w.y = pk2(v0[2], v0[3]); w.z = pk2(v1[0], v1[1]); w.w = pk2(v1[2], v1[3]);
    *(u32x4*)((bf16_t*)(e.ws + WS_QP) + (size_t)row * 2048 + col) = w;
  }
}
template <int EPI> __device__ __forceinline__ void ph_gemm(int bid, int nb, const bf16_t* __restrict__ A, const bf16_t* __restrict__ Bt, int N, int K, const EP& e) {
  const int tid = threadIdx.x & 255, half = threadIdx.x >> 8, wave = tid >> 6, lane = tid & 63, fr = lane & 15, fq = lane >> 4;
  const int ntn = N / 64, ntiles = ntn * (T / 64);
  for (int tile = bid * 2 + half; tile < ntiles; tile += nb * 2) {
    const int m0 = (tile / ntn) * 64 + (wave & 1) * 32, n0 = (tile % ntn) * 64 + (wave >> 1) * 32;
    f32x4 acc[2][2];
#pragma unroll
    for (int i = 0; i < 2; ++i)
#pragma unroll
      for (int j = 0; j < 2; ++j) acc[i][j] = (f32x4){0.f, 0.f, 0.f, 0.f};
    const bf16_t* ap = A + (size_t)(m0 + fr) * K + fq * 8; const bf16_t* bp = Bt + (size_t)(n0 + fr) * K + fq * 8;
    for (int k0 = 0; k0 < K; k0 += 32) {
      bf16x8 a[2], b[2];
#pragma unroll
      for (int i = 0; i < 2; ++i) { a[i] = *(const bf16x8*)(ap + (size_t)i * 16 * K + k0); b[i] = *(const bf16x8*)(bp + (size_t)i * 16 * K + k0); }
#pragma unroll
      for (int i = 0; i < 2; ++i)
#pragma unroll
        for (int j = 0; j < 2; ++j) acc[i][j] = __builtin_amdgcn_mfma_f32_16x16x32_bf16(b[j], a[i], acc[i][j], 0, 0, 0);
    }
#pragma unroll
    for (int i = 0; i < 2; ++i)
#pragma unroll
      for (int j = 0; j < 2; ++j) epi4<EPI>(e, m0 + 16 * i + fr, n0 + 16 * j + 4 * fq, acc[i][j]);
  }
}

namespace pg8 {
#define PG8_LAS __attribute__((address_space(3)))
typedef unsigned short bf16_t;
typedef short bf16x8 __attribute__((ext_vector_type(8)));
typedef float f32x4 __attribute__((ext_vector_type(4)));
typedef unsigned u32x4 __attribute__((ext_vector_type(4)));
constexpr int BM = 256, BK = 64, HALF = 128, HTB = HALF * BK * 2  , STAGE_BYTES = 8 * HTB, NXCD = 8, WGM = 8;

__host__ __device__ __forceinline__ int lds_byte(int r, int c) { const int st = (r >> 4) * 2 + (c >> 5), rr = r & 15, cc = c & 31, ob = rr * 64 + cc * 2; return st * 1024 + (ob ^ (((ob >> 9) & 1) << 5)); }
__host__ __device__ __forceinline__ void stage_rc(int b, int& R, int& C) { const int st = b / 1024, sb = b % 1024, swz = sb ^ (((sb >> 9) & 1) << 5); R = (st >> 1) * 16 + swz / 64; C = (st & 1) * 32 + (swz % 64) / 2; }
__host__ __device__ __forceinline__ int perm32(int rho) { const int n = rho >> 4, i = rho & 15; return 8 * (i >> 2) + 4 * n + (i & 3); }

struct Unit { int pm, pn; };
struct Gemm { const bf16_t* A; const bf16_t* Bt; int M, N, K; };

struct StaticOrder {
    int nM, nN, nwg, G, c;
    __host__ __device__ void init(int M, int N, int G_, int c_) { nM = M / BM; nN = N / BM; nwg = nM * nN; G = G_; c = c_; }
    __host__ __device__ bool next(int i, Unit& u) const {
        const long L = (long)i * G + c; if (L >= nwg) return false;
        int wgid = (int)L; { const int q = nwg / NXCD, r = nwg % NXCD, xcd = wgid % NXCD, off = wgid / NXCD; wgid = (xcd < r ? xcd * (q + 1) : r * (q + 1) + (xcd - r) * q) + off; }
        const int nig = WGM * nN, gid = wgid / nig, fm = gid * WGM, gsz = (nM - fm) < WGM ? (nM - fm) : WGM;
        u.pm = fm + ((wgid % nig) % gsz); u.pn = (wgid % nig) / gsz; return true;
    }
    __device__ __forceinline__ void a_ready(const Unit&) const {}
    __device__ __forceinline__ void done(const Unit&) const {}
};

template <class Epi, class Sched, bool ALIGN_EPI = false, bool SP2 = false>
__device__ __forceinline__ void gemm_phase(PG8_LAS unsigned char* lds, const Gemm g, const Sched& S, const Epi& E) {
    const int tid = threadIdx.x, wid = __builtin_amdgcn_readfirstlane(tid >> 6), lane = tid & 63, wr = wid >> 2, wc = wid & 3, fr = lane & 15, fq = lane >> 4;
    const int K = g.K, nt = K / BK;
    unsigned voffA[2], voffB[2];
#pragma unroll
    for (int i = 0; i < 2; ++i) { int R, C; stage_rc(tid * 16 + i * 8192, R, C); const int Rb = Epi::PERM ? ((R & ~31) + perm32(R & 31)) : R;
        voffA[i] = (unsigned)(R * K + C) * 2u; voffB[i] = (unsigned)(Rb * K + C) * 2u; }
    const size_t kstep = (size_t)(BK * 2);
    const size_t hstep = (size_t)HALF * K * 2;
    const size_t tstep = 2 * hstep;
    const unsigned ldsw = (unsigned)wid * 1024u;
    const int aoff = lds_byte(wr * 64 + fr, fq * 8), boff = lds_byte(wc * 32 + fr, fq * 8);
#define PG8_SA(b, h) (((b) * 2 + (h)) * HTB)
#define PG8_SB(b, h) ((4 + (b) * 2 + (h)) * HTB)
#define PG8_STAGE(bufoff, gbase, voff) do { _Pragma("unroll") for (int _i = 0; _i < 2; ++_i) \
        __builtin_amdgcn_global_load_lds((const unsigned*)((const char*)(gbase) + (voff)[_i]), (PG8_LAS unsigned*)(lds + (bufoff) + ldsw + _i * 8192), 16, 0, 0); } while (0)
#define PG8_LDA(dst, b, h) do { _Pragma("unroll") for (int m = 0; m < 4; ++m) _Pragma("unroll") for (int k = 0; k < 2; ++k) dst[m][k] = *(const PG8_LAS bf16x8*)(lds + PG8_SA(b, h) + aoff + m * 2048 + k * 1024); } while (0)
#define PG8_LDB(dst, b, h) do { _Pragma("unroll") for (int n = 0; n < 2; ++n) _Pragma("unroll") for (int k = 0; k < 2; ++k) dst[n][k] = *(const PG8_LAS bf16x8*)(lds + PG8_SB(b, h) + boff + n * 2048 + k * 1024); } while (0)
#define PG8_MMA(ai, bj, At, Bt) do { __builtin_amdgcn_s_setprio(1); _Pragma("unroll") for (int m = 0; m < 4; ++m) _Pragma("unroll") for (int n = 0; n < 2; ++n) _Pragma("unroll") for (int k = 0; k < 2; ++k) \
        acc[ai][bj][m][n] = __builtin_amdgcn_mfma_f32_16x16x32_bf16(Bt[n][k], At[m][k], acc[ai][bj][m][n], 0, 0, 0); __builtin_amdgcn_s_setprio(0); } while (0)
#define PG8_WAIT_V(n) asm volatile("s_waitcnt vmcnt(" #n ")" ::: "memory")
#define PG8_WAIT_L(n) asm volatile("s_waitcnt lgkmcnt(" #n ")" ::: "memory")
#define PG8_BAR __builtin_amdgcn_s_barrier()
#define PG8_SCHED __builtin_amdgcn_sched_barrier(0)
    Unit cur, nxt; int ui = 0;
    if (!S.next(0, cur)) return;
    f32x4 acc[2][2][4][2];
#pragma unroll
    for (int a = 0; a < 2; ++a)
#pragma unroll
        for (int b = 0; b < 2; ++b)
#pragma unroll
            for (int m = 0; m < 4; ++m)
#pragma unroll
                for (int n = 0; n < 2; ++n) acc[a][b][m][n] = (f32x4){0.f, 0.f, 0.f, 0.f};
    bf16x8 At[4][2], B0[2][2], B1[2][2];
    const char* cA = (const char*)g.A + (size_t)cur.pm * tstep; const char* cB = (const char*)g.Bt + (size_t)cur.pn * tstep;
    S.a_ready(cur);
    if constexpr (SP2) {
        PG8_STAGE(PG8_SB(0, 0), cB, voffB); PG8_STAGE(PG8_SB(0, 1), cB + hstep, voffB); PG8_STAGE(PG8_SA(0, 0), cA, voffA); PG8_STAGE(PG8_SA(0, 1), cA + hstep, voffA);
        if (wr == 1) PG8_BAR;
        PG8_WAIT_V(2); PG8_BAR;
        PG8_STAGE(PG8_SB(1, 0), cB + kstep, voffB); PG8_STAGE(PG8_SA(1, 0), cA + kstep, voffA); PG8_STAGE(PG8_SB(1, 1), cB + hstep + kstep, voffB);
        PG8_WAIT_V(6); PG8_BAR;
    } else {
        PG8_STAGE(PG8_SB(0, 0), cB, voffB); PG8_STAGE(PG8_SA(0, 0), cA, voffA); PG8_STAGE(PG8_SB(0, 1), cB + hstep, voffB); PG8_STAGE(PG8_SA(0, 1), cA + hstep, voffA);
        if (wr == 1) PG8_BAR;
        PG8_WAIT_V(4); PG8_BAR;
        PG8_STAGE(PG8_SB(1, 0), cB + kstep, voffB); PG8_STAGE(PG8_SA(1, 0), cA + kstep, voffA); PG8_STAGE(PG8_SB(1, 1), cB + hstep + kstep, voffB);
        PG8_WAIT_V(6); PG8_BAR;
    }
    for (;;) {
        const bool has_next = S.next(ui + 1, nxt);
        const char* nA = has_next ? (const char*)g.A + (size_t)nxt.pm * tstep : cA; const char* nB = has_next ? (const char*)g.Bt + (size_t)nxt.pn * tstep : cB;
        for (int t = 0; t < nt; t += 2) {
            const bool last = (t == nt - 2);
            if constexpr (Epi::HAS_MID) { if (t == (nt >> 1)) E.mid(acc, cur, wr, wc, fr, fq); }
            const char* a1 = cA + (size_t)(t + 1) * kstep;
            const char* a2 = last ? nA : cA + (size_t)(t + 2) * kstep; const char* b2 = last ? nB : cB + (size_t)(t + 2) * kstep;
            const char* a3 = a2 + kstep; const char* b3 = b2 + kstep;
            if (last && has_next) S.a_ready(nxt);
            if constexpr (SP2) {
            PG8_LDB(B0, 0, 0); PG8_LDB(B1, 0, 1); PG8_SCHED; PG8_LDA(At, 0, 0); PG8_STAGE(PG8_SA(1, 1), a1 + hstep, voffA);
            PG8_WAIT_V(8); PG8_WAIT_L(0); PG8_BAR; PG8_MMA(0, 0, At, B0); PG8_MMA(0, 1, At, B1); PG8_BAR; PG8_SCHED;
            PG8_LDA(At, 0, 1); PG8_STAGE(PG8_SB(0, 0), b2, voffB); PG8_STAGE(PG8_SB(0, 1), b2 + hstep, voffB); PG8_STAGE(PG8_SA(0, 0), a2, voffA);
            PG8_WAIT_V(8); PG8_WAIT_L(0); PG8_BAR; PG8_MMA(1, 0, At, B0); PG8_MMA(1, 1, At, B1); PG8_BAR; PG8_SCHED;
            PG8_LDB(B0, 1, 0); PG8_LDB(B1, 1, 1); PG8_SCHED; PG8_LDA(At, 1, 0); PG8_STAGE(PG8_SA(0, 1), a2 + hstep, voffA);
            PG8_WAIT_V(8); PG8_WAIT_L(0); PG8_BAR; PG8_MMA(0, 0, At, B0); PG8_MMA(0, 1, At, B1); PG8_BAR; PG8_SCHED;
            PG8_LDA(At, 1, 1); PG8_STAGE(PG8_SB(1, 0), b3, voffB); PG8_STAGE(PG8_SB(1, 1), b3 + hstep, voffB); PG8_STAGE(PG8_SA(1, 0), a3, voffA);
            PG8_WAIT_V(8); PG8_WAIT_L(0); PG8_BAR; PG8_MMA(1, 0, At, B0); PG8_MMA(1, 1, At, B1); PG8_BAR; PG8_SCHED;
            } else {
            PG8_LDB(B0, 0, 0); PG8_SCHED; PG8_LDA(At, 0, 0); PG8_STAGE(PG8_SA(1, 1), a1 + hstep, voffA);
            PG8_WAIT_L(8); PG8_BAR; PG8_WAIT_L(0); PG8_MMA(0, 0, At, B0); PG8_BAR; PG8_SCHED;
            PG8_LDB(B1, 0, 1); PG8_STAGE(PG8_SB(0, 0), b2, voffB);
            PG8_BAR; PG8_WAIT_L(0); PG8_MMA(0, 1, At, B1); PG8_BAR;
            PG8_LDA(At, 0, 1); PG8_STAGE(PG8_SA(0, 0), a2, voffA);
            PG8_BAR; PG8_WAIT_L(0); PG8_MMA(1, 0, At, B0); PG8_BAR; PG8_SCHED;
            PG8_STAGE(PG8_SB(0, 1), b2 + hstep, voffB);
            PG8_WAIT_V(6); PG8_BAR; PG8_MMA(1, 1, At, B1); PG8_BAR;
            PG8_LDB(B0, 1, 0); PG8_SCHED; PG8_LDA(At, 1, 0); PG8_STAGE(PG8_SA(0, 1), a2 + hstep, voffA);
            PG8_WAIT_L(8); PG8_BAR; PG8_WAIT_L(0); PG8_MMA(0, 0, At, B0); PG8_BAR; PG8_SCHED;
            PG8_LDB(B1, 1, 1); PG8_STAGE(PG8_SB(1, 0), b3, voffB);
            PG8_BAR; PG8_WAIT_L(0); PG8_MMA(0, 1, At, B1); PG8_BAR;
            PG8_LDA(At, 1, 1); PG8_STAGE(PG8_SA(1, 0), a3, voffA);
            PG8_BAR; PG8_WAIT_L(0); PG8_MMA(1, 0, At, B0); PG8_BAR; PG8_SCHED;
            PG8_STAGE(PG8_SB(1, 1), b3 + hstep, voffB);
            PG8_WAIT_V(6); PG8_BAR; PG8_MMA(1, 1, At, B1); PG8_BAR;
            }
        }
        if constexpr (ALIGN_EPI) { if (wr == 0) PG8_BAR; }
        if constexpr (!Epi::AFTER_DRAIN) { E(acc, cur, wr, wc, fr, fq); S.done(cur); }
        if (!has_next) break;
#pragma unroll
        for (int a = 0; a < 2; ++a)
#pragma unroll
            for (int b = 0; b < 2; ++b)
#pragma unroll
                for (int m = 0; m < 4; ++m)
#pragma unroll
                    for (int n = 0; n < 2; ++n) acc[a][b][m][n] = (f32x4){0.f, 0.f, 0.f, 0.f};
        cur = nxt; cA = nA; cB = nB; ++ui;
        if constexpr (ALIGN_EPI) { if (wr == 1) PG8_BAR; }
    }
    PG8_WAIT_V(0);
    if constexpr (!ALIGN_EPI) { if (wr == 0) PG8_BAR; }
    PG8_BAR;
    if constexpr (Epi::AFTER_DRAIN) { E.fused(acc, cur, wr, wc, fr, fq, lds, wid, lane); S.done(cur); }
#undef PG8_SA
#undef PG8_SB
#undef PG8_STAGE
#undef PG8_LDA
#undef PG8_LDB
#undef PG8_MMA
#undef PG8_WAIT_V
#undef PG8_WAIT_L
#undef PG8_BAR
#undef PG8_SCHED
}
}

template <int EPI> struct EpiAd {
  static constexpr bool PERM = true, AFTER_DRAIN = false, HAS_MID = false;
  EP e;
  __device__ __forceinline__ void operator()(const pg8::f32x4 (&acc)[2][2][4][2], const pg8::Unit& u, int wr, int wc, int fr, int fq) const {
#pragma unroll
    for (int ai = 0; ai < 2; ++ai)
#pragma unroll
      for (int m = 0; m < 4; ++m)
#pragma unroll
        for (int bj = 0; bj < 2; ++bj)
          epi8<EPI>(e, u.pm * 256 + ai * 128 + wr * 64 + m * 16 + fr, u.pn * 256 + bj * 128 + wc * 32 + 8 * fq, acc[ai][bj][m][0], acc[ai][bj][m][1]);
  }
};
struct EpiMergeK {
  static constexpr bool PERM = true, AFTER_DRAIN = false, HAS_MID = true;
  unsigned char* ws;
  __device__ __forceinline__ void mid(pg8::f32x4 (&acc)[2][2][4][2], const pg8::Unit& u, int wr, int wc, int fr, int fq) const {
    const bf16_t* bg = (const bf16_t*)(ws + WS_BG);
#pragma unroll
    for (int ai = 0; ai < 2; ++ai)
#pragma unroll
      for (int m = 0; m < 4; ++m)
#pragma unroll
        for (int bj = 0; bj < 2; ++bj) {
          const int row = u.pm * 256 + ai * 128 + wr * 64 + m * 16 + fr, col = u.pn * 256 + bj * 128 + wc * 32 + 8 * fq;
          float g0[8], g1[8]; unpk8(*(const u32x4*)(bg + (size_t)row * 2048 + col), g0); unpk8(*(const u32x4*)(bg + (size_t)row * 2048 + 1024 + col), g1);
#pragma unroll
          for (int i = 0; i < 4; ++i) { acc[ai][bj][m][0][i] *= g0[i] * __builtin_amdgcn_rcpf(fmaxf(g1[i], 8.673617379884035e-19f));
                                        acc[ai][bj][m][1][i] *= g0[4 + i] * __builtin_amdgcn_rcpf(fmaxf(g1[4 + i], 8.673617379884035e-19f)); }
        }
  }
  __device__ __forceinline__ void operator()(const pg8::f32x4 (&acc)[2][2][4][2], const pg8::Unit& u, int wr, int wc, int fr, int fq) const {
    const bf16_t* bg = (const bf16_t*)(ws + WS_BG); bf16_t* mg = (bf16_t*)(ws + WS_MG);
#pragma unroll
    for (int ai = 0; ai < 2; ++ai)
#pragma unroll
      for (int m = 0; m < 4; ++m)
#pragma unroll
        for (int bj = 0; bj < 2; ++bj) {
          const int row = u.pm * 256 + ai * 128 + wr * 64 + m * 16 + fr, col = u.pn * 256 + bj * 128 + wc * 32 + 8 * fq;
          float g1[8], r[8]; unpk8(*(const u32x4*)(bg + (size_t)row * 2048 + 1024 + col), g1);
#pragma unroll
          for (int i = 0; i < 4; ++i) { r[i] = acc[ai][bj][m][0][i] * fmaxf(g1[i], 8.673617379884035e-19f); r[4 + i] = acc[ai][bj][m][1][i] * fmaxf(g1[4 + i], 8.673617379884035e-19f); }
          u32x4 w; w.x = pk2(r[0], r[1]); w.y = pk2(r[2], r[3]); w.z = pk2(r[4], r[5]); w.w = pk2(r[6], r[7]); *(u32x4*)(mg + (size_t)row * 1024 + col) = w;
        }
  }
};
__device__ __forceinline__ void ph_gemm_merge(unsigned char* lds, unsigned char* ws) {
  pg8::Gemm g{(const bf16_t*)(ws + WS_YA), (const bf16_t*)(ws + WS_WA), T, 1024, 1024}; pg8::StaticOrder S; S.init(T, 1024, (int)gridDim.x, (int)blockIdx.x);
  EpiMergeK E{ws};
  pg8::gemm_phase<EpiMergeK, pg8::StaticOrder, true, true>((PG8_LAS unsigned char*)lds, g, S, E);
}
template <int EPI> __device__ __forceinline__ void ph_gemm8(unsigned char* lds, const bf16_t* A, const bf16_t* Bt, int N, int K, const EP& e) {
  pg8::Gemm g{A, Bt, T, N, K}; pg8::StaticOrder S; S.init(T, N, (int)gridDim.x, (int)blockIdx.x);
  EpiAd<EPI> E{e};
  pg8::gemm_phase<EpiAd<EPI>, pg8::StaticOrder, true, true>((PG8_LAS unsigned char*)lds, g, S, E);
}

__device__ __forceinline__ float log_sigmoid(float f) { return fminf(f, 0.f) - log1pf(expf(-fabsf(f))); }
constexpr size_t WS_GP_P = 3 * MB, WS_GP_M = 3 * MB + 512 * 1024, WS_GP_B = 4 * MB, WS_GP_MC = 4 * MB + 512 * 1024, WS_GP_AC = 4 * MB + 520 * 1024;
constexpr size_t WS_NU = 5 * MB;
constexpr int RS = 136, TS = 72;
__device__ __forceinline__ void gp_scan(int scan, const float* __restrict__ gpre, unsigned char* ws, unsigned char* lds) {
  const int lane = threadIdx.x & 63, wave = threadIdx.x >> 6, dir = scan >> 3, b = (scan >> 2) & 1, h = scan & 3;
  float* P = (float*)(ws + WS_GP_P) + (size_t)scan * SEQ; float* Rp = (float*)(ws + WS_GP_M) + (size_t)scan * SEQ; float* BBp = (float*)(ws + WS_GP_B) + (size_t)scan * SEQ;
  float* mC = (float*)(ws + WS_GP_MC) + scan * 128; float* aC = (float*)(ws + WS_GP_AC) + scan * 128;
  float* LBL = (float*)lds; float* LR = LBL + 128;
  const int gi = (dir ? 8 : 0) + h, gf = (dir ? 12 : 4) + h;
  float ig[16], fg[16];
#pragma unroll
  for (int i = 0; i < 16; ++i) { const int c = wave * 16 + i, j = dir ? 127 - c : c, s = 64 * j + (dir ? 63 - lane : lane); const size_t t = (size_t)b * SEQ + s;
    ig[i] = gpre[t * 16 + gi]; fg[i] = gpre[t * 16 + gf]; }
#pragma unroll
  for (int i = 0; i < 16; ++i) { const int c = wave * 16 + i, j = dir ? 127 - c : c, s = 64 * j + (dir ? 63 - lane : lane);
    float bsum = log_sigmoid(fg[i]);
#pragma unroll
    for (int o = 1; o < 64; o <<= 1) { const float v = __shfl_up(bsum, o); if (lane >= o) bsum += v; }
    const float p = ig[i] - bsum; float r = p;
#pragma unroll
    for (int o = 1; o < 64; o <<= 1) { const float v = __shfl_up(r, o); if (lane >= o) r = fmaxf(r, v); }
    P[s] = p; Rp[s] = r; BBp[s] = bsum;
    if (lane == 63) { LBL[c] = bsum; LR[c] = r; } }
  __syncthreads();
  if (wave == 0) { float m = -1e30f;
    for (int c = 0; c < 128; ++c) { const int j = dir ? 127 - c : c; const float Ml = fmaxf(m, LR[c]);
      if (lane == 0) { mC[j] = m; aC[j] = expf(m - Ml); }
      m = LBL[c] + Ml; } }
  __syncthreads();
}
struct M1Pre { u32x4 raw[5]; u32x4 v[2]; float cwl[3]; float pv, rv, mc; };
__device__ __forceinline__ void m1_prefetch(int u, M1Pre& pr, const unsigned char* ws, const float* __restrict__ cw, const float* __restrict__ cb) {
  const int tid = threadIdx.x, lane = tid & 63, wave = __builtin_amdgcn_readfirstlane(tid >> 6);
  const int bh = u >> 7, j = u & 127, b = bh >> 2, h = bh & 3;
  const bf16_t* mq = (const bf16_t*)(ws + WS_MQ); const bf16_t* mk = (const bf16_t*)(ws + WS_MK); const bf16_t* mv = (const bf16_t*)(ws + WS_MV);
#pragma unroll
  for (int i = 0; i < 5; ++i) { const int it = tid + 512 * i; const int which = it >= 68 * 16, r = (it - which * 68 * 16) >> 4, ch = it & 15; const int s = 64 * j - 2 + r;
    pr.raw[i] = (u32x4){0u, 0u, 0u, 0u};
    if (it < 2 * 68 * 16 && s >= 0 && s < SEQ) pr.raw[i] = *(const u32x4*)((which ? mk : mq) + ((size_t)b * SEQ + s) * 512 + h * 128 + ch * 8); }
#pragma unroll
  for (int k2 = 0; k2 < 2; ++k2) pr.v[k2] = *(const u32x4*)(mv + ((size_t)b * SEQ + 64 * j + lane) * 512 + h * 128 + (wave + 8 * k2) * 8);
#pragma unroll
  for (int i3 = 0; i3 < 3; ++i3) { const int i = tid + 512 * i3; const int w = i >> 8, c = i & 255, ch = (c >> 7) * 512 + h * 128 + (c & 127); pr.cwl[i3] = w < 5 ? cw[w * 1024 + ch] : cb[ch]; }
  pr.pv = 0.f; pr.rv = 0.f; pr.mc = 0.f;
  if (tid < 128) { const int dir = tid >> 6, l = tid & 63; const int scan = dir * 8 + bh;
    pr.pv = ((const float*)(ws + WS_GP_P))[(size_t)scan * SEQ + 64 * j + l]; pr.rv = ((const float*)(ws + WS_GP_M))[(size_t)scan * SEQ + 64 * j + (dir ? 0 : 63)];
    pr.mc = ((const float*)(ws + WS_GP_MC))[scan * 128 + j]; }
}
template <bool HAS_NEXT> __device__ __forceinline__ void m1_unit(int u, int un, M1Pre& pr, unsigned char* lds, unsigned char* ws, bf16_t* UT, const float* __restrict__ cw, const float* __restrict__ cb) {
  const int tid = threadIdx.x, lane = tid & 63, wave = __builtin_amdgcn_readfirstlane(tid >> 6), fr = lane & 15, fq = lane >> 4;
  const int bh = u >> 7, j = u & 127, b = bh >> 2, h = bh & 3;
  bf16_t* RAWQ = (bf16_t*)lds; bf16_t* RAWK = RAWQ + 68 * RS; bf16_t* KWT0 = RAWK + 68 * RS; bf16_t* KWT1 = KWT0 + 128 * TS; bf16_t* VT = KWT1 + 128 * TS;
  float* WK = (float*)(VT + 144 * TS);
  float* CWL = WK + 128;
  bf16_t* qc = (bf16_t*)(ws + WS_QC); bf16_t* kc = (bf16_t*)(ws + WS_KC);
  const size_t trow0 = (size_t)b * SEQ + 64 * j;
#pragma unroll
  for (int i = 0; i < 5; ++i) { const int it = tid + 512 * i; const int which = it >= 68 * 16, r = (it - which * 68 * 16) >> 4, ch = it & 15;
    if (it < 2 * 68 * 16) *(u32x4*)((which ? RAWK : RAWQ) + r * RS + ch * 8) = pr.raw[i]; }
#pragma unroll
  for (int i3 = 0; i3 < 3; ++i3) CWL[tid + 512 * i3] = pr.cwl[i3];
  if (tid < 128) WK[tid] = expf(pr.pv - fmaxf(pr.mc, pr.rv));
#pragma unroll
  for (int k2 = 0; k2 < 2; ++k2) { const int ch = wave + 8 * k2; const u32x4 v = pr.v[k2];
#pragma unroll
    for (int i = 0; i < 4; ++i) { VT[(ch * 8 + 2 * i) * TS + lane] = (bf16_t)(v[i] & 0xffffu); VT[(ch * 8 + 2 * i + 1) * TS + lane] = (bf16_t)(v[i] >> 16); } }
  if (tid < 64) VT[128 * TS + tid] = 0x3f80;
  __syncthreads();
  if (HAS_NEXT) m1_prefetch(un, pr, ws, cw, cb);
  const float wkf = WK[lane], wkb = WK[64 + lane];
#pragma unroll
  for (int which = 0; which < 2; ++which)
#pragma unroll
    for (int k2 = 0; k2 < 2; ++k2) {
      const int ch = wave + 8 * k2; const float* cwl = CWL + which * 128 + ch * 8;
      float y[8];
      { const float4 ba = *(const float4*)(cwl + 5 * 256), bb = *(const float4*)(cwl + 5 * 256 + 4); y[0] = ba.x; y[1] = ba.y; y[2] = ba.z; y[3] = ba.w; y[4] = bb.x; y[5] = bb.y; y[6] = bb.z; y[7] = bb.w; }
#pragma unroll
      for (int w = 0; w < 5; ++w) {
        const u32x4 v = *(const u32x4*)((which ? RAWK : RAWQ) + (lane + w) * RS + ch * 8);
        const float4 wa = *(const float4*)(cwl + w * 256), wb = *(const float4*)(cwl + w * 256 + 4);
        y[0] += __uint_as_float(v[0] << 16) * wa.x; y[1] += __uint_as_float(v[0] & 0xffff0000u) * wa.y; y[2] += __uint_as_float(v[1] << 16) * wa.z; y[3] += __uint_as_float(v[1] & 0xffff0000u) * wa.w;
        y[4] += __uint_as_float(v[2] << 16) * wb.x; y[5] += __uint_as_float(v[2] & 0xffff0000u) * wb.y; y[6] += __uint_as_float(v[3] << 16) * wb.z; y[7] += __uint_as_float(v[3] & 0xffff0000u) * wb.w;
      }
#pragma unroll
      for (int i = 0; i < 8; ++i) { y[i] = y[i] * fsig(y[i]); if (which) y[i] *= 0.08838834764831845f; }
      u32x4 o; o.x = pk2(y[0], y[1]); o.y = pk2(y[2], y[3]); o.z = pk2(y[4], y[5]); o.w = pk2(y[6], y[7]);
      *(u32x4*)((which ? kc : qc) + (trow0 + lane) * 512 + h * 128 + ch * 8) = o;
      if (which) {
#pragma unroll
        for (int i = 0; i < 8; ++i) { const float kv = bf2f(f2bf(y[i])); KWT0[(ch * 8 + i) * TS + lane] = f2bf(kv * wkf); KWT1[(ch * 8 + i) * TS + lane] = f2bf(kv * wkb); }
      }
    }
  __syncthreads();
  bf16x8 xf[2][2];
#pragma unroll
  for (int dir = 0; dir < 2; ++dir)
#pragma unroll
    for (int ks = 0; ks < 2; ++ks) xf[dir][ks] = *(const bf16x8*)((dir ? KWT1 : KWT0) + (16 * wave + fr) * TS + ks * 32 + fq * 8);
#pragma unroll
  for (int et = 0; et < 9; ++et) {
    const bf16x8 y0 = *(const bf16x8*)(VT + (16 * et + fr) * TS + fq * 8), y1 = *(const bf16x8*)(VT + (16 * et + fr) * TS + 32 + fq * 8);
#pragma unroll
    for (int dir = 0; dir < 2; ++dir) {
      f32x4 acc = {0.f, 0.f, 0.f, 0.f};
      acc = __builtin_amdgcn_mfma_f32_16x16x32_bf16(xf[dir][0], y0, acc, 0, 0, 0);
      acc = __builtin_amdgcn_mfma_f32_16x16x32_bf16(xf[dir][1], y1, acc, 0, 0, 0);
      const int scan = dir * 8 + bh;
      if (et < 8) { u32x2 w; w.x = pk2(acc[0], acc[1]); w.y = pk2(acc[2], acc[3]);
        *(u32x2*)(UT + (((size_t)scan * 128 + j) * 128 + 16 * et + fr) * 128 + 16 * wave + 4 * fq) = w; }
      else if (fr == 0) *(f32x4*)((float*)(ws + WS_NU) + ((size_t)scan * 128 + j) * 128 + 16 * wave + 4 * fq) = acc;
    }
  }
  __syncthreads();
}
__device__ __forceinline__ void m2_scan(int bid, int nb, unsigned char* ws, bf16_t* UT) {
  for (int slab = bid; slab < 16 * 16; slab += nb) {
    const int scan = slab >> 4, dir = scan >> 3, el = ((slab & 15) * 512 + threadIdx.x) * 2;
    const float* aC = (const float*)(ws + WS_GP_AC) + scan * 128;
    bf16_t* base = UT + (size_t)scan * 128 * 16384 + el;
    float c0 = 0.f, c1 = 0.f;
    for (int c16 = 0; c16 < 128; c16 += 16) {
      unsigned uv[16];
#pragma unroll
      for (int i = 0; i < 16; ++i) { const int j = dir ? 127 - (c16 + i) : c16 + i; uv[i] = *(const unsigned*)(base + (size_t)j * 16384); }
#pragma unroll
      for (int i = 0; i < 16; ++i) { const int j = dir ? 127 - (c16 + i) : c16 + i; const float a = aC[j]; *(unsigned*)(base + (size_t)j * 16384) = pk2(c0, c1);
        c0 = a * c0 + __uint_as_float(uv[i] << 16); c1 = a * c1 + __uint_as_float(uv[i] & 0xffff0000u); }
    }
  }
  const int gt = bid * 512 + threadIdx.x, nthreads = nb * 512;
  for (int item = gt; item < 16 * 128; item += nthreads) {
    const int scan = item >> 7, d = item & 127, dir = scan >> 3;
    const float* aC = (const float*)(ws + WS_GP_AC) + scan * 128; float* base = (float*)(ws + WS_NU) + (size_t)scan * 128 * 128 + d;
    float n = 0.f;
    for (int c16 = 0; c16 < 128; c16 += 16) { float uv[16], av[16];
#pragma unroll
      for (int i = 0; i < 16; ++i) { const int j = dir ? 127 - (c16 + i) : c16 + i; uv[i] = base[j * 128]; av[i] = aC[j]; }
#pragma unroll
      for (int i = 0; i < 16; ++i) { const int j = dir ? 127 - (c16 + i) : c16 + i; base[j * 128] = n; n = av[i] * n + uv[i]; } }
  }
}
struct M3Pre { u32x4 qk[4], ct[8], mvv[2]; float nu, ga; };
__device__ __forceinline__ void m3_prefetch(int u, M3Pre& pr, const unsigned char* ws, const bf16_t* UT) {
  int tid = threadIdx.x; asm volatile("" : "+v"(tid));
  const int lane = tid & 63, wave = tid >> 6;
  const int bh = u >> 7, j = u & 127, b = bh >> 2, h = bh & 3;
  const bf16_t* qc = (const bf16_t*)(ws + WS_QC); const bf16_t* kc = (const bf16_t*)(ws + WS_KC); const bf16_t* mv = (const bf16_t*)(ws + WS_MV);
  const size_t trow0 = (size_t)b * SEQ + 64 * j;
#pragma unroll
  for (int i = 0; i < 4; ++i) { const int it = tid + 512 * i, which = it >> 10, r = (it >> 4) & 63, ch = it & 15;
    pr.qk[i] = *(const u32x4*)((which ? kc : qc) + (trow0 + r) * 512 + h * 128 + ch * 8); }
#pragma unroll
  for (int i = 0; i < 8; ++i) { const int it = tid + 512 * i, dir = it >> 11, e = (it >> 4) & 127, ch = it & 15; const int scan = dir * 8 + bh;
    pr.ct[i] = *(const u32x4*)(UT + (((size_t)scan * 128 + j) * 128 + e) * 128 + ch * 8); }
  pr.nu = 0.f; pr.ga = 0.f;
  if (tid < 256) { const int dir = tid >> 7, d = tid & 127; const int scan = dir * 8 + bh; pr.nu = ((const float*)(ws + WS_NU))[((size_t)scan * 128 + j) * 128 + d]; }
  if (tid < 384) { const int dir = tid / 192, k3 = (tid % 192) >> 6, l = tid & 63; const int scan = dir * 8 + bh;
    const float* src = (const float*)(ws + (k3 == 0 ? WS_GP_P : k3 == 1 ? WS_GP_M : WS_GP_B)) + (size_t)scan * SEQ; pr.ga = src[64 * j + l]; }
#pragma unroll
  for (int k2 = 0; k2 < 2; ++k2) { const int ch = wave + 8 * k2; pr.mvv[k2] = *(const u32x4*)(mv + (trow0 + lane) * 512 + h * 128 + ch * 8); }
}
template <bool HAS_NEXT> __device__ __forceinline__ void m3_unit(int u, int un, M3Pre& pr, unsigned char* lds, unsigned char* ws, const bf16_t* UT, const float* __restrict__ ng) {
  int tid = threadIdx.x; asm volatile("" : "+v"(tid));
  const int lane = tid & 63, wave = __builtin_amdgcn_readfirstlane(tid >> 6), fr = lane & 15, fq = lane >> 4;
  const int bh = u >> 7, j = u & 127, b = bh >> 2, h = bh & 3, tt = wave & 3, eh = wave >> 2;
  bf16_t* QCS = (bf16_t*)lds; bf16_t* KCS = QCS + 64 * RS; bf16_t* VT = KCS + 64 * RS; bf16_t* CT0 = VT + 144 * TS; bf16_t* CT1 = CT0 + 144 * RS;
  float* GA = (float*)(CT1 + 144 * RS);
  float* ST = GA + 384;
  const bf16_t* qc = (const bf16_t*)(ws + WS_QC); const bf16_t* kc = (const bf16_t*)(ws + WS_KC); const bf16_t* mv = (const bf16_t*)(ws + WS_MV); const bf16_t* mo = (const bf16_t*)(ws + WS_MO);
  bf16_t* ym = (bf16_t*)(ws + WS_YA);
  const size_t trow0 = (size_t)b * SEQ + 64 * j;
#pragma unroll
  for (int i = 0; i < 4; ++i) { const int it = tid + 512 * i, which = it >> 10, r = (it >> 4) & 63, ch = it & 15; *(u32x4*)((which ? KCS : QCS) + r * RS + ch * 8) = pr.qk[i]; }
#pragma unroll
  for (int i = 0; i < 8; ++i) { const int it = tid + 512 * i, dir = it >> 11, e = (it >> 4) & 127, ch = it & 15; *(u32x4*)((dir ? CT1 : CT0) + e * RS + ch * 8) = pr.ct[i]; }
  if (tid < 256) { const int dir = tid >> 7, d = tid & 127; (dir ? CT1 : CT0)[128 * RS + d] = f2bf(pr.nu); }
  if (tid < 384) { const int dir = tid / 192, k3 = (tid % 192) >> 6, l = tid & 63; GA[(dir * 3 + k3) * 64 + l] = pr.ga; }
#pragma unroll
  for (int k2 = 0; k2 < 2; ++k2) { const int ch = wave + 8 * k2; const u32x4 v = pr.mvv[k2];
#pragma unroll
    for (int i = 0; i < 4; ++i) { VT[(ch * 8 + 2 * i) * TS + lane] = (bf16_t)(v[i] & 0xffffu); VT[(ch * 8 + 2 * i + 1) * TS + lane] = (bf16_t)(v[i] >> 16); } }
  if (tid < 64) VT[128 * TS + tid] = 0x3f80;
  __syncthreads();
  if (HAS_NEXT) m3_prefetch(un, pr, ws, UT);
  f32x4 g[4];
  {
    bf16x8 qf[4];
#pragma unroll
    for (int ks = 0; ks < 4; ++ks) qf[ks] = *(const bf16x8*)(QCS + (16 * tt + fr) * RS + ks * 32 + fq * 8);
#pragma unroll
    for (int lt = 0; lt < 4; ++lt) { g[lt] = (f32x4){0.f, 0.f, 0.f, 0.f};
#pragma unroll
      for (int ks = 0; ks < 4; ++ks) { const bf16x8 kf = *(const bf16x8*)(KCS + (16 * lt + fr) * RS + ks * 32 + fq * 8);
        g[lt] = __builtin_amdgcn_mfma_f32_16x16x32_bf16(kf, qf[ks], g[lt], 0, 0, 0); } }
  }
  const int etl[5] = {4 * eh, 4 * eh + 1, 4 * eh + 2, 4 * eh + 3, 8};
  float hsum[4][4];
#pragma unroll
  for (int i = 0; i < 4; ++i)
#pragma unroll
    for (int r = 0; r < 4; ++r) hsum[i][r] = 0.f;
#pragma unroll
  for (int dir = 0; dir < 2; ++dir) {
    const float* Pd = GA + (dir * 3 + 0) * 64; const float* Md = GA + (dir * 3 + 1) * 64; const float* Bd = GA + (dir * 3 + 2) * 64;
    const int scan = dir * 8 + bh; const float mc = ((const float*)(ws + WS_GP_MC))[scan * 128 + j];
    const bf16_t* CT = dir ? CT1 : CT0;
    f32x4 acc[5];
#pragma unroll
    for (int i = 0; i < 5; ++i) acc[i] = (f32x4){0.f, 0.f, 0.f, 0.f};
#pragma unroll
    for (int ks = 0; ks < 4; ++ks) { const bf16x8 qf = *(const bf16x8*)(QCS + (16 * tt + fr) * RS + ks * 32 + fq * 8);
#pragma unroll
      for (int i = 0; i < 5; ++i) { const bf16x8 cf = *(const bf16x8*)(CT + (16 * etl[i] + fr) * RS + ks * 32 + fq * 8);
        acc[i] = __builtin_amdgcn_mfma_f32_16x16x32_bf16(qf, cf, acc[i], 0, 0, 0); } }
    float Mt[4], wi[4], emr[4];
#pragma unroll
    for (int r = 0; r < 4; ++r) { const int t = 16 * tt + 4 * fq + r; Mt[r] = fmaxf(mc, Md[t]); wi[r] = __expf(mc - Mt[r]); emr[r] = __expf(-(Bd[t] + Mt[r])); }
#pragma unroll
    for (int i = 0; i < 5; ++i)
#pragma unroll
      for (int r = 0; r < 4; ++r) acc[i][r] *= wi[r];
    const float Mrow = fmaxf(mc, Md[16 * tt + fr]); const int trow = 16 * tt + fr;
    bf16x8 sf[2];
#pragma unroll
    for (int ks = 0; ks < 2; ++ks) { unsigned pw[4];
#pragma unroll
      for (int hh = 0; hh < 2; ++hh) { const int lt = 2 * ks + hh; float sv[4];
#pragma unroll
        for (int r = 0; r < 4; ++r) { const int l = 16 * lt + 4 * fq + r; const bool ok = dir ? (l >= trow) : (l <= trow);
          sv[r] = ok ? g[lt][r] * __expf(Pd[l] - Mrow) : 0.f; }
        pw[2 * hh] = pk2(sv[0], sv[1]); pw[2 * hh + 1] = pk2(sv[2], sv[3]); }
      u32x4 w4 = {pw[0], pw[1], pw[2], pw[3]}; sf[ks] = *(bf16x8*)&w4; }
#pragma unroll
    for (int ks = 0; ks < 2; ++ks)
#pragma unroll
      for (int i = 0; i < 5; ++i) { const bf16_t* vr = VT + (16 * etl[i] + fr) * TS + 32 * ks + 4 * fq;
        const u32x2 lo = *(const u32x2*)vr, hi = *(const u32x2*)(vr + 16); u32x4 w4 = {lo.x, lo.y, hi.x, hi.y};
        acc[i] = __builtin_amdgcn_mfma_f32_16x16x32_bf16(sf[ks], *(bf16x8*)&w4, acc[i], 0, 0, 0); }
#pragma unroll
    for (int r = 0; r < 4; ++r) { const float den = __shfl(acc[4][r], lane & 48); const float inv = __builtin_amdgcn_rcpf(fmaxf(fabsf(den), emr[r]));
#pragma unroll
      for (int i = 0; i < 4; ++i) hsum[i][r] += acc[i][r] * inv; }
  }
#pragma unroll
  for (int r = 0; r < 4; ++r) { float s1 = 0.f, s2 = 0.f;
#pragma unroll
    for (int i = 0; i < 4; ++i) { s1 += hsum[i][r]; s2 += hsum[i][r] * hsum[i][r]; }
#pragma unroll
    for (int o = 1; o < 16; o <<= 1) { s1 += __shfl_xor(s1, o); s2 += __shfl_xor(s2, o); }
    if (fr == 0) { ST[(eh * 64 + 16 * tt + 4 * fq + r) * 2] = s1; ST[(eh * 64 + 16 * tt + 4 * fq + r) * 2 + 1] = s2; } }
  __syncthreads();
  bf16_t* YT = QCS;
#pragma unroll
  for (int r = 0; r < 4; ++r) { const int t = 16 * tt + 4 * fq + r;
    const float s1 = ST[t * 2] + ST[(64 + t) * 2], s2 = ST[t * 2 + 1] + ST[(64 + t) * 2 + 1];
    const float mu = s1 * (1.f / 128.f), var = fmaxf(s2 * (1.f / 128.f) - mu * mu, 0.f), rs = rsqrtf(var + LN_EPS);
#pragma unroll
    for (int i = 0; i < 4; ++i) { const int e = 16 * (4 * eh + i) + fr; YT[t * RS + e] = f2bf((hsum[i][r] - mu) * rs * ng[h * 128 + e]); } }
  __syncthreads();
  for (int it = tid; it < 64 * 16; it += 512) { const int r = it >> 4, ch = it & 15;
    const u32x4 yv = *(const u32x4*)(YT + r * RS + ch * 8); const u32x4 ov = *(const u32x4*)(mo + (trow0 + r) * 512 + h * 128 + ch * 8); u32x4 o;
#pragma unroll
    for (int i = 0; i < 4; ++i) o[i] = pk2(__uint_as_float(yv[i] << 16) * __uint_as_float(ov[i] << 16), __uint_as_float(yv[i] & 0xffff0000u) * __uint_as_float(ov[i] & 0xffff0000u));
    *(u32x4*)(ym + (trow0 + r) * 1024 + 512 + h * 128 + ch * 8) = o; }
  __syncthreads();
}
constexpr int LDS_BYTES = 155648;
__device__ __forceinline__ float compute_lambda(const float* __restrict__ lp, int lane) {
  const float s1 = wave_sum(lp[lane] * lp[64 + lane]), s2 = wave_sum(lp[128 + lane] * lp[192 + lane]);
  return expf(s1) - expf(s2) + LAMBDA_INIT;
}
namespace att {
using f32x16 = __attribute__((ext_vector_type(16))) float;
using s16x4 = __attribute__((ext_vector_type(4))) short;
constexpr int NW = 8, QBLK = 32, KVBLK = 64, LD = 512;
constexpr int SHM_V = KVBLK * 128 * 2, SHM_K = KVBLK * 64 * 2;
constexpr int NSL = 4;
constexpr int SHM_ATTN = NSL * SHM_V + NSL * SHM_K + NW * 64 * 4;
constexpr int ATT_QF = SHM_ATTN;
constexpr int ATT_STG = 0;
constexpr float THR = 8.f;
#define KSWZ64(row, colB) ((row) * 128 + ((colB) ^ ((((row) >> 1) & 7) << 4)))
#define SBAR() __builtin_amdgcn_sched_barrier(0)
__device__ __forceinline__ int crow(int r, int hi) { return (r & 3) + 8 * (r >> 2) + 4 * hi; }
__device__ __forceinline__ unsigned cvtpk(float lo, float hi) { unsigned r; asm volatile("v_cvt_pk_bf16_f32 %0, %1, %2" : "=v"(r) : "v"(lo), "v"(hi)); return r; }
template <bool FIRST> __device__ __forceinline__ void partialSM(f32x16& p0, f32x16& p1, float& m_reg, float& alpha) {
  constexpr float THR2 = THR * 1.4426950408889634f;
  float pmax = p0[0];
#pragma unroll
  for (int r = 1; r < 16; ++r) pmax = fmaxf(pmax, p0[r]);
#pragma unroll
  for (int r = 0; r < 16; ++r) pmax = fmaxf(pmax, p1[r]);
  { auto rr = __builtin_amdgcn_permlane32_swap(__float_as_uint(pmax), __float_as_uint(pmax), false, false);
    pmax = fmaxf(__uint_as_float(rr[0]), __uint_as_float(rr[1])); }
  if (!FIRST && __builtin_expect(__all(pmax <= THR2), 1)) { alpha = 1.f; }
  else { const float dl = FIRST ? pmax : fmaxf(pmax, 0.f); m_reg += dl; alpha = FIRST ? 1.f : __builtin_amdgcn_exp2f(-dl);
#pragma unroll
    for (int r = 0; r < 16; ++r) { p0[r] -= dl; p1[r] -= dl; } }
#pragma unroll
  for (int r = 0; r < 16; ++r) p0[r] = __builtin_amdgcn_exp2f(p0[r]);
}
__device__ __forceinline__ void finishSM(f32x16& p0, f32x16& p1, float alpha, float& l_reg, bf16x8& pa0, bf16x8& pa1, bf16x8& pa2, bf16x8& pa3) {
#pragma unroll
  for (int r = 0; r < 16; ++r) p1[r] = __builtin_amdgcn_exp2f(p1[r]);
  float ps = 0;
#pragma unroll
  for (int r = 0; r < 16; ++r) ps += p0[r];
#pragma unroll
  for (int r = 0; r < 16; ++r) ps += p1[r];
  { auto rr = __builtin_amdgcn_permlane32_swap(__float_as_uint(ps), __float_as_uint(ps), false, false);
    ps = __uint_as_float(rr[0]) + __uint_as_float(rr[1]); }
  l_reg = l_reg * alpha + ps;
#define PK4(P, BASE, OUT) do { unsigned a0 = cvtpk(P[BASE + 0], P[BASE + 1]), a1 = cvtpk(P[BASE + 2], P[BASE + 3]);   \
    unsigned b0 = cvtpk(P[BASE + 4], P[BASE + 5]), b1 = cvtpk(P[BASE + 6], P[BASE + 7]);                              \
    auto r0 = __builtin_amdgcn_permlane32_swap(a0, b0, false, false); auto r1 = __builtin_amdgcn_permlane32_swap(a1, b1, false, false); \
    u32x4 w = {r0[0], r1[0], r0[1], r1[1]}; OUT = *reinterpret_cast<bf16x8*>(&w); } while (0)
  PK4(p0, 0, pa0); PK4(p0, 8, pa1); PK4(p1, 0, pa2); PK4(p1, 8, pa3);
#undef PK4
}
__device__ __forceinline__ void qkt(f32x16& p0, f32x16& p1, const char* Ks, const char* ql, float negm, int r32, int hi) {
#pragma unroll
  for (int r = 0; r < 16; ++r) { p0[r] = negm; p1[r] = negm; }
#pragma unroll
  for (int d0 = 0; d0 < 4; ++d0) { const int cb = (d0 * 16 + hi * 8) * 2;
    const bf16x8 qf = *reinterpret_cast<const bf16x8*>(ql + d0 * 1024);
    const bf16x8 b0 = *reinterpret_cast<const bf16x8*>(Ks + KSWZ64(r32, cb));
    const bf16x8 b1 = *reinterpret_cast<const bf16x8*>(Ks + KSWZ64(32 + r32, cb));
    p0 = __builtin_amdgcn_mfma_f32_32x32x16_bf16(b0, qf, p0, 0, 0, 0);
    p1 = __builtin_amdgcn_mfma_f32_32x32x16_bf16(b1, qf, p1, 0, 0, 0); }
}
__device__ __forceinline__ int v_st(int k, int c) { const int kk = (k & ~0xC) | ((k & 4) << 1) | ((k & 8) >> 1); return ((kk >> 3) * 4 + (c >> 5)) * 512 + ((kk & 7) * 32 + (c & 31)) * 2; }
__device__ __forceinline__ int v_rd_base(int lane) { return ((lane & 3) << 3) | (((lane >> 2) & 3) << 6) | (((lane >> 4) & 1) << 5) | (((lane >> 5) & 1) << 8); }
constexpr int v_rd_off(int d0, int ks, int half) { return d0 * 512 + ks * 4096 + half * 2048; }
template <int OFF> __device__ __forceinline__ s16x4 tr_read(int vb) {
  s16x4 r; asm volatile("ds_read_b64_tr_b16 %0, %1 offset:%2" : "=&v"(r) : "v"(vb), "i"(OFF) : "memory"); return r;
}
#define PKV(L, H) (bf16x8){L[0], L[1], L[2], L[3], H[0], H[1], H[2], H[3]}
#define PV_R(X0, X1, X2, X3, D0, HF) do { X0 = tr_read<v_rd_off(D0, 2 * (HF), 0)>(vb); X1 = tr_read<v_rd_off(D0, 2 * (HF), 1)>(vb); \
    X2 = tr_read<v_rd_off(D0, 2 * (HF) + 1, 0)>(vb); X3 = tr_read<v_rd_off(D0, 2 * (HF) + 1, 1)>(vb); } while (0)
#define PV_M(X0, X1, X2, X3, D0, PA, PB) do { o[D0] = __builtin_amdgcn_mfma_f32_32x32x16_bf16(PA, PKV(X0, X1), o[D0], 0, 0, 0); \
    o[D0] = __builtin_amdgcn_mfma_f32_32x32x16_bf16(PB, PKV(X2, X3), o[D0], 0, 0, 0); } while (0)
#define PV_W(N) do { asm volatile("s_waitcnt lgkmcnt(" #N ")" ::: "memory"); SBAR(); } while (0)
__device__ __forceinline__ void pv_d0(f32x16* o, int vb, bf16x8 pa0, bf16x8 pa1, bf16x8 pa2, bf16x8 pa3) {
  s16x4 a0, a1, a2, a3, b0, b1, b2, b3;
  PV_R(a0, a1, a2, a3, 0, 0); PV_R(b0, b1, b2, b3, 0, 1);
  PV_W(4); PV_M(a0, a1, a2, a3, 0, pa0, pa1); SBAR(); PV_R(a0, a1, a2, a3, 1, 0);
  PV_W(4); PV_M(b0, b1, b2, b3, 0, pa2, pa3); SBAR(); PV_R(b0, b1, b2, b3, 1, 1);
  PV_W(4); PV_M(a0, a1, a2, a3, 1, pa0, pa1); SBAR(); PV_R(a0, a1, a2, a3, 2, 0);
  PV_W(4); PV_M(b0, b1, b2, b3, 1, pa2, pa3); SBAR(); PV_R(b0, b1, b2, b3, 2, 1);
  PV_W(4); PV_M(a0, a1, a2, a3, 2, pa0, pa1); SBAR(); PV_R(a0, a1, a2, a3, 3, 0);
  PV_W(4); PV_M(b0, b1, b2, b3, 2, pa2, pa3); SBAR(); PV_R(b0, b1, b2, b3, 3, 1);
  PV_W(4); PV_M(a0, a1, a2, a3, 3, pa0, pa1); SBAR();
  PV_W(0); PV_M(b0, b1, b2, b3, 3, pa2, pa3);
}
#undef PKV
__device__ __forceinline__ void attn_unit(int bh, int qb, const unsigned char* __restrict__ ws, int unit,
                                          float lam, const float* __restrict__ sg, char* lds) {
  const int tid = threadIdx.x, lane = tid & 63, r32 = lane & 31, hi = lane >> 5;
  const int wid = __builtin_amdgcn_readfirstlane(tid >> 6);
  const int b = bh >> 2, h = bh & 3;
  char* V_lds = lds; char* K_lds = lds + NSL * SHM_V;
  float* wsf = (float*)(lds + NSL * SHM_V + NSL * SHM_K) + wid * 64; float* li_l = wsf; float* al_l = wsf + 32;
  const unsigned row0 = (unsigned)b * SEQ; const int q0 = qb * 256;
  const unsigned char* Vh = ws + WS_V + ((size_t)row0 * LD + h * 128) * 2;
  const int sr = tid >> 4, sc = (tid & 15) * 8, vst0 = v_st(sr, sc);
  constexpr int vst1d = 8192;
  const unsigned voffV = (unsigned)(sr * LD + sc) * 2u, voffK = (unsigned)((tid >> 3) * LD + (tid & 7) * 8) * 2u;
  const int kst = KSWZ64(tid >> 3, (tid & 7) * 16);
  const int vb0 = (int)(uintptr_t)V_lds + v_rd_base(lane);
  constexpr int NT = SEQ / KVBLK;
  constexpr unsigned TILEB = KVBLK * LD * 2;
  for (int mp = 0; mp < 2; ++mp) {
    const unsigned char* Kh = ws + WS_K + ((size_t)row0 * LD + h * 128 + mp * 64) * 2;
    const __amdgpu_buffer_rsrc_t rsK = __builtin_amdgcn_make_buffer_rsrc((void*)Kh, (short)0, SEQ * LD * 2, 0x00020000);
    const __amdgpu_buffer_rsrc_t rsV = __builtin_amdgcn_make_buffer_rsrc((void*)Vh, (short)0, SEQ * LD * 2, 0x00020000);
    float m_reg = 0.f, l_reg = 0; f32x16 o[4] = {};
    char* ql = lds + ATT_QF + wid * 4096 + lane * 16;
    { const unsigned char* Qb = ws + WS_Q + ((size_t)(row0 + q0 + wid * QBLK) * LD + h * 128 + mp * 64) * 2;
      int tq = lane; asm volatile("" : "+v"(tq));
      const unsigned qoff = (unsigned)((tq & 31) * LD + (tq >> 5) * 8) * 2u;
#pragma unroll
      for (int d0 = 0; d0 < 4; ++d0) *reinterpret_cast<bf16x8*>(ql + d0 * 1024) = *reinterpret_cast<const bf16x8*>(Qb + qoff + d0 * 32); }
    struct { bf16x8 vs0, vs1, ks0; } sr_[2];
#define SLOAD(i, t) do { const unsigned so_ = (unsigned)(t) * TILEB; \
    sr_[i].vs0 = __builtin_bit_cast(bf16x8, __builtin_amdgcn_raw_buffer_load_b128(rsV, voffV, so_, 0)); \
    sr_[i].vs1 = __builtin_bit_cast(bf16x8, __builtin_amdgcn_raw_buffer_load_b128(rsV, voffV + 32 * LD * 2, so_, 0)); \
    sr_[i].ks0 = __builtin_bit_cast(bf16x8, __builtin_amdgcn_raw_buffer_load_b128(rsK, voffK, so_, 0)); } while (0)
#define SWRITE(bb, i) do { *(bf16x8*)(V_lds + (bb) * SHM_V + vst0) = sr_[i].vs0; *(bf16x8*)(V_lds + (bb) * SHM_V + vst0 + vst1d) = sr_[i].vs1; \
    *(bf16x8*)(K_lds + (bb) * SHM_K + kst) = sr_[i].ks0; } while (0)
#define SWAIT() asm volatile("s_waitcnt vmcnt(3)" ::: "memory")
#define RESC(a) do { if (__any((a) < 1.f)) { if (hi == 0) al_l[r32] = (a); asm volatile("s_waitcnt lgkmcnt(0)" ::: "memory"); \
    _Pragma("unroll") for (int d = 0; d < 4; ++d) _Pragma("unroll") for (int r = 0; r < 16; ++r) o[d][r] *= al_l[crow(r, hi)]; } } while (0)
    f32x16 pA0, pA1, pB0, pB1; float alA, alB; bf16x8 pa0, pa1, pa2, pa3;
    int s_pp = 0, s_prev = 0, s_cur = 1, s_next = 2;
#define ROT() do { s_pp = s_prev; s_prev = s_cur; s_cur = s_next; s_next = (s_next + 1) & (NSL - 1); } while (0)
    SLOAD(0, 0); asm volatile("s_waitcnt vmcnt(0)" ::: "memory"); SWRITE(0, 0); __syncthreads();
    if (wid < 4) {
      qkt(pA0, pA1, K_lds, ql, -m_reg, r32, hi); partialSM<true>(pA0, pA1, m_reg, alA);
      SLOAD(1, 1); SLOAD(0, 2);
      SWAIT(); SWRITE(1, 1); __syncthreads();
      for (int j = 1; j + 1 < NT; j += 2) {
        SBAR(); qkt(pB0, pB1, K_lds + s_cur * SHM_K, ql, -m_reg, r32, hi);
        finishSM(pA0, pA1, alA, l_reg, pa0, pa1, pa2, pa3); SBAR();
        SLOAD(1, j + 2); SBAR();
        pv_d0(o, vb0 + s_prev * SHM_V, pa0, pa1, pa2, pa3); partialSM<false>(pB0, pB1, m_reg, alB);
        SWAIT(); SWRITE(s_next, 0);
        RESC(alB); __syncthreads(); ROT();
        SBAR(); qkt(pA0, pA1, K_lds + s_cur * SHM_K, ql, -m_reg, r32, hi);
        finishSM(pB0, pB1, alB, l_reg, pa0, pa1, pa2, pa3); SBAR();
        if (j + 3 < NT) SLOAD(0, j + 3); SBAR();
        pv_d0(o, vb0 + s_prev * SHM_V, pa0, pa1, pa2, pa3); partialSM<false>(pA0, pA1, m_reg, alA);
        SWAIT(); SWRITE(s_next, 1);
        RESC(alA); __syncthreads(); ROT();
      }
      SBAR(); qkt(pB0, pB1, K_lds + s_cur * SHM_K, ql, -m_reg, r32, hi);
      finishSM(pA0, pA1, alA, l_reg, pa0, pa1, pa2, pa3); SBAR();
      pv_d0(o, vb0 + s_prev * SHM_V, pa0, pa1, pa2, pa3); partialSM<false>(pB0, pB1, m_reg, alB);
      RESC(alB);
      finishSM(pB0, pB1, alB, l_reg, pa0, pa1, pa2, pa3); SBAR();
      pv_d0(o, vb0 + s_cur * SHM_V, pa0, pa1, pa2, pa3);
    } else {
      qkt(pA0, pA1, K_lds, ql, -m_reg, r32, hi);
      SLOAD(1, 1); SLOAD(0, 2);
      SWAIT(); SWRITE(1, 1); __syncthreads();
      SBAR(); partialSM<true>(pA0, pA1, m_reg, alA);
      SBAR(); SLOAD(1, 3); SBAR();
      qkt(pB0, pB1, K_lds + s_cur * SHM_K, ql, -m_reg, r32, hi);
      finishSM(pA0, pA1, alA, l_reg, pa0, pa1, pa2, pa3); SBAR();
      SWAIT(); SWRITE(s_next, 0);
      __syncthreads(); ROT();
      for (int j = 2; j + 2 < NT; j += 2) {
        SBAR(); pv_d0(o, vb0 + s_pp * SHM_V, pa0, pa1, pa2, pa3); partialSM<false>(pB0, pB1, m_reg, alB); RESC(alB);
        SBAR(); SLOAD(0, j + 2); SBAR();
        qkt(pA0, pA1, K_lds + s_cur * SHM_K, ql, -m_reg, r32, hi);
        finishSM(pB0, pB1, alB, l_reg, pa0, pa1, pa2, pa3); SBAR();
        SWAIT(); SWRITE(s_next, 1);
        __syncthreads(); ROT();
        SBAR(); pv_d0(o, vb0 + s_pp * SHM_V, pa0, pa1, pa2, pa3); partialSM<false>(pA0, pA1, m_reg, alA); RESC(alA);
        SBAR(); SLOAD(1, j + 3); SBAR();
        qkt(pB0, pB1, K_lds + s_cur * SHM_K, ql, -m_reg, r32, hi);
        finishSM(pA0, pA1, alA, l_reg, pa0, pa1, pa2, pa3); SBAR();
        SWAIT(); SWRITE(s_next, 0);
        __syncthreads(); ROT();
      }
      SBAR(); pv_d0(o, vb0 + s_pp * SHM_V, pa0, pa1, pa2, pa3); partialSM<false>(pB0, pB1, m_reg, alB); RESC(alB);
      SBAR(); qkt(pA0, pA1, K_lds + s_cur * SHM_K, ql, -m_reg, r32, hi);
      finishSM(pB0, pB1, alB, l_reg, pa0, pa1, pa2, pa3); SBAR();
      SWAIT(); SWRITE(s_next, 1);
      __syncthreads(); ROT();
      SBAR(); pv_d0(o, vb0 + s_pp * SHM_V, pa0, pa1, pa2, pa3); partialSM<false>(pA0, pA1, m_reg, alA); RESC(alA);
      SBAR(); qkt(pB0, pB1, K_lds + s_cur * SHM_K, ql, -m_reg, r32, hi);
      finishSM(pA0, pA1, alA, l_reg, pa0, pa1, pa2, pa3); SBAR();
      pv_d0(o, vb0 + s_prev * SHM_V, pa0, pa1, pa2, pa3); partialSM<false>(pB0, pB1, m_reg, alB); RESC(alB);
      finishSM(pB0, pB1, alB, l_reg, pa0, pa1, pa2, pa3); SBAR();
      pv_d0(o, vb0 + s_cur * SHM_V, pa0, pa1, pa2, pa3);
    }
#undef ROT
    __syncthreads();
    if (hi == 0) li_l[r32] = l_reg; asm volatile("s_waitcnt lgkmcnt(0)" ::: "memory");
    float rli[16];
#pragma unroll
    for (int r = 0; r < 16; ++r) rli[r] = __builtin_amdgcn_rcpf(li_l[crow(r, hi)]);
    int t2 = tid; asm volatile("" : "+v"(t2));
    const int lane2 = t2 & 63, wid2 = __builtin_amdgcn_readfirstlane(t2 >> 6);
    f32x4* st = (f32x4*)((unsigned char*)ws + WS_O0) + ((size_t)unit * 512 + t2) * 16;
    if (mp == 0) {
#pragma unroll
      for (int d0 = 0; d0 < 4; ++d0)
#pragma unroll
        for (int r4 = 0; r4 < 4; ++r4) st[d0 * 4 + r4] = (f32x4){o[d0][4 * r4] * rli[4 * r4], o[d0][4 * r4 + 1] * rli[4 * r4 + 1], o[d0][4 * r4 + 2] * rli[4 * r4 + 2], o[d0][4 * r4 + 3] * rli[4 * r4 + 3]};
    } else {
      float ss[16];
#pragma unroll
      for (int r = 0; r < 16; ++r) ss[r] = 0.f;
#pragma unroll
      for (int d0 = 0; d0 < 4; ++d0)
#pragma unroll
        for (int r4 = 0; r4 < 4; ++r4) { const f32x4 o0 = st[d0 * 4 + r4];
#pragma unroll
          for (int i = 0; i < 4; ++i) { const int r = 4 * r4 + i; const float v = o0[i] - lam * (o[d0][r] * rli[r]); o[d0][r] = v; ss[r] += v * v; } }
#pragma unroll
      for (int r = 0; r < 16; ++r) {
#pragma unroll
        for (int of = 1; of < 32; of <<= 1) ss[r] += __shfl_xor(ss[r], of);
        ss[r] = rsqrtf(ss[r] * (1.f / 128.f) + LN_EPS) * (1.f - LAMBDA_INIT); }
      bf16_t* stg = (bf16_t*)(lds + ATT_STG + wid2 * 8704);
      const int r32b = lane2 & 31, hib = lane2 >> 5;
#pragma unroll
      for (int d0 = 0; d0 < 4; ++d0) { const float g = sg[d0 * 32 + r32b];
#pragma unroll
        for (int r = 0; r < 16; ++r) stg[crow(r, hib) * 136 + d0 * 32 + r32b] = f2bf(o[d0][r] * ss[r] * g); }
      asm volatile("s_waitcnt lgkmcnt(0)" ::: "memory");
      const int orow = lane2 >> 1, oh = lane2 & 1;
      bf16_t* yw = (bf16_t*)((unsigned char*)ws + WS_YA) + ((size_t)(row0 + q0 + wid2 * QBLK + orow) * 1024 + h * 128 + oh * 64);
#pragma unroll
      for (int i = 0; i < 8; ++i) *(u32x4*)(yw + i * 8) = *(const u32x4*)(stg + orow * 136 + oh * 64 + i * 8);
    }
    __syncthreads();
#undef SLOAD
#undef SWRITE
#undef SWAIT
#undef RESC
  }
}
#undef SBAR
}
__device__ __forceinline__ void ph_ln1(int bid, int nb, float* __restrict__ x1, const float* __restrict__ g, const float* __restrict__ bb, bf16_t* __restrict__ x1b) {
  const int lane = threadIdx.x & 63;
  for (int t0 = (bid * 8 + (threadIdx.x >> 6)) * 2; t0 < T; t0 += nb * 16) {
    float4 v[2][4]; float s[2] = {0.f, 0.f};
#pragma unroll
    for (int r = 0; r < 2; ++r) { const float4* xr = (const float4*)(x1 + (size_t)(t0 + r) * DM);
#pragma unroll
      for (int j = 0; j < 4; ++j) { v[r][j] = xr[lane + 64 * j]; s[r] += (v[r][j].x + v[r][j].y) + (v[r][j].z + v[r][j].w); } }
#pragma unroll
    for (int r = 0; r < 2; ++r) {
      const float mu = wave_sum(s[r]) * (1.f / DM); float q = 0.f;
#pragma unroll
      for (int j = 0; j < 4; ++j) { v[r][j].x -= mu; v[r][j].y -= mu; v[r][j].z -= mu; v[r][j].w -= mu; q += (v[r][j].x * v[r][j].x + v[r][j].y * v[r][j].y) + (v[r][j].z * v[r][j].z + v[r][j].w * v[r][j].w); }
      const float rs = rsqrtf(wave_sum(q) * (1.f / DM) + LN_EPS);
      float4* xo = (float4*)(x1 + (size_t)(t0 + r) * DM);
#pragma unroll
      for (int j = 0; j < 4; ++j) { const float4 gg = ((const float4*)g)[lane + 64 * j], b4 = ((const float4*)bb)[lane + 64 * j];
        float4 o; o.x = v[r][j].x * rs * gg.x + b4.x; o.y = v[r][j].y * rs * gg.y + b4.y; o.z = v[r][j].z * rs * gg.z + b4.z; o.w = v[r][j].w * rs * gg.w + b4.w;
        xo[lane + 64 * j] = o; u32x2 w; w.x = pk2(o.x, o.y); w.y = pk2(o.z, o.w); *(u32x2*)(x1b + (size_t)(t0 + r) * DM + 4 * (lane + 64 * j)) = w; }
    }
  }
}

constexpr size_t WS_TU8 = 128 * MB, WS_SU = 160 * MB, WS_SV = 160 * MB + 65536;
constexpr int REC6 = 1280;
typedef float f32x2v __attribute__((ext_vector_type(2)));
__device__ __forceinline__ unsigned f2ord(float f) { const unsigned u = __float_as_uint(f); return (u & 0x80000000u) ? ~u : (u | 0x80000000u); }
__device__ __forceinline__ float ord2f(unsigned o) { const unsigned u = (o & 0x80000000u) ? (o & 0x7fffffffu) : ~o; return __uint_as_float(u); }
template <int CTRL, int RM> __device__ __forceinline__ float dppf(float s) { return __uint_as_float(__builtin_amdgcn_update_dpp(0u, __float_as_uint(s), CTRL, RM, 0xf, true)); }
__device__ __forceinline__ float readlane_f(float v, int l) { return __uint_as_float((unsigned)__builtin_amdgcn_readlane((int)__float_as_uint(v), l)); }
__device__ __forceinline__ float wave_sum63(float v) {
  v += dppf<0xB1, 0xf>(v); v += dppf<0x4E, 0xf>(v); v += dppf<0x141, 0xf>(v); v += dppf<0x140, 0xf>(v);
  v += dppf<0x142, 0xA>(v); v += dppf<0x143, 0xC>(v);
  return v;
}
__device__ __forceinline__ float gelu_erf(float v) {
  const float t = __builtin_amdgcn_rcpf(fabsf(v) * 0.2316418882f + 1.0f);
  float q = t * 0.5307027145f + (-0.7265760135f); q = q * t + 0.7107068705f; q = q * t + (-0.142248368f); q = q * t + 0.127414796f; q = q * t;
  const float m = v * (q * __builtin_amdgcn_exp2f((v * v) * (-0.72134752044f)));
  return v < 0.f ? m : v - m;
}
__device__ __forceinline__ unsigned fp6_code(float a) {
  const float m = fabsf(a);
  const float c = m < 2.f ? __builtin_rintf(m * 8.f) : (m < 4.f ? __builtin_rintf(m * 4.f) + 8.f : __builtin_rintf(m * 2.f) + 16.f);
  const unsigned code = (unsigned)fminf(c, 31.f);
  return a < 0.f ? (code | 32u) : code;
}
struct U3 { unsigned x, y, z; };
__device__ __forceinline__ U3 fp6_pack16(const float4 (&v)[4], float inv) {
  unsigned f[16];
#pragma unroll
  for (int c = 0; c < 4; ++c) { f[4 * c] = fp6_code(v[c].x * inv); f[4 * c + 1] = fp6_code(v[c].y * inv); f[4 * c + 2] = fp6_code(v[c].z * inv); f[4 * c + 3] = fp6_code(v[c].w * inv); }
  U3 o;
  o.x = f[0] | (f[1] << 6) | (f[2] << 12) | (f[3] << 18) | (f[4] << 24) | (f[5] << 30);
  o.y = (f[5] >> 2) | (f[6] << 4) | (f[7] << 10) | (f[8] << 16) | (f[9] << 22) | (f[10] << 28);
  o.z = (f[10] >> 4) | (f[11] << 2) | (f[12] << 8) | (f[13] << 14) | (f[14] << 20) | (f[15] << 26);
  return o;
}
__device__ __forceinline__ unsigned fp4_code(float a) {
  const float m = fabsf(a);
  const float c = m < 2.f ? __builtin_rintf(m * 2.f) : (m < 4.f ? __builtin_rintf(m) + 2.f : __builtin_rintf(m * 0.5f) + 4.f);
  const unsigned code = (unsigned)fminf(c, 7.f);
  return a < 0.f ? (code | 8u) : code;
}
__device__ __forceinline__ u32x2 fp4_pack16(const float4 (&v)[4], float inv) {
  u32x2 o; o.x = 0u; o.y = 0u;
#pragma unroll
  for (int c = 0; c < 4; ++c) { const unsigned h = fp4_code(v[c].x * inv) | (fp4_code(v[c].y * inv) << 4) | (fp4_code(v[c].z * inv) << 8) | (fp4_code(v[c].w * inv) << 12);
    if (c < 2) o.x |= h << (16 * c); else o.y |= h << (16 * (c - 2)); }
  return o;
}
__device__ __forceinline__ void ph_ln1_tab8(int bid, int nb, float* __restrict__ x1, const float* __restrict__ g, const float* __restrict__ bb, bf16_t* __restrict__ x1b,
                                            const float* __restrict__ pu, const float* __restrict__ pv, unsigned char* ws) {
  const int lane = threadIdx.x & 63, gw = bid * 8 + (threadIdx.x >> 6), ngw = nb * 8;
  int t0 = gw * 2, r4 = gw * 4;
  for (; t0 < T || r4 < 32768; t0 += ngw * 2, r4 += ngw * 4) {
    const bool do_ln = t0 < T, do_tb = r4 < 32768;
    float4 v[2][4], va[4][4];
    if (do_ln) {
#pragma unroll
      for (int r = 0; r < 2; ++r) { const u32x2* xr = (const u32x2*)((const bf16_t*)x1 + (size_t)(t0 + r) * DM);
#pragma unroll
        for (int j = 0; j < 4; ++j) { const u32x2 a = xr[lane + 64 * j]; v[r][j] = make_float4(__uint_as_float(a.x << 16), __uint_as_float(a.x & 0xffff0000u), __uint_as_float(a.y << 16), __uint_as_float(a.y & 0xffff0000u)); } } }
    if (do_tb) {
#pragma unroll
      for (int i = 0; i < 4; ++i) { const int r = r4 + i, which = r >> 14, row = r & 16383; const float4* src = (const float4*)((which ? pv : pu) + (size_t)row * DM) + (which ? 128 * (lane & 1) + (lane >> 1) : 4 * lane); const int cst = which ? 32 : 1;
#pragma unroll
        for (int c = 0; c < 4; ++c) va[i][c] = src[cst * c]; } }
    if (do_ln) {
#pragma unroll
      for (int r = 0; r < 2; ++r) { float sm = 0.f;
#pragma unroll
        for (int j = 0; j < 4; ++j) sm += (v[r][j].x + v[r][j].y) + (v[r][j].z + v[r][j].w);
        const float mu = wave_sum(sm) * (1.f / DM); float q = 0.f;
#pragma unroll
        for (int j = 0; j < 4; ++j) { v[r][j].x -= mu; v[r][j].y -= mu; v[r][j].z -= mu; v[r][j].w -= mu; q += (v[r][j].x * v[r][j].x + v[r][j].y * v[r][j].y) + (v[r][j].z * v[r][j].z + v[r][j].w * v[r][j].w); }
        const float rs = rsqrtf(wave_sum(q) * (1.f / DM) + LN_EPS);
#pragma unroll
        for (int j = 0; j < 4; ++j) { const float4 gg = ((const float4*)g)[lane + 64 * j], b4 = ((const float4*)bb)[lane + 64 * j];
          float4 o; o.x = v[r][j].x * rs * gg.x + b4.x; o.y = v[r][j].y * rs * gg.y + b4.y; o.z = v[r][j].z * rs * gg.z + b4.z; o.w = v[r][j].w * rs * gg.w + b4.w;
          u32x2 w; w.x = pk2(o.x, o.y); w.y = pk2(o.z, o.w); *(u32x2*)(x1b + (size_t)(t0 + r) * DM + 4 * (lane + 64 * j)) = w; } } }
    if (do_tb) {
#pragma unroll
      for (int i = 0; i < 4; ++i) { const int r = r4 + i, which = r >> 14, row = r & 16383;
        float mx = 0.f;
#pragma unroll
        for (int c = 0; c < 4; ++c) mx = fmaxf(mx, fmaxf(fmaxf(fabsf(va[i][c].x), fabsf(va[i][c].y)), fmaxf(fabsf(va[i][c].z), fabsf(va[i][c].w))));
        mx = wave_max(mx);
        const float scale = fmaxf(mx, 1e-30f) * (which ? 1.f / 7.5f : 1.f / 6.f), inv = 1.f / scale;
        if (which == 0) *(u32x2*)(ws + WS_TU8 + (size_t)row * REC6 + 8 * lane) = fp4_pack16(va[i], inv);
        else { const U3 o = fp6_pack16(va[i], inv); unsigned char* rec = ws + WS_TU8 + (size_t)row * REC6 + 512;
          if ((lane & 1) == 0) *(U3*)(rec + 16 * (lane >> 1)) = o;
          else { *(unsigned*)(rec + 16 * (lane >> 1) + 12) = o.x; u32x2 q; q.x = o.y; q.y = o.z; *(u32x2*)(rec + 512 + 8 * (lane >> 1)) = q; } }
        if (lane == 0) ((float*)(ws + (which ? WS_SV : WS_SU)))[row] = scale; } }
  }
}
#define CE_D(a, b) do { const unsigned hi_ = (a) > (b) ? (a) : (b), lo_ = (a) > (b) ? (b) : (a); (a) = hi_; (b) = lo_; } while (0)
__device__ __forceinline__ void merge16_desc(unsigned* m) {
#pragma unroll
  for (int j = 8; j > 0; j >>= 1)
#pragma unroll
    for (int i = 0; i < 16; ++i) { const int l = i ^ j; if (l > i) CE_D(m[i], m[l]); }
}
__device__ __forceinline__ void sort16_desc(unsigned* k) {
#pragma unroll
  for (int kk = 2; kk <= 16; kk <<= 1)
#pragma unroll
    for (int j = kk >> 1; j > 0; j >>= 1)
#pragma unroll
      for (int i = 0; i < 16; ++i) { const int l = i ^ j; if (l > i) { if ((i & kk) == 0) CE_D(k[i], k[l]); else CE_D(k[l], k[i]); } }
}
__device__ __forceinline__ void top16_of_64(unsigned* k, unsigned* out) {
  sort16_desc(k); sort16_desc(k + 16); sort16_desc(k + 32); sort16_desc(k + 48);
  unsigned m1[16];
#pragma unroll
  for (int i = 0; i < 16; ++i) { out[i] = k[i] > k[31 - i] ? k[i] : k[31 - i]; m1[i] = k[32 + i] > k[63 - i] ? k[32 + i] : k[63 - i]; }
  merge16_desc(out); merge16_desc(m1);
#pragma unroll
  for (int i = 0; i < 16; ++i) out[i] = out[i] > m1[15 - i] ? out[i] : m1[15 - i];
  merge16_desc(out);
}
constexpr int pairs_before(int r, int c) { int n = 0; for (int rr = 0; rr < 16; ++rr) for (int cc = 0; cc < 16; ++cc) { if (rr == r && cc == c) return n; if ((rr + 1) * (cc + 1) <= 16) ++n; } return n; }
constexpr int PEER_TB = 32;
constexpr int PL_SK = 0, PL_LIST = 2 * 128 * 136 * 2, PL_LBUF = PEER_TB * 128 * 8, PL_IDX = PL_LIST + 2 * PL_LBUF;
__device__ __forceinline__ void peer_select_tile(int t0, int lb, unsigned char* lds, const bf16_t* __restrict__ qp) {
  using f32x16 = att::f32x16;
  int lane = threadIdx.x & 63; asm volatile("" : "+v"(lane));
  const int r32 = lane & 31, hi = lane >> 5, h = __builtin_amdgcn_readfirstlane(threadIdx.x >> 6);
  const bf16_t* SK = (const bf16_t*)(lds + PL_SK);
  unsigned top[2][16];
#pragma unroll
  for (int p = 0; p < 2; ++p) {
    f32x16 acc[4] = {};
    const bf16_t* qrow = qp + (size_t)(t0 + r32) * 2048 + h * 256 + p * 128 + hi * 8;
    bf16x8 qf[8];
#pragma unroll
    for (int ks = 0; ks < 8; ++ks) qf[ks] = *(const bf16x8*)(qrow + ks * 16);
#pragma unroll
    for (int ks = 0; ks < 8; ++ks) {
#pragma unroll
      for (int nt = 0; nt < 4; ++nt) { const bf16x8 kf = *(const bf16x8*)(SK + (p * 128 + nt * 32 + r32) * 136 + ks * 16 + hi * 8);
        acc[nt] = __builtin_amdgcn_mfma_f32_32x32x16_bf16(kf, qf[ks], acc[nt], 0, 0, 0); }
      __builtin_amdgcn_sched_barrier(0); }
    unsigned k[64];
#pragma unroll
    for (int nt = 0; nt < 4; ++nt)
#pragma unroll
      for (int r = 0; r < 16; ++r) k[nt * 16 + r] = (f2ord(acc[nt][r]) & 0xffffff80u) | (unsigned)(nt * 32 + (r & 3) + 8 * (r >> 2) + 4 * hi);
    unsigned own[16]; top16_of_64(k, own);
    unsigned X[16], Y[16];
#pragma unroll
    for (int i = 0; i < 16; ++i) { auto rr = __builtin_amdgcn_permlane32_swap(own[i], own[i], false, false); X[i] = rr[0]; Y[i] = rr[1]; }
#pragma unroll
    for (int i = 0; i < 16; ++i) top[p][i] = X[i] > Y[15 - i] ? X[i] : Y[15 - i];
    merge16_desc(top[p]);
  }
  float sa[16], sb[16];
#pragma unroll
  for (int i = 0; i < 16; ++i) { sa[i] = ord2f(top[0][i] & 0xffffff80u); sb[i] = ord2f(top[1][i] & 0xffffff80u); }
  unsigned ck[64];
#pragma unroll
  for (int i = 0; i < 64; ++i) ck[i] = 0u;
#pragma unroll
  for (int r = 0; r < 16; ++r)
#pragma unroll
    for (int c = 0; c < 16; ++c) if ((r + 1) * (c + 1) <= 16) ck[pairs_before(r, c)] = (f2ord(sa[r] + sb[c]) & 0xffffff00u) | (unsigned)(r * 16 + c);
  unsigned win[16]; top16_of_64(ck, win);
  unsigned char* slot = lds + PL_IDX + ((threadIdx.x >> 6) * 32 + r32) * 32;
  u32x4 ia, ib;
#pragma unroll
  for (int q4 = 0; q4 < 4; ++q4) { ia[q4] = (top[0][4 * q4] & 127u) | ((top[0][4 * q4 + 1] & 127u) << 8) | ((top[0][4 * q4 + 2] & 127u) << 16) | ((top[0][4 * q4 + 3] & 127u) << 24);
    ib[q4] = (top[1][4 * q4] & 127u) | ((top[1][4 * q4 + 1] & 127u) << 8) | ((top[1][4 * q4 + 2] & 127u) << 16) | ((top[1][4 * q4 + 3] & 127u) << 24); }
  *(u32x4*)slot = ia; *(u32x4*)(slot + 16) = ib;
  asm volatile("s_waitcnt lgkmcnt(0)" ::: "memory");
  const float s0 = ord2f(win[0] & 0xffffff00u);
  float ex[16], sum = 0.f; int ee[16];
#pragma unroll
  for (int j = 0; j < 16; ++j) { const unsigned pr = (win[j] >> 4) & 15u, pc = win[j] & 15u;
    ee[j] = (int)slot[pr] * 128 + (int)slot[16 + pc];
    ex[j] = __expf(ord2f(win[j] & 0xffffff00u) - s0); sum += ex[j]; }
  const float inv = 1.f / sum;
  if (hi == 0) { u32x2* L = (u32x2*)(lds + PL_LIST + lb * PL_LBUF) + r32 * 128 + h * 16;
#pragma unroll
    for (int j = 0; j < 16; ++j) L[j] = (u32x2){(unsigned)ee[j], __float_as_uint(ex[j] * inv)}; }
}
typedef unsigned u32x6 __attribute__((ext_vector_type(6)));
typedef float f32x32 __attribute__((ext_vector_type(32)));
typedef __bf16 bf16x32v __attribute__((ext_vector_type(32)));
typedef __bf16 bf16x2v __attribute__((ext_vector_type(2)));
__device__ __forceinline__ float half_sum(float v, bool hi) {
  v += dppf<0xB1, 0xf>(v); v += dppf<0x4E, 0xf>(v); v += dppf<0x141, 0xf>(v); v += dppf<0x140, 0xf>(v); v += dppf<0x142, 0xA>(v);
  const float a = readlane_f(v, 31), b = readlane_f(v, 63); return hi ? b : a;
}
typedef int i32x8 __attribute__((ext_vector_type(8)));
__device__ __forceinline__ void peer_expert_tok2(int t0, int tl, int lb, unsigned char* lds, const unsigned char* __restrict__ ws, float* __restrict__ x1io, const float* __restrict__ g2, const float* __restrict__ b2) {
  int lane = threadIdx.x & 63; asm volatile("" : "+v"(lane));
  const int li = lane & 31; const bool hi = lane >= 32;
  const int t = t0 + tl + (hi ? 1 : 0);
  float y[32];
#pragma unroll
  for (int i = 0; i < 32; ++i) y[i] = 0.f;
  const __amdgpu_buffer_rsrc_t rsT = __builtin_amdgcn_make_buffer_rsrc((void*)(ws + WS_TU8), (short)0, 16384 * REC6, 0x00020000);
  const int voP0 = 512 + li * 16, voQ0 = 1024 + li * 8;
  const float* SU = (const float*)(ws + WS_SU); const float* SV = (const float*)(ws + WS_SV);
  u32x2* SORT = (u32x2*)(lds + PL_IDX) + (threadIdx.x >> 6) * 256;
  unsigned char* XQ = lds + PL_LIST + lb * PL_LBUF + tl * 1024;
#pragma unroll
  for (int hh = 0; hh < 2; ++hh) { const u32x2* Lraw = (const u32x2*)(lds + PL_LIST + lb * PL_LBUF) + (tl + hh) * 128;
    const u32x2 p0 = Lraw[2 * lane], p1 = Lraw[2 * lane + 1];
    const int b0 = (int)(p0.x >> 10), b1 = (int)(p1.x >> 10);
    int base = 0, pos0 = 0, pos1 = 0;
#pragma unroll
    for (int v = 0; v < 16; ++v) {
      const unsigned long long m0 = __ballot(b0 == v), m1 = __ballot(b1 == v);
      const int c0 = __builtin_popcountll(m0), c1 = __builtin_popcountll(m1);
      const int r0 = __builtin_amdgcn_mbcnt_hi((unsigned)(m0 >> 32), __builtin_amdgcn_mbcnt_lo((unsigned)m0, 0u));
      const int r1 = __builtin_amdgcn_mbcnt_hi((unsigned)(m1 >> 32), __builtin_amdgcn_mbcnt_lo((unsigned)m1, 0u));
      if (b0 == v) pos0 = base + r0;
      if (b1 == v) pos1 = base + c0 + r1;
      base += c0 + c1; }
    SORT[2 * pos0 + hh] = p0; SORT[2 * pos1 + hh] = p1; }
  asm volatile("s_waitcnt lgkmcnt(0)" ::: "memory");
  { const bf16_t* xbr = (const bf16_t*)(ws + WS_X1B) + (size_t)t * DM + li * 4;
    u32x2 a[8];
#pragma unroll
    for (int c = 0; c < 8; ++c) a[c] = *(const u32x2*)(xbr + 128 * c);
#pragma unroll
    for (int c = 0; c < 8; ++c) { unsigned w = __builtin_amdgcn_cvt_pk_fp8_f32(__uint_as_float(a[c].x << 16) * 16.f, __uint_as_float(a[c].x & 0xffff0000u) * 16.f, 0, false);
      w = __builtin_amdgcn_cvt_pk_fp8_f32(__uint_as_float(a[c].y << 16) * 16.f, __uint_as_float(a[c].y & 0xffff0000u) * 16.f, w, true);
      *(unsigned*)(XQ + (hi ? 1024 : 0) + 128 * c + 4 * li) = w; } }
  asm volatile("s_waitcnt lgkmcnt(0)" ::: "memory");
  const u32x2* L = SORT;
  constexpr int NG = 16;
  const int mn = lane & 15, mq = lane >> 4;
  const unsigned char* xa = XQ + (mn & 1) * 1024 + 16 * mq;
  const int uo = mq * 16;
#define UG_LOAD(UB, EL, GL, SUv, SVv, g) do { const u32x2 eg_ = L[(g) * 16 + mn]; EL = (int)eg_.x; GL = __uint_as_float(eg_.y); SUv = SU[EL]; SVv = SV[EL]; \
    const int eb_ = EL * REC6 + uo; \
    _Pragma("unroll") for (int ks = 0; ks < 8; ++ks) UB[ks] = __builtin_amdgcn_raw_buffer_load_b128(rsT, eb_ + 64 * ks, 0, 0); } while (0)
#define UG_COMP(UB, GL, SUv, SVv, WL) do { f32x4 acc_ = {0.f, 0.f, 0.f, 0.f}; \
    _Pragma("unroll") for (int ks = 0; ks < 8; ++ks) { const u32x4 a0_ = *(const u32x4*)(xa + 128 * ks), a1_ = *(const u32x4*)(xa + 128 * ks + 64); \
      const i32x8 A_ = {(int)a0_.x, (int)a0_.y, (int)a0_.z, (int)a0_.w, (int)a1_.x, (int)a1_.y, (int)a1_.z, (int)a1_.w}; \
      const i32x8 B_ = {(int)UB[ks].x, (int)UB[ks].y, (int)UB[ks].z, (int)UB[ks].w, 0, 0, 0, 0}; \
      acc_ = __builtin_amdgcn_mfma_scale_f32_16x16x128_f8f6f4(A_, B_, acc_, 0, 4, 0, 0x7F7F7F7F, 0, 0x7F7F7F7F); } \
    const float h_ = ((lane & 1) ? acc_[1] : acc_[0]) * 0.0625f * SUv; WL = GL * gelu_erf(h_) * SVv; } while (0)
#define VH_LOAD(VP, VQ, g, s0) do { _Pragma("unroll") for (int pr = 0; pr < 2; ++pr) { const int eb_ = (int)L[(g) * 16 + 2 * ((s0) + pr) + (hi ? 1 : 0)].x * REC6; \
      VP[pr] = __builtin_amdgcn_raw_buffer_load_b128(rsT, eb_ + voP0, 0, 0); VQ[pr] = __builtin_amdgcn_raw_buffer_load_b64(rsT, eb_ + voQ0, 0, 0); } } while (0)
#define VH_COMP(VP, VQ, WL, s0) do { _Pragma("unroll") for (int pr = 0; pr < 2; ++pr) { \
      const float w0_ = readlane_f(WL, 2 * ((s0) + pr)), w1_ = readlane_f(WL, 2 * ((s0) + pr) + 1); const float w_ = hi ? w1_ : w0_; \
      u32x6 vv_ = {VP[pr].x, VP[pr].y, VP[pr].z, VP[pr].w, VQ[pr].x, VQ[pr].y}; asm volatile("" : "+v"(vv_));     \
      const f32x32 vf_ = __builtin_amdgcn_cvt_scalef32_pk32_f32_fp6(vv_, 1.0f); \
      _Pragma("unroll") for (int i = 0; i < 32; ++i) y[i] = __builtin_fmaf(w_, vf_[i], y[i]); \
      YPIN(); __builtin_amdgcn_sched_barrier(0); } } while (0)
#define YPIN() do { asm volatile("" : "+v"(y[0]), "+v"(y[1]), "+v"(y[2]), "+v"(y[3]), "+v"(y[4]), "+v"(y[5]), "+v"(y[6]), "+v"(y[7]), "+v"(y[8]), "+v"(y[9]), "+v"(y[10]), "+v"(y[11]), "+v"(y[12]), "+v"(y[13]), "+v"(y[14]), "+v"(y[15])); \
    asm volatile("" : "+v"(y[16]), "+v"(y[17]), "+v"(y[18]), "+v"(y[19]), "+v"(y[20]), "+v"(y[21]), "+v"(y[22]), "+v"(y[23]), "+v"(y[24]), "+v"(y[25]), "+v"(y[26]), "+v"(y[27]), "+v"(y[28]), "+v"(y[29]), "+v"(y[30]), "+v"(y[31])); } while (0)
  {
    u32x4 ub[8], vpa[2], vpb[2], vpc[2], vpd[2]; u32x2 vqa[2], vqb[2], vqc[2], vqd[2]; int el; float gl, su, sv, wl;
    UG_LOAD(ub, el, gl, su, sv, 0); VH_LOAD(vpa, vqa, 0, 0); VH_LOAD(vpb, vqb, 0, 2); VH_LOAD(vpc, vqc, 0, 4); VH_LOAD(vpd, vqd, 0, 6);
#define SB __builtin_amdgcn_sched_barrier(0)
    for (int g = 0; g < NG - 1; ++g) {
      SB; UG_COMP(ub, gl, su, sv, wl); SB;
      UG_LOAD(ub, el, gl, su, sv, g + 1); SB;
      VH_COMP(vpa, vqa, wl, 0); SB; VH_LOAD(vpa, vqa, g + 1, 0); SB;
      VH_COMP(vpb, vqb, wl, 2); SB; VH_LOAD(vpb, vqb, g + 1, 2); SB;
      VH_COMP(vpc, vqc, wl, 4); SB; VH_LOAD(vpc, vqc, g + 1, 4); SB;
      VH_COMP(vpd, vqd, wl, 6); SB; VH_LOAD(vpd, vqd, g + 1, 6); SB;
    }
    UG_COMP(ub, gl, su, sv, wl); SB;
    VH_COMP(vpa, vqa, wl, 0); SB; VH_COMP(vpb, vqb, wl, 2); SB; VH_COMP(vpc, vqc, wl, 4); SB; VH_COMP(vpd, vqd, wl, 6);
#undef SB
  }
#undef UG_LOAD
#undef UG_COMP
#undef VH_LOAD
#undef VH_COMP
#undef YPIN
  float s = 0.f;
  { const bf16_t* xbr = (const bf16_t*)(ws + WS_X1B) + (size_t)t * DM + li * 4;
#pragma unroll
    for (int c = 0; c < 8; ++c) { const u32x2 a = *(const u32x2*)(xbr + 128 * c);
      y[4 * c] += ALPHA * __uint_as_float(a.x << 16); y[4 * c + 1] += ALPHA * __uint_as_float(a.x & 0xffff0000u); y[4 * c + 2] += ALPHA * __uint_as_float(a.y << 16); y[4 * c + 3] += ALPHA * __uint_as_float(a.y & 0xffff0000u);
      s += (y[4 * c] + y[4 * c + 1]) + (y[4 * c + 2] + y[4 * c + 3]); } }
  const float mu = half_sum(s, hi) * (1.f / DM); float q = 0.f;
#pragma unroll
  for (int i = 0; i < 32; ++i) { y[i] -= mu; q += y[i] * y[i]; }
  const float rs = rsqrtf(half_sum(q, hi) * (1.f / DM) + LN_EPS);
  int ch0 = li * 4; asm volatile("" : "+v"(ch0));
  float* xr = x1io + (size_t)t * DM + ch0;
#pragma unroll
  for (int c = 0; c < 8; ++c) { const float4 gg = *(const float4*)(g2 + ch0 + 128 * c), bb = *(const float4*)(b2 + ch0 + 128 * c);
    float4 o; o.x = y[4 * c] * rs * gg.x + bb.x; o.y = y[4 * c + 1] * rs * gg.y + bb.y; o.z = y[4 * c + 2] * rs * gg.z + bb.z; o.w = y[4 * c + 3] * rs * gg.w + bb.w;
    *(float4*)(xr + 128 * c) = o; }
}
__device__ __forceinline__ void ph_peer(int bid, int nb, unsigned char* lds, unsigned char* ws, const float* __restrict__ subk, float* __restrict__ dout, const float* __restrict__ g2, const float* __restrict__ b2) {
  bf16_t* SK = (bf16_t*)(lds + PL_SK);
  for (int i = threadIdx.x; i < 2 * 128 * 32; i += 512) { const int row = i >> 5, c4 = i & 31; const float4 v = ((const float4*)subk)[i];
    u32x2 w; w.x = pk2(v.x, v.y); w.y = pk2(v.z, v.w); *(u32x2*)(SK + row * 136 + c4 * 4) = w; }
  __syncthreads();
  const int wave = threadIdx.x >> 6;
  const bf16_t* qp = (const bf16_t*)(ws + WS_QP);
  const bool both_first = (bid & 1) != 0;
  for (int tile = bid; tile < T / PEER_TB; tile += 2 * nb) {
    const int ta = tile * PEER_TB, tb = (tile + nb) * PEER_TB; const bool has_b = tile + nb < T / PEER_TB;
    peer_select_tile(ta, 0, lds, qp);
    if (both_first && has_b) peer_select_tile(tb, 1, lds, qp);
    __syncthreads();
    for (int i = 0; i < PEER_TB / 8; i += 2) { const int tl = wave * (PEER_TB / 8) + i; peer_expert_tok2(ta, tl, 0, lds, ws, dout, g2, b2); }
    if (has_b) {
      if (!both_first) { __syncthreads(); peer_select_tile(tb, 1, lds, qp); __syncthreads(); }
      for (int i = 0; i < PEER_TB / 8; i += 2) { const int tl = wave * (PEER_TB / 8) + i; peer_expert_tok2(tb, tl, 1, lds, ws, dout, g2, b2); }
    }
    __syncthreads();
  }
}

#define LAS __attribute__((address_space(3)))
#define XB_TMO      128
#define XB_XCNT(j)  (256  + 64 * (j))
#define XB_XSUB(j)  (1280 + 64 * (j))
#define XB_XGEN(j)  (2304 + 64 * (j))
#define XB_TOP      3328
#define XB_TOPGEN   3392
#define XCD_BAR_WORDS 3456
#define XB_SPIN_CAP (1u << 18)

__device__ __forceinline__ unsigned xb_ld(unsigned* p)              { return __hip_atomic_load(p, __ATOMIC_RELAXED, __HIP_MEMORY_SCOPE_AGENT); }
__device__ __forceinline__ unsigned xb_add(unsigned* p, unsigned v) { return __hip_atomic_fetch_add(p, v, __ATOMIC_RELAXED, __HIP_MEMORY_SCOPE_AGENT); }
__device__ __forceinline__ unsigned xb_xcc_id() { return (unsigned)__builtin_amdgcn_s_getreg((3 << 11) | 20) & 0xFu; }
#define XB_SPIN(cond, bar) do { unsigned _sp = 0; while (cond) { __builtin_amdgcn_s_sleep(1); \
    if ((++_sp & 255u) == 0u) { if (xb_ld(&(bar)[XB_TMO])) break; if (_sp > XB_SPIN_CAP) { atomicAdd(&(bar)[XB_TMO], 1u); break; } } } } while (0)

struct XcdBarrier {
    unsigned* bar; unsigned x;
    volatile LAS unsigned* st;
};

__device__ __forceinline__ XcdBarrier xcd_barrier_post(unsigned* bar, volatile LAS unsigned* st) {
    XcdBarrier b; b.bar = bar; b.x = xb_xcc_id(); b.st = st;
    if (threadIdx.x == 0) (void)xb_add(&bar[XB_XCNT(b.x)], 1u);
    return b;
}
__device__ __forceinline__ void xcd_barrier_complete(unsigned* bar, unsigned x, unsigned& nloc, unsigned& nx) {
    const unsigned G = gridDim.x * gridDim.y * gridDim.z;
    unsigned sum, cnt, mine, sp = 0u;
    for (;;) {
        sum = 0u; cnt = 0u; mine = 0u;
#pragma unroll
        for (unsigned j = 0; j < 16; ++j) { const unsigned c = xb_ld(&bar[XB_XCNT(j)]); sum += c; cnt += (c > 0u) ? 1u : 0u; mine = (j == x) ? c : mine; }
        if (sum == G) break;
        __builtin_amdgcn_s_sleep(1);
        if ((++sp & 255u) == 0u) { if (xb_ld(&bar[XB_TMO])) break; if (sp > XB_SPIN_CAP) { atomicAdd(&bar[XB_TMO], 1u); break; } }
    }
    nloc = mine > 0u ? mine : 1u; nx = cnt > 0u ? cnt : 1u;
}

__device__ __forceinline__ void xcd_barrier(const XcdBarrier& b) {
    asm volatile("s_waitcnt vmcnt(0)" ::: "memory");
    __syncthreads();
    if (threadIdx.x == 0) {
        unsigned* bar = b.bar;
        __builtin_amdgcn_s_waitcnt(0);
        unsigned nloc = b.st[0], nx = b.st[1];
        if (nloc == 0u) { xcd_barrier_complete(bar, b.x, nloc, nx); b.st[0] = nloc; b.st[1] = nx; }
        const unsigned old = xb_add(&bar[XB_XSUB(b.x)], 1u);
        const unsigned gen = old / nloc;
        if (old + 1u == (gen + 1u) * nloc) {
            __builtin_amdgcn_fence(__ATOMIC_RELEASE, "agent");
            asm volatile("s_waitcnt vmcnt(0)" ::: "memory");
            const unsigned og = xb_add(&bar[XB_TOP], 1u);
            const unsigned tg = og / nx;
            if (og + 1u == (tg + 1u) * nx) xb_add(&bar[XB_TOPGEN], 1u);
            else XB_SPIN(xb_ld(&bar[XB_TOPGEN]) == tg, bar);
            __builtin_amdgcn_fence(__ATOMIC_ACQUIRE, "agent");
            xb_add(&bar[XB_XGEN(b.x)], 1u);
            asm volatile("s_waitcnt vmcnt(0)" ::: "memory");
        } else {
            XB_SPIN(xb_ld(&bar[XB_XGEN(b.x)]) == gen, bar);
            __builtin_amdgcn_fence(__ATOMIC_ACQUIRE, "agent");
            asm volatile("s_waitcnt vmcnt(0)" ::: "memory");
        }
    }
    __syncthreads();
}

struct KP { const float* in[19]; float* out; unsigned char* ws; int ph_lo, ph_hi; };
constexpr int NPHASE = 10;
#ifndef MK_LAUNCHES
#define MK_LAUNCHES 1
#endif
__global__ __launch_bounds__(512) void mega(KP p) {
  extern __shared__ __attribute__((aligned(16))) unsigned char lds[];
  cg::grid_group grid = cg::this_grid();
  const int bid = blockIdx.x, nb = gridDim.x, lane = threadIdx.x & 63;
  unsigned char* ws = p.ws; unsigned char* dob = (unsigned char*)p.out; float* dout = p.out;
  const float* x = p.in[0]; const float* w_in = p.in[1];
  bf16_t* xb = (bf16_t*)(dob + DO_XB); bf16_t* WinT = (bf16_t*)(dob + DO_WINT); bf16_t* UT = (bf16_t*)dob;
  float* gpre = (float*)(ws + WS_GPRE); float2* cs = (float2*)(ws + WS_CS);
  EP e; e.x = x; e.ws = ws; e.dout = dout; e.cs = cs;
#ifdef ONLY_PH
#define IN(k) ((k) == ONLY_PH && p.ph_lo <= (k) && (k) < p.ph_hi)
#else
#define IN(k) (p.ph_lo <= (k) && (k) < p.ph_hi)
#endif
  volatile LAS unsigned* bst = (volatile LAS unsigned*)((LAS unsigned char*)lds + (LDS_BYTES - 64));
  if (threadIdx.x < 2) bst[threadIdx.x] = 0u;
  __syncthreads();
  const XcdBarrier xbar = xcd_barrier_post((unsigned*)ws, bst);
#define SEAM(k) do { if (IN(k) && IN((k) + 1)) xcd_barrier(xbar); } while (0)
  if (IN(0)) {
    ph_prep_x(bid, nb, lds, x, w_in, p.in[6], xb, gpre);
    ph_prep_weights(bid, nb, lds, w_in, p.in[8], p.in[9], p.in[10], p.in[13], WinT, ws);
    ph_rope_tab(bid, nb, cs);
  }
  SEAM(0);
  if (IN(1)) {
    if (bid >= nb - 16) gp_scan(bid - (nb - 16), gpre, ws, lds);
    ph_gemm8<EPI_G1>(lds, xb, WinT, 5632, 1024, e);
  }
  SEAM(1);
  if (IN(2)) { M1Pre pr; if (bid < 1024) m1_prefetch(bid, pr, ws, p.in[4], p.in[5]);
    for (int u = bid; u < 1024; u += nb) { if (u + nb < 1024) m1_unit<true>(u, u + nb, pr, lds, ws, UT, p.in[4], p.in[5]); else m1_unit<false>(u, u, pr, lds, ws, UT, p.in[4], p.in[5]); } }
  SEAM(2);
  if (IN(3)) m2_scan(bid, nb, ws, UT);
  SEAM(3);
  if (IN(4)) {
    const float lam = compute_lambda(p.in[2], lane);
    for (int u = bid; u < 256; u += nb) att::attn_unit(u & 7, u >> 3, ws, u, lam, p.in[3], (char*)lds);
    { M3Pre pr3; if (bid < 1024) m3_prefetch(bid, pr3, ws, UT);
      for (int u = bid; u < 1024; u += nb) { if (u + nb < 1024) m3_unit<true>(u, u + nb, pr3, lds, ws, UT, p.in[7]); else m3_unit<false>(u, u, pr3, lds, ws, UT, p.in[7]); } }
  }
  SEAM(4);
  if (IN(5)) {
    ph_gemm_merge(lds, ws);
  }
  SEAM(5);
  if (IN(6)) ph_gemm8<EPI_OUT>(lds, (const bf16_t*)(ws + WS_MG), (const bf16_t*)(ws + WS_WOUT), 1024, 1024, e);
  SEAM(6);
  if (IN(7)) {
    ph_ln1_tab8(bid, nb, dout, p.in[11], p.in[12], (bf16_t*)(ws + WS_X1B), p.in[15], p.in[16], ws);
  }
  SEAM(7);
  if (IN(8)) ph_gemm8<EPI_QP>(lds, (const bf16_t*)(ws + WS_X1B), (const bf16_t*)(ws + WS_WQ), 2048, 1024, e);
  SEAM(8);
  if (IN(9)) ph_peer(bid, nb, lds, ws, p.in[14], dout, p.in[17], p.in[18]);
  if (p.ph_hi - p.ph_lo == NPHASE) grid.sync();
#undef IN
#undef SEAM
}

extern "C" void kernel_launch(void* const* d_in, const int* in_sizes, int n_in, void* d_out, int out_size, void* d_ws, size_t ws_size, hipStream_t stream) {
  static int grid = 0;
  if (grid == 0) {
    int dev = 0, cus = 0, per_cu = 0;
    hipGetDevice(&dev); hipDeviceGetAttribute(&cus, hipDeviceAttributeMultiprocessorCount, dev);
    hipFuncSetAttribute((const void*)mega, hipFuncAttributeMaxDynamicSharedMemorySize, LDS_BYTES);
    hipOccupancyMaxActiveBlocksPerMultiprocessor(&per_cu, (const void*)mega, 512, LDS_BYTES);
    if (per_cu < 1) { fprintf(stderr, "kernel_launch: occupancy query says %d blocks per CU\n", per_cu); per_cu = 1; }
    grid = cus * 1;
  }
  hipMemsetAsync(d_ws, 0, 16384, stream);
  KP p{};
  for (int i = 0; i < 19; ++i) p.in[i] = (const float*)d_in[i];
  p.out = (float*)d_out; p.ws = (unsigned char*)d_ws;
  if (MK_LAUNCHES == 1) {
    p.ph_lo = 0; p.ph_hi = NPHASE;
    void* args[] = {&p};
    hipError_t er = hipLaunchCooperativeKernel((void*)mega, dim3(grid), dim3(512), args, LDS_BYTES, stream);
    if (er != hipSuccess) fprintf(stderr, "cooperative launch failed: %s (grid %d)\n", hipGetErrorString(er), grid);
  } else {
    for (int k = 0; k < NPHASE; ++k) { p.ph_lo = k; p.ph_hi = k + 1; hipLaunchKernelGGL(mega, dim3(grid), dim3(512), LDS_BYTES, stream, p); }
  }
}
```
